# Optimizing an MI355X kernel written in HIP

```python
import jax
import jax.numpy as jnp
from jax import lax
import numpy as np

D_MODEL = 1024
BATCH = 2
SEQ = 8192
DEPTH = 1

POOL_WINDOWS = (2, 4, 8, 16)
POOL_GROUPS = 4
POOL_GROUP_W = 128
POOL_W = POOL_GROUPS * POOL_GROUP_W
GLA_HEADS = 4
GLA_DK = 64
GLA_DV = 128
GLA_KEY = GLA_HEADS * GLA_DK
GLA_VAL = GLA_HEADS * GLA_DV
GATE_RANK = 16
GATE_NORMALIZER = 16.0
CHUNK = 64
MIX_W = POOL_W + GLA_VAL
IN_COLS = POOL_W + 2 * GLA_KEY + GLA_VAL + GATE_RANK + GLA_VAL
IN_SPLITS = (POOL_W,
             POOL_W + GLA_KEY,
             POOL_W + 2 * GLA_KEY,
             POOL_W + 2 * GLA_KEY + GLA_VAL,
             POOL_W + 2 * GLA_KEY + GLA_VAL + GATE_RANK)
MEM_LEN = 256
XATTN_HEADS = 4
XATTN_HD = D_MODEL // XATTN_HEADS
N_EXPERTS = 32
TOP_K = 4
D_FF = D_MODEL
SWIGLU_LIMIT = 7.0
SWIGLU_ALPHA = 1.702
MOE_BLOCK = 128
EPS = 1e-6

kernel_name = 'hybrid_pool_gla_xattn_moe_block'


def rms_norm(x, g):
    xf = x.astype(jnp.float32)
    y = xf * lax.rsqrt(jnp.mean(xf * xf, axis=-1, keepdims=True) + EPS)
    return (y * g.astype(jnp.float32)).astype(x.dtype)


def pool_mixer(u, w_pool, pool_scale):
    b, s, _ = u.shape
    uf = u.astype(jnp.float32).reshape(b, s, POOL_GROUPS, POOL_GROUP_W)
    cs = jnp.cumsum(uf, axis=1)
    pos = jnp.arange(s) + 1
    outs = []
    for gi, w in enumerate(POOL_WINDOWS):
        c = cs[:, :, gi]
        lag = jnp.pad(c, ((0, 0), (w, 0), (0, 0)))[:, :s]
        cnt = jnp.minimum(pos, w).astype(jnp.float32)[None, :, None]
        outs.append((c - lag) / cnt - uf[:, :, gi])
    p = jnp.stack(outs, axis=2).astype(u.dtype)
    y = jnp.einsum('bsgc,gcd->bsgd', p, w_pool).reshape(b, s, POOL_W)
    return y * pool_scale


def gla_mixer(q, k, v, g_lr, r, w_gate_up, b_gate_up, gla_norm_g):
    b, s, _ = q.shape
    n = s // CHUNK

    def chunked(a, d):
        return a.reshape(b, n, CHUNK, GLA_HEADS, d).transpose(0, 3, 1, 2, 4).astype(jnp.float32)

    g = jax.nn.log_sigmoid((g_lr @ w_gate_up + b_gate_up).astype(jnp.float32)) / GATE_NORMALIZER
    qc = chunked(q, GLA_DK) * (GLA_DK ** -0.5)
    kc = chunked(k, GLA_DK)
    vc = chunked(v, GLA_DV)
    gc = jnp.cumsum(chunked(g, GLA_DK), axis=3)
    qe = qc * jnp.exp(gc)
    ke = kc * jnp.exp(-gc)
    causal = jnp.tril(jnp.ones((CHUNK, CHUNK), dtype=bool))
    att = jnp.where(causal, jnp.einsum('bhnid,bhnjd->bhnij', qe, ke), 0.0)
    o = jnp.einsum('bhnij,bhnje->bhnie', att, vc)
    g_last = gc[:, :, :, -1]
    d_state = jnp.einsum('bhnjd,bhnje->bhnde',
                         kc * jnp.exp(g_last[:, :, :, None] - gc), vc)

    def step(state, inp):
        dec, ds = inp
        return dec[..., None] * state + ds, state

    init = jnp.zeros((b, GLA_HEADS, GLA_DK, GLA_DV), jnp.float32)
    _, s_prev = lax.scan(step, init,
                         (jnp.exp(g_last).transpose(2, 0, 1, 3),
                          d_state.transpose(2, 0, 1, 3, 4)))
    s_prev = s_prev.transpose(1, 2, 0, 3, 4)
    o = o + jnp.einsum('bhnid,bhnde->bhnie', qe, s_prev)
    o = o.transpose(0, 2, 3, 1, 4).reshape(b, s, GLA_HEADS, GLA_DV)
    o = o * lax.rsqrt(jnp.mean(o * o, axis=-1, keepdims=True) + EPS) * gla_norm_g.astype(jnp.float32)
    rf = jax.nn.silu(r.astype(jnp.float32)).reshape(b, s, GLA_HEADS, GLA_DV)
    return (o * rf).reshape(b, s, GLA_VAL).astype(q.dtype)


def memory_xattn(h, hm, w_xq, w_xk, w_xv, w_xo):
    b, s, _ = h.shape
    m = hm.shape[1]
    q = (h @ w_xq).reshape(b, s, XATTN_HEADS, XATTN_HD)
    k = (hm @ w_xk).reshape(b, m, XATTN_HEADS, XATTN_HD)
    v = (hm @ w_xv).reshape(b, m, XATTN_HEADS, XATTN_HD)
    sc = jnp.einsum('bshd,bmhd->bhsm', q, k).astype(jnp.float32) * (XATTN_HD ** -0.5)
    p = jax.nn.softmax(sc, axis=-1).astype(v.dtype)
    o = jnp.einsum('bhsm,bmhd->bshd', p, v).reshape(b, s, D_MODEL)
    return o @ w_xo


def clamped_swiglu(gu):
    gate = jnp.minimum(gu[..., :D_FF], SWIGLU_LIMIT)
    up = jnp.clip(gu[..., D_FF:], -SWIGLU_LIMIT, SWIGLU_LIMIT)
    return gate * jax.nn.sigmoid(SWIGLU_ALPHA * gate) * (up + 1.0)


def moe(h, w_router, b_router, w_gu, b_gu, w_dn, b_dn):
    b, s, d = h.shape
    n_tok = b * s
    t = h.reshape(n_tok, d)
    logits = (t @ w_router + b_router).astype(jnp.float32)
    top_val, top_idx = lax.top_k(logits, TOP_K)
    gates = jax.nn.softmax(top_val, axis=-1)
    n_assign = n_tok * TOP_K
    e_flat = top_idx.reshape(n_assign)
    tok_flat = jnp.repeat(jnp.arange(n_tok, dtype=jnp.int32), TOP_K)
    g_flat = gates.reshape(n_assign)
    order = jnp.argsort(e_flat)
    e_s = e_flat[order]
    tok_s = tok_flat[order]
    g_s = g_flat[order]
    counts = jnp.bincount(e_flat, length=N_EXPERTS)
    starts = jnp.cumsum(counts) - counts
    pcounts = (counts + MOE_BLOCK - 1) // MOE_BLOCK * MOE_BLOCK
    pends = jnp.cumsum(pcounts)
    pstarts = pends - pcounts
    dest = pstarts[e_s] + jnp.arange(n_assign) - starts[e_s]
    n_blocks = -(-n_assign // MOE_BLOCK) + N_EXPERTS
    n_rows = n_blocks * MOE_BLOCK
    tok_pad = jnp.zeros((n_rows,), jnp.int32).at[dest].set(tok_s)
    g_pad = jnp.zeros((n_rows,), jnp.float32).at[dest].set(g_s)
    blk_e = jnp.minimum(jnp.searchsorted(pends, jnp.arange(n_blocks) * MOE_BLOCK, side='right'),
                        N_EXPERTS - 1)

    def expert_block(args):
        tok_b, g_b, e = args
        xb = t[tok_b]
        a = clamped_swiglu((xb @ w_gu[e] + b_gu[e]).astype(jnp.float32)).astype(t.dtype)
        yb = a @ w_dn[e] + b_dn[e]
        return (yb.astype(jnp.float32) * g_b[:, None]).astype(t.dtype)

    y = lax.map(expert_block, (tok_pad.reshape(n_blocks, MOE_BLOCK),
                               g_pad.reshape(n_blocks, MOE_BLOCK), blk_e))
    out = jnp.zeros((n_tok, d), jnp.float32).at[tok_pad].add(
        y.reshape(n_rows, d).astype(jnp.float32))
    return out.reshape(b, s, d).astype(h.dtype)


def setup_inputs(seed: int = 0) -> dict:
    key = jax.random.key(seed)
    ks = jax.random.split(key, 24)
    L = DEPTH

    def nrm(k, shape, scale):
        return jax.random.normal(k, shape, jnp.float32) * scale

    return {
        'x': nrm(ks[0], (BATCH, SEQ, D_MODEL), 1.0),
        'mem': nrm(ks[1], (BATCH, MEM_LEN, D_MODEL), 1.0),
        'norm_mix_g': 1.0 + nrm(ks[2], (L, D_MODEL), 0.05),
        'w_in': nrm(ks[3], (L, D_MODEL, IN_COLS), D_MODEL ** -0.5),
        'w_pool': nrm(ks[4], (L, POOL_GROUPS, POOL_GROUP_W, POOL_GROUP_W), POOL_GROUP_W ** -0.5),
        'pool_scale': 1.0 + nrm(ks[5], (L, POOL_W), 0.1),
        'w_gate_up': nrm(ks[6], (L, GATE_RANK, GLA_KEY), GATE_RANK ** -0.5),
        'b_gate_up': nrm(ks[7], (L, GLA_KEY), 0.1),
        'gla_norm_g': 1.0 + nrm(ks[8], (L, GLA_DV), 0.05),
        'w_out': nrm(ks[9], (L, MIX_W, D_MODEL), MIX_W ** -0.5),
        'norm_xattn_g': 1.0 + nrm(ks[10], (L, D_MODEL), 0.05),
        'norm_mem_g': 1.0 + nrm(ks[11], (L, D_MODEL), 0.05),
        'w_xq': nrm(ks[12], (L, D_MODEL, D_MODEL), D_MODEL ** -0.5),
        'w_xk': nrm(ks[13], (L, D_MODEL, D_MODEL), D_MODEL ** -0.5),
        'w_xv': nrm(ks[14], (L, D_MODEL, D_MODEL), D_MODEL ** -0.5),
        'w_xo': nrm(ks[15], (L, D_MODEL, D_MODEL), D_MODEL ** -0.5),
        'norm_moe_g': 1.0 + nrm(ks[16], (L, D_MODEL), 0.05),
        'w_router': nrm(ks[17], (L, D_MODEL, N_EXPERTS), D_MODEL ** -0.5),
        'b_router': nrm(ks[18], (L, N_EXPERTS), 0.01),
        'w_gu': nrm(ks[19], (L, N_EXPERTS, D_MODEL, 2 * D_FF), D_MODEL ** -0.5),
        'b_gu': nrm(ks[20], (L, N_EXPERTS, 2 * D_FF), 0.01),
        'w_dn': nrm(ks[21], (L, N_EXPERTS, D_FF, D_MODEL), D_FF ** -0.5),
        'b_dn': nrm(ks[22], (L, N_EXPERTS, D_MODEL), 0.01),
        'norm_final_g': 1.0 + nrm(ks[23], (D_MODEL,), 0.05),
    }


def reference(x, mem, norm_mix_g, w_in, w_pool, pool_scale, w_gate_up, b_gate_up,
              gla_norm_g, w_out, norm_xattn_g, norm_mem_g, w_xq, w_xk, w_xv, w_xo,
              norm_moe_g, w_router, b_router, w_gu, b_gu, w_dn, b_dn, norm_final_g):
    for l in range(DEPTH):
        h = rms_norm(x, norm_mix_g[l])
        z = h @ w_in[l]
        u, q, k, v, g_lr, r = jnp.split(z, IN_SPLITS, axis=-1)
        mix = jnp.concatenate(
            [pool_mixer(u, w_pool[l], pool_scale[l]),
             gla_mixer(q, k, v, g_lr, r, w_gate_up[l], b_gate_up[l], gla_norm_g[l])],
            axis=-1)
        x = x + mix @ w_out[l]
        x = x + memory_xattn(rms_norm(x, norm_xattn_g[l]), rms_norm(mem, norm_mem_g[l]),
                             w_xq[l], w_xk[l], w_xv[l], w_xo[l])
        x = x + moe(rms_norm(x, norm_moe_g[l]), w_router[l], b_router[l],
                    w_gu[l], b_gu[l], w_dn[l], b_dn[l])
    return rms_norm(x, norm_final_g)
```

```cpp
#include <hip/hip_runtime.h>
#include <cstdio>
#include <cstdint>

#define LAS __attribute__((address_space(3)))
typedef unsigned short bf16;
typedef float f32x4 __attribute__((ext_vector_type(4)));
typedef unsigned u32x4 __attribute__((ext_vector_type(4)));
typedef unsigned u32x2 __attribute__((ext_vector_type(2)));

constexpr int BATCH = 2, SEQ = 8192, M = BATCH * SEQ, D = 1024;
constexpr int IN_COLS = 2064, NZ = 2304;
constexpr int ZQ = 512, ZK = 768, ZV = 1024, ZR = 1536, ZG = 2048;
constexpr int NE = 32, TOPK = 4, DFF = 1024, MEMLEN = 256;
constexpr int NASSIGN = M * TOPK, MAXSLOT = NASSIGN + NE * 256, MAXMT = MAXSLOT / 256;
constexpr int NCHUNK = SEQ / 64;
constexpr float EPS = 1e-6f;
constexpr int NTHREADS = 512, NWAVES = 8;

constexpr size_t MiB = 1u << 20;
constexpr size_t WS_CTL = 0, CTL_BYTES = 1 * MiB;
constexpr size_t WS_WT_OUT = 2 * MiB, WS_WT_XQ = 4 * MiB, WS_WT_XK = 6 * MiB, WS_WT_XV = 8 * MiB, WS_WT_XO = 10 * MiB, WS_WT_IN = 12 * MiB;
constexpr size_t WS_SMALL = 17 * MiB;
constexpr size_t WS_RS2 = WS_SMALL, WS_TOPI = WS_SMALL + 64 * 1024, WS_TOPG = WS_TOPI + 256 * 1024, WS_SLOTOF = WS_TOPG + 256 * 1024,
                 WS_GSLOT = WS_SLOTOF + 256 * 1024, WS_TILEE = WS_GSLOT + 320 * 1024;
constexpr size_t WS_WT_GU = 20 * MiB, WS_WT_DN = 148 * MiB, WS_X2 = 212 * MiB, WS_B = 276 * MiB;
constexpr size_t WS_XN = WS_B, WS_HM = WS_B + 32 * MiB, WS_Z1 = WS_B + 33 * MiB, WS_MIX = WS_B + 121 * MiB, WS_SPREV = WS_B + 153 * MiB,
                 WS_DS = WS_B + 185 * MiB, WS_DEC = WS_B + 217 * MiB, WS_X1 = WS_B + 218 * MiB, WS_A2 = WS_B + 282 * MiB, WS_KX = WS_B + 314 * MiB, WS_VXT = WS_B + 315 * MiB;
constexpr size_t WS_QX = WS_Z1, WS_PX = WS_Z1 + 32 * MiB, WS_SC = WS_MIX, WS_OX = WS_DS;
constexpr size_t WS_XS = WS_B, WS_H = WS_B + 144 * MiB, WS_Y = WS_B + 288 * MiB, WS_END = WS_B + 432 * MiB;
constexpr int CW_COUNT = 8192, CW_CURSOR = 8256, CW_ROWSQ1 = 16384;

__device__ __forceinline__ float bf_lo(unsigned w) { return __uint_as_float(w << 16); }
__device__ __forceinline__ float bf_hi(unsigned w) { return __uint_as_float(w & 0xffff0000u); }
__device__ __forceinline__ float bf2f(bf16 v) { return __uint_as_float((unsigned)v << 16); }
__device__ __forceinline__ unsigned f2bf(float f) { unsigned u = __float_as_uint(f); return (u + 0x7fffu + ((u >> 16) & 1u)) >> 16; }
__device__ __forceinline__ unsigned pk2(float lo, float hi) { return f2bf(lo) | (f2bf(hi) << 16); }
__device__ __forceinline__ float wave_sum(float v) {
#pragma unroll
    for (int o = 1; o < 64; o <<= 1) v += __shfl_xor(v, o);
    return v;
}
__device__ __forceinline__ float logsigmoid(float x) { return fminf(x, 0.f) - log1pf(expf(-fabsf(x))); }

struct P {
    const float *x, *mem, *g_mix, *w_in, *w_pool, *pool_scale, *w_gate_up, *b_gate_up, *gla_g, *w_out, *g_xattn, *g_mem, *w_xq, *w_xk, *w_xv, *w_xo,
                *g_moe, *w_router, *b_router, *w_gu, *b_gu, *w_dn, *b_dn, *g_final;
    float* out;
    unsigned* ctl;
    bf16 *wt_in, *wt_out, *wt_xq, *wt_xk, *wt_xv, *wt_xo, *wt_gu, *wt_dn;
    bf16 *xn, *hm, *z1, *mix, *a2, *kx, *vxt, *qx, *px, *ox, *xs, *h, *y;
    float *sprev, *ds, *dec, *x1, *x2, *sc, *rs2, *topg, *gslot;
    int *topi, *slotof, *tilee;
};

struct MapId { __device__ __forceinline__ int operator()(int n) const { return n; } };
struct MapIn { __device__ __forceinline__ int operator()(int n) const { return n < 1536 ? n : (n < 2048 ? 1552 + (n - 1536) : (n < 2064 ? 1536 + (n - 2048) : -1)); } };
struct MapGu { __device__ __forceinline__ int operator()(int n) const { const int pn = n >> 8, w = n & 255; return w < 128 ? pn * 128 + w : 1024 + pn * 128 + (w - 128); } };

template <class Map>
__device__ __forceinline__ void transpose_item(const float* W, int ldw, int K, bf16* WT, float* scr, int kb, int nb, int lane, Map map) {
    const int k0 = 64 * kb, n0 = 32 * nb;
    const int sc = map(n0 + (lane & 31));
#pragma unroll 8
    for (int i = 0; i < 32; ++i) { const int kk = 2 * i + (lane >> 5); scr[kk * 33 + (lane & 31)] = sc >= 0 ? W[(size_t)(k0 + kk) * ldw + sc] : 0.f; }
    __builtin_amdgcn_s_waitcnt(0xC07F); asm volatile("" ::: "memory");
    const int c = lane & 7;
#pragma unroll
    for (int j = 0; j < 4; ++j) { const int n = (lane >> 3) + 8 * j; const float* s = scr + (8 * c) * 33 + n;
        u32x4 o; o.x = pk2(s[0 * 33], s[1 * 33]); o.y = pk2(s[2 * 33], s[3 * 33]); o.z = pk2(s[4 * 33], s[5 * 33]); o.w = pk2(s[6 * 33], s[7 * 33]);
        *(u32x4*)(WT + (size_t)(n0 + n) * K + k0 + 8 * c) = o; }
    __builtin_amdgcn_s_waitcnt(0xC07F); asm volatile("" ::: "memory");
}
__device__ __forceinline__ void rms_row_bf16(const float* xrow, const float* g, bf16* orow, int lane) {
    const f32x4* xr = (const f32x4*)xrow + lane; f32x4 v[4]; float s = 0.f;
#pragma unroll
    for (int j = 0; j < 4; ++j) { v[j] = xr[64 * j]; s += (v[j].x * v[j].x + v[j].y * v[j].y) + (v[j].z * v[j].z + v[j].w * v[j].w); }
    const float rs = 1.0f / sqrtf(wave_sum(s) * (1.f / D) + EPS);
    u32x2* o8 = (u32x2*)orow + lane; const f32x4* gr = (const f32x4*)g + lane;
#pragma unroll
    for (int j = 0; j < 4; ++j) { const f32x4 gg = gr[64 * j]; u32x2 w; w.x = pk2(v[j].x * rs * gg.x, v[j].y * rs * gg.y); w.y = pk2(v[j].z * rs * gg.z, v[j].w * rs * gg.w); o8[64 * j] = w; }
}
__device__ __forceinline__ void phase_prologue(const P& p, float* ldsf, int bid, int nb) {
    const int tid = threadIdx.x, lane = tid & 63, wave = tid >> 6;
    float* scr = ldsf + wave * (64 * 33 + 32);
    const int gw = bid * NWAVES + wave, NGW = nb * NWAVES;
    constexpr int I_IN = 16 * (NZ / 32), I_SQ = 16 * 32, I_GU = 16 * 64, I_DN = 16 * 32;
    constexpr int NITEMS = I_IN + 5 * I_SQ + NE * I_GU + NE * I_DN;
    for (int it = gw; it < NITEMS; it += NGW) {
        int r = it;
        if (r < I_IN) { transpose_item(p.w_in, IN_COLS, D, p.wt_in, scr, r / (NZ / 32), r % (NZ / 32), lane, MapIn()); continue; } r -= I_IN;
        if (r < 5 * I_SQ) { const int w = r / I_SQ, q = r % I_SQ; const float* src = w == 0 ? p.w_out : w == 1 ? p.w_xq : w == 2 ? p.w_xk : w == 3 ? p.w_xv : p.w_xo;
            bf16* dst = w == 0 ? p.wt_out : w == 1 ? p.wt_xq : w == 2 ? p.wt_xk : w == 3 ? p.wt_xv : p.wt_xo;
            transpose_item(src, D, D, dst, scr, q / 32, q % 32, lane, MapId()); continue; } r -= 5 * I_SQ;
        if (r < NE * I_GU) { const int e = r / I_GU, q = r % I_GU; transpose_item(p.w_gu + (size_t)e * D * 2 * DFF, 2 * DFF, D, p.wt_gu + (size_t)e * 2 * DFF * D, scr, q / 64, q % 64, lane, MapGu()); continue; } r -= NE * I_GU;
        { const int e = r / I_DN, q = r % I_DN; transpose_item(p.w_dn + (size_t)e * DFF * D, D, DFF, p.wt_dn + (size_t)e * D * DFF, scr, q / 32, q % 32, lane, MapId()); }
    }
    for (int m = gw; m < M; m += NGW) rms_row_bf16(p.x + (size_t)m * D, p.g_mix, p.xn + (size_t)m * D, lane);
    for (int m = gw; m < BATCH * MEMLEN; m += NGW) rms_row_bf16(p.mem + (size_t)m * D, p.g_mem, p.hm + (size_t)m * D, lane);
}

struct NG { const bf16* A; int lda; const bf16* Bt; int ldb; int Mr, N, K; const int* tile_e; size_t sBe; };
template <class Epi>
__device__ __forceinline__ void ngemm(const NG g, const Epi& E, float* lds, int bid, int nb) {
    float* As = lds; float* Bs = lds + 32 * 128;
    const int tid = threadIdx.x, tr = tid >> 4, tc = tid & 15;
    const int nMt = g.Mr / 128, nNt = g.N / 256;
    for (int u = bid; u < nMt * nNt; u += nb) {
        const int mt = u / nNt, nt = u % nNt, row0 = mt * 128, col0 = nt * 256;
        int e = 0; const bf16* Bt = g.Bt;
        if (g.tile_e) { e = g.tile_e[row0 >> 8]; Bt += (size_t)e * g.sBe; }
        float acc[4][16];
#pragma unroll
        for (int i = 0; i < 4; ++i)
#pragma unroll
            for (int j = 0; j < 16; ++j) acc[i][j] = 0.f;
        for (int k0 = 0; k0 < g.K; k0 += 32) {
            __syncthreads();
            { const int r = tid >> 2, kk = (tid & 3) * 8;
              const u32x4 v = *(const u32x4*)(g.A + (size_t)(row0 + r) * g.lda + k0 + kk);
              As[(kk + 0) * 128 + r] = bf_lo(v.x); As[(kk + 1) * 128 + r] = bf_hi(v.x); As[(kk + 2) * 128 + r] = bf_lo(v.y); As[(kk + 3) * 128 + r] = bf_hi(v.y);
              As[(kk + 4) * 128 + r] = bf_lo(v.z); As[(kk + 5) * 128 + r] = bf_hi(v.z); As[(kk + 6) * 128 + r] = bf_lo(v.w); As[(kk + 7) * 128 + r] = bf_hi(v.w);
#pragma unroll
              for (int h = 0; h < 2; ++h) { const int rb = r + 128 * h;
                const u32x4 w = *(const u32x4*)(Bt + (size_t)(col0 + rb) * g.ldb + k0 + kk);
                Bs[(kk + 0) * 256 + rb] = bf_lo(w.x); Bs[(kk + 1) * 256 + rb] = bf_hi(w.x); Bs[(kk + 2) * 256 + rb] = bf_lo(w.y); Bs[(kk + 3) * 256 + rb] = bf_hi(w.y);
                Bs[(kk + 4) * 256 + rb] = bf_lo(w.z); Bs[(kk + 5) * 256 + rb] = bf_hi(w.z); Bs[(kk + 6) * 256 + rb] = bf_lo(w.w); Bs[(kk + 7) * 256 + rb] = bf_hi(w.w); } }
            __syncthreads();
#pragma unroll 4
            for (int k = 0; k < 32; ++k) {
                const f32x4 a = *(const f32x4*)&As[k * 128 + 4 * tr];
                const f32x4 b0 = *(const f32x4*)&Bs[k * 256 + tc * 8], b1 = *(const f32x4*)&Bs[k * 256 + tc * 8 + 4];
                const f32x4 b2 = *(const f32x4*)&Bs[k * 256 + 128 + tc * 8], b3 = *(const f32x4*)&Bs[k * 256 + 128 + tc * 8 + 4];
#pragma unroll
                for (int i = 0; i < 4; ++i) {
#pragma unroll
                    for (int j = 0; j < 4; ++j) { acc[i][j] += a[i] * b0[j]; acc[i][4 + j] += a[i] * b1[j]; acc[i][8 + j] += a[i] * b2[j]; acc[i][12 + j] += a[i] * b3[j]; }
                }
            }
        }
#pragma unroll
        for (int i = 0; i < 4; ++i)
#pragma unroll
            for (int j = 0; j < 8; ++j) E(e, row0 + 4 * tr + i, col0 + tc * 8 + j, acc[i][j], acc[i][8 + j]);
    }
}
struct EpiBf { bf16* C; int ldc; __device__ __forceinline__ void operator()(int, int r, int c, float a, float b) const { C[(size_t)r * ldc + c] = (bf16)f2bf(a); C[(size_t)r * ldc + c + 128] = (bf16)f2bf(b); } };
struct EpiF32 { float* C; int ldc; __device__ __forceinline__ void operator()(int, int r, int c, float a, float b) const { C[(size_t)r * ldc + c] = a; C[(size_t)r * ldc + c + 128] = b; } };
struct EpiOut { const float* x; float* x1; bf16* a2; const float* g; float* rowsq;
    __device__ __forceinline__ void one(int r, int c, float a) const { const size_t o = (size_t)r * D + c; const float v = x[o] + a; x1[o] = v; a2[o] = (bf16)f2bf(v * g[c]); atomicAdd(rowsq + r, v * v); }
    __device__ __forceinline__ void operator()(int, int r, int c, float a, float b) const { one(r, c, a); one(r, c + 128, b); } };
struct EpiQ { bf16* q; const float* rowsq;
    __device__ __forceinline__ void operator()(int, int r, int c, float a, float b) const { const float s = 0.0625f / sqrtf(rowsq[r] * (1.f / D) + EPS); q[(size_t)r * D + c] = (bf16)f2bf(a * s); q[(size_t)r * D + c + 128] = (bf16)f2bf(b * s); } };
struct EpiRes { const float* base; float* o; __device__ __forceinline__ void operator()(int, int r, int c, float a, float b) const { const size_t i = (size_t)r * D + c; o[i] = base[i] + a; o[i + 128] = base[i + 128] + b; } };
__device__ __forceinline__ float swiglu(float g, float u) { g = fminf(g, 7.f); u = fminf(fmaxf(u, -7.f), 7.f); return g * (1.f / (1.f + expf(-1.702f * g))) * (u + 1.f); }
struct EpiUp { bf16* h; const float* b_gu;
    __device__ __forceinline__ void operator()(int e, int r, int c, float a, float b) const { const int ff = (c >> 8) * 128 + (c & 127); const float* bb = b_gu + (size_t)e * 2 * DFF;
        h[(size_t)r * DFF + ff] = (bf16)f2bf(swiglu(a + bb[ff], b + bb[DFF + ff])); } };
struct EpiDn { bf16* y; const float* b_dn; const float* gs;
    __device__ __forceinline__ void operator()(int e, int r, int c, float a, float b) const { const float g = gs[r]; const float* bb = b_dn + (size_t)e * D;
        y[(size_t)r * D + c] = (bf16)f2bf(g * (a + bb[c])); y[(size_t)r * D + c + 128] = (bf16)f2bf(g * (b + bb[c + 128])); } };

__device__ __forceinline__ void phase_pool(const P& p, float* lds, int bid, int nb) {
    float* pt = lds;
    float* wp = lds + 64 * 129;
    const int tid = threadIdx.x;
    for (int u = bid; u < (M / 64) * 4; u += nb) {
        const int g = u & 3, tt = u >> 2, t0 = tt * 64, w = 2 << g;
        __syncthreads();
        for (int i = tid; i < 128 * 128; i += NTHREADS) wp[i] = p.w_pool[(size_t)g * 128 * 128 + i];
        { const int i = tid >> 3, c0 = (tid & 7) * 16, t = t0 + i, s = t & (SEQ - 1);
          const int cnt = (s + 1 < w) ? s + 1 : w;
          float acc[16];
#pragma unroll
          for (int c = 0; c < 16; ++c) acc[c] = 0.f;
          for (int d = 0; d < cnt; ++d) { const bf16* up = p.z1 + (size_t)(t - d) * NZ + g * 128 + c0;
#pragma unroll
              for (int c = 0; c < 16; ++c) acc[c] += bf2f(up[c]); }
          const bf16* u0 = p.z1 + (size_t)t * NZ + g * 128 + c0; const float inv = 1.f / (float)cnt;
#pragma unroll
          for (int c = 0; c < 16; ++c) pt[i * 129 + c0 + c] = acc[c] * inv - bf2f(u0[c]); }
        __syncthreads();
        { const int i = tid >> 3, d0 = (tid & 7) * 16; float acc[16];
#pragma unroll
          for (int c = 0; c < 16; ++c) acc[c] = 0.f;
          for (int c = 0; c < 128; ++c) { const float pv = pt[i * 129 + c];
#pragma unroll
              for (int d = 0; d < 16; ++d) acc[d] += pv * wp[c * 128 + d0 + d]; }
          bf16* o = p.mix + (size_t)(t0 + i) * D + g * 128 + d0;
#pragma unroll
          for (int d = 0; d < 16; ++d) o[d] = (bf16)f2bf(acc[d] * p.pool_scale[g * 128 + d0 + d]); }
    }
}

__device__ __forceinline__ void gla_gc(const P& p, float* glr, float* wgu, float* gc, int b, int h, int n) {
    const int tid = threadIdx.x, t0 = b * SEQ + n * 64;
    __syncthreads();
    for (int i = tid; i < 64 * 16; i += NTHREADS) glr[i] = bf2f(p.z1[(size_t)(t0 + (i >> 4)) * NZ + ZG + (i & 15)]);
    for (int i = tid; i < 16 * 64; i += NTHREADS) wgu[i] = p.w_gate_up[(i >> 6) * 256 + h * 64 + (i & 63)];
    __syncthreads();
    for (int idx = tid; idx < 64 * 64; idx += NTHREADS) { const int i = idx >> 6, d = idx & 63; float s = p.b_gate_up[h * 64 + d];
#pragma unroll
        for (int r = 0; r < 16; ++r) s += glr[i * 16 + r] * wgu[r * 64 + d];
        gc[i * 65 + d] = logsigmoid(s) * (1.f / 16.f); }
    __syncthreads();
    if (tid < 64) { float run = 0.f; for (int i = 0; i < 64; ++i) { run += gc[i * 65 + tid]; gc[i * 65 + tid] = run; } }
    __syncthreads();
}
__device__ __forceinline__ void phase_gla_a(const P& p, float* lds, int bid, int nb) {
    float* glr = lds; float* wgu = lds + 1024; float* gc = lds + 2048; float* kd = gc + 64 * 65; float* vv = kd + 64 * 65;
    const int tid = threadIdx.x;
    for (int u = bid; u < 8 * NCHUNK; u += nb) {
        const int bh = u / NCHUNK, n = u % NCHUNK, b = bh >> 2, h = bh & 3, t0 = b * SEQ + n * 64;
        gla_gc(p, glr, wgu, gc, b, h, n);
        for (int idx = tid; idx < 64 * 64; idx += NTHREADS) { const int j = idx >> 6, d = idx & 63;
            kd[j * 65 + d] = bf2f(p.z1[(size_t)(t0 + j) * NZ + ZK + h * 64 + d]) * expf(gc[63 * 65 + d] - gc[j * 65 + d]); }
        for (int idx = tid; idx < 64 * 128; idx += NTHREADS) { const int j = idx >> 7, e = idx & 127; vv[idx] = bf2f(p.z1[(size_t)(t0 + j) * NZ + ZV + h * 128 + e]); }
        __syncthreads();
        { const int d = tid >> 3, e0 = (tid & 7) * 16; float acc[16];
#pragma unroll
          for (int e = 0; e < 16; ++e) acc[e] = 0.f;
          for (int j = 0; j < 64; ++j) { const float kv = kd[j * 65 + d];
#pragma unroll
              for (int e = 0; e < 16; ++e) acc[e] += kv * vv[j * 128 + e0 + e]; }
          float* o = p.ds + ((size_t)u * 64 + d) * 128 + e0;
#pragma unroll
          for (int e = 0; e < 16; ++e) o[e] = acc[e]; }
        if (tid < 64) p.dec[(size_t)u * 64 + tid] = expf(gc[63 * 65 + tid]);
    }
}
__device__ __forceinline__ void phase_scan(const P& p, int bid, int nb) {
    for (int idx = bid * NTHREADS + threadIdx.x; idx < 8 * 64 * 128; idx += nb * NTHREADS) {
        const int bh = idx >> 13, de = idx & 8191, d = de >> 7;
        float st = 0.f;
        for (int n = 0; n < NCHUNK; ++n) { const size_t u = (size_t)bh * NCHUNK + n;
            p.sprev[u * 8192 + de] = st; st = p.dec[u * 64 + d] * st + p.ds[u * 8192 + de]; }
    }
}
__device__ __forceinline__ void phase_gla_b(const P& p, float* lds, int bid, int nb) {
    float* glr = lds; float* wgu = lds + 1024; float* gc = lds + 2048; float* qe = gc + 64 * 65; float* ke = qe + 64 * 65; float* vv = ke + 64 * 65; float* sp = vv + 64 * 128;
    float* att = gc;
    const int tid = threadIdx.x;
    for (int u = bid; u < 8 * NCHUNK; u += nb) {
        const int bh = u / NCHUNK, n = u % NCHUNK, b = bh >> 2, h = bh & 3, t0 = b * SEQ + n * 64;
        gla_gc(p, glr, wgu, gc, b, h, n);
        for (int idx = tid; idx < 64 * 64; idx += NTHREADS) { const int i = idx >> 6, d = idx & 63; const float g = gc[i * 65 + d];
            qe[i * 65 + d] = bf2f(p.z1[(size_t)(t0 + i) * NZ + ZQ + h * 64 + d]) * 0.125f * expf(g);
            ke[i * 65 + d] = bf2f(p.z1[(size_t)(t0 + i) * NZ + ZK + h * 64 + d]) * expf(-g); }
        for (int idx = tid; idx < 64 * 128; idx += NTHREADS) { const int j = idx >> 7, e = idx & 127; vv[idx] = bf2f(p.z1[(size_t)(t0 + j) * NZ + ZV + h * 128 + e]); sp[idx] = p.sprev[(size_t)u * 8192 + idx]; }
        __syncthreads();
        { const int i = tid >> 3, j0 = (tid & 7) * 8; float a[8];
#pragma unroll
          for (int j = 0; j < 8; ++j) a[j] = 0.f;
          for (int d = 0; d < 64; ++d) { const float qv = qe[i * 65 + d];
#pragma unroll
              for (int j = 0; j < 8; ++j) a[j] += qv * ke[(j0 + j) * 65 + d]; }
#pragma unroll
          for (int j = 0; j < 8; ++j) att[i * 65 + j0 + j] = (j0 + j <= i) ? a[j] : 0.f; }
        __syncthreads();
        { const int i = tid >> 3, e0 = (tid & 7) * 16; float o[16];
#pragma unroll
          for (int e = 0; e < 16; ++e) o[e] = 0.f;
          for (int j = 0; j < 64; ++j) { const float av = att[i * 65 + j];
#pragma unroll
              for (int e = 0; e < 16; ++e) o[e] += av * vv[j * 128 + e0 + e]; }
          for (int d = 0; d < 64; ++d) { const float qv = qe[i * 65 + d];
#pragma unroll
              for (int e = 0; e < 16; ++e) o[e] += qv * sp[d * 128 + e0 + e]; }
          float ss = 0.f;
#pragma unroll
          for (int e = 0; e < 16; ++e) ss += o[e] * o[e];
          ss += __shfl_xor(ss, 1); ss += __shfl_xor(ss, 2); ss += __shfl_xor(ss, 4);
          const float rs = 1.0f / sqrtf(ss * (1.f / 128.f) + EPS);
          const bf16* rp = p.z1 + (size_t)(t0 + i) * NZ + ZR + h * 128 + e0; bf16* op = p.mix + (size_t)(t0 + i) * D + 512 + h * 128 + e0;
#pragma unroll
          for (int e = 0; e < 16; ++e) { const float r = bf2f(rp[e]); const float sl = r / (1.f + expf(-r)); op[e] = (bf16)f2bf(o[e] * rs * p.gla_g[e0 + e] * sl); } }
    }
}

__device__ __forceinline__ void phase_softmax(const P& p, int bid, int nb) {
    const int lane = threadIdx.x & 63, gw = bid * NWAVES + (threadIdx.x >> 6), NGW = nb * NWAVES;
    for (int it = gw; it < M * 4; it += NGW) {
        const f32x4 v = *((const f32x4*)(p.sc + (size_t)it * 256) + lane);
        float m = fmaxf(fmaxf(v.x, v.y), fmaxf(v.z, v.w));
#pragma unroll
        for (int o = 1; o < 64; o <<= 1) m = fmaxf(m, __shfl_xor(m, o));
        const float e0 = expf(v.x - m), e1 = expf(v.y - m), e2 = expf(v.z - m), e3 = expf(v.w - m);
        const float inv = 1.f / wave_sum((e0 + e1) + (e2 + e3));
        u32x2 w; w.x = pk2(e0 * inv, e1 * inv); w.y = pk2(e2 * inv, e3 * inv);
        *((u32x2*)(p.px + (size_t)it * 256) + lane) = w;
    }
}

__device__ __forceinline__ void phase_router(const P& p, float* lds, int bid, int nb) {
    const int tid = threadIdx.x, lane = tid & 63, gw = bid * NWAVES + (tid >> 6), NGW = nb * NWAVES;
    __syncthreads();
    for (int i = tid; i < D * NE; i += NTHREADS) lds[(i & 31) * D + (i >> 5)] = p.w_router[i];
    __syncthreads();
    for (int t = gw; t < M; t += NGW) {
        const f32x4* xr = (const f32x4*)(p.x2 + (size_t)t * D) + lane; f32x4 v[4]; float s = 0.f;
#pragma unroll
        for (int j = 0; j < 4; ++j) { v[j] = xr[64 * j]; s += (v[j].x * v[j].x + v[j].y * v[j].y) + (v[j].z * v[j].z + v[j].w * v[j].w); }
        const float rs = 1.0f / sqrtf(wave_sum(s) * (1.f / D) + EPS);
#pragma unroll
        for (int j = 0; j < 4; ++j) { const f32x4 gg = *((const f32x4*)p.g_moe + lane + 64 * j); v[j] = v[j] * rs * gg; }
        float mylg = -INFINITY;
#pragma unroll 2
        for (int e = 0; e < NE; ++e) { float a = 0.f;
#pragma unroll
            for (int j = 0; j < 4; ++j) { const f32x4 w = *((const f32x4*)(lds + e * D) + lane + 64 * j); a += (v[j].x * w.x + v[j].y * w.y) + (v[j].z * w.z + v[j].w * w.w); }
            a = wave_sum(a); if (lane == e) mylg = a + p.b_router[e]; }
        int idx[4]; float val[4];
#pragma unroll
        for (int j = 0; j < 4; ++j) { float bv = mylg; int bi = lane;
#pragma unroll
            for (int o = 1; o < 64; o <<= 1) { const float ov = __shfl_xor(bv, o); const int oi = __shfl_xor(bi, o); const bool tk = (ov > bv) || (ov == bv && oi < bi); bv = tk ? ov : bv; bi = tk ? oi : bi; }
            idx[j] = bi; val[j] = bv; if (lane == bi) mylg = -INFINITY; }
        const float e1 = expf(val[1] - val[0]), e2 = expf(val[2] - val[0]), e3 = expf(val[3] - val[0]); const float inv = 1.f / (1.f + e1 + e2 + e3);
        if (lane == 0) { p.rs2[t] = rs;
            p.topi[t * 4 + 0] = idx[0]; p.topi[t * 4 + 1] = idx[1]; p.topi[t * 4 + 2] = idx[2]; p.topi[t * 4 + 3] = idx[3];
            p.topg[t * 4 + 0] = inv; p.topg[t * 4 + 1] = e1 * inv; p.topg[t * 4 + 2] = e2 * inv; p.topg[t * 4 + 3] = e3 * inv;
#pragma unroll
            for (int j = 0; j < 4; ++j) atomicAdd(p.ctl + CW_COUNT + idx[j], 1u); }
    }
}
__device__ __forceinline__ void phase_dispatch(const P& p, int* ldsi, int bid, int nb) {
    const int tid = threadIdx.x, lane = tid & 63, gw = bid * NWAVES + (tid >> 6), NGW = nb * NWAVES;
    __syncthreads();
    if (tid == 0) { int off = 0; for (int e = 0; e < NE; ++e) { ldsi[e] = off; const int c = (int)p.ctl[CW_COUNT + e]; const int nt = (c + 255) >> 8;
            if (bid == 0) for (int i = 0; i < nt; ++i) p.tilee[(off >> 8) + i] = e;
            off += nt << 8; }
        if (bid == 0) p.tilee[MAXMT] = off >> 8; }
    __syncthreads();
    for (int t = gw; t < M; t += NGW) {
        int slot = 0;
        if (lane < 4) { const int e = p.topi[t * 4 + lane]; slot = ldsi[e] + (int)atomicAdd(p.ctl + CW_CURSOR + e, 1u); p.slotof[t * 4 + lane] = slot; p.gslot[slot] = p.topg[t * 4 + lane]; }
        const float rs = p.rs2[t];
        const f32x4* xr = (const f32x4*)(p.x2 + (size_t)t * D) + lane; u32x2 w[4];
#pragma unroll
        for (int j = 0; j < 4; ++j) { const f32x4 v = xr[64 * j]; const f32x4 gg = *((const f32x4*)p.g_moe + lane + 64 * j);
            w[j].x = pk2(v.x * rs * gg.x, v.y * rs * gg.y); w[j].y = pk2(v.z * rs * gg.z, v.w * rs * gg.w); }
#pragma unroll
        for (int q = 0; q < 4; ++q) { const int sl = __shfl(slot, q); u32x2* o = (u32x2*)(p.xs + (size_t)sl * D) + lane;
#pragma unroll
            for (int j = 0; j < 4; ++j) o[64 * j] = w[j]; }
    }
}
__device__ __forceinline__ void phase_final(const P& p, int bid, int nb) {
    const int lane = threadIdx.x & 63, gw = bid * NWAVES + (threadIdx.x >> 6), NGW = nb * NWAVES;
    for (int t = gw; t < M; t += NGW) {
        const f32x4* xr = (const f32x4*)(p.x2 + (size_t)t * D) + lane; f32x4 v[4];
#pragma unroll
        for (int j = 0; j < 4; ++j) v[j] = xr[64 * j];
#pragma unroll
        for (int q = 0; q < 4; ++q) { const int sl = p.slotof[t * 4 + q]; const u32x2* yr = (const u32x2*)(p.y + (size_t)sl * D) + lane;
#pragma unroll
            for (int j = 0; j < 4; ++j) { const u32x2 w = yr[64 * j]; v[j].x += bf_lo(w.x); v[j].y += bf_hi(w.x); v[j].z += bf_lo(w.y); v[j].w += bf_hi(w.y); } }
        float s = 0.f;
#pragma unroll
        for (int j = 0; j < 4; ++j) s += (v[j].x * v[j].x + v[j].y * v[j].y) + (v[j].z * v[j].z + v[j].w * v[j].w);
        const float rs = 1.0f / sqrtf(wave_sum(s) * (1.f / D) + EPS);
        f32x4* o = (f32x4*)(p.out + (size_t)t * D) + lane;
#pragma unroll
        for (int j = 0; j < 4; ++j) { const f32x4 gg = *((const f32x4*)p.g_final + lane + 64 * j); o[64 * j] = v[j] * rs * gg; }
    }
}

constexpr int LDS_BYTES = 147456;
constexpr int NPHASE = 16;
struct Args { const float* in[24]; float* out; unsigned char* ws; int ph_lo, ph_hi; };

__global__ void __launch_bounds__(NTHREADS, 2) mk_fwd(Args a) {
    extern __shared__ __attribute__((aligned(16))) unsigned char lds[];
    float* ldsf = (float*)lds;
    P p;
    p.x = a.in[0]; p.mem = a.in[1]; p.g_mix = a.in[2]; p.w_in = a.in[3]; p.w_pool = a.in[4]; p.pool_scale = a.in[5]; p.w_gate_up = a.in[6]; p.b_gate_up = a.in[7];
    p.gla_g = a.in[8]; p.w_out = a.in[9]; p.g_xattn = a.in[10]; p.g_mem = a.in[11]; p.w_xq = a.in[12]; p.w_xk = a.in[13]; p.w_xv = a.in[14]; p.w_xo = a.in[15];
    p.g_moe = a.in[16]; p.w_router = a.in[17]; p.b_router = a.in[18]; p.w_gu = a.in[19]; p.b_gu = a.in[20]; p.w_dn = a.in[21]; p.b_dn = a.in[22]; p.g_final = a.in[23];
    p.out = a.out; unsigned char* ws = a.ws; p.ctl = (unsigned*)(ws + WS_CTL);
    p.wt_in = (bf16*)(ws + WS_WT_IN); p.wt_out = (bf16*)(ws + WS_WT_OUT); p.wt_xq = (bf16*)(ws + WS_WT_XQ); p.wt_xk = (bf16*)(ws + WS_WT_XK); p.wt_xv = (bf16*)(ws + WS_WT_XV); p.wt_xo = (bf16*)(ws + WS_WT_XO);
    p.wt_gu = (bf16*)(ws + WS_WT_GU); p.wt_dn = (bf16*)(ws + WS_WT_DN);
    p.xn = (bf16*)(ws + WS_XN); p.hm = (bf16*)(ws + WS_HM); p.z1 = (bf16*)(ws + WS_Z1); p.mix = (bf16*)(ws + WS_MIX); p.a2 = (bf16*)(ws + WS_A2); p.kx = (bf16*)(ws + WS_KX); p.vxt = (bf16*)(ws + WS_VXT);
    p.qx = (bf16*)(ws + WS_QX); p.px = (bf16*)(ws + WS_PX); p.ox = (bf16*)(ws + WS_OX); p.xs = (bf16*)(ws + WS_XS); p.h = (bf16*)(ws + WS_H); p.y = (bf16*)(ws + WS_Y);
    p.sprev = (float*)(ws + WS_SPREV); p.ds = (float*)(ws + WS_DS); p.dec = (float*)(ws + WS_DEC); p.x1 = (float*)(ws + WS_X1); p.x2 = (float*)(ws + WS_X2); p.sc = (float*)(ws + WS_SC);
    p.rs2 = (float*)(ws + WS_RS2); p.topg = (float*)(ws + WS_TOPG); p.gslot = (float*)(ws + WS_GSLOT); p.topi = (int*)(ws + WS_TOPI); p.slotof = (int*)(ws + WS_SLOTOF); p.tilee = (int*)(ws + WS_TILEE);
    const int bid = blockIdx.x, nb = gridDim.x;
    const int lo = a.ph_lo, hi = a.ph_hi;
#ifndef PH
#define PH -1
#endif
#define IN(k) ((PH < 0 || PH == (k)) && lo <= (k) && (k) < hi)
    if (IN(0)) phase_prologue(p, ldsf, bid, nb);
    if (IN(1)) {
        ngemm(NG{p.xn, D, p.wt_in, D, M, NZ, D, nullptr, 0}, EpiBf{p.z1, NZ}, ldsf, bid, nb);
        ngemm(NG{p.hm, D, p.wt_xk, D, BATCH * MEMLEN, D, D, nullptr, 0}, EpiBf{p.kx, D}, ldsf, bid, nb);
        ngemm(NG{p.wt_xv, D, p.hm, D, D, BATCH * MEMLEN, D, nullptr, 0}, EpiBf{p.vxt, BATCH * MEMLEN}, ldsf, bid, nb);
    }
    if (IN(2)) { phase_pool(p, ldsf, bid, nb); phase_gla_a(p, ldsf, bid, nb); }
    if (IN(3)) phase_scan(p, bid, nb);
    if (IN(4)) phase_gla_b(p, ldsf, bid, nb);
    if (IN(5)) ngemm(NG{p.mix, D, p.wt_out, D, M, D, D, nullptr, 0}, EpiOut{p.x, p.x1, p.a2, p.g_xattn, (float*)(p.ctl + CW_ROWSQ1)}, ldsf, bid, nb);
    if (IN(6)) ngemm(NG{p.a2, D, p.wt_xq, D, M, D, D, nullptr, 0}, EpiQ{p.qx, (const float*)(p.ctl + CW_ROWSQ1)}, ldsf, bid, nb);
    if (IN(7)) for (int bh = 0; bh < 8; ++bh) { const int b = bh >> 2, h = bh & 3; const size_t o = (size_t)b * SEQ * D + h * 256;
        ngemm(NG{p.qx + o, D, p.kx + (size_t)b * MEMLEN * D + h * 256, D, SEQ, 256, 256, nullptr, 0}, EpiF32{p.sc + o, D}, ldsf, bid, nb); }
    if (IN(8)) phase_softmax(p, bid, nb);
    if (IN(9)) for (int bh = 0; bh < 8; ++bh) { const int b = bh >> 2, h = bh & 3; const size_t o = (size_t)b * SEQ * D + h * 256;
        ngemm(NG{p.px + o, D, p.vxt + (size_t)h * 256 * (BATCH * MEMLEN) + b * MEMLEN, BATCH * MEMLEN, SEQ, 256, 256, nullptr, 0}, EpiBf{p.ox + o, D}, ldsf, bid, nb); }
    if (IN(10)) ngemm(NG{p.ox, D, p.wt_xo, D, M, D, D, nullptr, 0}, EpiRes{p.x1, p.x2}, ldsf, bid, nb);
    if (IN(11)) phase_router(p, ldsf, bid, nb);
    if (IN(12)) phase_dispatch(p, (int*)lds, bid, nb);
    if (IN(13)) { const int nmt = p.tilee[MAXMT]; ngemm(NG{p.xs, D, p.wt_gu, D, nmt * 256, 2 * DFF, D, p.tilee, (size_t)2 * DFF * D}, EpiUp{p.h, p.b_gu}, ldsf, bid, nb); }
    if (IN(14)) { const int nmt = p.tilee[MAXMT]; ngemm(NG{p.h, DFF, p.wt_dn, DFF, nmt * 256, D, DFF, p.tilee, (size_t)D * DFF}, EpiDn{p.y, p.b_dn, p.gslot}, ldsf, bid, nb); }
    if (IN(15)) phase_final(p, bid, nb);
#undef IN
}

extern "C" void kernel_launch(void* const* d_in, const int* in_sizes, int n_in, void* d_out, int out_size, void* d_ws, size_t ws_size, hipStream_t stream) {
    static int grid = 0;
    if (grid == 0) {
        if (n_in != 24 || in_sizes[0] != M * D || out_size != M * D || ws_size < WS_END) { fprintf(stderr, "kernel_launch: unexpected shapes (n_in %d, in0 %d, out %d, ws %zu)\n", n_in, n_in > 0 ? in_sizes[0] : -1, out_size, ws_size); grid = -1; return; }
        int dev = 0, cus = 0;
        if (hipGetDevice(&dev) != hipSuccess || hipDeviceGetAttribute(&cus, hipDeviceAttributeMultiprocessorCount, dev) != hipSuccess) { grid = -1; return; }
        if (hipFuncSetAttribute((const void*)mk_fwd, hipFuncAttributeMaxDynamicSharedMemorySize, LDS_BYTES) != hipSuccess) { fprintf(stderr, "kernel_launch: hipFuncSetAttribute failed\n"); grid = -1; return; }
        grid = cus > 0 ? cus : 256;
    }
    if (grid < 0) return;
    (void)hipMemsetAsync((char*)d_ws + WS_CTL, 0, CTL_BYTES, stream);
    Args a{};
    for (int i = 0; i < 24; ++i) a.in[i] = (const float*)d_in[i];
    a.out = (float*)d_out; a.ws = (unsigned char*)d_ws;
    for (int ph = 0; ph < NPHASE; ++ph) { a.ph_lo = ph; a.ph_hi = ph + 1; hipLaunchKernelGGL(mk_fwd, dim3(grid), dim3(NTHREADS), LDS_BYTES, stream, a); }
}
```

```cpp
#include <hip/hip_runtime.h>
#include <cstdio>
#include <cstdint>

#define LAS __attribute__((address_space(3)))
typedef unsigned short bf16;
typedef float f32x4 __attribute__((ext_vector_type(4)));
typedef unsigned u32x4 __attribute__((ext_vector_type(4)));
typedef unsigned u32x2 __attribute__((ext_vector_type(2)));

constexpr int BATCH = 2, SEQ = 8192, M = BATCH * SEQ, D = 1024;
constexpr int IN_COLS = 2064, NZ = 2304;
constexpr int ZQ = 512, ZK = 768, ZV = 1024, ZR = 1536, ZG = 2048;
constexpr int NE = 32, TOPK = 4, DFF = 1024, MEMLEN = 256;
constexpr int NASSIGN = M * TOPK, MAXSLOT = NASSIGN + NE * 256, MAXMT = MAXSLOT / 256;
constexpr int NCHUNK = SEQ / 64;
constexpr float EPS = 1e-6f;
constexpr int NTHREADS = 512, NWAVES = 8;

constexpr size_t MiB = 1u << 20;
constexpr size_t WS_CTL = 0, CTL_BYTES = 1 * MiB;
constexpr size_t WS_WT_OUT = 2 * MiB, WS_WT_XQ = 4 * MiB, WS_WT_XK = 6 * MiB, WS_WT_XV = 8 * MiB, WS_WT_XO = 10 * MiB, WS_WT_IN = 12 * MiB;
constexpr size_t WS_SMALL = 17 * MiB;
constexpr size_t WS_RS2 = WS_SMALL, WS_TOPI = WS_SMALL + 64 * 1024, WS_TOPG = WS_TOPI + 256 * 1024, WS_SLOTOF = WS_TOPG + 256 * 1024,
                 WS_GSLOT = WS_SLOTOF + 256 * 1024, WS_TILEE = WS_GSLOT + 320 * 1024;
constexpr size_t WS_WT_GU = 20 * MiB, WS_WT_DN = 148 * MiB, WS_X2 = 212 * MiB, WS_B = 276 * MiB;
constexpr size_t WS_XN = WS_B, WS_HM = WS_B + 32 * MiB, WS_Z1 = WS_B + 33 * MiB, WS_MIX = WS_B + 121 * MiB, WS_SPREV = WS_B + 153 * MiB,
                 WS_DS = WS_B + 185 * MiB, WS_DEC = WS_B + 217 * MiB, WS_X1 = WS_B + 218 * MiB, WS_A2 = WS_B + 282 * MiB, WS_KX = WS_B + 314 * MiB, WS_VXT = WS_B + 315 * MiB;
constexpr size_t WS_QX = WS_Z1, WS_PX = WS_Z1 + 32 * MiB, WS_SC = WS_MIX, WS_OX = WS_DS;
constexpr size_t WS_XS = WS_B, WS_H = WS_B + 144 * MiB, WS_Y = WS_B + 288 * MiB, WS_END = WS_B + 432 * MiB;
constexpr int CW_BAR = 4096, CW_COUNT = 8192, CW_CURSOR = 8256, CW_ROWSQ1 = 16384;

__device__ __forceinline__ float bf_lo(unsigned w) { return __uint_as_float(w << 16); }
__device__ __forceinline__ float bf_hi(unsigned w) { return __uint_as_float(w & 0xffff0000u); }
__device__ __forceinline__ float bf2f(bf16 v) { return __uint_as_float((unsigned)v << 16); }
__device__ __forceinline__ unsigned f2bf(float f) { unsigned u = __float_as_uint(f); return (u + 0x7fffu + ((u >> 16) & 1u)) >> 16; }
__device__ __forceinline__ unsigned pk2(float lo, float hi) { return f2bf(lo) | (f2bf(hi) << 16); }
__device__ __forceinline__ float wave_sum(float v) {
#pragma unroll
    for (int o = 1; o < 64; o <<= 1) v += __shfl_xor(v, o);
    return v;
}
__device__ __forceinline__ float logsigmoid(float x) { return fminf(x, 0.f) - log1pf(expf(-fabsf(x))); }

struct P {
    const float *x, *mem, *g_mix, *w_in, *w_pool, *pool_scale, *w_gate_up, *b_gate_up, *gla_g, *w_out, *g_xattn, *g_mem, *w_xq, *w_xk, *w_xv, *w_xo,
                *g_moe, *w_router, *b_router, *w_gu, *b_gu, *w_dn, *b_dn, *g_final;
    float* out;
    unsigned* ctl;
    bf16 *wt_in, *wt_out, *wt_xq, *wt_xk, *wt_xv, *wt_xo, *wt_gu, *wt_dn;
    bf16 *xn, *hm, *z1, *mix, *a2, *kx, *vxt, *qx, *px, *ox, *xs, *h, *y;
    float *sprev, *ds, *dec, *x1, *x2, *sc, *rs2, *topg, *gslot;
    int *topi, *slotof, *tilee;
};

struct MapId { __device__ __forceinline__ int operator()(int n) const { return n; } };
struct MapIn { __device__ __forceinline__ int operator()(int n) const { return n < 1536 ? n : (n < 2048 ? 1552 + (n - 1536) : (n < 2064 ? 1536 + (n - 2048) : -1)); } };
struct MapGu { __device__ __forceinline__ int operator()(int n) const { const int pn = n >> 8, w = n & 255; return w < 128 ? pn * 128 + w : 1024 + pn * 128 + (w - 128); } };

template <class Map>
__device__ __forceinline__ void transpose_item(const float* W, int ldw, int K, bf16* WT, float* scr, int kb, int nb, int lane, Map map) {
    const int k0 = 64 * kb, n0 = 32 * nb;
    const int sc = map(n0 + (lane & 31));
#pragma unroll 8
    for (int i = 0; i < 32; ++i) { const int kk = 2 * i + (lane >> 5); scr[kk * 33 + (lane & 31)] = sc >= 0 ? W[(size_t)(k0 + kk) * ldw + sc] : 0.f; }
    __builtin_amdgcn_s_waitcnt(0xC07F); asm volatile("" ::: "memory");
    const int c = lane & 7;
#pragma unroll
    for (int j = 0; j < 4; ++j) { const int n = (lane >> 3) + 8 * j; const float* s = scr + (8 * c) * 33 + n;
        u32x4 o; o.x = pk2(s[0 * 33], s[1 * 33]); o.y = pk2(s[2 * 33], s[3 * 33]); o.z = pk2(s[4 * 33], s[5 * 33]); o.w = pk2(s[6 * 33], s[7 * 33]);
        *(u32x4*)(WT + (size_t)(n0 + n) * K + k0 + 8 * c) = o; }
    __builtin_amdgcn_s_waitcnt(0xC07F); asm volatile("" ::: "memory");
}
__device__ __forceinline__ void rms_row_bf16(const float* xrow, const float* g, bf16* orow, int lane) {
    const f32x4* xr = (const f32x4*)xrow + lane; f32x4 v[4]; float s = 0.f;
#pragma unroll
    for (int j = 0; j < 4; ++j) { v[j] = xr[64 * j]; s += (v[j].x * v[j].x + v[j].y * v[j].y) + (v[j].z * v[j].z + v[j].w * v[j].w); }
    const float rs = 1.0f / sqrtf(wave_sum(s) * (1.f / D) + EPS);
    u32x2* o8 = (u32x2*)orow + lane; const f32x4* gr = (const f32x4*)g + lane;
#pragma unroll
    for (int j = 0; j < 4; ++j) { const f32x4 gg = gr[64 * j]; u32x2 w; w.x = pk2(v[j].x * rs * gg.x, v[j].y * rs * gg.y); w.y = pk2(v[j].z * rs * gg.z, v[j].w * rs * gg.w); o8[64 * j] = w; }
}
__device__ __forceinline__ void phase_prologue(const P& p, float* ldsf, int bid, int nb) {
    const int tid = threadIdx.x, lane = tid & 63, wave = tid >> 6;
    float* scr = ldsf + wave * (64 * 33 + 32);
    const int gw = bid * NWAVES + wave, NGW = nb * NWAVES;
    constexpr int I_IN = 16 * (NZ / 32), I_SQ = 16 * 32, I_GU = 16 * 64, I_DN = 16 * 32;
    constexpr int NITEMS = I_IN + 5 * I_SQ + NE * I_GU + NE * I_DN;
    for (int it = gw; it < NITEMS; it += NGW) {
        int r = it;
        if (r < I_IN) { transpose_item(p.w_in, IN_COLS, D, p.wt_in, scr, r / (NZ / 32), r % (NZ / 32), lane, MapIn()); continue; } r -= I_IN;
        if (r < 5 * I_SQ) { const int w = r / I_SQ, q = r % I_SQ; const float* src = w == 0 ? p.w_out : w == 1 ? p.w_xq : w == 2 ? p.w_xk : w == 3 ? p.w_xv : p.w_xo;
            bf16* dst = w == 0 ? p.wt_out : w == 1 ? p.wt_xq : w == 2 ? p.wt_xk : w == 3 ? p.wt_xv : p.wt_xo;
            transpose_item(src, D, D, dst, scr, q / 32, q % 32, lane, MapId()); continue; } r -= 5 * I_SQ;
        if (r < NE * I_GU) { const int e = r / I_GU, q = r % I_GU; transpose_item(p.w_gu + (size_t)e * D * 2 * DFF, 2 * DFF, D, p.wt_gu + (size_t)e * 2 * DFF * D, scr, q / 64, q % 64, lane, MapGu()); continue; } r -= NE * I_GU;
        { const int e = r / I_DN, q = r % I_DN; transpose_item(p.w_dn + (size_t)e * DFF * D, D, DFF, p.wt_dn + (size_t)e * D * DFF, scr, q / 32, q % 32, lane, MapId()); }
    }
    for (int m = gw; m < M; m += NGW) rms_row_bf16(p.x + (size_t)m * D, p.g_mix, p.xn + (size_t)m * D, lane);
    for (int m = gw; m < BATCH * MEMLEN; m += NGW) rms_row_bf16(p.mem + (size_t)m * D, p.g_mem, p.hm + (size_t)m * D, lane);
}

struct NG { const bf16* A; int lda; const bf16* Bt; int ldb; int Mr, N, K; const int* tile_e; size_t sBe; };
template <class Epi>
__device__ __forceinline__ void ngemm(const NG g, const Epi& E, float* lds, int bid, int nb) {
    float* As = lds; float* Bs = lds + 32 * 128;
    const int tid = threadIdx.x, tr = tid >> 4, tc = tid & 15;
    const int nMt = g.Mr / 128, nNt = g.N / 256;
    for (int u = bid; u < nMt * nNt; u += nb) {
        const int mt = u / nNt, nt = u % nNt, row0 = mt * 128, col0 = nt * 256;
        int e = 0; const bf16* Bt = g.Bt;
        if (g.tile_e) { e = g.tile_e[row0 >> 8]; Bt += (size_t)e * g.sBe; }
        float acc[4][16];
#pragma unroll
        for (int i = 0; i < 4; ++i)
#pragma unroll
            for (int j = 0; j < 16; ++j) acc[i][j] = 0.f;
        for (int k0 = 0; k0 < g.K; k0 += 32) {
            __syncthreads();
            { const int r = tid >> 2, kk = (tid & 3) * 8;
              const u32x4 v = *(const u32x4*)(g.A + (size_t)(row0 + r) * g.lda + k0 + kk);
              As[(kk + 0) * 128 + r] = bf_lo(v.x); As[(kk + 1) * 128 + r] = bf_hi(v.x); As[(kk + 2) * 128 + r] = bf_lo(v.y); As[(kk + 3) * 128 + r] = bf_hi(v.y);
              As[(kk + 4) * 128 + r] = bf_lo(v.z); As[(kk + 5) * 128 + r] = bf_hi(v.z); As[(kk + 6) * 128 + r] = bf_lo(v.w); As[(kk + 7) * 128 + r] = bf_hi(v.w);
#pragma unroll
              for (int h = 0; h < 2; ++h) { const int rb = r + 128 * h;
                const u32x4 w = *(const u32x4*)(Bt + (size_t)(col0 + rb) * g.ldb + k0 + kk);
                Bs[(kk + 0) * 256 + rb] = bf_lo(w.x); Bs[(kk + 1) * 256 + rb] = bf_hi(w.x); Bs[(kk + 2) * 256 + rb] = bf_lo(w.y); Bs[(kk + 3) * 256 + rb] = bf_hi(w.y);
                Bs[(kk + 4) * 256 + rb] = bf_lo(w.z); Bs[(kk + 5) * 256 + rb] = bf_hi(w.z); Bs[(kk + 6) * 256 + rb] = bf_lo(w.w); Bs[(kk + 7) * 256 + rb] = bf_hi(w.w); } }
            __syncthreads();
#pragma unroll 4
            for (int k = 0; k < 32; ++k) {
                const f32x4 a = *(const f32x4*)&As[k * 128 + 4 * tr];
                const f32x4 b0 = *(const f32x4*)&Bs[k * 256 + tc * 8], b1 = *(const f32x4*)&Bs[k * 256 + tc * 8 + 4];
                const f32x4 b2 = *(const f32x4*)&Bs[k * 256 + 128 + tc * 8], b3 = *(const f32x4*)&Bs[k * 256 + 128 + tc * 8 + 4];
#pragma unroll
                for (int i = 0; i < 4; ++i) {
#pragma unroll
                    for (int j = 0; j < 4; ++j) { acc[i][j] += a[i] * b0[j]; acc[i][4 + j] += a[i] * b1[j]; acc[i][8 + j] += a[i] * b2[j]; acc[i][12 + j] += a[i] * b3[j]; }
                }
            }
        }
#pragma unroll
        for (int i = 0; i < 4; ++i)
#pragma unroll
            for (int j = 0; j < 8; ++j) E(e, row0 + 4 * tr + i, col0 + tc * 8 + j, acc[i][j], acc[i][8 + j]);
    }
}
struct EpiBf { bf16* C; int ldc; __device__ __forceinline__ void operator()(int, int r, int c, float a, float b) const { C[(size_t)r * ldc + c] = (bf16)f2bf(a); C[(size_t)r * ldc + c + 128] = (bf16)f2bf(b); } };
struct EpiF32 { float* C; int ldc; __device__ __forceinline__ void operator()(int, int r, int c, float a, float b) const { C[(size_t)r * ldc + c] = a; C[(size_t)r * ldc + c + 128] = b; } };
struct EpiOut { const float* x; float* x1; bf16* a2; const float* g; float* rowsq;
    __device__ __forceinline__ void one(int r, int c, float a) const { const size_t o = (size_t)r * D + c; const float v = x[o] + a; x1[o] = v; a2[o] = (bf16)f2bf(v * g[c]); atomicAdd(rowsq + r, v * v); }
    __device__ __forceinline__ void operator()(int, int r, int c, float a, float b) const { one(r, c, a); one(r, c + 128, b); } };
struct EpiQ { bf16* q; const float* rowsq;
    __device__ __forceinline__ void operator()(int, int r, int c, float a, float b) const { const float s = 0.0625f / sqrtf(rowsq[r] * (1.f / D) + EPS); q[(size_t)r * D + c] = (bf16)f2bf(a * s); q[(size_t)r * D + c + 128] = (bf16)f2bf(b * s); } };
struct EpiRes { const float* base; float* o; __device__ __forceinline__ void operator()(int, int r, int c, float a, float b) const { const size_t i = (size_t)r * D + c; o[i] = base[i] + a; o[i + 128] = base[i + 128] + b; } };
__device__ __forceinline__ float swiglu(float g, float u) { g = fminf(g, 7.f); u = fminf(fmaxf(u, -7.f), 7.f); return g * (1.f / (1.f + expf(-1.702f * g))) * (u + 1.f); }
struct EpiUp { bf16* h; const float* b_gu;
    __device__ __forceinline__ void operator()(int e, int r, int c, float a, float b) const { const int ff = (c >> 8) * 128 + (c & 127); const float* bb = b_gu + (size_t)e * 2 * DFF;
        h[(size_t)r * DFF + ff] = (bf16)f2bf(swiglu(a + bb[ff], b + bb[DFF + ff])); } };
struct EpiDn { bf16* y; const float* b_dn; const float* gs;
    __device__ __forceinline__ void operator()(int e, int r, int c, float a, float b) const { const float g = gs[r]; const float* bb = b_dn + (size_t)e * D;
        y[(size_t)r * D + c] = (bf16)f2bf(g * (a + bb[c])); y[(size_t)r * D + c + 128] = (bf16)f2bf(g * (b + bb[c + 128])); } };

__device__ __forceinline__ void phase_pool(const P& p, float* lds, int bid, int nb) {
    float* pt = lds;
    float* wp = lds + 64 * 129;
    const int tid = threadIdx.x;
    for (int u = bid; u < (M / 64) * 4; u += nb) {
        const int g = u & 3, tt = u >> 2, t0 = tt * 64, w = 2 << g;
        __syncthreads();
        for (int i = tid; i < 128 * 128; i += NTHREADS) wp[i] = p.w_pool[(size_t)g * 128 * 128 + i];
        { const int i = tid >> 3, c0 = (tid & 7) * 16, t = t0 + i, s = t & (SEQ - 1);
          const int cnt = (s + 1 < w) ? s + 1 : w;
          float acc[16];
#pragma unroll
          for (int c = 0; c < 16; ++c) acc[c] = 0.f;
          for (int d = 0; d < cnt; ++d) { const bf16* up = p.z1 + (size_t)(t - d) * NZ + g * 128 + c0;
#pragma unroll
              for (int c = 0; c < 16; ++c) acc[c] += bf2f(up[c]); }
          const bf16* u0 = p.z1 + (size_t)t * NZ + g * 128 + c0; const float inv = 1.f / (float)cnt;
#pragma unroll
          for (int c = 0; c < 16; ++c) pt[i * 129 + c0 + c] = acc[c] * inv - bf2f(u0[c]); }
        __syncthreads();
        { const int i = tid >> 3, d0 = (tid & 7) * 16; float acc[16];
#pragma unroll
          for (int c = 0; c < 16; ++c) acc[c] = 0.f;
          for (int c = 0; c < 128; ++c) { const float pv = pt[i * 129 + c];
#pragma unroll
              for (int d = 0; d < 16; ++d) acc[d] += pv * wp[c * 128 + d0 + d]; }
          bf16* o = p.mix + (size_t)(t0 + i) * D + g * 128 + d0;
#pragma unroll
          for (int d = 0; d < 16; ++d) o[d] = (bf16)f2bf(acc[d] * p.pool_scale[g * 128 + d0 + d]); }
    }
}

__device__ __forceinline__ void gla_gc(const P& p, float* glr, float* wgu, float* gc, int b, int h, int n) {
    const int tid = threadIdx.x, t0 = b * SEQ + n * 64;
    __syncthreads();
    for (int i = tid; i < 64 * 16; i += NTHREADS) glr[i] = bf2f(p.z1[(size_t)(t0 + (i >> 4)) * NZ + ZG + (i & 15)]);
    for (int i = tid; i < 16 * 64; i += NTHREADS) wgu[i] = p.w_gate_up[(i >> 6) * 256 + h * 64 + (i & 63)];
    __syncthreads();
    for (int idx = tid; idx < 64 * 64; idx += NTHREADS) { const int i = idx >> 6, d = idx & 63; float s = p.b_gate_up[h * 64 + d];
#pragma unroll
        for (int r = 0; r < 16; ++r) s += glr[i * 16 + r] * wgu[r * 64 + d];
        gc[i * 65 + d] = logsigmoid(s) * (1.f / 16.f); }
    __syncthreads();
    if (tid < 64) { float run = 0.f; for (int i = 0; i < 64; ++i) { run += gc[i * 65 + tid]; gc[i * 65 + tid] = run; } }
    __syncthreads();
}
__device__ __forceinline__ void phase_gla_a(const P& p, float* lds, int bid, int nb) {
    float* glr = lds; float* wgu = lds + 1024; float* gc = lds + 2048; float* kd = gc + 64 * 65; float* vv = kd + 64 * 65;
    const int tid = threadIdx.x;
    for (int u = bid; u < 8 * NCHUNK; u += nb) {
        const int bh = u / NCHUNK, n = u % NCHUNK, b = bh >> 2, h = bh & 3, t0 = b * SEQ + n * 64;
        gla_gc(p, glr, wgu, gc, b, h, n);
        for (int idx = tid; idx < 64 * 64; idx += NTHREADS) { const int j = idx >> 6, d = idx & 63;
            kd[j * 65 + d] = bf2f(p.z1[(size_t)(t0 + j) * NZ + ZK + h * 64 + d]) * expf(gc[63 * 65 + d] - gc[j * 65 + d]); }
        for (int idx = tid; idx < 64 * 128; idx += NTHREADS) { const int j = idx >> 7, e = idx & 127; vv[idx] = bf2f(p.z1[(size_t)(t0 + j) * NZ + ZV + h * 128 + e]); }
        __syncthreads();
        { const int d = tid >> 3, e0 = (tid & 7) * 16; float acc[16];
#pragma unroll
          for (int e = 0; e < 16; ++e) acc[e] = 0.f;
          for (int j = 0; j < 64; ++j) { const float kv = kd[j * 65 + d];
#pragma unroll
              for (int e = 0; e < 16; ++e) acc[e] += kv * vv[j * 128 + e0 + e]; }
          float* o = p.ds + ((size_t)u * 64 + d) * 128 + e0;
#pragma unroll
          for (int e = 0; e < 16; ++e) o[e] = acc[e]; }
        if (tid < 64) p.dec[(size_t)u * 64 + tid] = expf(gc[63 * 65 + tid]);
    }
}
__device__ __forceinline__ void phase_scan(const P& p, int bid, int nb) {
    for (int idx = bid * NTHREADS + threadIdx.x; idx < 8 * 64 * 128; idx += nb * NTHREADS) {
        const int bh = idx >> 13, de = idx & 8191, d = de >> 7;
        float st = 0.f;
        for (int n = 0; n < NCHUNK; ++n) { const size_t u = (size_t)bh * NCHUNK + n;
            p.sprev[u * 8192 + de] = st; st = p.dec[u * 64 + d] * st + p.ds[u * 8192 + de]; }
    }
}
__device__ __forceinline__ void phase_gla_b(const P& p, float* lds, int bid, int nb) {
    float* glr = lds; float* wgu = lds + 1024; float* gc = lds + 2048; float* qe = gc + 64 * 65; float* ke = qe + 64 * 65; float* vv = ke + 64 * 65; float* sp = vv + 64 * 128;
    float* att = gc;
    const int tid = threadIdx.x;
    for (int u = bid; u < 8 * NCHUNK; u += nb) {
        const int bh = u / NCHUNK, n = u % NCHUNK, b = bh >> 2, h = bh & 3, t0 = b * SEQ + n * 64;
        gla_gc(p, glr, wgu, gc, b, h, n);
        for (int idx = tid; idx < 64 * 64; idx += NTHREADS) { const int i = idx >> 6, d = idx & 63; const float g = gc[i * 65 + d];
            qe[i * 65 + d] = bf2f(p.z1[(size_t)(t0 + i) * NZ + ZQ + h * 64 + d]) * 0.125f * expf(g);
            ke[i * 65 + d] = bf2f(p.z1[(size_t)(t0 + i) * NZ + ZK + h * 64 + d]) * expf(-g); }
        for (int idx = tid; idx < 64 * 128; idx += NTHREADS) { const int j = idx >> 7, e = idx & 127; vv[idx] = bf2f(p.z1[(size_t)(t0 + j) * NZ + ZV + h * 128 + e]); sp[idx] = p.sprev[(size_t)u * 8192 + idx]; }
        __syncthreads();
        { const int i = tid >> 3, j0 = (tid & 7) * 8; float a[8];
#pragma unroll
          for (int j = 0; j < 8; ++j) a[j] = 0.f;
          for (int d = 0; d < 64; ++d) { const float qv = qe[i * 65 + d];
#pragma unroll
              for (int j = 0; j < 8; ++j) a[j] += qv * ke[(j0 + j) * 65 + d]; }
#pragma unroll
          for (int j = 0; j < 8; ++j) att[i * 65 + j0 + j] = (j0 + j <= i) ? a[j] : 0.f; }
        __syncthreads();
        { const int i = tid >> 3, e0 = (tid & 7) * 16; float o[16];
#pragma unroll
          for (int e = 0; e < 16; ++e) o[e] = 0.f;
          for (int j = 0; j < 64; ++j) { const float av = att[i * 65 + j];
#pragma unroll
              for (int e = 0; e < 16; ++e) o[e] += av * vv[j * 128 + e0 + e]; }
          for (int d = 0; d < 64; ++d) { const float qv = qe[i * 65 + d];
#pragma unroll
              for (int e = 0; e < 16; ++e) o[e] += qv * sp[d * 128 + e0 + e]; }
          float ss = 0.f;
#pragma unroll
          for (int e = 0; e < 16; ++e) ss += o[e] * o[e];
          ss += __shfl_xor(ss, 1); ss += __shfl_xor(ss, 2); ss += __shfl_xor(ss, 4);
          const float rs = 1.0f / sqrtf(ss * (1.f / 128.f) + EPS);
          const bf16* rp = p.z1 + (size_t)(t0 + i) * NZ + ZR + h * 128 + e0; bf16* op = p.mix + (size_t)(t0 + i) * D + 512 + h * 128 + e0;
#pragma unroll
          for (int e = 0; e < 16; ++e) { const float r = bf2f(rp[e]); const float sl = r / (1.f + expf(-r)); op[e] = (bf16)f2bf(o[e] * rs * p.gla_g[e0 + e] * sl); } }
    }
}

__device__ __forceinline__ void phase_softmax(const P& p, int bid, int nb) {
    const int lane = threadIdx.x & 63, gw = bid * NWAVES + (threadIdx.x >> 6), NGW = nb * NWAVES;
    for (int it = gw; it < M * 4; it += NGW) {
        const f32x4 v = *((const f32x4*)(p.sc + (size_t)it * 256) + lane);
        float m = fmaxf(fmaxf(v.x, v.y), fmaxf(v.z, v.w));
#pragma unroll
        for (int o = 1; o < 64; o <<= 1) m = fmaxf(m, __shfl_xor(m, o));
        const float e0 = expf(v.x - m), e1 = expf(v.y - m), e2 = expf(v.z - m), e3 = expf(v.w - m);
        const float inv = 1.f / wave_sum((e0 + e1) + (e2 + e3));
        u32x2 w; w.x = pk2(e0 * inv, e1 * inv); w.y = pk2(e2 * inv, e3 * inv);
        *((u32x2*)(p.px + (size_t)it * 256) + lane) = w;
    }
}

__device__ __forceinline__ void phase_router(const P& p, float* lds, int bid, int nb) {
    const int tid = threadIdx.x, lane = tid & 63, gw = bid * NWAVES + (tid >> 6), NGW = nb * NWAVES;
    __syncthreads();
    for (int i = tid; i < D * NE; i += NTHREADS) lds[(i & 31) * D + (i >> 5)] = p.w_router[i];
    __syncthreads();
    for (int t = gw; t < M; t += NGW) {
        const f32x4* xr = (const f32x4*)(p.x2 + (size_t)t * D) + lane; f32x4 v[4]; float s = 0.f;
#pragma unroll
        for (int j = 0; j < 4; ++j) { v[j] = xr[64 * j]; s += (v[j].x * v[j].x + v[j].y * v[j].y) + (v[j].z * v[j].z + v[j].w * v[j].w); }
        const float rs = 1.0f / sqrtf(wave_sum(s) * (1.f / D) + EPS);
#pragma unroll
        for (int j = 0; j < 4; ++j) { const f32x4 gg = *((const f32x4*)p.g_moe + lane + 64 * j); v[j] = v[j] * rs * gg; }
        float mylg = -INFINITY;
#pragma unroll 2
        for (int e = 0; e < NE; ++e) { float a = 0.f;
#pragma unroll
            for (int j = 0; j < 4; ++j) { const f32x4 w = *((const f32x4*)(lds + e * D) + lane + 64 * j); a += (v[j].x * w.x + v[j].y * w.y) + (v[j].z * w.z + v[j].w * w.w); }
            a = wave_sum(a); if (lane == e) mylg = a + p.b_router[e]; }
        int idx[4]; float val[4];
#pragma unroll
        for (int j = 0; j < 4; ++j) { float bv = mylg; int bi = lane;
#pragma unroll
            for (int o = 1; o < 64; o <<= 1) { const float ov = __shfl_xor(bv, o); const int oi = __shfl_xor(bi, o); const bool tk = (ov > bv) || (ov == bv && oi < bi); bv = tk ? ov : bv; bi = tk ? oi : bi; }
            idx[j] = bi; val[j] = bv; if (lane == bi) mylg = -INFINITY; }
        const float e1 = expf(val[1] - val[0]), e2 = expf(val[2] - val[0]), e3 = expf(val[3] - val[0]); const float inv = 1.f / (1.f + e1 + e2 + e3);
        if (lane == 0) { p.rs2[t] = rs;
            p.topi[t * 4 + 0] = idx[0]; p.topi[t * 4 + 1] = idx[1]; p.topi[t * 4 + 2] = idx[2]; p.topi[t * 4 + 3] = idx[3];
            p.topg[t * 4 + 0] = inv; p.topg[t * 4 + 1] = e1 * inv; p.topg[t * 4 + 2] = e2 * inv; p.topg[t * 4 + 3] = e3 * inv;
#pragma unroll
            for (int j = 0; j < 4; ++j) atomicAdd(p.ctl + CW_COUNT + idx[j], 1u); }
    }
}
__device__ __forceinline__ void phase_dispatch(const P& p, int* ldsi, int bid, int nb) {
    const int tid = threadIdx.x, lane = tid & 63, gw = bid * NWAVES + (tid >> 6), NGW = nb * NWAVES;
    __syncthreads();
    if (tid == 0) { int off = 0; for (int e = 0; e < NE; ++e) { ldsi[e] = off; const int c = (int)p.ctl[CW_COUNT + e]; const int nt = (c + 255) >> 8;
            if (bid == 0) for (int i = 0; i < nt; ++i) p.tilee[(off >> 8) + i] = e;
            off += nt << 8; }
        if (bid == 0) p.tilee[MAXMT] = off >> 8; }
    __syncthreads();
    for (int t = gw; t < M; t += NGW) {
        int slot = 0;
        if (lane < 4) { const int e = p.topi[t * 4 + lane]; slot = ldsi[e] + (int)atomicAdd(p.ctl + CW_CURSOR + e, 1u); p.slotof[t * 4 + lane] = slot; p.gslot[slot] = p.topg[t * 4 + lane]; }
        const float rs = p.rs2[t];
        const f32x4* xr = (const f32x4*)(p.x2 + (size_t)t * D) + lane; u32x2 w[4];
#pragma unroll
        for (int j = 0; j < 4; ++j) { const f32x4 v = xr[64 * j]; const f32x4 gg = *((const f32x4*)p.g_moe + lane + 64 * j);
            w[j].x = pk2(v.x * rs * gg.x, v.y * rs * gg.y); w[j].y = pk2(v.z * rs * gg.z, v.w * rs * gg.w); }
#pragma unroll
        for (int q = 0; q < 4; ++q) { const int sl = __shfl(slot, q); u32x2* o = (u32x2*)(p.xs + (size_t)sl * D) + lane;
#pragma unroll
            for (int j = 0; j < 4; ++j) o[64 * j] = w[j]; }
    }
}
__device__ __forceinline__ void phase_final(const P& p, int bid, int nb) {
    const int lane = threadIdx.x & 63, gw = bid * NWAVES + (threadIdx.x >> 6), NGW = nb * NWAVES;
    for (int t = gw; t < M; t += NGW) {
        const f32x4* xr = (const f32x4*)(p.x2 + (size_t)t * D) + lane; f32x4 v[4];
#pragma unroll
        for (int j = 0; j < 4; ++j) v[j] = xr[64 * j];
#pragma unroll
        for (int q = 0; q < 4; ++q) { const int sl = p.slotof[t * 4 + q]; const u32x2* yr = (const u32x2*)(p.y + (size_t)sl * D) + lane;
#pragma unroll
            for (int j = 0; j < 4; ++j) { const u32x2 w = yr[64 * j]; v[j].x += bf_lo(w.x); v[j].y += bf_hi(w.x); v[j].z += bf_lo(w.y); v[j].w += bf_hi(w.y); } }
        float s = 0.f;
#pragma unroll
        for (int j = 0; j < 4; ++j) s += (v[j].x * v[j].x + v[j].y * v[j].y) + (v[j].z * v[j].z + v[j].w * v[j].w);
        const float rs = 1.0f / sqrtf(wave_sum(s) * (1.f / D) + EPS);
        f32x4* o = (f32x4*)(p.out + (size_t)t * D) + lane;
#pragma unroll
        for (int j = 0; j < 4; ++j) { const f32x4 gg = *((const f32x4*)p.g_final + lane + 64 * j); o[64 * j] = v[j] * rs * gg; }
    }
}

namespace pg {
typedef short bf16x8 __attribute__((ext_vector_type(8)));
constexpr int BM = 256, BK = 64, HALF = 128, HTB = HALF * BK * 2, STAGE_BYTES = 8 * HTB;
__device__ __forceinline__ int lds_byte(int r, int c) { const int st = (r >> 4) * 2 + (c >> 5), rr = r & 15, cc = c & 31, ob = rr * 64 + cc * 2; return st * 1024 + (ob ^ (((ob >> 9) & 1) << 5)); }
__device__ __forceinline__ void stage_rc(int b, int& R, int& C) { const int st = b / 1024, sb = b % 1024, swz = sb ^ (((sb >> 9) & 1) << 5); R = (st >> 1) * 16 + swz / 64; C = (st & 1) * 32 + (swz % 64) / 2; }
__device__ __forceinline__ int perm32(int rho) { const int n = rho >> 4, i = rho & 15; return 8 * (i >> 2) + 4 * n + (i & 3); }
struct Unit { int pm, pn, e; const char* a; const char* b; };
struct Gemm { int lda, ldb, K; };
__device__ __forceinline__ void map2d(int L, int nM, int nN, int& pm, int& pn) {
    const int nwg = nM * nN; int wgid = L;
    { const int q = nwg / 8, r = nwg % 8, xcd = wgid % 8, off = wgid / 8; wgid = (xcd < r ? xcd * (q + 1) : r * (q + 1) + (xcd - r) * q) + off; }
    const int nig = 8 * nN, gid = wgid / nig, fm = gid * 8, gsz = (nM - fm) < 8 ? (nM - fm) : 8;
    pm = fm + ((wgid % nig) % gsz); pn = (wgid % nig) / gsz;
}
struct Sched2D { const bf16* A; const bf16* Bt; int lda, ldb, nM, nN, G, c;
    __device__ __forceinline__ bool next(int i, Unit& u) const { const long L = (long)i * G + c; if (L >= (long)nM * nN) return false; map2d((int)L, nM, nN, u.pm, u.pn); u.e = 0;
        u.a = (const char*)(A + (size_t)u.pm * 256 * lda); u.b = (const char*)(Bt + (size_t)u.pn * 256 * ldb); return true; } };
struct SchedG1 { const char* ws; int G, c;
    __device__ __forceinline__ bool next(int i, Unit& u) const { const long L = (long)i * G + c; if (L >= 592) return false;
        const int Li = (int)L, l2 = Li - 576, l3 = Li - 584; int pm, pn; map2d(Li < 576 ? Li : 0, 64, 9, pm, pn);
        const int e = Li < 576 ? 0 : (Li < 584 ? 1 : 2);
        pm = e == 0 ? pm : (e == 1 ? (l2 >> 2) : (l3 >> 1)); pn = e == 0 ? pn : (e == 1 ? (l2 & 3) : (l3 & 1));
        const size_t m1 = (size_t)(e == 1), m2 = (size_t)(e == 2);
        const size_t ao = WS_XN + m1 * (WS_HM - WS_XN) + m2 * (WS_WT_XV - WS_XN), bo = WS_WT_IN + m1 * (WS_WT_XK - WS_WT_IN) + m2 * (WS_HM - WS_WT_IN);
        u.pm = pm; u.pn = pn; u.e = e; u.a = ws + ao + (size_t)pm * 256 * D * 2; u.b = ws + bo + (size_t)pn * 256 * D * 2; return true; } };
struct SchedAttn { const bf16* A; const bf16* Bt; size_t sBb, sBh; int G, c;
    __device__ __forceinline__ bool next(int i, Unit& u) const { const long L = (long)i * G + c; if (L >= 256) return false; const int bh = (int)L >> 5, b = bh >> 2, h = bh & 3;
        u.pm = b * 32 + ((int)L & 31); u.pn = h; u.e = 0; u.a = (const char*)(A + (size_t)u.pm * 256 * D + h * 256); u.b = (const char*)(Bt + b * sBb + h * sBh); return true; } };
struct SchedMoE { const bf16* A; const bf16* Bt; const int* tile_e; size_t sBe; int nM, nN, G, c;
    __device__ __forceinline__ bool next(int i, Unit& u) const { const long L = (long)i * G + c; if (L >= (long)nM * nN) return false; map2d((int)L, nM, nN, u.pm, u.pn); u.e = tile_e[u.pm];
        u.a = (const char*)(A + (size_t)u.pm * 256 * D); u.b = (const char*)(Bt + (size_t)u.e * sBe + (size_t)u.pn * 256 * D); return true; } };

typedef f32x4 Acc[2][2][4][2];
__device__ __forceinline__ u32x4 pack8(const f32x4 v0, const f32x4 v1) { u32x4 w; w.x = pk2(v0[0], v0[1]); w.y = pk2(v0[2], v0[3]); w.z = pk2(v1[0], v1[1]); w.w = pk2(v1[2], v1[3]); return w; }
struct EpiBf3 { static constexpr bool PERM = true; unsigned char* ws; size_t o0, o1, o2; int ld0, ld1, ld2;
    __device__ __forceinline__ void operator()(const Acc& acc, const Unit& u, int wr, int wc, int fr, int fq) const {
        const size_t m1 = (size_t)(u.e == 1), m2 = (size_t)(u.e == 2);
        bf16* base = (bf16*)(ws + o0 + m1 * (o1 - o0) + m2 * (o2 - o0)); const int ld = ld0 + (int)m1 * (ld1 - ld0) + (int)m2 * (ld2 - ld0);
        const int row0 = u.pm * BM + wr * 64 + fr, col0 = u.pn * BM + wc * 32 + 8 * fq;
#pragma unroll
        for (int ai = 0; ai < 2; ++ai)
#pragma unroll
            for (int m = 0; m < 4; ++m) { bf16* rowp = base + (size_t)(row0 + ai * HALF + m * 16) * ld + col0;
#pragma unroll
                for (int bj = 0; bj < 2; ++bj) *(u32x4*)(rowp + bj * HALF) = pack8(acc[ai][bj][m][0], acc[ai][bj][m][1]); } } };
struct EpiF { static constexpr bool PERM = false; float* C; int ldc;
    __device__ __forceinline__ void operator()(const Acc& acc, const Unit& u, int wr, int wc, int fr, int fq) const {
        const int row0 = u.pm * BM + wr * 64 + fr, col0 = u.pn * BM + wc * 32 + 4 * fq;
#pragma unroll
        for (int ai = 0; ai < 2; ++ai)
#pragma unroll
            for (int m = 0; m < 4; ++m) { float* rowp = C + (size_t)(row0 + ai * HALF + m * 16) * ldc + col0;
#pragma unroll
                for (int bj = 0; bj < 2; ++bj)
#pragma unroll
                    for (int n = 0; n < 2; ++n) *(f32x4*)(rowp + bj * HALF + n * 16) = acc[ai][bj][m][n]; } } };
struct EpiOutF { static constexpr bool PERM = false; const float* x; float* x1; bf16* a2; const float* g; float* rowsq;
    __device__ __forceinline__ void operator()(const Acc& acc, const Unit& u, int wr, int wc, int fr, int fq) const {
        const int row0 = u.pm * BM + wr * 64 + fr, col0 = u.pn * BM + wc * 32 + 4 * fq;
        f32x4 gv[2][2];
#pragma unroll
        for (int bj = 0; bj < 2; ++bj)
#pragma unroll
            for (int n = 0; n < 2; ++n) gv[bj][n] = *(const f32x4*)(g + col0 + bj * HALF + n * 16);
#pragma unroll
        for (int ai = 0; ai < 2; ++ai)
#pragma unroll
            for (int m = 0; m < 4; ++m) { const int row = row0 + ai * HALF + m * 16; const size_t off = (size_t)row * D + col0; float ss = 0.f;
#pragma unroll
                for (int bj = 0; bj < 2; ++bj)
#pragma unroll
                    for (int n = 0; n < 2; ++n) { const size_t o = off + bj * HALF + n * 16; const f32x4 v = *(const f32x4*)(x + o) + acc[ai][bj][m][n]; *(f32x4*)(x1 + o) = v;
                        const f32x4 t = v * gv[bj][n]; u32x2 w; w.x = pk2(t[0], t[1]); w.y = pk2(t[2], t[3]); *(u32x2*)(a2 + o) = w; ss += (v[0] * v[0] + v[1] * v[1]) + (v[2] * v[2] + v[3] * v[3]); }
                ss += __shfl_xor(ss, 16); ss += __shfl_xor(ss, 32);
                if (fq == 0) atomicAdd(rowsq + row, ss); } } };
struct EpiQF { static constexpr bool PERM = true; bf16* q; const float* rowsq;
    __device__ __forceinline__ void operator()(const Acc& acc, const Unit& u, int wr, int wc, int fr, int fq) const {
        const int row0 = u.pm * BM + wr * 64 + fr, col0 = u.pn * BM + wc * 32 + 8 * fq;
#pragma unroll
        for (int ai = 0; ai < 2; ++ai)
#pragma unroll
            for (int m = 0; m < 4; ++m) { const int row = row0 + ai * HALF + m * 16; const float s = 0.0625f / sqrtf(rowsq[row] * (1.f / D) + EPS); bf16* rowp = q + (size_t)row * D + col0;
#pragma unroll
                for (int bj = 0; bj < 2; ++bj) *(u32x4*)(rowp + bj * HALF) = pack8(acc[ai][bj][m][0] * s, acc[ai][bj][m][1] * s); } } };
struct EpiResF { static constexpr bool PERM = false; const float* base; float* o;
    __device__ __forceinline__ void operator()(const Acc& acc, const Unit& u, int wr, int wc, int fr, int fq) const {
        const int row0 = u.pm * BM + wr * 64 + fr, col0 = u.pn * BM + wc * 32 + 4 * fq;
#pragma unroll
        for (int ai = 0; ai < 2; ++ai)
#pragma unroll
            for (int m = 0; m < 4; ++m) { const size_t off = (size_t)(row0 + ai * HALF + m * 16) * D + col0;
#pragma unroll
                for (int bj = 0; bj < 2; ++bj)
#pragma unroll
                    for (int n = 0; n < 2; ++n) { const size_t o2 = off + bj * HALF + n * 16; *(f32x4*)(o + o2) = *(const f32x4*)(base + o2) + acc[ai][bj][m][n]; } } } };
struct EpiUpF { static constexpr bool PERM = true; bf16* h; const float* b_gu;
    __device__ __forceinline__ void operator()(const Acc& acc, const Unit& u, int wr, int wc, int fr, int fq) const {
        const int row0 = u.pm * BM + wr * 64 + fr, ff0 = u.pn * HALF + wc * 32 + 8 * fq; const float* bb = b_gu + (size_t)u.e * 2 * DFF + ff0;
        const f32x4 bg0 = *(const f32x4*)bb, bg1 = *(const f32x4*)(bb + 4), bu0 = *(const f32x4*)(bb + DFF), bu1 = *(const f32x4*)(bb + DFF + 4);
#pragma unroll
        for (int ai = 0; ai < 2; ++ai)
#pragma unroll
            for (int m = 0; m < 4; ++m) { const f32x4 g0 = acc[ai][0][m][0] + bg0, g1 = acc[ai][0][m][1] + bg1, u0 = acc[ai][1][m][0] + bu0, u1 = acc[ai][1][m][1] + bu1; f32x4 r0, r1;
#pragma unroll
                for (int i = 0; i < 4; ++i) { r0[i] = swiglu(g0[i], u0[i]); r1[i] = swiglu(g1[i], u1[i]); }
                *(u32x4*)(h + (size_t)(row0 + ai * HALF + m * 16) * DFF + ff0) = pack8(r0, r1); } } };
struct EpiDnF { static constexpr bool PERM = true; bf16* y; const float* b_dn; const float* gs;
    __device__ __forceinline__ void operator()(const Acc& acc, const Unit& u, int wr, int wc, int fr, int fq) const {
        const int row0 = u.pm * BM + wr * 64 + fr, col0 = u.pn * BM + wc * 32 + 8 * fq; const float* bb = b_dn + (size_t)u.e * D + col0;
        f32x4 bv[2][2];
#pragma unroll
        for (int bj = 0; bj < 2; ++bj)
#pragma unroll
            for (int n = 0; n < 2; ++n) bv[bj][n] = *(const f32x4*)(bb + bj * HALF + 4 * n);
#pragma unroll
        for (int ai = 0; ai < 2; ++ai)
#pragma unroll
            for (int m = 0; m < 4; ++m) { const int row = row0 + ai * HALF + m * 16; const float g = gs[row]; bf16* rowp = y + (size_t)row * D + col0;
#pragma unroll
                for (int bj = 0; bj < 2; ++bj) *(u32x4*)(rowp + bj * HALF) = pack8((acc[ai][bj][m][0] + bv[bj][0]) * g, (acc[ai][bj][m][1] + bv[bj][1]) * g); } } };

template <class Epi, class Sched, bool ALIGN_EPI>
__device__ __forceinline__ void gemm_phase(LAS unsigned char* lds, const Gemm g, const Sched& S, const Epi& E) {
    const int tid = threadIdx.x, wid = __builtin_amdgcn_readfirstlane(tid >> 6), lane = tid & 63, wr = wid >> 2, wc = wid & 3, fr = lane & 15, fq = lane >> 4;
    const int K = g.K, nt = K / BK;
    unsigned voffA[2], voffB[2];
#pragma unroll
    for (int i = 0; i < 2; ++i) { int R, C; stage_rc(tid * 16 + i * 8192, R, C); const int Rb = Epi::PERM ? ((R & ~31) + perm32(R & 31)) : R;
        voffA[i] = (unsigned)(R * g.lda + C) * 2u; voffB[i] = (unsigned)(Rb * g.ldb + C) * 2u; }
    const size_t kstep = (size_t)(BK * 2);
    const size_t hstepA = (size_t)HALF * g.lda * 2, hstepB = (size_t)HALF * g.ldb * 2;
    const unsigned ldsw = (unsigned)wid * 1024u;
    const int aoff = lds_byte(wr * 64 + fr, fq * 8), boff = lds_byte(wc * 32 + fr, fq * 8);
#define PG_SA(b, h) (((b) * 2 + (h)) * HTB)
#define PG_SB(b, h) ((4 + (b) * 2 + (h)) * HTB)
#define PG_STAGE(bufoff, gbase, voff) do { _Pragma("unroll") for (int _i = 0; _i < 2; ++_i) \
        __builtin_amdgcn_global_load_lds((const unsigned*)((const char*)(gbase) + (voff)[_i]), (LAS unsigned*)(lds + (bufoff) + ldsw + _i * 8192), 16, 0, 0); } while (0)
#define PG_LDA(dst, b, h) do { _Pragma("unroll") for (int m = 0; m < 4; ++m) _Pragma("unroll") for (int k = 0; k < 2; ++k) dst[m][k] = *(const LAS bf16x8*)(lds + PG_SA(b, h) + aoff + m * 2048 + k * 1024); } while (0)
#define PG_LDB(dst, b, h) do { _Pragma("unroll") for (int n = 0; n < 2; ++n) _Pragma("unroll") for (int k = 0; k < 2; ++k) dst[n][k] = *(const LAS bf16x8*)(lds + PG_SB(b, h) + boff + n * 2048 + k * 1024); } while (0)
#define PG_MMA(ai, bj, At, Bt) do { __builtin_amdgcn_s_setprio(1); _Pragma("unroll") for (int m = 0; m < 4; ++m) _Pragma("unroll") for (int n = 0; n < 2; ++n) _Pragma("unroll") for (int k = 0; k < 2; ++k) \
        acc[ai][bj][m][n] = __builtin_amdgcn_mfma_f32_16x16x32_bf16(Bt[n][k], At[m][k], acc[ai][bj][m][n], 0, 0, 0); __builtin_amdgcn_s_setprio(0); } while (0)
#define PG_WAIT_V(n) asm volatile("s_waitcnt vmcnt(" #n ")" ::: "memory")
#define PG_WAIT_L(n) asm volatile("s_waitcnt lgkmcnt(" #n ")" ::: "memory")
#define PG_BAR __builtin_amdgcn_s_barrier()
#define PG_SCHED __builtin_amdgcn_sched_barrier(0)
    Unit cur, nxt; int ui = 0;
    if (!S.next(0, cur)) return;
    f32x4 acc[2][2][4][2];
#pragma unroll
    for (int a = 0; a < 2; ++a)
#pragma unroll
        for (int b = 0; b < 2; ++b)
#pragma unroll
            for (int m = 0; m < 4; ++m)
#pragma unroll
                for (int n = 0; n < 2; ++n) acc[a][b][m][n] = (f32x4){0.f, 0.f, 0.f, 0.f};
    bf16x8 At[4][2], B0[2][2], B1[2][2];
    const char* cA = cur.a; const char* cB = cur.b;
    PG_STAGE(PG_SB(0, 0), cB, voffB); PG_STAGE(PG_SB(0, 1), cB + hstepB, voffB); PG_STAGE(PG_SA(0, 0), cA, voffA); PG_STAGE(PG_SA(0, 1), cA + hstepA, voffA);
    if (wr == 1) PG_BAR;
    PG_WAIT_V(2); PG_BAR;
    PG_STAGE(PG_SB(1, 0), cB + kstep, voffB); PG_STAGE(PG_SA(1, 0), cA + kstep, voffA); PG_STAGE(PG_SB(1, 1), cB + hstepB + kstep, voffB);
    PG_WAIT_V(6); PG_BAR;
    for (;;) {
        const bool has_next = S.next(ui + 1, nxt);
        const char* nA = has_next ? nxt.a : cA; const char* nB = has_next ? nxt.b : cB;
        for (int t = 0; t < nt; t += 2) {
            const bool last = (t == nt - 2);
            const char* a1 = cA + (size_t)(t + 1) * kstep;
            const char* a2 = last ? nA : cA + (size_t)(t + 2) * kstep; const char* b2 = last ? nB : cB + (size_t)(t + 2) * kstep;
            const char* a3 = a2 + kstep; const char* b3 = b2 + kstep;
            PG_LDB(B0, 0, 0); PG_LDB(B1, 0, 1); PG_SCHED; PG_LDA(At, 0, 0); PG_STAGE(PG_SA(1, 1), a1 + hstepA, voffA);
            PG_WAIT_V(8); PG_WAIT_L(0); PG_BAR; PG_MMA(0, 0, At, B0); PG_MMA(0, 1, At, B1); PG_BAR; PG_SCHED;
            PG_LDA(At, 0, 1); PG_STAGE(PG_SB(0, 0), b2, voffB); PG_STAGE(PG_SB(0, 1), b2 + hstepB, voffB); PG_STAGE(PG_SA(0, 0), a2, voffA);
            PG_WAIT_V(8); PG_WAIT_L(0); PG_BAR; PG_MMA(1, 0, At, B0); PG_MMA(1, 1, At, B1); PG_BAR; PG_SCHED;
            PG_LDB(B0, 1, 0); PG_LDB(B1, 1, 1); PG_SCHED; PG_LDA(At, 1, 0); PG_STAGE(PG_SA(0, 1), a2 + hstepA, voffA);
            PG_WAIT_V(8); PG_WAIT_L(0); PG_BAR; PG_MMA(0, 0, At, B0); PG_MMA(0, 1, At, B1); PG_BAR; PG_SCHED;
            PG_LDA(At, 1, 1); PG_STAGE(PG_SB(1, 0), b3, voffB); PG_STAGE(PG_SB(1, 1), b3 + hstepB, voffB); PG_STAGE(PG_SA(1, 0), a3, voffA);
            PG_WAIT_V(8); PG_WAIT_L(0); PG_BAR; PG_MMA(1, 0, At, B0); PG_MMA(1, 1, At, B1); PG_BAR; PG_SCHED;
        }
        if constexpr (ALIGN_EPI) { if (wr == 0) PG_BAR; }
        E(acc, cur, wr, wc, fr, fq);
        if (!has_next) break;
#pragma unroll
        for (int a = 0; a < 2; ++a)
#pragma unroll
            for (int b = 0; b < 2; ++b)
#pragma unroll
                for (int m = 0; m < 4; ++m)
#pragma unroll
                    for (int n = 0; n < 2; ++n) acc[a][b][m][n] = (f32x4){0.f, 0.f, 0.f, 0.f};
        cur = nxt; cA = nA; cB = nB; ++ui;
        if constexpr (ALIGN_EPI) { if (wr == 1) PG_BAR; }
    }
    PG_WAIT_V(0);
    if constexpr (!ALIGN_EPI) { if (wr == 0) PG_BAR; }
    PG_BAR;
#undef PG_SA
#undef PG_SB
#undef PG_STAGE
#undef PG_LDA
#undef PG_LDB
#undef PG_MMA
#undef PG_WAIT_V
#undef PG_WAIT_L
#undef PG_BAR
#undef PG_SCHED
}
}

#define XB_TMO      128
#define XB_XCNT(j)  (256  + 64 * (j))
#define XB_XSUB(j)  (1280 + 64 * (j))
#define XB_XGEN(j)  (2304 + 64 * (j))
#define XB_TOP      3328
#define XB_TOPGEN   3392
#define XCD_BAR_WORDS 3456
#define XB_SPIN_CAP (1u << 18)
__device__ __forceinline__ unsigned xb_ld(unsigned* p)              { return __hip_atomic_load(p, __ATOMIC_RELAXED, __HIP_MEMORY_SCOPE_AGENT); }
__device__ __forceinline__ unsigned xb_add(unsigned* p, unsigned v) { return __hip_atomic_fetch_add(p, v, __ATOMIC_RELAXED, __HIP_MEMORY_SCOPE_AGENT); }
__device__ __forceinline__ unsigned xb_xcc_id() { return (unsigned)__builtin_amdgcn_s_getreg((3 << 11) | 20) & 0xFu; }
#define XB_SPIN(cond, bar) do { unsigned _sp = 0; while (cond) { __builtin_amdgcn_s_sleep(1); \
    if ((++_sp & 255u) == 0u) { if (xb_ld(&(bar)[XB_TMO])) break; if (_sp > XB_SPIN_CAP) { atomicAdd(&(bar)[XB_TMO], 1u); break; } } } } while (0)
struct XcdBarrier { unsigned* bar; unsigned x; volatile LAS unsigned* st; };
__device__ __forceinline__ XcdBarrier xcd_barrier_post(unsigned* bar, volatile LAS unsigned* st) {
    XcdBarrier b; b.bar = bar; b.x = xb_xcc_id(); b.st = st;
    if (threadIdx.x == 0) (void)xb_add(&bar[XB_XCNT(b.x)], 1u);
    return b;
}
__device__ __forceinline__ void xcd_barrier_complete(unsigned* bar, unsigned x, unsigned& nloc, unsigned& nx) {
    const unsigned G = gridDim.x * gridDim.y * gridDim.z;
    unsigned sum, cnt, mine, sp = 0u;
    for (;;) {
        sum = 0u; cnt = 0u; mine = 0u;
#pragma unroll
        for (unsigned j = 0; j < 16; ++j) { const unsigned c = xb_ld(&bar[XB_XCNT(j)]); sum += c; cnt += (c > 0u) ? 1u : 0u; mine = (j == x) ? c : mine; }
        if (sum == G) break;
        __builtin_amdgcn_s_sleep(1);
        if ((++sp & 255u) == 0u) { if (xb_ld(&bar[XB_TMO])) break; if (sp > XB_SPIN_CAP) { atomicAdd(&bar[XB_TMO], 1u); break; } }
    }
    nloc = mine > 0u ? mine : 1u; nx = cnt > 0u ? cnt : 1u;
}
__device__ __forceinline__ void xcd_barrier(const XcdBarrier& b) {
    asm volatile("s_waitcnt vmcnt(0)" ::: "memory");
    __syncthreads();
    if (threadIdx.x == 0) {
        unsigned* bar = b.bar;
        __builtin_amdgcn_s_waitcnt(0);
        unsigned nloc = b.st[0], nx = b.st[1];
        if (nloc == 0u) { xcd_barrier_complete(bar, b.x, nloc, nx); b.st[0] = nloc; b.st[1] = nx; }
        const unsigned old = xb_add(&bar[XB_XSUB(b.x)], 1u);
        const unsigned gen = old / nloc;
        if (old + 1u == (gen + 1u) * nloc) {
            __builtin_amdgcn_fence(__ATOMIC_RELEASE, "agent");
            asm volatile("s_waitcnt vmcnt(0)" ::: "memory");
            const unsigned og = xb_add(&bar[XB_TOP], 1u);
            const unsigned tg = og / nx;
            if (og + 1u == (tg + 1u) * nx) xb_add(&bar[XB_TOPGEN], 1u);
            else XB_SPIN(xb_ld(&bar[XB_TOPGEN]) == tg, bar);
            __builtin_amdgcn_fence(__ATOMIC_ACQUIRE, "agent");
            xb_add(&bar[XB_XGEN(b.x)], 1u);
            asm volatile("s_waitcnt vmcnt(0)" ::: "memory");
        } else {
            XB_SPIN(xb_ld(&bar[XB_XGEN(b.x)]) == gen, bar);
            __builtin_amdgcn_fence(__ATOMIC_ACQUIRE, "agent");
            asm volatile("s_waitcnt vmcnt(0)" ::: "memory");
        }
    }
    __syncthreads();
}

constexpr int LDS_BYTES = 147456, MISC_OFF = LDS_BYTES - 128;
constexpr int NPHASE = 16;
struct Args { const float* in[24]; float* out; unsigned char* ws; int ph_lo, ph_hi; };

__global__ void __launch_bounds__(NTHREADS, 2) mk_fwd(Args a) {
    extern __shared__ __attribute__((aligned(16))) unsigned char lds[];
    float* ldsf = (float*)lds;
    P p;
    p.x = a.in[0]; p.mem = a.in[1]; p.g_mix = a.in[2]; p.w_in = a.in[3]; p.w_pool = a.in[4]; p.pool_scale = a.in[5]; p.w_gate_up = a.in[6]; p.b_gate_up = a.in[7];
    p.gla_g = a.in[8]; p.w_out = a.in[9]; p.g_xattn = a.in[10]; p.g_mem = a.in[11]; p.w_xq = a.in[12]; p.w_xk = a.in[13]; p.w_xv = a.in[14]; p.w_xo = a.in[15];
    p.g_moe = a.in[16]; p.w_router = a.in[17]; p.b_router = a.in[18]; p.w_gu = a.in[19]; p.b_gu = a.in[20]; p.w_dn = a.in[21]; p.b_dn = a.in[22]; p.g_final = a.in[23];
    p.out = a.out; unsigned char* ws = a.ws; p.ctl = (unsigned*)(ws + WS_CTL);
    p.wt_in = (bf16*)(ws + WS_WT_IN); p.wt_out = (bf16*)(ws + WS_WT_OUT); p.wt_xq = (bf16*)(ws + WS_WT_XQ); p.wt_xk = (bf16*)(ws + WS_WT_XK); p.wt_xv = (bf16*)(ws + WS_WT_XV); p.wt_xo = (bf16*)(ws + WS_WT_XO);
    p.wt_gu = (bf16*)(ws + WS_WT_GU); p.wt_dn = (bf16*)(ws + WS_WT_DN);
    p.xn = (bf16*)(ws + WS_XN); p.hm = (bf16*)(ws + WS_HM); p.z1 = (bf16*)(ws + WS_Z1); p.mix = (bf16*)(ws + WS_MIX); p.a2 = (bf16*)(ws + WS_A2); p.kx = (bf16*)(ws + WS_KX); p.vxt = (bf16*)(ws + WS_VXT);
    p.qx = (bf16*)(ws + WS_QX); p.px = (bf16*)(ws + WS_PX); p.ox = (bf16*)(ws + WS_OX); p.xs = (bf16*)(ws + WS_XS); p.h = (bf16*)(ws + WS_H); p.y = (bf16*)(ws + WS_Y);
    p.sprev = (float*)(ws + WS_SPREV); p.ds = (float*)(ws + WS_DS); p.dec = (float*)(ws + WS_DEC); p.x1 = (float*)(ws + WS_X1); p.x2 = (float*)(ws + WS_X2); p.sc = (float*)(ws + WS_SC);
    p.rs2 = (float*)(ws + WS_RS2); p.topg = (float*)(ws + WS_TOPG); p.gslot = (float*)(ws + WS_GSLOT); p.topi = (int*)(ws + WS_TOPI); p.slotof = (int*)(ws + WS_SLOTOF); p.tilee = (int*)(ws + WS_TILEE);
    const int bid = blockIdx.x, nb = gridDim.x;
    const int lo = a.ph_lo, hi = a.ph_hi;
#ifndef PH
#define PH -1
#endif
#ifndef FASTMASK
#define FASTMASK 0xFF
#endif
#define IN(k) ((PH < 0 || PH == (k)) && lo <= (k) && (k) < hi)
    LAS unsigned char* ldsl = (LAS unsigned char*)lds;
    float* rowsq1 = (float*)(p.ctl + CW_ROWSQ1);
    volatile LAS unsigned* MISC = (volatile LAS unsigned*)(ldsl + MISC_OFF);
    if (threadIdx.x < 32) MISC[threadIdx.x] = 0u;
    __syncthreads();
    const bool fused = (hi - lo) > 1;
    XcdBarrier bar; bar.bar = p.ctl + CW_BAR; bar.x = 0; bar.st = MISC + 8;
    if (fused) bar = xcd_barrier_post(p.ctl + CW_BAR, MISC + 8);
#define SEAM(k) do { if (fused && IN(k) && IN((k) + 1)) xcd_barrier(bar); } while (0)
    if (IN(0)) phase_prologue(p, ldsf, bid, nb);
    SEAM(0);
    if (IN(1)) {
        if (FASTMASK & 1) { pg::SchedG1 S{(const char*)ws, nb, bid}; pg::EpiBf3 E{ws, WS_Z1, WS_KX, WS_VXT, NZ, D, BATCH * MEMLEN};
            pg::gemm_phase<pg::EpiBf3, pg::SchedG1, true>(ldsl, pg::Gemm{D, D, D}, S, E); }
        else {
        ngemm(NG{p.xn, D, p.wt_in, D, M, NZ, D, nullptr, 0}, EpiBf{p.z1, NZ}, ldsf, bid, nb);
        ngemm(NG{p.hm, D, p.wt_xk, D, BATCH * MEMLEN, D, D, nullptr, 0}, EpiBf{p.kx, D}, ldsf, bid, nb);
        ngemm(NG{p.wt_xv, D, p.hm, D, D, BATCH * MEMLEN, D, nullptr, 0}, EpiBf{p.vxt, BATCH * MEMLEN}, ldsf, bid, nb); }
    }
    SEAM(1);
    if (IN(2)) { phase_pool(p, ldsf, bid, nb); phase_gla_a(p, ldsf, bid, nb); }
    SEAM(2);
    if (IN(3)) phase_scan(p, bid, nb);
    SEAM(3);
    if (IN(4)) phase_gla_b(p, ldsf, bid, nb);
    SEAM(4);
    if (IN(5)) {
        if (FASTMASK & 2) { pg::Sched2D S{p.mix, p.wt_out, D, D, M / 256, D / 256, nb, bid}; pg::EpiOutF E{p.x, p.x1, p.a2, p.g_xattn, rowsq1};
            pg::gemm_phase<pg::EpiOutF, pg::Sched2D, false>(ldsl, pg::Gemm{D, D, D}, S, E); }
        else ngemm(NG{p.mix, D, p.wt_out, D, M, D, D, nullptr, 0}, EpiOut{p.x, p.x1, p.a2, p.g_xattn, rowsq1}, ldsf, bid, nb);
    }
    SEAM(5);
    if (IN(6)) {
        if (FASTMASK & 4) { pg::Sched2D S{p.a2, p.wt_xq, D, D, M / 256, D / 256, nb, bid}; pg::EpiQF E{p.qx, rowsq1};
            pg::gemm_phase<pg::EpiQF, pg::Sched2D, false>(ldsl, pg::Gemm{D, D, D}, S, E); }
        else ngemm(NG{p.a2, D, p.wt_xq, D, M, D, D, nullptr, 0}, EpiQ{p.qx, rowsq1}, ldsf, bid, nb);
    }
    SEAM(6);
    if (IN(7)) {
        if (FASTMASK & 8) { pg::SchedAttn S{p.qx, p.kx, (size_t)MEMLEN * D, 256, nb, bid}; pg::EpiF E{p.sc, D};
            pg::gemm_phase<pg::EpiF, pg::SchedAttn, false>(ldsl, pg::Gemm{D, D, 256}, S, E); }
        else for (int bh = 0; bh < 8; ++bh) { const int b = bh >> 2, h = bh & 3; const size_t o = (size_t)b * SEQ * D + h * 256;
            ngemm(NG{p.qx + o, D, p.kx + (size_t)b * MEMLEN * D + h * 256, D, SEQ, 256, 256, nullptr, 0}, EpiF32{p.sc + o, D}, ldsf, bid, nb); }
    }
    SEAM(7);
    if (IN(8)) phase_softmax(p, bid, nb);
    SEAM(8);
    if (IN(9)) {
        if (FASTMASK & 16) { pg::SchedAttn S{p.px, p.vxt, (size_t)MEMLEN, (size_t)256 * BATCH * MEMLEN, nb, bid}; pg::EpiBf3 E{ws, WS_OX, WS_OX, WS_OX, D, D, D};
            pg::gemm_phase<pg::EpiBf3, pg::SchedAttn, false>(ldsl, pg::Gemm{D, BATCH * MEMLEN, 256}, S, E); }
        else for (int bh = 0; bh < 8; ++bh) { const int b = bh >> 2, h = bh & 3; const size_t o = (size_t)b * SEQ * D + h * 256;
            ngemm(NG{p.px + o, D, p.vxt + (size_t)h * 256 * (BATCH * MEMLEN) + b * MEMLEN, BATCH * MEMLEN, SEQ, 256, 256, nullptr, 0}, EpiBf{p.ox + o, D}, ldsf, bid, nb); }
    }
    SEAM(9);
    if (IN(10)) {
        if (FASTMASK & 32) { pg::Sched2D S{p.ox, p.wt_xo, D, D, M / 256, D / 256, nb, bid}; pg::EpiResF E{p.x1, p.x2};
            pg::gemm_phase<pg::EpiResF, pg::Sched2D, false>(ldsl, pg::Gemm{D, D, D}, S, E); }
        else ngemm(NG{p.ox, D, p.wt_xo, D, M, D, D, nullptr, 0}, EpiRes{p.x1, p.x2}, ldsf, bid, nb);
    }
    SEAM(10);
    if (IN(11)) phase_router(p, ldsf, bid, nb);
    SEAM(11);
    if (IN(12)) phase_dispatch(p, (int*)lds, bid, nb);
    SEAM(12);
    if (IN(13)) { const int nmt = p.tilee[MAXMT];
        if (FASTMASK & 64) { pg::SchedMoE S{p.xs, p.wt_gu, p.tilee, (size_t)2 * DFF * D, nmt, 8, nb, bid}; pg::EpiUpF E{p.h, p.b_gu};
            pg::gemm_phase<pg::EpiUpF, pg::SchedMoE, true>(ldsl, pg::Gemm{D, D, D}, S, E); }
        else ngemm(NG{p.xs, D, p.wt_gu, D, nmt * 256, 2 * DFF, D, p.tilee, (size_t)2 * DFF * D}, EpiUp{p.h, p.b_gu}, ldsf, bid, nb); }
    SEAM(13);
    if (IN(14)) { const int nmt = p.tilee[MAXMT];
        if (FASTMASK & 128) { pg::SchedMoE S{p.h, p.wt_dn, p.tilee, (size_t)D * DFF, nmt, 4, nb, bid}; pg::EpiDnF E{p.y, p.b_dn, p.gslot};
            pg::gemm_phase<pg::EpiDnF, pg::SchedMoE, true>(ldsl, pg::Gemm{DFF, DFF, DFF}, S, E); }
        else ngemm(NG{p.h, DFF, p.wt_dn, DFF, nmt * 256, D, DFF, p.tilee, (size_t)D * DFF}, EpiDn{p.y, p.b_dn, p.gslot}, ldsf, bid, nb); }
    SEAM(14);
    if (IN(15)) phase_final(p, bid, nb);
#undef IN
#undef SEAM
}

extern "C" void kernel_launch(void* const* d_in, const int* in_sizes, int n_in, void* d_out, int out_size, void* d_ws, size_t ws_size, hipStream_t stream) {
    static int grid = 0;
    if (grid == 0) {
        if (n_in != 24 || in_sizes[0] != M * D || out_size != M * D || ws_size < WS_END) { fprintf(stderr, "kernel_launch: unexpected shapes (n_in %d, in0 %d, out %d, ws %zu)\n", n_in, n_in > 0 ? in_sizes[0] : -1, out_size, ws_size); grid = -1; return; }
        int dev = 0, cus = 0;
        if (hipGetDevice(&dev) != hipSuccess || hipDeviceGetAttribute(&cus, hipDeviceAttributeMultiprocessorCount, dev) != hipSuccess) { grid = -1; return; }
        if (hipFuncSetAttribute((const void*)mk_fwd, hipFuncAttributeMaxDynamicSharedMemorySize, LDS_BYTES) != hipSuccess) { fprintf(stderr, "kernel_launch: hipFuncSetAttribute failed\n"); grid = -1; return; }
        grid = cus > 0 ? cus : 256;
    }
    if (grid < 0) return;
    (void)hipMemsetAsync((char*)d_ws + WS_CTL, 0, CTL_BYTES, stream);
    Args a{};
    for (int i = 0; i < 24; ++i) a.in[i] = (const float*)d_in[i];
    a.out = (float*)d_out; a.ws = (unsigned char*)d_ws;
#if defined(MK_PER_PHASE)
    for (int ph = 0; ph < NPHASE; ++ph) { a.ph_lo = ph; a.ph_hi = ph + 1; hipLaunchKernelGGL(mk_fwd, dim3(grid), dim3(NTHREADS), LDS_BYTES, stream, a); }
#else
    a.ph_lo = 0; a.ph_hi = NPHASE; hipLaunchKernelGGL(mk_fwd, dim3(grid), dim3(NTHREADS), LDS_BYTES, stream, a);
#endif
}
```

```cpp
#include <hip/hip_runtime.h>
#include <cstdio>
#include <cstdint>

#define LAS __attribute__((address_space(3)))
typedef unsigned short bf16;
typedef float f32x4 __attribute__((ext_vector_type(4)));
typedef unsigned u32x4 __attribute__((ext_vector_type(4)));
typedef unsigned u32x2 __attribute__((ext_vector_type(2)));

constexpr int BATCH = 2, SEQ = 8192, M = BATCH * SEQ, D = 1024;
constexpr int IN_COLS = 2064, NZ = 2304;
constexpr int ZQ = 512, ZK = 768, ZV = 1024, ZR = 1536, ZG = 2048;
constexpr int NE = 32, TOPK = 4, DFF = 1024, MEMLEN = 256;
constexpr int NASSIGN = M * TOPK, MAXSLOT = NASSIGN + NE * 256, MAXMT = MAXSLOT / 256;
constexpr int NCHUNK = SEQ / 64;
constexpr float EPS = 1e-6f;
constexpr int NTHREADS = 512, NWAVES = 8;

constexpr size_t MiB = 1u << 20;
constexpr size_t WS_CTL = 0, CTL_BYTES = 1 * MiB;
constexpr size_t WS_WT_OUT = 2 * MiB, WS_WT_XQ = 4 * MiB, WS_WT_XK = 6 * MiB, WS_WT_XV = 8 * MiB, WS_WT_XO = 10 * MiB, WS_WT_IN = 12 * MiB;
constexpr size_t WS_SMALL = 17 * MiB;
constexpr size_t WS_RS2 = WS_SMALL, WS_TOPI = WS_SMALL + 64 * 1024, WS_TOPG = WS_TOPI + 256 * 1024, WS_SLOTOF = WS_TOPG + 256 * 1024,
                 WS_GSLOT = WS_SLOTOF + 256 * 1024, WS_TILEE = WS_GSLOT + 320 * 1024, WS_BLKCNT = WS_TILEE + 4096, WS_WAVEBASE = WS_BLKCNT + 32768;
constexpr size_t WS_WT_GU = 20 * MiB, WS_WT_DN = 148 * MiB, WS_X2 = 212 * MiB, WS_B = 276 * MiB;
constexpr size_t WS_XN = WS_B, WS_HM = WS_B + 32 * MiB, WS_Z1 = WS_B + 33 * MiB, WS_MIX = WS_B + 121 * MiB, WS_SPREV = WS_B + 153 * MiB,
                 WS_DS = WS_B + 185 * MiB, WS_DEC = WS_B + 217 * MiB, WS_X1 = WS_B + 218 * MiB, WS_A2 = WS_B + 282 * MiB, WS_KX = WS_B + 314 * MiB, WS_VXT = WS_B + 315 * MiB;
constexpr size_t WS_QX = WS_Z1, WS_PX = WS_Z1 + 32 * MiB, WS_SC = WS_MIX, WS_OX = WS_DS;
constexpr size_t WS_XS = WS_B, WS_H = WS_B + 144 * MiB, WS_Y = WS_B + 288 * MiB, WS_END = WS_B + 432 * MiB;
constexpr int CW_BAR = 4096, CW_COUNT = 8192, CW_CURSOR = 8256, CW_ROWSQ1 = 16384;

__device__ __forceinline__ float bf_lo(unsigned w) { return __uint_as_float(w << 16); }
__device__ __forceinline__ float bf_hi(unsigned w) { return __uint_as_float(w & 0xffff0000u); }
__device__ __forceinline__ float bf2f(bf16 v) { return __uint_as_float((unsigned)v << 16); }
__device__ __forceinline__ unsigned f2bf(float f) { unsigned u = __float_as_uint(f); return (u + 0x7fffu + ((u >> 16) & 1u)) >> 16; }
__device__ __forceinline__ unsigned pk2(float lo, float hi) { return f2bf(lo) | (f2bf(hi) << 16); }
__device__ __forceinline__ float wave_sum(float v) {
#pragma unroll
    for (int o = 1; o < 64; o <<= 1) v += __shfl_xor(v, o);
    return v;
}
__device__ __forceinline__ float logsigmoid(float x) { return fminf(x, 0.f) - log1pf(expf(-fabsf(x))); }

struct P {
    const float *x, *mem, *g_mix, *w_in, *w_pool, *pool_scale, *w_gate_up, *b_gate_up, *gla_g, *w_out, *g_xattn, *g_mem, *w_xq, *w_xk, *w_xv, *w_xo,
                *g_moe, *w_router, *b_router, *w_gu, *b_gu, *w_dn, *b_dn, *g_final;
    float* out;
    unsigned* ctl;
    bf16 *wt_in, *wt_out, *wt_xq, *wt_xk, *wt_xv, *wt_xo, *wt_gu, *wt_dn;
    bf16 *xn, *hm, *z1, *mix, *a2, *kx, *vxt, *qx, *px, *ox, *xs, *h, *y;
    float *sprev, *ds, *dec, *x1, *x2, *sc, *rs2, *topg, *gslot;
    int *topi, *slotof, *tilee;
};

struct MapId { __device__ __forceinline__ int operator()(int n) const { return n; } };
struct MapIn { __device__ __forceinline__ int operator()(int n) const { return n < 1536 ? n : (n < 2048 ? 1552 + (n - 1536) : (n < 2064 ? 1536 + (n - 2048) : -1)); } };
struct MapGu { __device__ __forceinline__ int operator()(int n) const { const int pn = n >> 8, w = n & 255; return w < 128 ? pn * 128 + w : 1024 + pn * 128 + (w - 128); } };

template <class Map>
__device__ __forceinline__ void transpose_item(const float* W, int ldw, int K, bf16* WT, float* scr, int kb, int nb, int lane, Map map) {
    const int k0 = 64 * kb, n0 = 32 * nb;
    const int sc = map(n0 + (lane & 31));
#pragma unroll 8
    for (int i = 0; i < 32; ++i) { const int kk = 2 * i + (lane >> 5); scr[kk * 33 + (lane & 31)] = sc >= 0 ? W[(size_t)(k0 + kk) * ldw + sc] : 0.f; }
    __builtin_amdgcn_s_waitcnt(0xC07F); asm volatile("" ::: "memory");
    const int c = lane & 7;
#pragma unroll
    for (int j = 0; j < 4; ++j) { const int n = (lane >> 3) + 8 * j; const float* s = scr + (8 * c) * 33 + n;
        u32x4 o; o.x = pk2(s[0 * 33], s[1 * 33]); o.y = pk2(s[2 * 33], s[3 * 33]); o.z = pk2(s[4 * 33], s[5 * 33]); o.w = pk2(s[6 * 33], s[7 * 33]);
        *(u32x4*)(WT + (size_t)(n0 + n) * K + k0 + 8 * c) = o; }
    __builtin_amdgcn_s_waitcnt(0xC07F); asm volatile("" ::: "memory");
}
__device__ __forceinline__ void rms_row_bf16(const float* xrow, const float* g, bf16* orow, int lane) {
    const f32x4* xr = (const f32x4*)xrow + lane; f32x4 v[4]; float s = 0.f;
#pragma unroll
    for (int j = 0; j < 4; ++j) { v[j] = xr[64 * j]; s += (v[j].x * v[j].x + v[j].y * v[j].y) + (v[j].z * v[j].z + v[j].w * v[j].w); }
    const float rs = 1.0f / sqrtf(wave_sum(s) * (1.f / D) + EPS);
    u32x2* o8 = (u32x2*)orow + lane; const f32x4* gr = (const f32x4*)g + lane;
#pragma unroll
    for (int j = 0; j < 4; ++j) { const f32x4 gg = gr[64 * j]; u32x2 w; w.x = pk2(v[j].x * rs * gg.x, v[j].y * rs * gg.y); w.y = pk2(v[j].z * rs * gg.z, v[j].w * rs * gg.w); o8[64 * j] = w; }
}
__device__ __forceinline__ void phase_prologue(const P& p, float* ldsf, int bid, int nb) {
    const int tid = threadIdx.x, lane = tid & 63, wave = tid >> 6;
    float* scr = ldsf + wave * (64 * 33 + 32);
    const int gw = bid * NWAVES + wave, NGW = nb * NWAVES;
    constexpr int I_IN = 16 * (NZ / 32), I_SQ = 16 * 32, I_GU = 16 * 64, I_DN = 16 * 32;
    constexpr int NITEMS = I_IN + 5 * I_SQ + NE * I_GU + NE * I_DN;
    for (int it = gw; it < NITEMS; it += NGW) {
        int r = it;
        if (r < I_IN) { transpose_item(p.w_in, IN_COLS, D, p.wt_in, scr, r / (NZ / 32), r % (NZ / 32), lane, MapIn()); continue; } r -= I_IN;
        if (r < 5 * I_SQ) { const int w = r / I_SQ, q = r % I_SQ; const float* src = w == 0 ? p.w_out : w == 1 ? p.w_xq : w == 2 ? p.w_xk : w == 3 ? p.w_xv : p.w_xo;
            bf16* dst = w == 0 ? p.wt_out : w == 1 ? p.wt_xq : w == 2 ? p.wt_xk : w == 3 ? p.wt_xv : p.wt_xo;
            transpose_item(src, D, D, dst, scr, q / 32, q % 32, lane, MapId()); continue; } r -= 5 * I_SQ;
        if (r < NE * I_GU) { const int e = r / I_GU, q = r % I_GU; transpose_item(p.w_gu + (size_t)e * D * 2 * DFF, 2 * DFF, D, p.wt_gu + (size_t)e * 2 * DFF * D, scr, q / 64, q % 64, lane, MapGu()); continue; } r -= NE * I_GU;
        { const int e = r / I_DN, q = r % I_DN; transpose_item(p.w_dn + (size_t)e * DFF * D, D, DFF, p.wt_dn + (size_t)e * D * DFF, scr, q / 32, q % 32, lane, MapId()); }
    }
    for (int m = gw; m < M; m += NGW) rms_row_bf16(p.x + (size_t)m * D, p.g_mix, p.xn + (size_t)m * D, lane);
    for (int m = gw; m < BATCH * MEMLEN; m += NGW) rms_row_bf16(p.mem + (size_t)m * D, p.g_mem, p.hm + (size_t)m * D, lane);
}

struct NG { const bf16* A; int lda; const bf16* Bt; int ldb; int Mr, N, K; const int* tile_e; size_t sBe; };
template <class Epi>
__device__ __forceinline__ void ngemm(const NG g, const Epi& E, float* lds, int bid, int nb) {
    float* As = lds; float* Bs = lds + 32 * 128;
    const int tid = threadIdx.x, tr = tid >> 4, tc = tid & 15;
    const int nMt = g.Mr / 128, nNt = g.N / 256;
    for (int u = bid; u < nMt * nNt; u += nb) {
        const int mt = u / nNt, nt = u % nNt, row0 = mt * 128, col0 = nt * 256;
        int e = 0; const bf16* Bt = g.Bt;
        if (g.tile_e) { e = g.tile_e[row0 >> 8]; Bt += (size_t)e * g.sBe; }
        float acc[4][16];
#pragma unroll
        for (int i = 0; i < 4; ++i)
#pragma unroll
            for (int j = 0; j < 16; ++j) acc[i][j] = 0.f;
        for (int k0 = 0; k0 < g.K; k0 += 32) {
            __syncthreads();
            { const int r = tid >> 2, kk = (tid & 3) * 8;
              const u32x4 v = *(const u32x4*)(g.A + (size_t)(row0 + r) * g.lda + k0 + kk);
              As[(kk + 0) * 128 + r] = bf_lo(v.x); As[(kk + 1) * 128 + r] = bf_hi(v.x); As[(kk + 2) * 128 + r] = bf_lo(v.y); As[(kk + 3) * 128 + r] = bf_hi(v.y);
              As[(kk + 4) * 128 + r] = bf_lo(v.z); As[(kk + 5) * 128 + r] = bf_hi(v.z); As[(kk + 6) * 128 + r] = bf_lo(v.w); As[(kk + 7) * 128 + r] = bf_hi(v.w);
#pragma unroll
              for (int h = 0; h < 2; ++h) { const int rb = r + 128 * h;
                const u32x4 w = *(const u32x4*)(Bt + (size_t)(col0 + rb) * g.ldb + k0 + kk);
                Bs[(kk + 0) * 256 + rb] = bf_lo(w.x); Bs[(kk + 1) * 256 + rb] = bf_hi(w.x); Bs[(kk + 2) * 256 + rb] = bf_lo(w.y); Bs[(kk + 3) * 256 + rb] = bf_hi(w.y);
                Bs[(kk + 4) * 256 + rb] = bf_lo(w.z); Bs[(kk + 5) * 256 + rb] = bf_hi(w.z); Bs[(kk + 6) * 256 + rb] = bf_lo(w.w); Bs[(kk + 7) * 256 + rb] = bf_hi(w.w); } }
            __syncthreads();
#pragma unroll 4
            for (int k = 0; k < 32; ++k) {
                const f32x4 a = *(const f32x4*)&As[k * 128 + 4 * tr];
                const f32x4 b0 = *(const f32x4*)&Bs[k * 256 + tc * 8], b1 = *(const f32x4*)&Bs[k * 256 + tc * 8 + 4];
                const f32x4 b2 = *(const f32x4*)&Bs[k * 256 + 128 + tc * 8], b3 = *(const f32x4*)&Bs[k * 256 + 128 + tc * 8 + 4];
#pragma unroll
                for (int i = 0; i < 4; ++i) {
#pragma unroll
                    for (int j = 0; j < 4; ++j) { acc[i][j] += a[i] * b0[j]; acc[i][4 + j] += a[i] * b1[j]; acc[i][8 + j] += a[i] * b2[j]; acc[i][12 + j] += a[i] * b3[j]; }
                }
            }
        }
#pragma unroll
        for (int i = 0; i < 4; ++i)
#pragma unroll
            for (int j = 0; j < 8; ++j) E(e, row0 + 4 * tr + i, col0 + tc * 8 + j, acc[i][j], acc[i][8 + j]);
    }
}
struct EpiBf { bf16* C; int ldc; __device__ __forceinline__ void operator()(int, int r, int c, float a, float b) const { C[(size_t)r * ldc + c] = (bf16)f2bf(a); C[(size_t)r * ldc + c + 128] = (bf16)f2bf(b); } };
struct EpiF32 { float* C; int ldc; __device__ __forceinline__ void operator()(int, int r, int c, float a, float b) const { C[(size_t)r * ldc + c] = a; C[(size_t)r * ldc + c + 128] = b; } };
struct EpiOut { const float* x; float* x1; bf16* a2; const float* g; float* rowsq;
    __device__ __forceinline__ void one(int r, int c, float a) const { const size_t o = (size_t)r * D + c; const float v = x[o] + a; x1[o] = v; a2[o] = (bf16)f2bf(v * g[c]); atomicAdd(rowsq + r, v * v); }
    __device__ __forceinline__ void operator()(int, int r, int c, float a, float b) const { one(r, c, a); one(r, c + 128, b); } };
struct EpiQ { bf16* q; const float* rowsq;
    __device__ __forceinline__ void operator()(int, int r, int c, float a, float b) const { const float s = 0.0625f / sqrtf(rowsq[r] * (1.f / D) + EPS); q[(size_t)r * D + c] = (bf16)f2bf(a * s); q[(size_t)r * D + c + 128] = (bf16)f2bf(b * s); } };
struct EpiRes { const float* base; float* o; __device__ __forceinline__ void operator()(int, int r, int c, float a, float b) const { const size_t i = (size_t)r * D + c; o[i] = base[i] + a; o[i + 128] = base[i + 128] + b; } };
__device__ __forceinline__ float swiglu(float g, float u) { g = fminf(g, 7.f); u = fminf(fmaxf(u, -7.f), 7.f); return g * (1.f / (1.f + expf(-1.702f * g))) * (u + 1.f); }
struct EpiUp { bf16* h; const float* b_gu;
    __device__ __forceinline__ void operator()(int e, int r, int c, float a, float b) const { const int ff = (c >> 8) * 128 + (c & 127); const float* bb = b_gu + (size_t)e * 2 * DFF;
        h[(size_t)r * DFF + ff] = (bf16)f2bf(swiglu(a + bb[ff], b + bb[DFF + ff])); } };
struct EpiDn { bf16* y; const float* b_dn; const float* gs;
    __device__ __forceinline__ void operator()(int e, int r, int c, float a, float b) const { const float g = gs[r]; const float* bb = b_dn + (size_t)e * D;
        y[(size_t)r * D + c] = (bf16)f2bf(g * (a + bb[c])); y[(size_t)r * D + c + 128] = (bf16)f2bf(g * (b + bb[c + 128])); } };

__device__ __forceinline__ void phase_pool(const P& p, float* lds, int bid, int nb) {
    float* pt = lds;
    float* wp = lds + 64 * 129;
    const int tid = threadIdx.x;
    for (int u = bid; u < (M / 64) * 4; u += nb) {
        const int g = u & 3, tt = u >> 2, t0 = tt * 64, w = 2 << g;
        __syncthreads();
        for (int i = tid; i < 128 * 128; i += NTHREADS) wp[i] = p.w_pool[(size_t)g * 128 * 128 + i];
        { const int i = tid >> 3, c0 = (tid & 7) * 16, t = t0 + i, s = t & (SEQ - 1);
          const int cnt = (s + 1 < w) ? s + 1 : w;
          float acc[16];
#pragma unroll
          for (int c = 0; c < 16; ++c) acc[c] = 0.f;
          for (int d = 0; d < cnt; ++d) { const bf16* up = p.z1 + (size_t)(t - d) * NZ + g * 128 + c0;
#pragma unroll
              for (int c = 0; c < 16; ++c) acc[c] += bf2f(up[c]); }
          const bf16* u0 = p.z1 + (size_t)t * NZ + g * 128 + c0; const float inv = 1.f / (float)cnt;
#pragma unroll
          for (int c = 0; c < 16; ++c) pt[i * 129 + c0 + c] = acc[c] * inv - bf2f(u0[c]); }
        __syncthreads();
        { const int i = tid >> 3, d0 = (tid & 7) * 16; float acc[16];
#pragma unroll
          for (int c = 0; c < 16; ++c) acc[c] = 0.f;
          for (int c = 0; c < 128; ++c) { const float pv = pt[i * 129 + c];
#pragma unroll
              for (int d = 0; d < 16; ++d) acc[d] += pv * wp[c * 128 + d0 + d]; }
          bf16* o = p.mix + (size_t)(t0 + i) * D + g * 128 + d0;
#pragma unroll
          for (int d = 0; d < 16; ++d) o[d] = (bf16)f2bf(acc[d] * p.pool_scale[g * 128 + d0 + d]); }
    }
}

__device__ __forceinline__ void gla_gc(const P& p, float* glr, float* wgu, float* gc, int b, int h, int n) {
    const int tid = threadIdx.x, t0 = b * SEQ + n * 64;
    __syncthreads();
    for (int i = tid; i < 64 * 16; i += NTHREADS) glr[i] = bf2f(p.z1[(size_t)(t0 + (i >> 4)) * NZ + ZG + (i & 15)]);
    for (int i = tid; i < 16 * 64; i += NTHREADS) wgu[i] = p.w_gate_up[(i >> 6) * 256 + h * 64 + (i & 63)];
    __syncthreads();
    for (int idx = tid; idx < 64 * 64; idx += NTHREADS) { const int i = idx >> 6, d = idx & 63; float s = p.b_gate_up[h * 64 + d];
#pragma unroll
        for (int r = 0; r < 16; ++r) s += glr[i * 16 + r] * wgu[r * 64 + d];
        gc[i * 65 + d] = logsigmoid(s) * (1.f / 16.f); }
    __syncthreads();
    if (tid < 64) { float run = 0.f; for (int i = 0; i < 64; ++i) { run += gc[i * 65 + tid]; gc[i * 65 + tid] = run; } }
    __syncthreads();
}
__device__ __forceinline__ void phase_gla_a(const P& p, float* lds, int bid, int nb) {
    float* glr = lds; float* wgu = lds + 1024; float* gc = lds + 2048; float* kd = gc + 64 * 65; float* vv = kd + 64 * 65;
    const int tid = threadIdx.x;
    for (int u = bid; u < 8 * NCHUNK; u += nb) {
        const int bh = u / NCHUNK, n = u % NCHUNK, b = bh >> 2, h = bh & 3, t0 = b * SEQ + n * 64;
        gla_gc(p, glr, wgu, gc, b, h, n);
        for (int idx = tid; idx < 64 * 64; idx += NTHREADS) { const int j = idx >> 6, d = idx & 63;
            kd[j * 65 + d] = bf2f(p.z1[(size_t)(t0 + j) * NZ + ZK + h * 64 + d]) * expf(gc[63 * 65 + d] - gc[j * 65 + d]); }
        for (int idx = tid; idx < 64 * 128; idx += NTHREADS) { const int j = idx >> 7, e = idx & 127; vv[idx] = bf2f(p.z1[(size_t)(t0 + j) * NZ + ZV + h * 128 + e]); }
        __syncthreads();
        { const int d = tid >> 3, e0 = (tid & 7) * 16; float acc[16];
#pragma unroll
          for (int e = 0; e < 16; ++e) acc[e] = 0.f;
          for (int j = 0; j < 64; ++j) { const float kv = kd[j * 65 + d];
#pragma unroll
              for (int e = 0; e < 16; ++e) acc[e] += kv * vv[j * 128 + e0 + e]; }
          float* o = p.ds + ((size_t)u * 64 + d) * 128 + e0;
#pragma unroll
          for (int e = 0; e < 16; ++e) o[e] = acc[e]; }
        if (tid < 64) p.dec[(size_t)u * 64 + tid] = expf(gc[63 * 65 + tid]);
    }
}
__device__ __forceinline__ void phase_scan(const P& p, int bid, int nb) {
    for (int idx = bid * NTHREADS + threadIdx.x; idx < 8 * 64 * 128; idx += nb * NTHREADS) {
        const int bh = idx >> 13, de = idx & 8191, d = de >> 7;
        float st = 0.f;
        for (int n = 0; n < NCHUNK; ++n) { const size_t u = (size_t)bh * NCHUNK + n;
            p.sprev[u * 8192 + de] = st; st = p.dec[u * 64 + d] * st + p.ds[u * 8192 + de]; }
    }
}
__device__ __forceinline__ void phase_gla_b(const P& p, float* lds, int bid, int nb) {
    float* glr = lds; float* wgu = lds + 1024; float* gc = lds + 2048; float* qe = gc + 64 * 65; float* ke = qe + 64 * 65; float* vv = ke + 64 * 65; float* sp = vv + 64 * 128;
    float* att = gc;
    const int tid = threadIdx.x;
    for (int u = bid; u < 8 * NCHUNK; u += nb) {
        const int bh = u / NCHUNK, n = u % NCHUNK, b = bh >> 2, h = bh & 3, t0 = b * SEQ + n * 64;
        gla_gc(p, glr, wgu, gc, b, h, n);
        for (int idx = tid; idx < 64 * 64; idx += NTHREADS) { const int i = idx >> 6, d = idx & 63; const float g = gc[i * 65 + d];
            qe[i * 65 + d] = bf2f(p.z1[(size_t)(t0 + i) * NZ + ZQ + h * 64 + d]) * 0.125f * expf(g);
            ke[i * 65 + d] = bf2f(p.z1[(size_t)(t0 + i) * NZ + ZK + h * 64 + d]) * expf(-g); }
        for (int idx = tid; idx < 64 * 128; idx += NTHREADS) { const int j = idx >> 7, e = idx & 127; vv[idx] = bf2f(p.z1[(size_t)(t0 + j) * NZ + ZV + h * 128 + e]); sp[idx] = p.sprev[(size_t)u * 8192 + idx]; }
        __syncthreads();
        { const int i = tid >> 3, j0 = (tid & 7) * 8; float a[8];
#pragma unroll
          for (int j = 0; j < 8; ++j) a[j] = 0.f;
          for (int d = 0; d < 64; ++d) { const float qv = qe[i * 65 + d];
#pragma unroll
              for (int j = 0; j < 8; ++j) a[j] += qv * ke[(j0 + j) * 65 + d]; }
#pragma unroll
          for (int j = 0; j < 8; ++j) att[i * 65 + j0 + j] = (j0 + j <= i) ? a[j] : 0.f; }
        __syncthreads();
        { const int i = tid >> 3, e0 = (tid & 7) * 16; float o[16];
#pragma unroll
          for (int e = 0; e < 16; ++e) o[e] = 0.f;
          for (int j = 0; j < 64; ++j) { const float av = att[i * 65 + j];
#pragma unroll
              for (int e = 0; e < 16; ++e) o[e] += av * vv[j * 128 + e0 + e]; }
          for (int d = 0; d < 64; ++d) { const float qv = qe[i * 65 + d];
#pragma unroll
              for (int e = 0; e < 16; ++e) o[e] += qv * sp[d * 128 + e0 + e]; }
          float ss = 0.f;
#pragma unroll
          for (int e = 0; e < 16; ++e) ss += o[e] * o[e];
          ss += __shfl_xor(ss, 1); ss += __shfl_xor(ss, 2); ss += __shfl_xor(ss, 4);
          const float rs = 1.0f / sqrtf(ss * (1.f / 128.f) + EPS);
          const bf16* rp = p.z1 + (size_t)(t0 + i) * NZ + ZR + h * 128 + e0; bf16* op = p.mix + (size_t)(t0 + i) * D + 512 + h * 128 + e0;
#pragma unroll
          for (int e = 0; e < 16; ++e) { const float r = bf2f(rp[e]); const float sl = r / (1.f + expf(-r)); op[e] = (bf16)f2bf(o[e] * rs * p.gla_g[e0 + e] * sl); } }
    }
}

__device__ __forceinline__ void phase_softmax(const P& p, int bid, int nb) {
    const int lane = threadIdx.x & 63, gw = bid * NWAVES + (threadIdx.x >> 6), NGW = nb * NWAVES;
    for (int it = gw; it < M * 4; it += NGW) {
        const f32x4 v = *((const f32x4*)(p.sc + (size_t)it * 256) + lane);
        float m = fmaxf(fmaxf(v.x, v.y), fmaxf(v.z, v.w));
#pragma unroll
        for (int o = 1; o < 64; o <<= 1) m = fmaxf(m, __shfl_xor(m, o));
        const float e0 = expf(v.x - m), e1 = expf(v.y - m), e2 = expf(v.z - m), e3 = expf(v.w - m);
        const float inv = 1.f / wave_sum((e0 + e1) + (e2 + e3));
        u32x2 w; w.x = pk2(e0 * inv, e1 * inv); w.y = pk2(e2 * inv, e3 * inv);
        *((u32x2*)(p.px + (size_t)it * 256) + lane) = w;
    }
}

__device__ __forceinline__ void phase_router(const P& p, float* lds, int bid, int nb) {
    const int tid = threadIdx.x, lane = tid & 63, gw = bid * NWAVES + (tid >> 6), NGW = nb * NWAVES;
    __syncthreads();
    for (int i = tid; i < D * NE; i += NTHREADS) lds[(i & 31) * D + (i >> 5)] = p.w_router[i];
    __syncthreads();
    for (int t = gw; t < M; t += NGW) {
        const f32x4* xr = (const f32x4*)(p.x2 + (size_t)t * D) + lane; f32x4 v[4]; float s = 0.f;
#pragma unroll
        for (int j = 0; j < 4; ++j) { v[j] = xr[64 * j]; s += (v[j].x * v[j].x + v[j].y * v[j].y) + (v[j].z * v[j].z + v[j].w * v[j].w); }
        const float rs = 1.0f / sqrtf(wave_sum(s) * (1.f / D) + EPS);
#pragma unroll
        for (int j = 0; j < 4; ++j) { const f32x4 gg = *((const f32x4*)p.g_moe + lane + 64 * j); v[j] = v[j] * rs * gg; }
        float mylg = -INFINITY;
#pragma unroll 2
        for (int e = 0; e < NE; ++e) { float a = 0.f;
#pragma unroll
            for (int j = 0; j < 4; ++j) { const f32x4 w = *((const f32x4*)(lds + e * D) + lane + 64 * j); a += (v[j].x * w.x + v[j].y * w.y) + (v[j].z * w.z + v[j].w * w.w); }
            a = wave_sum(a); if (lane == e) mylg = a + p.b_router[e]; }
        int idx[4]; float val[4];
#pragma unroll
        for (int j = 0; j < 4; ++j) { float bv = mylg; int bi = lane;
#pragma unroll
            for (int o = 1; o < 64; o <<= 1) { const float ov = __shfl_xor(bv, o); const int oi = __shfl_xor(bi, o); const bool tk = (ov > bv) || (ov == bv && oi < bi); bv = tk ? ov : bv; bi = tk ? oi : bi; }
            idx[j] = bi; val[j] = bv; if (lane == bi) mylg = -INFINITY; }
        const float e1 = expf(val[1] - val[0]), e2 = expf(val[2] - val[0]), e3 = expf(val[3] - val[0]); const float inv = 1.f / (1.f + e1 + e2 + e3);
        if (lane == 0) { p.rs2[t] = rs;
            p.topi[t * 4 + 0] = idx[0]; p.topi[t * 4 + 1] = idx[1]; p.topi[t * 4 + 2] = idx[2]; p.topi[t * 4 + 3] = idx[3];
            p.topg[t * 4 + 0] = inv; p.topg[t * 4 + 1] = e1 * inv; p.topg[t * 4 + 2] = e2 * inv; p.topg[t * 4 + 3] = e3 * inv;
#pragma unroll
            for (int j = 0; j < 4; ++j) atomicAdd(p.ctl + CW_COUNT + idx[j], 1u); }
    }
}
__device__ __forceinline__ void phase_dispatch(const P& p, int* ldsi, int bid, int nb) {
    const int tid = threadIdx.x, lane = tid & 63, gw = bid * NWAVES + (tid >> 6), NGW = nb * NWAVES;
    __syncthreads();
    if (tid == 0) { int off = 0; for (int e = 0; e < NE; ++e) { ldsi[e] = off; const int c = (int)p.ctl[CW_COUNT + e]; const int nt = (c + 255) >> 8;
            if (bid == 0) for (int i = 0; i < nt; ++i) p.tilee[(off >> 8) + i] = e;
            off += nt << 8; }
        if (bid == 0) p.tilee[MAXMT] = off >> 8; }
    __syncthreads();
    for (int t = gw; t < M; t += NGW) {
        int slot = 0;
        if (lane < 4) { const int e = p.topi[t * 4 + lane]; slot = ldsi[e] + (int)atomicAdd(p.ctl + CW_CURSOR + e, 1u); p.slotof[t * 4 + lane] = slot; p.gslot[slot] = p.topg[t * 4 + lane]; }
        const float rs = p.rs2[t];
        const f32x4* xr = (const f32x4*)(p.x2 + (size_t)t * D) + lane; u32x2 w[4];
#pragma unroll
        for (int j = 0; j < 4; ++j) { const f32x4 v = xr[64 * j]; const f32x4 gg = *((const f32x4*)p.g_moe + lane + 64 * j);
            w[j].x = pk2(v.x * rs * gg.x, v.y * rs * gg.y); w[j].y = pk2(v.z * rs * gg.z, v.w * rs * gg.w); }
#pragma unroll
        for (int q = 0; q < 4; ++q) { const int sl = __shfl(slot, q); u32x2* o = (u32x2*)(p.xs + (size_t)sl * D) + lane;
#pragma unroll
            for (int j = 0; j < 4; ++j) o[64 * j] = w[j]; }
    }
}
__device__ __forceinline__ void phase_final(const P& p, int bid, int nb) {
    const int lane = threadIdx.x & 63, gw = bid * NWAVES + (threadIdx.x >> 6), NGW = nb * NWAVES;
    for (int t = gw; t < M; t += NGW) {
        const f32x4* xr = (const f32x4*)(p.x2 + (size_t)t * D) + lane; f32x4 v[4];
#pragma unroll
        for (int j = 0; j < 4; ++j) v[j] = xr[64 * j];
#pragma unroll
        for (int q = 0; q < 4; ++q) { const int sl = p.slotof[t * 4 + q]; const u32x2* yr = (const u32x2*)(p.y + (size_t)sl * D) + lane;
#pragma unroll
            for (int j = 0; j < 4; ++j) { const u32x2 w = yr[64 * j]; v[j].x += bf_lo(w.x); v[j].y += bf_hi(w.x); v[j].z += bf_lo(w.y); v[j].w += bf_hi(w.y); } }
        float s = 0.f;
#pragma unroll
        for (int j = 0; j < 4; ++j) s += (v[j].x * v[j].x + v[j].y * v[j].y) + (v[j].z * v[j].z + v[j].w * v[j].w);
        const float rs = 1.0f / sqrtf(wave_sum(s) * (1.f / D) + EPS);
        f32x4* o = (f32x4*)(p.out + (size_t)t * D) + lane;
#pragma unroll
        for (int j = 0; j < 4; ++j) { const f32x4 gg = *((const f32x4*)p.g_final + lane + 64 * j); o[64 * j] = v[j] * rs * gg; }
    }
}

typedef short bf16x8 __attribute__((ext_vector_type(8)));
typedef float f32x16 __attribute__((ext_vector_type(16)));
template <int K>
__device__ __forceinline__ void mma_tile(f32x16& acc, const bf16* a, int pa, const bf16* b, int pb, int lane) {
    const int r = lane & 31, hf = lane >> 5;
#pragma unroll
    for (int k0 = 0; k0 < K; k0 += 16) { const bf16x8 av = *(const bf16x8*)(a + r * pa + k0 + 8 * hf); const bf16x8 bv = *(const bf16x8*)(b + r * pb + k0 + 8 * hf);
        acc = __builtin_amdgcn_mfma_f32_32x32x16_bf16(av, bv, acc, 0, 0, 0); }
}
__device__ __forceinline__ int crow(int reg, int hf) { return (reg & 3) + 8 * (reg >> 2) + 4 * hf; }
__device__ __forceinline__ f32x16 zero16() { f32x16 z;
#pragma unroll
    for (int i = 0; i < 16; ++i) z[i] = 0.f;
    return z; }
__device__ __forceinline__ float fast_logsigmoid(float x) { return fminf(x, 0.f) - __logf(1.f + __expf(-fabsf(x))); }

__device__ __forceinline__ void phase_pool2(const P& p, unsigned char* lds, int bid, int nb) {
    bf16* wpT = (bf16*)lds;
    float* ut = (float*)(lds + 34816);
    bf16* pt = (bf16*)(lds + 34816 + 40960);
    const int tid = threadIdx.x, lane = tid & 63, w = tid >> 6;
    int cur_g = -1;
    for (int u = bid; u < (M / 64) * 4; u += nb) {
        const int g = u & 3, t0 = (u >> 2) * 64, win = 2 << g, s0 = t0 & (SEQ - 1);
        __syncthreads();
        if (g != cur_g) { cur_g = g;
            for (int i = tid; i < 128 * 128; i += NTHREADS) { const int c = i >> 7, d = i & 127; wpT[d * 136 + c] = (bf16)f2bf(p.w_pool[(size_t)g * 16384 + i]); } }
        for (int c = tid; c < 80 * 16; c += NTHREADS) { const int r = c >> 4, ch = (c & 15) * 8; const int srel = s0 - 16 + r;
            f32x4 lo = {0.f, 0.f, 0.f, 0.f}, hi = {0.f, 0.f, 0.f, 0.f};
            if (srel >= 0) { const u32x4 v = *(const u32x4*)(p.z1 + (size_t)(t0 - 16 + r) * NZ + g * 128 + ch); lo = (f32x4){bf_lo(v.x), bf_hi(v.x), bf_lo(v.y), bf_hi(v.y)}; hi = (f32x4){bf_lo(v.z), bf_hi(v.z), bf_lo(v.w), bf_hi(v.w)}; }
            *(f32x4*)(ut + r * 128 + ch) = lo; *(f32x4*)(ut + r * 128 + ch + 4) = hi; }
        __syncthreads();
        { const int c = tid & 127, q = tid >> 7, i0 = 16 * q; float sum = 0.f;
          for (int d = 1; d < win; ++d) sum += ut[(16 + i0 - d) * 128 + c];
          for (int ii = 0; ii < 16; ++ii) { const int i = i0 + ii, s = s0 + i; const float uv = ut[(16 + i) * 128 + c]; sum += uv; const int cnt = (s + 1 < win) ? s + 1 : win;
              pt[i * 136 + c] = (bf16)f2bf(sum / (float)cnt - uv); sum -= ut[(16 + i - win + 1) * 128 + c]; } }
        __syncthreads();
        { const int db = w >> 1, ib = w & 1, r = lane & 31, hf = lane >> 5; f32x16 acc = zero16();
          mma_tile<128>(acc, wpT + (db * 32) * 136, 136, pt + (ib * 32) * 136, 136, lane);
          bf16* orow = p.mix + (size_t)(t0 + ib * 32 + r) * D + g * 128 + db * 32;
#pragma unroll
          for (int rg = 0; rg < 4; ++rg) { const int d0 = 8 * rg + 4 * hf; const f32x4 sc = *(const f32x4*)(p.pool_scale + g * 128 + db * 32 + d0);
              u32x2 o; o.x = pk2(acc[4 * rg] * sc.x, acc[4 * rg + 1] * sc.y); o.y = pk2(acc[4 * rg + 2] * sc.z, acc[4 * rg + 3] * sc.w); *(u32x2*)(orow + d0) = o; } }
    }
}

__device__ __forceinline__ void gla_gc2(const P& p, float* glr, float* wtot, int t0, int h, float (&gcl)[8], float& tot) {
    const int tid = threadIdx.x, d = tid & 63, w = tid >> 6;
    __syncthreads();
    for (int i = tid; i < 64 * 16; i += NTHREADS) glr[i] = bf2f(p.z1[(size_t)(t0 + (i >> 4)) * NZ + ZG + (i & 15)]);
    float wg[16];
#pragma unroll
    for (int r = 0; r < 16; ++r) wg[r] = p.w_gate_up[r * 256 + h * 64 + d];
    const float bias = p.b_gate_up[h * 64 + d];
    __syncthreads();
    float run = 0.f;
#pragma unroll
    for (int ii = 0; ii < 8; ++ii) { const float* gr = glr + (8 * w + ii) * 16; float s = bias;
#pragma unroll
        for (int r = 0; r < 16; ++r) s += gr[r] * wg[r];
        run += fast_logsigmoid(s) * (1.f / 16.f); gcl[ii] = run; }
    wtot[w * 64 + d] = run;
    __syncthreads();
    float pre = 0.f; tot = 0.f;
#pragma unroll
    for (int ww = 0; ww < 8; ++ww) { const float v = wtot[ww * 64 + d]; pre += (ww < w) ? v : 0.f; tot += v; }
#pragma unroll
    for (int ii = 0; ii < 8; ++ii) gcl[ii] += pre;
}
__device__ __forceinline__ void load_vT(const P& p, bf16* vT, int t0, int colbase) {
    const int tid = threadIdx.x, e = tid & 127, jb = tid >> 7; unsigned short v[16];
#pragma unroll
    for (int jj = 0; jj < 16; ++jj) v[jj] = p.z1[(size_t)(t0 + 16 * jb + jj) * NZ + colbase + e];
    u32x4 a, b; a.x = v[0] | (v[1] << 16); a.y = v[2] | (v[3] << 16); a.z = v[4] | (v[5] << 16); a.w = v[6] | (v[7] << 16);
    b.x = v[8] | (v[9] << 16); b.y = v[10] | (v[11] << 16); b.z = v[12] | (v[13] << 16); b.w = v[14] | (v[15] << 16);
    *(u32x4*)(vT + e * 72 + 16 * jb) = a; *(u32x4*)(vT + e * 72 + 16 * jb + 8) = b;
}
__device__ __forceinline__ void phase_gla_a2(const P& p, unsigned char* lds, int bid, int nb) {
    float* glr = (float*)lds; float* wtot = (float*)(lds + 4096); bf16* kdT = (bf16*)(lds + 8192); bf16* vT = (bf16*)(lds + 8192 + 9216);
    const int tid = threadIdx.x, lane = tid & 63, w = tid >> 6, d = tid & 63;
    for (int u = bid; u < 8 * NCHUNK; u += nb) {
        const int bh = u / NCHUNK, n = u % NCHUNK, b = bh >> 2, h = bh & 3, t0 = b * SEQ + n * 64;
        float gcl[8], tot; gla_gc2(p, glr, wtot, t0, h, gcl, tot);
        { unsigned pk[4];
#pragma unroll
          for (int ii = 0; ii < 8; ii += 2) { const float k0 = bf2f(p.z1[(size_t)(t0 + 8 * w + ii) * NZ + ZK + h * 64 + d]) * __expf(tot - gcl[ii]);
              const float k1 = bf2f(p.z1[(size_t)(t0 + 8 * w + ii + 1) * NZ + ZK + h * 64 + d]) * __expf(tot - gcl[ii + 1]); pk[ii >> 1] = pk2(k0, k1); }
          *(u32x4*)(kdT + d * 72 + 8 * w) = (u32x4){pk[0], pk[1], pk[2], pk[3]}; }
        if (w == 0) p.dec[(size_t)u * 64 + d] = __expf(tot);
        load_vT(p, vT, t0, ZV + h * 128);
        __syncthreads();
        { const int eb = w >> 1, db = w & 1, r = lane & 31, hf = lane >> 5; f32x16 acc = zero16();
          mma_tile<64>(acc, vT + (eb * 32) * 72, 72, kdT + (db * 32) * 72, 72, lane);
          float* o = p.ds + (size_t)u * 8192 + db * 32 + r;
#pragma unroll
          for (int reg = 0; reg < 16; ++reg) o[(eb * 32 + crow(reg, hf)) * 64] = acc[reg]; }
    }
}
__device__ __forceinline__ void phase_scan2(const P& p, int bid, int nb) {
    bf16* sp = (bf16*)p.sprev;
    if (threadIdx.x < 256)
    for (int idx = bid * 256 + threadIdx.x; idx < 8 * 8192; idx += nb * 256) {
        const int bh = idx >> 13, ed = idx & 8191, d = ed & 63; float st = 0.f;
        for (int n0 = 0; n0 < NCHUNK; n0 += 8) { float dv[8], dc[8];
#pragma unroll
            for (int k = 0; k < 8; ++k) { const size_t u = (size_t)bh * NCHUNK + n0 + k; dv[k] = p.ds[u * 8192 + ed]; dc[k] = p.dec[u * 64 + d]; }
#pragma unroll
            for (int k = 0; k < 8; ++k) { const size_t u = (size_t)bh * NCHUNK + n0 + k; sp[u * 8192 + ed] = (bf16)f2bf(st); st = dc[k] * st + dv[k]; } }
    }
}
__device__ __forceinline__ void phase_gla_b2(const P& p, unsigned char* lds, int bid, int nb) {
    float* glr = (float*)lds; float* wtot = (float*)(lds + 4096); float* ssq = (float*)(lds + 6144);
    bf16* qe = (bf16*)(lds + 8192); bf16* ke = qe + 64 * 72; bf16* att = ke + 64 * 72; bf16* vT = att + 64 * 72; bf16* spT = vT + 128 * 72;
    const bf16* sp = (const bf16*)p.sprev;
    const int tid = threadIdx.x, lane = tid & 63, w = tid >> 6, d = tid & 63, r = lane & 31, hf = lane >> 5;
    for (int u = bid; u < 8 * NCHUNK; u += nb) {
        const int bh = u / NCHUNK, n = u % NCHUNK, b = bh >> 2, h = bh & 3, t0 = b * SEQ + n * 64;
        float gcl[8], tot; gla_gc2(p, glr, wtot, t0, h, gcl, tot);
#pragma unroll
        for (int ii = 0; ii < 8; ++ii) { const int i = 8 * w + ii; const size_t zo = (size_t)(t0 + i) * NZ + h * 64 + d;
            qe[i * 72 + d] = (bf16)f2bf(bf2f(p.z1[zo + ZQ]) * 0.125f * __expf(gcl[ii])); ke[i * 72 + d] = (bf16)f2bf(bf2f(p.z1[zo + ZK]) * __expf(-gcl[ii])); }
        load_vT(p, vT, t0, ZV + h * 128);
        for (int c = tid; c < 1024; c += NTHREADS) { const int e = c >> 3, d8 = (c & 7) * 8; *(u32x4*)(spT + e * 72 + d8) = *(const u32x4*)(sp + (size_t)u * 8192 + e * 64 + d8); }
        __syncthreads();
        if (w < 4) { const int ib = w & 1, jb = w >> 1; f32x16 acc = zero16();
            if (jb <= ib) mma_tile<64>(acc, qe + (ib * 32) * 72, 72, ke + (jb * 32) * 72, 72, lane);
#pragma unroll
            for (int reg = 0; reg < 16; ++reg) { const int i = ib * 32 + crow(reg, hf), j = jb * 32 + r; att[i * 72 + j] = (bf16)f2bf(j <= i ? acc[reg] : 0.f); } }
        __syncthreads();
        { const int eb = w >> 1, ib = w & 1, i = ib * 32 + r; f32x16 acc = zero16();
          mma_tile<64>(acc, vT + (eb * 32) * 72, 72, att + (ib * 32) * 72, 72, lane);
          mma_tile<64>(acc, spT + (eb * 32) * 72, 72, qe + (ib * 32) * 72, 72, lane);
          float ss = 0.f;
#pragma unroll
          for (int reg = 0; reg < 16; ++reg) ss += acc[reg] * acc[reg];
          ss += __shfl_xor(ss, 32);
          if (hf == 0) ssq[eb * 64 + i] = ss;
          __syncthreads();
          const float rs = 1.0f / sqrtf((ssq[i] + ssq[64 + i] + ssq[128 + i] + ssq[192 + i]) * (1.f / 128.f) + EPS);
          const bf16* rp = p.z1 + (size_t)(t0 + i) * NZ + ZR + h * 128 + eb * 32; bf16* op = p.mix + (size_t)(t0 + i) * D + 512 + h * 128 + eb * 32;
#pragma unroll
          for (int rg = 0; rg < 4; ++rg) { const int e0 = 8 * rg + 4 * hf; const u32x2 rv = *(const u32x2*)(rp + e0); const f32x4 gg = *(const f32x4*)(p.gla_g + eb * 32 + e0);
              const float r0 = bf_lo(rv.x), r1 = bf_hi(rv.x), r2 = bf_lo(rv.y), r3 = bf_hi(rv.y);
              const float o0 = acc[4 * rg] * rs * gg.x * (r0 / (1.f + __expf(-r0))), o1 = acc[4 * rg + 1] * rs * gg.y * (r1 / (1.f + __expf(-r1)));
              const float o2 = acc[4 * rg + 2] * rs * gg.z * (r2 / (1.f + __expf(-r2))), o3 = acc[4 * rg + 3] * rs * gg.w * (r3 / (1.f + __expf(-r3)));
              u32x2 o; o.x = pk2(o0, o1); o.y = pk2(o2, o3); *(u32x2*)(op + e0) = o; } }
    }
}

__device__ __forceinline__ void phase_router2(const P& p, float* lds, int* blkcnt, int* wavebase, int bid, int nb) {
    const int tid = threadIdx.x, lane = tid & 63, w = tid >> 6;
    int* cntw = (int*)(lds + 32768);
    __syncthreads();
    for (int i = tid; i < D * NE; i += NTHREADS) lds[(i & 31) * D + (i >> 5)] = p.w_router[i];
    __syncthreads();
    const float bias = p.b_router[lane >> 1];
    for (int gidx = bid; gidx < M / 64; gidx += nb) {
        int cnt = 0;
        for (int ii = 0; ii < 8; ++ii) {
            const int t = gidx * 64 + w * 8 + ii;
            const f32x4* xr = (const f32x4*)(p.x2 + (size_t)t * D) + lane; f32x4 v[4]; float s = 0.f;
#pragma unroll
            for (int j = 0; j < 4; ++j) { v[j] = xr[64 * j]; s += (v[j].x * v[j].x + v[j].y * v[j].y) + (v[j].z * v[j].z + v[j].w * v[j].w); }
            const float rs = 1.0f / sqrtf(wave_sum(s) * (1.f / D) + EPS);
#pragma unroll
            for (int j = 0; j < 4; ++j) { const f32x4 gg = *((const f32x4*)p.g_moe + lane + 64 * j); v[j] = v[j] * rs * gg; }
            float a[NE];
#pragma unroll
            for (int e = 0; e < NE; ++e) { float acc = 0.f;
#pragma unroll
                for (int j = 0; j < 4; ++j) { const f32x4 wv = *((const f32x4*)(lds + e * D) + lane + 64 * j); acc += (v[j].x * wv.x + v[j].y * wv.y) + (v[j].z * wv.z + v[j].w * wv.w); }
                a[e] = acc; if ((e & 3) == 3) __builtin_amdgcn_sched_barrier(0); }
#pragma unroll
            for (int k = 0; k < 16; ++k) { const bool up = (lane & 32) != 0; const float send = up ? a[k] : a[k + 16]; const float keep = up ? a[k + 16] : a[k]; a[k] = keep + __shfl_xor(send, 32); }
#pragma unroll
            for (int k = 0; k < 8; ++k) { const bool up = (lane & 16) != 0; const float send = up ? a[k] : a[k + 8]; const float keep = up ? a[k + 8] : a[k]; a[k] = keep + __shfl_xor(send, 16); }
#pragma unroll
            for (int k = 0; k < 4; ++k) { const bool up = (lane & 8) != 0; const float send = up ? a[k] : a[k + 4]; const float keep = up ? a[k + 4] : a[k]; a[k] = keep + __shfl_xor(send, 8); }
#pragma unroll
            for (int k = 0; k < 2; ++k) { const bool up = (lane & 4) != 0; const float send = up ? a[k] : a[k + 2]; const float keep = up ? a[k + 2] : a[k]; a[k] = keep + __shfl_xor(send, 4); }
            { const bool up = (lane & 2) != 0; const float send = up ? a[0] : a[1]; const float keep = up ? a[1] : a[0]; a[0] = keep + __shfl_xor(send, 2); }
            float mylg = a[0] + __shfl_xor(a[0], 1) + bias; const int myidx = lane >> 1;
            int idx[4]; float val[4];
#pragma unroll
            for (int j = 0; j < 4; ++j) { float bv = mylg; int bi = myidx;
#pragma unroll
                for (int o = 1; o < 64; o <<= 1) { const float ov = __shfl_xor(bv, o); const int oi = __shfl_xor(bi, o); const bool tk = (ov > bv) || (ov == bv && oi < bi); bv = tk ? ov : bv; bi = tk ? oi : bi; }
                idx[j] = bi; val[j] = bv; if (myidx == bi) mylg = -INFINITY; cnt += (lane == bi) ? 1 : 0; }
            const float e1 = __expf(val[1] - val[0]), e2 = __expf(val[2] - val[0]), e3 = __expf(val[3] - val[0]); const float inv = 1.f / (1.f + e1 + e2 + e3);
            if (lane == 0) { p.rs2[t] = rs;
                p.topi[t * 4 + 0] = idx[0]; p.topi[t * 4 + 1] = idx[1]; p.topi[t * 4 + 2] = idx[2]; p.topi[t * 4 + 3] = idx[3];
                p.topg[t * 4 + 0] = inv; p.topg[t * 4 + 1] = e1 * inv; p.topg[t * 4 + 2] = e2 * inv; p.topg[t * 4 + 3] = e3 * inv; }
        }
        __syncthreads();
        if (lane < 32) cntw[w * 32 + lane] = cnt;
        __syncthreads();
        if (tid < 32) { int run = 0;
#pragma unroll
            for (int ww = 0; ww < 8; ++ww) { wavebase[(gidx * 8 + ww) * 32 + tid] = run; run += cntw[ww * 32 + tid]; }
            blkcnt[gidx * 32 + tid] = run; }
    }
}
__device__ __forceinline__ void phase_dispatch2(const P& p, int* ldsi, const int* blkcnt, const int* wavebase, int bid, int nb) {
    const int tid = threadIdx.x, lane = tid & 63, w = tid >> 6;
    int* red_t = ldsi; int* red_p = ldsi + 512; int* base = ldsi + 1024;
    for (int gidx = bid; gidx < M / 64; gidx += nb) {
        __syncthreads();
        { const int e = tid & 31, part = tid >> 5; int tt = 0, pp = 0;
          for (int bb = part * 16; bb < part * 16 + 16; ++bb) { const int v = blkcnt[bb * 32 + e]; tt += v; pp += (bb < gidx) ? v : 0; }
          red_t[part * 32 + e] = tt; red_p[part * 32 + e] = pp; }
        __syncthreads();
        if (tid < 32) { int tt = 0, pp = 0;
#pragma unroll
            for (int q = 0; q < 16; ++q) { tt += red_t[q * 32 + tid]; pp += red_p[q * 32 + tid]; }
            red_t[tid] = tt; red_p[tid] = pp; }
        __syncthreads();
        if (tid == 0) { int off = 0; for (int e = 0; e < NE; ++e) { base[e] = off + red_p[e]; const int c = red_t[e]; const int nt = (c + 255) >> 8;
                if (gidx == 0) for (int i = 0; i < nt; ++i) p.tilee[(off >> 8) + i] = e;
                off += nt << 8; }
            if (gidx == 0) p.tilee[MAXMT] = off >> 8; }
        __syncthreads();
        int wb = (lane < 32) ? base[lane] + wavebase[(gidx * 8 + w) * 32 + lane] : 0;
        for (int ii = 0; ii < 8; ++ii) {
            const int t = gidx * 64 + w * 8 + ii;
            int slot = 0;
#pragma unroll
            for (int j = 0; j < 4; ++j) { const int e = p.topi[t * 4 + j]; const int sj = __shfl(wb, e); if (lane == e) wb += 1; if (lane == j) slot = sj; }
            if (lane < 4) { p.slotof[t * 4 + lane] = slot; p.gslot[slot] = p.topg[t * 4 + lane]; }
            const float rs = p.rs2[t];
            const f32x4* xr = (const f32x4*)(p.x2 + (size_t)t * D) + lane; u32x2 wv[4];
#pragma unroll
            for (int j = 0; j < 4; ++j) { const f32x4 v = xr[64 * j]; const f32x4 gg = *((const f32x4*)p.g_moe + lane + 64 * j);
                wv[j].x = pk2(v.x * rs * gg.x, v.y * rs * gg.y); wv[j].y = pk2(v.z * rs * gg.z, v.w * rs * gg.w); }
#pragma unroll
            for (int q = 0; q < 4; ++q) { const int sl = __shfl(slot, q); u32x2* o = (u32x2*)(p.xs + (size_t)sl * D) + lane;
#pragma unroll
                for (int j = 0; j < 4; ++j) o[64 * j] = wv[j]; }
        }
    }
}

namespace pg {
typedef short bf16x8 __attribute__((ext_vector_type(8)));
constexpr int BM = 256, BK = 64, HALF = 128, HTB = HALF * BK * 2, STAGE_BYTES = 8 * HTB;
__device__ __forceinline__ int lds_byte(int r, int c) { const int st = (r >> 4) * 2 + (c >> 5), rr = r & 15, cc = c & 31, ob = rr * 64 + cc * 2; return st * 1024 + (ob ^ (((ob >> 9) & 1) << 5)); }
__device__ __forceinline__ void stage_rc(int b, int& R, int& C) { const int st = b / 1024, sb = b % 1024, swz = sb ^ (((sb >> 9) & 1) << 5); R = (st >> 1) * 16 + swz / 64; C = (st & 1) * 32 + (swz % 64) / 2; }
__device__ __forceinline__ int perm32(int rho) { const int n = rho >> 4, i = rho & 15; return 8 * (i >> 2) + 4 * n + (i & 3); }
struct Unit { int pm, pn, e; const char* a; const char* b; };
struct Gemm { int lda, ldb, K; };
__device__ __forceinline__ void map2d(int L, int nM, int nN, int& pm, int& pn) {
    const int nwg = nM * nN; int wgid = L;
    { const int q = nwg / 8, r = nwg % 8, xcd = wgid % 8, off = wgid / 8; wgid = (xcd < r ? xcd * (q + 1) : r * (q + 1) + (xcd - r) * q) + off; }
    const int nig = 8 * nN, gid = wgid / nig, fm = gid * 8, gsz = (nM - fm) < 8 ? (nM - fm) : 8;
    pm = fm + ((wgid % nig) % gsz); pn = (wgid % nig) / gsz;
}
struct Sched2D { const bf16* A; const bf16* Bt; int lda, ldb, nM, nN, G, c;
    __device__ __forceinline__ bool next(int i, Unit& u) const { const long L = (long)i * G + c; if (L >= (long)nM * nN) return false; map2d((int)L, nM, nN, u.pm, u.pn); u.e = 0;
        u.a = (const char*)(A + (size_t)u.pm * 256 * lda); u.b = (const char*)(Bt + (size_t)u.pn * 256 * ldb); return true; } };
struct SchedG1 { const char* ws; int G, c;
    __device__ __forceinline__ bool next(int i, Unit& u) const { const long L = (long)i * G + c; if (L >= 592) return false;
        const int Li = (int)L, l2 = Li - 576, l3 = Li - 584; int pm, pn; map2d(Li < 576 ? Li : 0, 64, 9, pm, pn);
        const int e = Li < 576 ? 0 : (Li < 584 ? 1 : 2);
        pm = e == 0 ? pm : (e == 1 ? (l2 >> 2) : (l3 >> 1)); pn = e == 0 ? pn : (e == 1 ? (l2 & 3) : (l3 & 1));
        const size_t m1 = (size_t)(e == 1), m2 = (size_t)(e == 2);
        const size_t ao = WS_XN + m1 * (WS_HM - WS_XN) + m2 * (WS_WT_XV - WS_XN), bo = WS_WT_IN + m1 * (WS_WT_XK - WS_WT_IN) + m2 * (WS_HM - WS_WT_IN);
        u.pm = pm; u.pn = pn; u.e = e; u.a = ws + ao + (size_t)pm * 256 * D * 2; u.b = ws + bo + (size_t)pn * 256 * D * 2; return true; } };
struct SchedAttn { const bf16* A; const bf16* Bt; size_t sBb, sBh; int G, c;
    __device__ __forceinline__ bool next(int i, Unit& u) const { const long L = (long)i * G + c; if (L >= 256) return false; const int bh = (int)L >> 5, b = bh >> 2, h = bh & 3;
        u.pm = b * 32 + ((int)L & 31); u.pn = h; u.e = 0; u.a = (const char*)(A + (size_t)u.pm * 256 * D + h * 256); u.b = (const char*)(Bt + b * sBb + h * sBh); return true; } };
struct SchedMoE { const bf16* A; const bf16* Bt; const int* tile_e; size_t sBe; int nM, nN, G, c;
    __device__ __forceinline__ bool next(int i, Unit& u) const { const long L = (long)i * G + c; if (L >= (long)nM * nN) return false; map2d((int)L, nM, nN, u.pm, u.pn); u.e = tile_e[u.pm];
        u.a = (const char*)(A + (size_t)u.pm * 256 * D); u.b = (const char*)(Bt + (size_t)u.e * sBe + (size_t)u.pn * 256 * D); return true; } };

typedef f32x4 Acc[2][2][4][2];
__device__ __forceinline__ u32x4 pack8(const f32x4 v0, const f32x4 v1) { u32x4 w; w.x = pk2(v0[0], v0[1]); w.y = pk2(v0[2], v0[3]); w.z = pk2(v1[0], v1[1]); w.w = pk2(v1[2], v1[3]); return w; }
struct EpiBf3 { static constexpr bool PERM = true; unsigned char* ws; size_t o0, o1, o2; int ld0, ld1, ld2;
    __device__ __forceinline__ void operator()(const Acc& acc, const Unit& u, int wr, int wc, int fr, int fq) const {
        const size_t m1 = (size_t)(u.e == 1), m2 = (size_t)(u.e == 2);
        bf16* base = (bf16*)(ws + o0 + m1 * (o1 - o0) + m2 * (o2 - o0)); const int ld = ld0 + (int)m1 * (ld1 - ld0) + (int)m2 * (ld2 - ld0);
        const int row0 = u.pm * BM + wr * 64 + fr, col0 = u.pn * BM + wc * 32 + 8 * fq;
#pragma unroll
        for (int ai = 0; ai < 2; ++ai)
#pragma unroll
            for (int m = 0; m < 4; ++m) { bf16* rowp = base + (size_t)(row0 + ai * HALF + m * 16) * ld + col0;
#pragma unroll
                for (int bj = 0; bj < 2; ++bj) *(u32x4*)(rowp + bj * HALF) = pack8(acc[ai][bj][m][0], acc[ai][bj][m][1]); } } };
struct EpiF { static constexpr bool PERM = false; float* C; int ldc;
    __device__ __forceinline__ void operator()(const Acc& acc, const Unit& u, int wr, int wc, int fr, int fq) const {
        const int row0 = u.pm * BM + wr * 64 + fr, col0 = u.pn * BM + wc * 32 + 4 * fq;
#pragma unroll
        for (int ai = 0; ai < 2; ++ai)
#pragma unroll
            for (int m = 0; m < 4; ++m) { float* rowp = C + (size_t)(row0 + ai * HALF + m * 16) * ldc + col0;
#pragma unroll
                for (int bj = 0; bj < 2; ++bj)
#pragma unroll
                    for (int n = 0; n < 2; ++n) *(f32x4*)(rowp + bj * HALF + n * 16) = acc[ai][bj][m][n]; } } };
struct EpiOutF { static constexpr bool PERM = false; const float* x; float* x1; bf16* a2; const float* g; float* rowsq;
    __device__ __forceinline__ void operator()(const Acc& acc, const Unit& u, int wr, int wc, int fr, int fq) const {
        const int row0 = u.pm * BM + wr * 64 + fr, col0 = u.pn * BM + wc * 32 + 4 * fq;
        f32x4 gv[2][2];
#pragma unroll
        for (int bj = 0; bj < 2; ++bj)
#pragma unroll
            for (int n = 0; n < 2; ++n) gv[bj][n] = *(const f32x4*)(g + col0 + bj * HALF + n * 16);
#pragma unroll
        for (int ai = 0; ai < 2; ++ai)
#pragma unroll
            for (int m = 0; m < 4; ++m) { const int row = row0 + ai * HALF + m * 16; const size_t off = (size_t)row * D + col0; float ss = 0.f;
#pragma unroll
                for (int bj = 0; bj < 2; ++bj)
#pragma unroll
                    for (int n = 0; n < 2; ++n) { const size_t o = off + bj * HALF + n * 16; const f32x4 v = *(const f32x4*)(x + o) + acc[ai][bj][m][n]; *(f32x4*)(x1 + o) = v;
                        const f32x4 t = v * gv[bj][n]; u32x2 w; w.x = pk2(t[0], t[1]); w.y = pk2(t[2], t[3]); *(u32x2*)(a2 + o) = w; ss += (v[0] * v[0] + v[1] * v[1]) + (v[2] * v[2] + v[3] * v[3]); }
                ss += __shfl_xor(ss, 16); ss += __shfl_xor(ss, 32);
                if (fq == 0) atomicAdd(rowsq + row, ss); } } };
struct EpiQF { static constexpr bool PERM = true; bf16* q; const float* rowsq;
    __device__ __forceinline__ void operator()(const Acc& acc, const Unit& u, int wr, int wc, int fr, int fq) const {
        const int row0 = u.pm * BM + wr * 64 + fr, col0 = u.pn * BM + wc * 32 + 8 * fq;
#pragma unroll
        for (int ai = 0; ai < 2; ++ai)
#pragma unroll
            for (int m = 0; m < 4; ++m) { const int row = row0 + ai * HALF + m * 16; const float s = 0.0625f / sqrtf(rowsq[row] * (1.f / D) + EPS); bf16* rowp = q + (size_t)row * D + col0;
#pragma unroll
                for (int bj = 0; bj < 2; ++bj) *(u32x4*)(rowp + bj * HALF) = pack8(acc[ai][bj][m][0] * s, acc[ai][bj][m][1] * s); } } };
struct EpiResF { static constexpr bool PERM = false; const float* base; float* o;
    __device__ __forceinline__ void operator()(const Acc& acc, const Unit& u, int wr, int wc, int fr, int fq) const {
        const int row0 = u.pm * BM + wr * 64 + fr, col0 = u.pn * BM + wc * 32 + 4 * fq;
#pragma unroll
        for (int ai = 0; ai < 2; ++ai)
#pragma unroll
            for (int m = 0; m < 4; ++m) { const size_t off = (size_t)(row0 + ai * HALF + m * 16) * D + col0;
#pragma unroll
                for (int bj = 0; bj < 2; ++bj)
#pragma unroll
                    for (int n = 0; n < 2; ++n) { const size_t o2 = off + bj * HALF + n * 16; *(f32x4*)(o + o2) = *(const f32x4*)(base + o2) + acc[ai][bj][m][n]; } } } };
struct EpiUpF { static constexpr bool PERM = true; bf16* h; const float* b_gu;
    __device__ __forceinline__ void operator()(const Acc& acc, const Unit& u, int wr, int wc, int fr, int fq) const {
        const int row0 = u.pm * BM + wr * 64 + fr, ff0 = u.pn * HALF + wc * 32 + 8 * fq; const float* bb = b_gu + (size_t)u.e * 2 * DFF + ff0;
        const f32x4 bg0 = *(const f32x4*)bb, bg1 = *(const f32x4*)(bb + 4), bu0 = *(const f32x4*)(bb + DFF), bu1 = *(const f32x4*)(bb + DFF + 4);
#pragma unroll
        for (int ai = 0; ai < 2; ++ai)
#pragma unroll
            for (int m = 0; m < 4; ++m) { const f32x4 g0 = acc[ai][0][m][0] + bg0, g1 = acc[ai][0][m][1] + bg1, u0 = acc[ai][1][m][0] + bu0, u1 = acc[ai][1][m][1] + bu1; f32x4 r0, r1;
#pragma unroll
                for (int i = 0; i < 4; ++i) { r0[i] = swiglu(g0[i], u0[i]); r1[i] = swiglu(g1[i], u1[i]); }
                *(u32x4*)(h + (size_t)(row0 + ai * HALF + m * 16) * DFF + ff0) = pack8(r0, r1); } } };
struct EpiDnF { static constexpr bool PERM = true; bf16* y; const float* b_dn; const float* gs;
    __device__ __forceinline__ void operator()(const Acc& acc, const Unit& u, int wr, int wc, int fr, int fq) const {
        const int row0 = u.pm * BM + wr * 64 + fr, col0 = u.pn * BM + wc * 32 + 8 * fq; const float* bb = b_dn + (size_t)u.e * D + col0;
        f32x4 bv[2][2];
#pragma unroll
        for (int bj = 0; bj < 2; ++bj)
#pragma unroll
            for (int n = 0; n < 2; ++n) bv[bj][n] = *(const f32x4*)(bb + bj * HALF + 4 * n);
#pragma unroll
        for (int ai = 0; ai < 2; ++ai)
#pragma unroll
            for (int m = 0; m < 4; ++m) { const int row = row0 + ai * HALF + m * 16; const float g = gs[row]; bf16* rowp = y + (size_t)row * D + col0;
#pragma unroll
                for (int bj = 0; bj < 2; ++bj) *(u32x4*)(rowp + bj * HALF) = pack8((acc[ai][bj][m][0] + bv[bj][0]) * g, (acc[ai][bj][m][1] + bv[bj][1]) * g); } } };

template <class Epi, class Sched, bool ALIGN_EPI>
__device__ __forceinline__ void gemm_phase(LAS unsigned char* lds, const Gemm g, const Sched& S, const Epi& E) {
    const int tid = threadIdx.x, wid = __builtin_amdgcn_readfirstlane(tid >> 6), lane = tid & 63, wr = wid >> 2, wc = wid & 3, fr = lane & 15, fq = lane >> 4;
    const int K = g.K, nt = K / BK;
    unsigned voffA[2], voffB[2];
#pragma unroll
    for (int i = 0; i < 2; ++i) { int R, C; stage_rc(tid * 16 + i * 8192, R, C); const int Rb = Epi::PERM ? ((R & ~31) + perm32(R & 31)) : R;
        voffA[i] = (unsigned)(R * g.lda + C) * 2u; voffB[i] = (unsigned)(Rb * g.ldb + C) * 2u; }
    const size_t kstep = (size_t)(BK * 2);
    const size_t hstepA = (size_t)HALF * g.lda * 2, hstepB = (size_t)HALF * g.ldb * 2;
    const unsigned ldsw = (unsigned)wid * 1024u;
    const int aoff = lds_byte(wr * 64 + fr, fq * 8), boff = lds_byte(wc * 32 + fr, fq * 8);
#define PG_SA(b, h) (((b) * 2 + (h)) * HTB)
#define PG_SB(b, h) ((4 + (b) * 2 + (h)) * HTB)
#define PG_STAGE(bufoff, gbase, voff) do { _Pragma("unroll") for (int _i = 0; _i < 2; ++_i) \
        __builtin_amdgcn_global_load_lds((const unsigned*)((const char*)(gbase) + (voff)[_i]), (LAS unsigned*)(lds + (bufoff) + ldsw + _i * 8192), 16, 0, 0); } while (0)
#define PG_LDA(dst, b, h) do { _Pragma("unroll") for (int m = 0; m < 4; ++m) _Pragma("unroll") for (int k = 0; k < 2; ++k) dst[m][k] = *(const LAS bf16x8*)(lds + PG_SA(b, h) + aoff + m * 2048 + k * 1024); } while (0)
#define PG_LDB(dst, b, h) do { _Pragma("unroll") for (int n = 0; n < 2; ++n) _Pragma("unroll") for (int k = 0; k < 2; ++k) dst[n][k] = *(const LAS bf16x8*)(lds + PG_SB(b, h) + boff + n * 2048 + k * 1024); } while (0)
#define PG_MMA(ai, bj, At, Bt) do { __builtin_amdgcn_s_setprio(1); _Pragma("unroll") for (int m = 0; m < 4; ++m) _Pragma("unroll") for (int n = 0; n < 2; ++n) _Pragma("unroll") for (int k = 0; k < 2; ++k) \
        acc[ai][bj][m][n] = __builtin_amdgcn_mfma_f32_16x16x32_bf16(Bt[n][k], At[m][k], acc[ai][bj][m][n], 0, 0, 0); __builtin_amdgcn_s_setprio(0); } while (0)
#define PG_WAIT_V(n) asm volatile("s_waitcnt vmcnt(" #n ")" ::: "memory")
#define PG_WAIT_L(n) asm volatile("s_waitcnt lgkmcnt(" #n ")" ::: "memory")
#define PG_BAR __builtin_amdgcn_s_barrier()
#define PG_SCHED __builtin_amdgcn_sched_barrier(0)
    Unit cur, nxt; int ui = 0;
    if (!S.next(0, cur)) return;
    f32x4 acc[2][2][4][2];
#pragma unroll
    for (int a = 0; a < 2; ++a)
#pragma unroll
        for (int b = 0; b < 2; ++b)
#pragma unroll
            for (int m = 0; m < 4; ++m)
#pragma unroll
                for (int n = 0; n < 2; ++n) acc[a][b][m][n] = (f32x4){0.f, 0.f, 0.f, 0.f};
    bf16x8 At[4][2], B0[2][2], B1[2][2];
    const char* cA = cur.a; const char* cB = cur.b;
    PG_STAGE(PG_SB(0, 0), cB, voffB); PG_STAGE(PG_SB(0, 1), cB + hstepB, voffB); PG_STAGE(PG_SA(0, 0), cA, voffA); PG_STAGE(PG_SA(0, 1), cA + hstepA, voffA);
    if (wr == 1) PG_BAR;
    PG_WAIT_V(2); PG_BAR;
    PG_STAGE(PG_SB(1, 0), cB + kstep, voffB); PG_STAGE(PG_SA(1, 0), cA + kstep, voffA); PG_STAGE(PG_SB(1, 1), cB + hstepB + kstep, voffB);
    PG_WAIT_V(6); PG_BAR;
    for (;;) {
        const bool has_next = S.next(ui + 1, nxt);
        const char* nA = has_next ? nxt.a : cA; const char* nB = has_next ? nxt.b : cB;
        for (int t = 0; t < nt; t += 2) {
            const bool last = (t == nt - 2);
            const char* a1 = cA + (size_t)(t + 1) * kstep;
            const char* a2 = last ? nA : cA + (size_t)(t + 2) * kstep; const char* b2 = last ? nB : cB + (size_t)(t + 2) * kstep;
            const char* a3 = a2 + kstep; const char* b3 = b2 + kstep;
            PG_LDB(B0, 0, 0); PG_LDB(B1, 0, 1); PG_SCHED; PG_LDA(At, 0, 0); PG_STAGE(PG_SA(1, 1), a1 + hstepA, voffA);
            PG_WAIT_V(8); PG_WAIT_L(0); PG_BAR; PG_MMA(0, 0, At, B0); PG_MMA(0, 1, At, B1); PG_BAR; PG_SCHED;
            PG_LDA(At, 0, 1); PG_STAGE(PG_SB(0, 0), b2, voffB); PG_STAGE(PG_SB(0, 1), b2 + hstepB, voffB); PG_STAGE(PG_SA(0, 0), a2, voffA);
            PG_WAIT_V(8); PG_WAIT_L(0); PG_BAR; PG_MMA(1, 0, At, B0); PG_MMA(1, 1, At, B1); PG_BAR; PG_SCHED;
            PG_LDB(B0, 1, 0); PG_LDB(B1, 1, 1); PG_SCHED; PG_LDA(At, 1, 0); PG_STAGE(PG_SA(0, 1), a2 + hstepA, voffA);
            PG_WAIT_V(8); PG_WAIT_L(0); PG_BAR; PG_MMA(0, 0, At, B0); PG_MMA(0, 1, At, B1); PG_BAR; PG_SCHED;
            PG_LDA(At, 1, 1); PG_STAGE(PG_SB(1, 0), b3, voffB); PG_STAGE(PG_SB(1, 1), b3 + hstepB, voffB); PG_STAGE(PG_SA(1, 0), a3, voffA);
            PG_WAIT_V(8); PG_WAIT_L(0); PG_BAR; PG_MMA(1, 0, At, B0); PG_MMA(1, 1, At, B1); PG_BAR; PG_SCHED;
        }
        if constexpr (ALIGN_EPI) { if (wr == 0) PG_BAR; }
        E(acc, cur, wr, wc, fr, fq);
        if (!has_next) break;
#pragma unroll
        for (int a = 0; a < 2; ++a)
#pragma unroll
            for (int b = 0; b < 2; ++b)
#pragma unroll
                for (int m = 0; m < 4; ++m)
#pragma unroll
                    for (int n = 0; n < 2; ++n) acc[a][b][m][n] = (f32x4){0.f, 0.f, 0.f, 0.f};
        cur = nxt; cA = nA; cB = nB; ++ui;
        if constexpr (ALIGN_EPI) { if (wr == 1) PG_BAR; }
    }
    PG_WAIT_V(0);
    if constexpr (!ALIGN_EPI) { if (wr == 0) PG_BAR; }
    PG_BAR;
#undef PG_SA
#undef PG_SB
#undef PG_STAGE
#undef PG_LDA
#undef PG_LDB
#undef PG_MMA
#undef PG_WAIT_V
#undef PG_WAIT_L
#undef PG_BAR
#undef PG_SCHED
}
}

#define XB_TMO      128
#define XB_XCNT(j)  (256  + 64 * (j))
#define XB_XSUB(j)  (1280 + 64 * (j))
#define XB_XGEN(j)  (2304 + 64 * (j))
#define XB_TOP      3328
#define XB_TOPGEN   3392
#define XCD_BAR_WORDS 3456
#define XB_SPIN_CAP (1u << 18)
__device__ __forceinline__ unsigned xb_ld(unsigned* p)              { return __hip_atomic_load(p, __ATOMIC_RELAXED, __HIP_MEMORY_SCOPE_AGENT); }
__device__ __forceinline__ unsigned xb_add(unsigned* p, unsigned v) { return __hip_atomic_fetch_add(p, v, __ATOMIC_RELAXED, __HIP_MEMORY_SCOPE_AGENT); }
__device__ __forceinline__ unsigned xb_xcc_id() { return (unsigned)__builtin_amdgcn_s_getreg((3 << 11) | 20) & 0xFu; }
#define XB_SPIN(cond, bar) do { unsigned _sp = 0; while (cond) { __builtin_amdgcn_s_sleep(1); \
    if ((++_sp & 255u) == 0u) { if (xb_ld(&(bar)[XB_TMO])) break; if (_sp > XB_SPIN_CAP) { atomicAdd(&(bar)[XB_TMO], 1u); break; } } } } while (0)
struct XcdBarrier { unsigned* bar; unsigned x; volatile LAS unsigned* st; };
__device__ __forceinline__ XcdBarrier xcd_barrier_post(unsigned* bar, volatile LAS unsigned* st) {
    XcdBarrier b; b.bar = bar; b.x = xb_xcc_id(); b.st = st;
    if (threadIdx.x == 0) (void)xb_add(&bar[XB_XCNT(b.x)], 1u);
    return b;
}
__device__ __forceinline__ void xcd_barrier_complete(unsigned* bar, unsigned x, unsigned& nloc, unsigned& nx) {
    const unsigned G = gridDim.x * gridDim.y * gridDim.z;
    unsigned sum, cnt, mine, sp = 0u;
    for (;;) {
        sum = 0u; cnt = 0u; mine = 0u;
#pragma unroll
        for (unsigned j = 0; j < 16; ++j) { const unsigned c = xb_ld(&bar[XB_XCNT(j)]); sum += c; cnt += (c > 0u) ? 1u : 0u; mine = (j == x) ? c : mine; }
        if (sum == G) break;
        __builtin_amdgcn_s_sleep(1);
        if ((++sp & 255u) == 0u) { if (xb_ld(&bar[XB_TMO])) break; if (sp > XB_SPIN_CAP) { atomicAdd(&bar[XB_TMO], 1u); break; } }
    }
    nloc = mine > 0u ? mine : 1u; nx = cnt > 0u ? cnt : 1u;
}
__device__ __forceinline__ void xcd_barrier(const XcdBarrier& b) {
    asm volatile("s_waitcnt vmcnt(0)" ::: "memory");
    __syncthreads();
    if (threadIdx.x == 0) {
        unsigned* bar = b.bar;
        __builtin_amdgcn_s_waitcnt(0);
        unsigned nloc = b.st[0], nx = b.st[1];
        if (nloc == 0u) { xcd_barrier_complete(bar, b.x, nloc, nx); b.st[0] = nloc; b.st[1] = nx; }
        const unsigned old = xb_add(&bar[XB_XSUB(b.x)], 1u);
        const unsigned gen = old / nloc;
        if (old + 1u == (gen + 1u) * nloc) {
            __builtin_amdgcn_fence(__ATOMIC_RELEASE, "agent");
            asm volatile("s_waitcnt vmcnt(0)" ::: "memory");
            const unsigned og = xb_add(&bar[XB_TOP], 1u);
            const unsigned tg = og / nx;
            if (og + 1u == (tg + 1u) * nx) xb_add(&bar[XB_TOPGEN], 1u);
            else XB_SPIN(xb_ld(&bar[XB_TOPGEN]) == tg, bar);
            __builtin_amdgcn_fence(__ATOMIC_ACQUIRE, "agent");
            xb_add(&bar[XB_XGEN(b.x)], 1u);
            asm volatile("s_waitcnt vmcnt(0)" ::: "memory");
        } else {
            XB_SPIN(xb_ld(&bar[XB_XGEN(b.x)]) == gen, bar);
            __builtin_amdgcn_fence(__ATOMIC_ACQUIRE, "agent");
            asm volatile("s_waitcnt vmcnt(0)" ::: "memory");
        }
    }
    __syncthreads();
}

constexpr int LDS_BYTES = 147456, MISC_OFF = LDS_BYTES - 128;
constexpr int NPHASE = 16;
struct Args { const float* in[24]; float* out; unsigned char* ws; int ph_lo, ph_hi; };

__global__ void __launch_bounds__(NTHREADS, 2) mk_fwd(Args a) {
    extern __shared__ __attribute__((aligned(16))) unsigned char lds[];
    float* ldsf = (float*)lds;
    P p;
    p.x = a.in[0]; p.mem = a.in[1]; p.g_mix = a.in[2]; p.w_in = a.in[3]; p.w_pool = a.in[4]; p.pool_scale = a.in[5]; p.w_gate_up = a.in[6]; p.b_gate_up = a.in[7];
    p.gla_g = a.in[8]; p.w_out = a.in[9]; p.g_xattn = a.in[10]; p.g_mem = a.in[11]; p.w_xq = a.in[12]; p.w_xk = a.in[13]; p.w_xv = a.in[14]; p.w_xo = a.in[15];
    p.g_moe = a.in[16]; p.w_router = a.in[17]; p.b_router = a.in[18]; p.w_gu = a.in[19]; p.b_gu = a.in[20]; p.w_dn = a.in[21]; p.b_dn = a.in[22]; p.g_final = a.in[23];
    p.out = a.out; unsigned char* ws = a.ws; p.ctl = (unsigned*)(ws + WS_CTL);
    p.wt_in = (bf16*)(ws + WS_WT_IN); p.wt_out = (bf16*)(ws + WS_WT_OUT); p.wt_xq = (bf16*)(ws + WS_WT_XQ); p.wt_xk = (bf16*)(ws + WS_WT_XK); p.wt_xv = (bf16*)(ws + WS_WT_XV); p.wt_xo = (bf16*)(ws + WS_WT_XO);
    p.wt_gu = (bf16*)(ws + WS_WT_GU); p.wt_dn = (bf16*)(ws + WS_WT_DN);
    p.xn = (bf16*)(ws + WS_XN); p.hm = (bf16*)(ws + WS_HM); p.z1 = (bf16*)(ws + WS_Z1); p.mix = (bf16*)(ws + WS_MIX); p.a2 = (bf16*)(ws + WS_A2); p.kx = (bf16*)(ws + WS_KX); p.vxt = (bf16*)(ws + WS_VXT);
    p.qx = (bf16*)(ws + WS_QX); p.px = (bf16*)(ws + WS_PX); p.ox = (bf16*)(ws + WS_OX); p.xs = (bf16*)(ws + WS_XS); p.h = (bf16*)(ws + WS_H); p.y = (bf16*)(ws + WS_Y);
    p.sprev = (float*)(ws + WS_SPREV); p.ds = (float*)(ws + WS_DS); p.dec = (float*)(ws + WS_DEC); p.x1 = (float*)(ws + WS_X1); p.x2 = (float*)(ws + WS_X2); p.sc = (float*)(ws + WS_SC);
    p.rs2 = (float*)(ws + WS_RS2); p.topg = (float*)(ws + WS_TOPG); p.gslot = (float*)(ws + WS_GSLOT); p.topi = (int*)(ws + WS_TOPI); p.slotof = (int*)(ws + WS_SLOTOF); p.tilee = (int*)(ws + WS_TILEE);
    const int bid = blockIdx.x, nb = gridDim.x;
    const int lo = a.ph_lo, hi = a.ph_hi;
#ifndef PH
#define PH -1
#endif
#ifndef REPMASK
#define REPMASK 0
#endif
#define REP(k) ((((REPMASK) >> (k)) & 1) ? 2 : 1)
#ifndef FASTMASK
#define FASTMASK 0x7FF
#endif
#define IN(k) ((PH < 0 || PH == (k)) && lo <= (k) && (k) < hi)
    LAS unsigned char* ldsl = (LAS unsigned char*)lds;
    float* rowsq1 = (float*)(p.ctl + CW_ROWSQ1);
    volatile LAS unsigned* MISC = (volatile LAS unsigned*)(ldsl + MISC_OFF);
    if (threadIdx.x < 32) MISC[threadIdx.x] = 0u;
    __syncthreads();
    const bool fused = (hi - lo) > 1;
    XcdBarrier bar; bar.bar = p.ctl + CW_BAR; bar.x = 0; bar.st = MISC + 8;
    if (fused) bar = xcd_barrier_post(p.ctl + CW_BAR, MISC + 8);
#define SEAM(k) do { if (fused && IN(k) && IN((k) + 1)) xcd_barrier(bar); } while (0)
    if (IN(0)) for (int rep_ = 0; rep_ < REP(0); ++rep_) { if (rep_) xcd_barrier(bar);
    phase_prologue(p, ldsf, bid, nb);
    }
    SEAM(0);
    if (IN(1)) for (int rep_ = 0; rep_ < REP(1); ++rep_) { if (rep_) xcd_barrier(bar);
    {
        if (FASTMASK & 1) { pg::SchedG1 S{(const char*)ws, nb, bid}; pg::EpiBf3 E{ws, WS_Z1, WS_KX, WS_VXT, NZ, D, BATCH * MEMLEN};
            pg::gemm_phase<pg::EpiBf3, pg::SchedG1, true>(ldsl, pg::Gemm{D, D, D}, S, E); }
        else {
        ngemm(NG{p.xn, D, p.wt_in, D, M, NZ, D, nullptr, 0}, EpiBf{p.z1, NZ}, ldsf, bid, nb);
        ngemm(NG{p.hm, D, p.wt_xk, D, BATCH * MEMLEN, D, D, nullptr, 0}, EpiBf{p.kx, D}, ldsf, bid, nb);
        ngemm(NG{p.wt_xv, D, p.hm, D, D, BATCH * MEMLEN, D, nullptr, 0}, EpiBf{p.vxt, BATCH * MEMLEN}, ldsf, bid, nb); }
    }
    }
    SEAM(1);
    if (IN(2)) for (int rep_ = 0; rep_ < REP(2); ++rep_) { if (rep_) xcd_barrier(bar);
    { if (FASTMASK & 256) phase_pool2(p, lds, bid, nb); else phase_pool(p, ldsf, bid, nb);
      if (FASTMASK & 512) phase_gla_a2(p, lds, bid, nb); else phase_gla_a(p, ldsf, bid, nb); }
    }
    SEAM(2);
    if (IN(3)) for (int rep_ = 0; rep_ < REP(3); ++rep_) { if (rep_) xcd_barrier(bar);
    if (FASTMASK & 512) phase_scan2(p, bid, nb); else phase_scan(p, bid, nb);
    }
    SEAM(3);
    if (IN(4)) for (int rep_ = 0; rep_ < REP(4); ++rep_) { if (rep_) xcd_barrier(bar);
    if (FASTMASK & 512) phase_gla_b2(p, lds, bid, nb); else phase_gla_b(p, ldsf, bid, nb);
    }
    SEAM(4);
    if (IN(5)) for (int rep_ = 0; rep_ < REP(5); ++rep_) { if (rep_) xcd_barrier(bar);
    {
        if (FASTMASK & 2) { pg::Sched2D S{p.mix, p.wt_out, D, D, M / 256, D / 256, nb, bid}; pg::EpiOutF E{p.x, p.x1, p.a2, p.g_xattn, rowsq1};
            pg::gemm_phase<pg::EpiOutF, pg::Sched2D, false>(ldsl, pg::Gemm{D, D, D}, S, E); }
        else ngemm(NG{p.mix, D, p.wt_out, D, M, D, D, nullptr, 0}, EpiOut{p.x, p.x1, p.a2, p.g_xattn, rowsq1}, ldsf, bid, nb);
    }
    }
    SEAM(5);
    if (IN(6)) for (int rep_ = 0; rep_ < REP(6); ++rep_) { if (rep_) xcd_barrier(bar);
    {
        if (FASTMASK & 4) { pg::Sched2D S{p.a2, p.wt_xq, D, D, M / 256, D / 256, nb, bid}; pg::EpiQF E{p.qx, rowsq1};
            pg::gemm_phase<pg::EpiQF, pg::Sched2D, false>(ldsl, pg::Gemm{D, D, D}, S, E); }
        else ngemm(NG{p.a2, D, p.wt_xq, D, M, D, D, nullptr, 0}, EpiQ{p.qx, rowsq1}, ldsf, bid, nb);
    }
    }
    SEAM(6);
    if (IN(7)) for (int rep_ = 0; rep_ < REP(7); ++rep_) { if (rep_) xcd_barrier(bar);
    {
        if (FASTMASK & 8) { pg::SchedAttn S{p.qx, p.kx, (size_t)MEMLEN * D, 256, nb, bid}; pg::EpiF E{p.sc, D};
            pg::gemm_phase<pg::EpiF, pg::SchedAttn, false>(ldsl, pg::Gemm{D, D, 256}, S, E); }
        else for (int bh = 0; bh < 8; ++bh) { const int b = bh >> 2, h = bh & 3; const size_t o = (size_t)b * SEQ * D + h * 256;
            ngemm(NG{p.qx + o, D, p.kx + (size_t)b * MEMLEN * D + h * 256, D, SEQ, 256, 256, nullptr, 0}, EpiF32{p.sc + o, D}, ldsf, bid, nb); }
    }
    }
    SEAM(7);
    if (IN(8)) for (int rep_ = 0; rep_ < REP(8); ++rep_) { if (rep_) xcd_barrier(bar);
    phase_softmax(p, bid, nb);
    }
    SEAM(8);
    if (IN(9)) for (int rep_ = 0; rep_ < REP(9); ++rep_) { if (rep_) xcd_barrier(bar);
    {
        if (FASTMASK & 16) { pg::SchedAttn S{p.px, p.vxt, (size_t)MEMLEN, (size_t)256 * BATCH * MEMLEN, nb, bid}; pg::EpiBf3 E{ws, WS_OX, WS_OX, WS_OX, D, D, D};
            pg::gemm_phase<pg::EpiBf3, pg::SchedAttn, false>(ldsl, pg::Gemm{D, BATCH * MEMLEN, 256}, S, E); }
        else for (int bh = 0; bh < 8; ++bh) { const int b = bh >> 2, h = bh & 3; const size_t o = (size_t)b * SEQ * D + h * 256;
            ngemm(NG{p.px + o, D, p.vxt + (size_t)h * 256 * (BATCH * MEMLEN) + b * MEMLEN, BATCH * MEMLEN, SEQ, 256, 256, nullptr, 0}, EpiBf{p.ox + o, D}, ldsf, bid, nb); }
    }
    }
    SEAM(9);
    if (IN(10)) for (int rep_ = 0; rep_ < REP(10); ++rep_) { if (rep_) xcd_barrier(bar);
    {
        if (FASTMASK & 32) { pg::Sched2D S{p.ox, p.wt_xo, D, D, M / 256, D / 256, nb, bid}; pg::EpiResF E{p.x1, p.x2};
            pg::gemm_phase<pg::EpiResF, pg::Sched2D, false>(ldsl, pg::Gemm{D, D, D}, S, E); }
        else ngemm(NG{p.ox, D, p.wt_xo, D, M, D, D, nullptr, 0}, EpiRes{p.x1, p.x2}, ldsf, bid, nb);
    }
    }
    SEAM(10);
    if (IN(11)) for (int rep_ = 0; rep_ < REP(11); ++rep_) { if (rep_) xcd_barrier(bar);
    if (FASTMASK & 1024) phase_router2(p, ldsf, (int*)(ws + WS_BLKCNT), (int*)(ws + WS_WAVEBASE), bid, nb); else phase_router(p, ldsf, bid, nb);
    }
    SEAM(11);
    if (IN(12)) for (int rep_ = 0; rep_ < REP(12); ++rep_) { if (rep_) xcd_barrier(bar);
    if (FASTMASK & 1024) phase_dispatch2(p, (int*)lds, (const int*)(ws + WS_BLKCNT), (const int*)(ws + WS_WAVEBASE), bid, nb); else phase_dispatch(p, (int*)lds, bid, nb);
    }
    SEAM(12);
    if (IN(13)) for (int rep_ = 0; rep_ < REP(13); ++rep_) { if (rep_) xcd_barrier(bar);
    { const int nmt = p.tilee[MAXMT];
        if (FASTMASK & 64) { pg::SchedMoE S{p.xs, p.wt_gu, p.tilee, (size_t)2 * DFF * D, nmt, 8, nb, bid}; pg::EpiUpF E{p.h, p.b_gu};
            pg::gemm_phase<pg::EpiUpF, pg::SchedMoE, true>(ldsl, pg::Gemm{D, D, D}, S, E); }
        else ngemm(NG{p.xs, D, p.wt_gu, D, nmt * 256, 2 * DFF, D, p.tilee, (size_t)2 * DFF * D}, EpiUp{p.h, p.b_gu}, ldsf, bid, nb); }
    }
    SEAM(13);
    if (IN(14)) for (int rep_ = 0; rep_ < REP(14); ++rep_) { if (rep_) xcd_barrier(bar);
    { const int nmt = p.tilee[MAXMT];
        if (FASTMASK & 128) { pg::SchedMoE S{p.h, p.wt_dn, p.tilee, (size_t)D * DFF, nmt, 4, nb, bid}; pg::EpiDnF E{p.y, p.b_dn, p.gslot};
            pg::gemm_phase<pg::EpiDnF, pg::SchedMoE, true>(ldsl, pg::Gemm{DFF, DFF, DFF}, S, E); }
        else ngemm(NG{p.h, DFF, p.wt_dn, DFF, nmt * 256, D, DFF, p.tilee, (size_t)D * DFF}, EpiDn{p.y, p.b_dn, p.gslot}, ldsf, bid, nb); }
    }
    SEAM(14);
    if (IN(15)) for (int rep_ = 0; rep_ < REP(15); ++rep_) { if (rep_) xcd_barrier(bar);
    phase_final(p, bid, nb);
    }
#undef IN
#undef SEAM
}

extern "C" void kernel_launch(void* const* d_in, const int* in_sizes, int n_in, void* d_out, int out_size, void* d_ws, size_t ws_size, hipStream_t stream) {
    static int grid = 0;
    if (grid == 0) {
        if (n_in != 24 || in_sizes[0] != M * D || out_size != M * D || ws_size < WS_END) { fprintf(stderr, "kernel_launch: unexpected shapes (n_in %d, in0 %d, out %d, ws %zu)\n", n_in, n_in > 0 ? in_sizes[0] : -1, out_size, ws_size); grid = -1; return; }
        int dev = 0, cus = 0;
        if (hipGetDevice(&dev) != hipSuccess || hipDeviceGetAttribute(&cus, hipDeviceAttributeMultiprocessorCount, dev) != hipSuccess) { grid = -1; return; }
        if (hipFuncSetAttribute((const void*)mk_fwd, hipFuncAttributeMaxDynamicSharedMemorySize, LDS_BYTES) != hipSuccess) { fprintf(stderr, "kernel_launch: hipFuncSetAttribute failed\n"); grid = -1; return; }
        grid = cus > 0 ? cus : 256;
    }
    if (grid < 0) return;
    (void)hipMemsetAsync((char*)d_ws + WS_CTL, 0, CTL_BYTES, stream);
    Args a{};
    for (int i = 0; i < 24; ++i) a.in[i] = (const float*)d_in[i];
    a.out = (float*)d_out; a.ws = (unsigned char*)d_ws;
#if defined(MK_PER_PHASE)
    for (int ph = 0; ph < NPHASE; ++ph) { a.ph_lo = ph; a.ph_hi = ph + 1; hipLaunchKernelGGL(mk_fwd, dim3(grid), dim3(NTHREADS), LDS_BYTES, stream, a); }
#else
    a.ph_lo = 0; a.ph_hi = NPHASE; hipLaunchKernelGGL(mk_fwd, dim3(grid), dim3(NTHREADS), LDS_BYTES, stream, a);
#endif
}
```

```cpp
#include <hip/hip_runtime.h>
#include <cstdio>
#include <cstdint>

#define LAS __attribute__((address_space(3)))
typedef unsigned short bf16;
typedef float f32x4 __attribute__((ext_vector_type(4)));
typedef unsigned u32x4 __attribute__((ext_vector_type(4)));
typedef unsigned u32x2 __attribute__((ext_vector_type(2)));

constexpr int BATCH = 2, SEQ = 8192, M = BATCH * SEQ, D = 1024;
constexpr int IN_COLS = 2064, NZ = 2304;
constexpr int ZQ = 512, ZK = 768, ZV = 1024, ZR = 1536, ZG = 2048;
constexpr int NE = 32, TOPK = 4, DFF = 1024, MEMLEN = 256;
constexpr int NASSIGN = M * TOPK, MAXSLOT = NASSIGN + NE * 256, MAXMT = MAXSLOT / 256;
constexpr int NCHUNK = SEQ / 64;
constexpr float EPS = 1e-6f;
constexpr int NTHREADS = 512, NWAVES = 8, NBLOCKS = 256;

constexpr size_t MiB = 1u << 20;
constexpr size_t WS_CTL = 0, CTL_BYTES = 1 * MiB;
constexpr size_t WS_WT_OUT = 2 * MiB, WS_WT_XQ = 4 * MiB, WS_WT_XK = 6 * MiB, WS_WT_XV = 8 * MiB, WS_WT_XO = 10 * MiB, WS_WT_IN = 12 * MiB;
constexpr size_t WS_SMALL = 17 * MiB;
constexpr size_t WS_RS2 = WS_SMALL, WS_TOPI = WS_SMALL + 64 * 1024, WS_TOPG = WS_TOPI + 256 * 1024, WS_SLOTOF = WS_TOPG + 256 * 1024,
                 WS_GSLOT = WS_SLOTOF + 256 * 1024, WS_TILEE = WS_GSLOT + 320 * 1024, WS_BLKCNT = WS_TILEE + 4096, WS_WAVEBASE = WS_BLKCNT + 32768;
constexpr size_t WS_WT_GU = 20 * MiB, WS_WT_DN = 148 * MiB, WS_X2 = 212 * MiB, WS_B = 276 * MiB;
constexpr size_t WS_XN = WS_B, WS_HM = WS_B + 32 * MiB, WS_Z1 = WS_B + 33 * MiB, WS_MIX = WS_B + 121 * MiB, WS_SPREV = WS_B + 153 * MiB,
                 WS_DS = WS_B + 185 * MiB, WS_DEC = WS_B + 217 * MiB, WS_X1 = WS_B + 218 * MiB, WS_A2 = WS_B + 282 * MiB, WS_KX = WS_B + 314 * MiB, WS_VXT = WS_B + 315 * MiB;
constexpr size_t WS_QX = WS_Z1, WS_PX = WS_Z1 + 32 * MiB, WS_SC = WS_MIX, WS_OX = WS_DS;
constexpr size_t WS_XS = WS_B, WS_H = WS_B + 144 * MiB, WS_Y = WS_B + 288 * MiB, WS_END = WS_B + 432 * MiB;
constexpr int CW_BAR = 4096, CW_COUNT = 8192, CW_CURSOR = 8256, CW_ROWSQ1 = 16384;

__device__ __forceinline__ float bf_lo(unsigned w) { return __uint_as_float(w << 16); }
__device__ __forceinline__ float bf_hi(unsigned w) { return __uint_as_float(w & 0xffff0000u); }
__device__ __forceinline__ float bf2f(bf16 v) { return __uint_as_float((unsigned)v << 16); }
__device__ __forceinline__ unsigned f2bf(float f) { unsigned u = __float_as_uint(f); return (u + 0x7fffu + ((u >> 16) & 1u)) >> 16; }
__device__ __forceinline__ unsigned pk2(float lo, float hi) { return f2bf(lo) | (f2bf(hi) << 16); }
__device__ __forceinline__ float wave_sum(float v) {
#pragma unroll
    for (int o = 1; o < 64; o <<= 1) v += __shfl_xor(v, o);
    return v;
}
__device__ __forceinline__ float clamp8(float v) { return fminf(fmaxf(v, -448.f), 448.f); }
__device__ __forceinline__ unsigned pk4_fp8(float a, float b, float c, float d) { int w = __builtin_amdgcn_cvt_pk_fp8_f32(clamp8(a), clamp8(b), 0, false); w = __builtin_amdgcn_cvt_pk_fp8_f32(clamp8(c), clamp8(d), w, true); return (unsigned)w; }
constexpr float W8_SCALE = 32.f, W8_INV = 1.f / 32.f;
#ifndef MOE_FP8
#define MOE_FP8 1
#endif
__device__ __forceinline__ float logsigmoid(float x) { return fminf(x, 0.f) - log1pf(expf(-fabsf(x))); }

struct P {
    const float *x, *mem, *g_mix, *w_in, *w_pool, *pool_scale, *w_gate_up, *b_gate_up, *gla_g, *w_out, *g_xattn, *g_mem, *w_xq, *w_xk, *w_xv, *w_xo,
                *g_moe, *w_router, *b_router, *w_gu, *b_gu, *w_dn, *b_dn, *g_final;
    float* out; unsigned char* ws;
#define PACC(type, name, off) __device__ __forceinline__ type* name() const { return (type*)(ws + (off)); }
    PACC(unsigned, ctl, WS_CTL)
    PACC(bf16, wt_in, WS_WT_IN) PACC(bf16, wt_out, WS_WT_OUT) PACC(bf16, wt_xq, WS_WT_XQ) PACC(bf16, wt_xk, WS_WT_XK) PACC(bf16, wt_xv, WS_WT_XV) PACC(bf16, wt_xo, WS_WT_XO) PACC(bf16, wt_gu, WS_WT_GU) PACC(bf16, wt_dn, WS_WT_DN)
    PACC(bf16, xn, WS_XN) PACC(bf16, hm, WS_HM) PACC(bf16, z1, WS_Z1) PACC(bf16, mix, WS_MIX) PACC(bf16, a2, WS_A2) PACC(bf16, kx, WS_KX) PACC(bf16, vxt, WS_VXT)
    PACC(bf16, qx, WS_QX) PACC(bf16, px, WS_PX) PACC(bf16, ox, WS_OX) PACC(bf16, xs, WS_XS) PACC(bf16, h, WS_H) PACC(bf16, y, WS_Y)
    PACC(float, sprev, WS_SPREV) PACC(float, ds, WS_DS) PACC(float, dec, WS_DEC) PACC(float, x1, WS_X1) PACC(float, x2, WS_X2) PACC(float, sc, WS_SC)
    PACC(float, rs2, WS_RS2) PACC(float, topg, WS_TOPG) PACC(float, gslot, WS_GSLOT) PACC(int, topi, WS_TOPI) PACC(int, slotof, WS_SLOTOF) PACC(int, tilee, WS_TILEE)
#undef PACC
};

struct MapId { __device__ __forceinline__ int operator()(int n) const { return n; } };
struct MapIn { __device__ __forceinline__ int operator()(int n) const { return n < 1536 ? n : (n < 2048 ? 1552 + (n - 1536) : (n < 2064 ? 1536 + (n - 2048) : -1)); } };
struct MapGu { __device__ __forceinline__ int operator()(int n) const { const int pn = n >> 8, w = n & 255; return w < 128 ? pn * 128 + w : 1024 + pn * 128 + (w - 128); } };

template <class Map>
__device__ __forceinline__ void transpose_item(const float* W, int ldw, int K, bf16* WT, float* scr, int kb, int nb, int lane, Map map) {
    const int k0 = 64 * kb, n0 = 32 * nb;
    const int sc = map(n0 + (lane & 31));
#pragma unroll 8
    for (int i = 0; i < 32; ++i) { const int kk = 2 * i + (lane >> 5); scr[kk * 33 + (lane & 31)] = sc >= 0 ? W[(size_t)(k0 + kk) * ldw + sc] : 0.f; }
    __builtin_amdgcn_s_waitcnt(0xC07F); asm volatile("" ::: "memory");
    const int c = lane & 7;
#pragma unroll
    for (int j = 0; j < 4; ++j) { const int n = (lane >> 3) + 8 * j; const float* s = scr + (8 * c) * 33 + n;
        u32x4 o; o.x = pk2(s[0 * 33], s[1 * 33]); o.y = pk2(s[2 * 33], s[3 * 33]); o.z = pk2(s[4 * 33], s[5 * 33]); o.w = pk2(s[6 * 33], s[7 * 33]);
        *(u32x4*)(WT + (size_t)(n0 + n) * K + k0 + 8 * c) = o; }
    __builtin_amdgcn_s_waitcnt(0xC07F); asm volatile("" ::: "memory");
}
template <class Map>
__device__ __forceinline__ void transpose_item8(const float* W, int ldw, int K, unsigned char* WT, float* scr, int kb, int nb, int lane, Map map, float scale) {
    const int k0 = 128 * kb, n0 = 32 * nb;
    const int sc = map(n0 + (lane & 31));
#pragma unroll 8
    for (int i = 0; i < 64; ++i) { const int kk = 2 * i + (lane >> 5); scr[kk * 33 + (lane & 31)] = W[(size_t)(k0 + kk) * ldw + sc] * scale; }
    __builtin_amdgcn_s_waitcnt(0xC07F); asm volatile("" ::: "memory");
    const int c = lane & 7;
#pragma unroll
    for (int j = 0; j < 4; ++j) { const int n = (lane >> 3) + 8 * j; const float* s = scr + (16 * c) * 33 + n;
        u32x4 o; o.x = pk4_fp8(s[0 * 33], s[1 * 33], s[2 * 33], s[3 * 33]); o.y = pk4_fp8(s[4 * 33], s[5 * 33], s[6 * 33], s[7 * 33]);
        o.z = pk4_fp8(s[8 * 33], s[9 * 33], s[10 * 33], s[11 * 33]); o.w = pk4_fp8(s[12 * 33], s[13 * 33], s[14 * 33], s[15 * 33]);
        *(u32x4*)(WT + (size_t)(n0 + n) * K + k0 + 16 * c) = o; }
    __builtin_amdgcn_s_waitcnt(0xC07F); asm volatile("" ::: "memory");
}
template <class Dst>
__device__ __forceinline__ void conv8_item(const float* W, int ldw, int K, unsigned char* WT, int kb, int nb, int lane, Dst dst, float scale) {
    const int k0 = 64 * kb, n0 = 256 * nb + 4 * lane;
    const float* src = W + (size_t)k0 * ldw + n0;
    unsigned char* d0 = WT + (size_t)dst(n0) * K + k0;
#pragma unroll 2
    for (int c = 0; c < 4; ++c) {
        f32x4 v[16];
#pragma unroll
        for (int i = 0; i < 16; ++i) v[i] = *(const f32x4*)(src + (size_t)(16 * c + i) * ldw) * scale;
#pragma unroll
        for (int j = 0; j < 4; ++j) { u32x4 o; o.x = pk4_fp8(v[0][j], v[1][j], v[2][j], v[3][j]); o.y = pk4_fp8(v[4][j], v[5][j], v[6][j], v[7][j]);
            o.z = pk4_fp8(v[8][j], v[9][j], v[10][j], v[11][j]); o.w = pk4_fp8(v[12][j], v[13][j], v[14][j], v[15][j]);
            *(u32x4*)(d0 + (size_t)j * K + 16 * c) = o; }
    }
}
struct DstId { __device__ __forceinline__ int operator()(int n) const { return n; } };
struct DstGu { __device__ __forceinline__ int operator()(int n) const { const int up = n >> 10, ff = n & 1023; return (ff >> 7) * 256 + up * 128 + (ff & 127); } };
__device__ __forceinline__ void rms_row_bf16(const float* xrow, const float* g, bf16* orow, int lane) {
    const f32x4* xr = (const f32x4*)xrow + lane; f32x4 v[4]; float s = 0.f;
#pragma unroll
    for (int j = 0; j < 4; ++j) { v[j] = xr[64 * j]; s += (v[j].x * v[j].x + v[j].y * v[j].y) + (v[j].z * v[j].z + v[j].w * v[j].w); }
    const float rs = 1.0f / sqrtf(wave_sum(s) * (1.f / D) + EPS);
    u32x2* o8 = (u32x2*)orow + lane; const f32x4* gr = (const f32x4*)g + lane;
#pragma unroll
    for (int j = 0; j < 4; ++j) { const f32x4 gg = gr[64 * j]; u32x2 w; w.x = pk2(v[j].x * rs * gg.x, v[j].y * rs * gg.y); w.y = pk2(v[j].z * rs * gg.z, v[j].w * rs * gg.w); o8[64 * j] = w; }
}
__device__ __forceinline__ void phase_prologue(const P& p, float* ldsf, int bid, int nb) {
    const int tid = threadIdx.x, lane = tid & 63, wave = tid >> 6;
    float* scr = ldsf + wave * (128 * 33);
    const int gw = bid * NWAVES + wave, NGW = nb * NWAVES;
    constexpr int I_IN = 16 * (NZ / 32), I_SQ = 16 * 32, I_GU = MOE_FP8 ? 16 * 8 : 16 * 64, I_DN = MOE_FP8 ? 16 * 4 : 16 * 32;
    constexpr int NITEMS = I_IN + 5 * I_SQ + NE * I_GU + NE * I_DN;
    for (int it = gw; it < NITEMS; it += NGW) {
        int r = it;
        if (r < I_IN) { transpose_item(p.w_in, IN_COLS, D, p.wt_in(), scr, r / (NZ / 32), r % (NZ / 32), lane, MapIn()); continue; } r -= I_IN;
        if (r < 5 * I_SQ) { const int w = r / I_SQ, q = r % I_SQ; const float* src = w == 0 ? p.w_out : w == 1 ? p.w_xq : w == 2 ? p.w_xk : w == 3 ? p.w_xv : p.w_xo;
            bf16* dst = w == 0 ? p.wt_out() : w == 1 ? p.wt_xq() : w == 2 ? p.wt_xk() : w == 3 ? p.wt_xv() : p.wt_xo();
            transpose_item(src, D, D, dst, scr, q / 32, q % 32, lane, MapId()); continue; } r -= 5 * I_SQ;
        if (r < NE * I_GU) { const int e = r / I_GU, q = r % I_GU;
            if (MOE_FP8) conv8_item(p.w_gu + (size_t)e * D * 2 * DFF, 2 * DFF, D, (unsigned char*)p.wt_gu() + (size_t)e * 2 * DFF * D, q / 8, q % 8, lane, DstGu(), W8_SCALE);
            else transpose_item(p.w_gu + (size_t)e * D * 2 * DFF, 2 * DFF, D, p.wt_gu() + (size_t)e * 2 * DFF * D, scr, q / 64, q % 64, lane, MapGu()); continue; } r -= NE * I_GU;
        { const int e = r / I_DN, q = r % I_DN;
            if (MOE_FP8) conv8_item(p.w_dn + (size_t)e * DFF * D, D, DFF, (unsigned char*)p.wt_dn() + (size_t)e * D * DFF, q / 4, q % 4, lane, DstId(), W8_SCALE);
            else transpose_item(p.w_dn + (size_t)e * DFF * D, D, DFF, p.wt_dn() + (size_t)e * D * DFF, scr, q / 32, q % 32, lane, MapId()); }
    }
    for (int m = gw; m < M; m += NGW) rms_row_bf16(p.x + (size_t)m * D, p.g_mix, p.xn() + (size_t)m * D, lane);
    for (int m = gw; m < BATCH * MEMLEN; m += NGW) rms_row_bf16(p.mem + (size_t)m * D, p.g_mem, p.hm() + (size_t)m * D, lane);
}

struct NG { const bf16* A; int lda; const bf16* Bt; int ldb; int Mr, N, K; const int* tile_e; size_t sBe; };
template <class Epi>
__device__ __forceinline__ void ngemm(const NG g, const Epi& E, float* lds, int bid, int nb) {
    float* As = lds; float* Bs = lds + 32 * 128;
    const int tid = threadIdx.x, tr = tid >> 4, tc = tid & 15;
    const int nMt = g.Mr / 128, nNt = g.N / 256;
    for (int u = bid; u < nMt * nNt; u += nb) {
        const int mt = u / nNt, nt = u % nNt, row0 = mt * 128, col0 = nt * 256;
        int e = 0; const bf16* Bt = g.Bt;
        if (g.tile_e) { e = g.tile_e[row0 >> 8]; Bt += (size_t)e * g.sBe; }
        float acc[4][16];
#pragma unroll
        for (int i = 0; i < 4; ++i)
#pragma unroll
            for (int j = 0; j < 16; ++j) acc[i][j] = 0.f;
        for (int k0 = 0; k0 < g.K; k0 += 32) {
            __syncthreads();
            { const int r = tid >> 2, kk = (tid & 3) * 8;
              const u32x4 v = *(const u32x4*)(g.A + (size_t)(row0 + r) * g.lda + k0 + kk);
              As[(kk + 0) * 128 + r] = bf_lo(v.x); As[(kk + 1) * 128 + r] = bf_hi(v.x); As[(kk + 2) * 128 + r] = bf_lo(v.y); As[(kk + 3) * 128 + r] = bf_hi(v.y);
              As[(kk + 4) * 128 + r] = bf_lo(v.z); As[(kk + 5) * 128 + r] = bf_hi(v.z); As[(kk + 6) * 128 + r] = bf_lo(v.w); As[(kk + 7) * 128 + r] = bf_hi(v.w);
#pragma unroll
              for (int h = 0; h < 2; ++h) { const int rb = r + 128 * h;
                const u32x4 w = *(const u32x4*)(Bt + (size_t)(col0 + rb) * g.ldb + k0 + kk);
                Bs[(kk + 0) * 256 + rb] = bf_lo(w.x); Bs[(kk + 1) * 256 + rb] = bf_hi(w.x); Bs[(kk + 2) * 256 + rb] = bf_lo(w.y); Bs[(kk + 3) * 256 + rb] = bf_hi(w.y);
                Bs[(kk + 4) * 256 + rb] = bf_lo(w.z); Bs[(kk + 5) * 256 + rb] = bf_hi(w.z); Bs[(kk + 6) * 256 + rb] = bf_lo(w.w); Bs[(kk + 7) * 256 + rb] = bf_hi(w.w); } }
            __syncthreads();
#pragma unroll 4
            for (int k = 0; k < 32; ++k) {
                const f32x4 a = *(const f32x4*)&As[k * 128 + 4 * tr];
                const f32x4 b0 = *(const f32x4*)&Bs[k * 256 + tc * 8], b1 = *(const f32x4*)&Bs[k * 256 + tc * 8 + 4];
                const f32x4 b2 = *(const f32x4*)&Bs[k * 256 + 128 + tc * 8], b3 = *(const f32x4*)&Bs[k * 256 + 128 + tc * 8 + 4];
#pragma unroll
                for (int i = 0; i < 4; ++i) {
#pragma unroll
                    for (int j = 0; j < 4; ++j) { acc[i][j] += a[i] * b0[j]; acc[i][4 + j] += a[i] * b1[j]; acc[i][8 + j] += a[i] * b2[j]; acc[i][12 + j] += a[i] * b3[j]; }
                }
            }
        }
#pragma unroll
        for (int i = 0; i < 4; ++i)
#pragma unroll
            for (int j = 0; j < 8; ++j) E(e, row0 + 4 * tr + i, col0 + tc * 8 + j, acc[i][j], acc[i][8 + j]);
    }
}
struct EpiBf { bf16* C; int ldc; __device__ __forceinline__ void operator()(int, int r, int c, float a, float b) const { C[(size_t)r * ldc + c] = (bf16)f2bf(a); C[(size_t)r * ldc + c + 128] = (bf16)f2bf(b); } };
struct EpiF32 { float* C; int ldc; __device__ __forceinline__ void operator()(int, int r, int c, float a, float b) const { C[(size_t)r * ldc + c] = a; C[(size_t)r * ldc + c + 128] = b; } };
struct EpiOut { const float* x; float* x1; bf16* a2; const float* g; float* rowsq;
    __device__ __forceinline__ void one(int r, int c, float a) const { const size_t o = (size_t)r * D + c; const float v = x[o] + a; x1[o] = v; a2[o] = (bf16)f2bf(v * g[c]); atomicAdd(rowsq + r, v * v); }
    __device__ __forceinline__ void operator()(int, int r, int c, float a, float b) const { one(r, c, a); one(r, c + 128, b); } };
struct EpiQ { bf16* q; const float* rowsq;
    __device__ __forceinline__ void operator()(int, int r, int c, float a, float b) const { const float s = 0.0625f / sqrtf(rowsq[r] * (1.f / D) + EPS); q[(size_t)r * D + c] = (bf16)f2bf(a * s); q[(size_t)r * D + c + 128] = (bf16)f2bf(b * s); } };
struct EpiRes { const float* base; float* o; __device__ __forceinline__ void operator()(int, int r, int c, float a, float b) const { const size_t i = (size_t)r * D + c; o[i] = base[i] + a; o[i + 128] = base[i + 128] + b; } };
__device__ __forceinline__ float swiglu(float g, float u) { g = fminf(g, 7.f); u = fminf(fmaxf(u, -7.f), 7.f); return g * (1.f / (1.f + expf(-1.702f * g))) * (u + 1.f); }
struct EpiUp { bf16* h; const float* b_gu;
    __device__ __forceinline__ void operator()(int e, int r, int c, float a, float b) const { const int ff = (c >> 8) * 128 + (c & 127); const float* bb = b_gu + (size_t)e * 2 * DFF;
        h[(size_t)r * DFF + ff] = (bf16)f2bf(swiglu(a + bb[ff], b + bb[DFF + ff])); } };
struct EpiDn { bf16* y; const float* b_dn; const float* gs;
    __device__ __forceinline__ void operator()(int e, int r, int c, float a, float b) const { const float g = gs[r]; const float* bb = b_dn + (size_t)e * D;
        y[(size_t)r * D + c] = (bf16)f2bf(g * (a + bb[c])); y[(size_t)r * D + c + 128] = (bf16)f2bf(g * (b + bb[c + 128])); } };

__device__ __forceinline__ void phase_pool(const P& p, float* lds, int bid, int nb) {
    float* pt = lds;
    float* wp = lds + 64 * 129;
    const int tid = threadIdx.x;
    for (int u = bid; u < (M / 64) * 4; u += nb) {
        const int g = u & 3, tt = u >> 2, t0 = tt * 64, w = 2 << g;
        __syncthreads();
        for (int i = tid; i < 128 * 128; i += NTHREADS) wp[i] = p.w_pool[(size_t)g * 128 * 128 + i];
        { const int i = tid >> 3, c0 = (tid & 7) * 16, t = t0 + i, s = t & (SEQ - 1);
          const int cnt = (s + 1 < w) ? s + 1 : w;
          float acc[16];
#pragma unroll
          for (int c = 0; c < 16; ++c) acc[c] = 0.f;
          for (int d = 0; d < cnt; ++d) { const bf16* up = p.z1() + (size_t)(t - d) * NZ + g * 128 + c0;
#pragma unroll
              for (int c = 0; c < 16; ++c) acc[c] += bf2f(up[c]); }
          const bf16* u0 = p.z1() + (size_t)t * NZ + g * 128 + c0; const float inv = 1.f / (float)cnt;
#pragma unroll
          for (int c = 0; c < 16; ++c) pt[i * 129 + c0 + c] = acc[c] * inv - bf2f(u0[c]); }
        __syncthreads();
        { const int i = tid >> 3, d0 = (tid & 7) * 16; float acc[16];
#pragma unroll
          for (int c = 0; c < 16; ++c) acc[c] = 0.f;
          for (int c = 0; c < 128; ++c) { const float pv = pt[i * 129 + c];
#pragma unroll
              for (int d = 0; d < 16; ++d) acc[d] += pv * wp[c * 128 + d0 + d]; }
          bf16* o = p.mix() + (size_t)(t0 + i) * D + g * 128 + d0;
#pragma unroll
          for (int d = 0; d < 16; ++d) o[d] = (bf16)f2bf(acc[d] * p.pool_scale[g * 128 + d0 + d]); }
    }
}

__device__ __forceinline__ void gla_gc(const P& p, float* glr, float* wgu, float* gc, int b, int h, int n) {
    const int tid = threadIdx.x, t0 = b * SEQ + n * 64;
    __syncthreads();
    for (int i = tid; i < 64 * 16; i += NTHREADS) glr[i] = bf2f(p.z1()[(size_t)(t0 + (i >> 4)) * NZ + ZG + (i & 15)]);
    for (int i = tid; i < 16 * 64; i += NTHREADS) wgu[i] = p.w_gate_up[(i >> 6) * 256 + h * 64 + (i & 63)];
    __syncthreads();
    for (int idx = tid; idx < 64 * 64; idx += NTHREADS) { const int i = idx >> 6, d = idx & 63; float s = p.b_gate_up[h * 64 + d];
#pragma unroll
        for (int r = 0; r < 16; ++r) s += glr[i * 16 + r] * wgu[r * 64 + d];
        gc[i * 65 + d] = logsigmoid(s) * (1.f / 16.f); }
    __syncthreads();
    if (tid < 64) { float run = 0.f; for (int i = 0; i < 64; ++i) { run += gc[i * 65 + tid]; gc[i * 65 + tid] = run; } }
    __syncthreads();
}
__device__ __forceinline__ void phase_gla_a(const P& p, float* lds, int bid, int nb) {
    float* glr = lds; float* wgu = lds + 1024; float* gc = lds + 2048; float* kd = gc + 64 * 65; float* vv = kd + 64 * 65;
    const int tid = threadIdx.x;
    for (int u = bid; u < 8 * NCHUNK; u += nb) {
        const int bh = u / NCHUNK, n = u % NCHUNK, b = bh >> 2, h = bh & 3, t0 = b * SEQ + n * 64;
        gla_gc(p, glr, wgu, gc, b, h, n);
        for (int idx = tid; idx < 64 * 64; idx += NTHREADS) { const int j = idx >> 6, d = idx & 63;
            kd[j * 65 + d] = bf2f(p.z1()[(size_t)(t0 + j) * NZ + ZK + h * 64 + d]) * expf(gc[63 * 65 + d] - gc[j * 65 + d]); }
        for (int idx = tid; idx < 64 * 128; idx += NTHREADS) { const int j = idx >> 7, e = idx & 127; vv[idx] = bf2f(p.z1()[(size_t)(t0 + j) * NZ + ZV + h * 128 + e]); }
        __syncthreads();
        { const int d = tid >> 3, e0 = (tid & 7) * 16; float acc[16];
#pragma unroll
          for (int e = 0; e < 16; ++e) acc[e] = 0.f;
          for (int j = 0; j < 64; ++j) { const float kv = kd[j * 65 + d];
#pragma unroll
              for (int e = 0; e < 16; ++e) acc[e] += kv * vv[j * 128 + e0 + e]; }
          float* o = p.ds() + ((size_t)u * 64 + d) * 128 + e0;
#pragma unroll
          for (int e = 0; e < 16; ++e) o[e] = acc[e]; }
        if (tid < 64) p.dec()[(size_t)u * 64 + tid] = expf(gc[63 * 65 + tid]);
    }
}
__device__ __forceinline__ void phase_scan(const P& p, int bid, int nb) {
    for (int idx = bid * NTHREADS + threadIdx.x; idx < 8 * 64 * 128; idx += nb * NTHREADS) {
        const int bh = idx >> 13, de = idx & 8191, d = de >> 7;
        float st = 0.f;
        for (int n = 0; n < NCHUNK; ++n) { const size_t u = (size_t)bh * NCHUNK + n;
            p.sprev()[u * 8192 + de] = st; st = p.dec()[u * 64 + d] * st + p.ds()[u * 8192 + de]; }
    }
}
__device__ __forceinline__ void phase_gla_b(const P& p, float* lds, int bid, int nb) {
    float* glr = lds; float* wgu = lds + 1024; float* gc = lds + 2048; float* qe = gc + 64 * 65; float* ke = qe + 64 * 65; float* vv = ke + 64 * 65; float* sp = vv + 64 * 128;
    float* att = gc;
    const int tid = threadIdx.x;
    for (int u = bid; u < 8 * NCHUNK; u += nb) {
        const int bh = u / NCHUNK, n = u % NCHUNK, b = bh >> 2, h = bh & 3, t0 = b * SEQ + n * 64;
        gla_gc(p, glr, wgu, gc, b, h, n);
        for (int idx = tid; idx < 64 * 64; idx += NTHREADS) { const int i = idx >> 6, d = idx & 63; const float g = gc[i * 65 + d];
            qe[i * 65 + d] = bf2f(p.z1()[(size_t)(t0 + i) * NZ + ZQ + h * 64 + d]) * 0.125f * expf(g);
            ke[i * 65 + d] = bf2f(p.z1()[(size_t)(t0 + i) * NZ + ZK + h * 64 + d]) * expf(-g); }
        for (int idx = tid; idx < 64 * 128; idx += NTHREADS) { const int j = idx >> 7, e = idx & 127; vv[idx] = bf2f(p.z1()[(size_t)(t0 + j) * NZ + ZV + h * 128 + e]); sp[idx] = p.sprev()[(size_t)u * 8192 + idx]; }
        __syncthreads();
        { const int i = tid >> 3, j0 = (tid & 7) * 8; float a[8];
#pragma unroll
          for (int j = 0; j < 8; ++j) a[j] = 0.f;
          for (int d = 0; d < 64; ++d) { const float qv = qe[i * 65 + d];
#pragma unroll
              for (int j = 0; j < 8; ++j) a[j] += qv * ke[(j0 + j) * 65 + d]; }
#pragma unroll
          for (int j = 0; j < 8; ++j) att[i * 65 + j0 + j] = (j0 + j <= i) ? a[j] : 0.f; }
        __syncthreads();
        { const int i = tid >> 3, e0 = (tid & 7) * 16; float o[16];
#pragma unroll
          for (int e = 0; e < 16; ++e) o[e] = 0.f;
          for (int j = 0; j < 64; ++j) { const float av = att[i * 65 + j];
#pragma unroll
              for (int e = 0; e < 16; ++e) o[e] += av * vv[j * 128 + e0 + e]; }
          for (int d = 0; d < 64; ++d) { const float qv = qe[i * 65 + d];
#pragma unroll
              for (int e = 0; e < 16; ++e) o[e] += qv * sp[d * 128 + e0 + e]; }
          float ss = 0.f;
#pragma unroll
          for (int e = 0; e < 16; ++e) ss += o[e] * o[e];
          ss += __shfl_xor(ss, 1); ss += __shfl_xor(ss, 2); ss += __shfl_xor(ss, 4);
          const float rs = 1.0f / sqrtf(ss * (1.f / 128.f) + EPS);
          const bf16* rp = p.z1() + (size_t)(t0 + i) * NZ + ZR + h * 128 + e0; bf16* op = p.mix() + (size_t)(t0 + i) * D + 512 + h * 128 + e0;
#pragma unroll
          for (int e = 0; e < 16; ++e) { const float r = bf2f(rp[e]); const float sl = r / (1.f + expf(-r)); op[e] = (bf16)f2bf(o[e] * rs * p.gla_g[e0 + e] * sl); } }
    }
}

__device__ __forceinline__ void phase_softmax(const P& p, int bid, int nb) {
    const int lane = threadIdx.x & 63, gw = bid * NWAVES + (threadIdx.x >> 6), NGW = nb * NWAVES;
    for (int it = gw; it < M * 4; it += NGW) {
        const f32x4 v = *((const f32x4*)(p.sc() + (size_t)it * 256) + lane);
        float m = fmaxf(fmaxf(v.x, v.y), fmaxf(v.z, v.w));
#pragma unroll
        for (int o = 1; o < 64; o <<= 1) m = fmaxf(m, __shfl_xor(m, o));
        const float e0 = expf(v.x - m), e1 = expf(v.y - m), e2 = expf(v.z - m), e3 = expf(v.w - m);
        const float inv = 1.f / wave_sum((e0 + e1) + (e2 + e3));
        u32x2 w; w.x = pk2(e0 * inv, e1 * inv); w.y = pk2(e2 * inv, e3 * inv);
        *((u32x2*)(p.px() + (size_t)it * 256) + lane) = w;
    }
}

__device__ __forceinline__ void phase_router(const P& p, float* lds, int bid, int nb) {
    const int tid = threadIdx.x, lane = tid & 63, gw = bid * NWAVES + (tid >> 6), NGW = nb * NWAVES;
    __syncthreads();
    for (int i = tid; i < D * NE; i += NTHREADS) lds[(i & 31) * D + (i >> 5)] = p.w_router[i];
    __syncthreads();
    for (int t = gw; t < M; t += NGW) {
        const f32x4* xr = (const f32x4*)(p.x2() + (size_t)t * D) + lane; f32x4 v[4]; float s = 0.f;
#pragma unroll
        for (int j = 0; j < 4; ++j) { v[j] = xr[64 * j]; s += (v[j].x * v[j].x + v[j].y * v[j].y) + (v[j].z * v[j].z + v[j].w * v[j].w); }
        const float rs = 1.0f / sqrtf(wave_sum(s) * (1.f / D) + EPS);
#pragma unroll
        for (int j = 0; j < 4; ++j) { const f32x4 gg = *((const f32x4*)p.g_moe + lane + 64 * j); v[j] = v[j] * rs * gg; }
        float mylg = -INFINITY;
#pragma unroll 2
        for (int e = 0; e < NE; ++e) { float a = 0.f;
#pragma unroll
            for (int j = 0; j < 4; ++j) { const f32x4 w = *((const f32x4*)(lds + e * D) + lane + 64 * j); a += (v[j].x * w.x + v[j].y * w.y) + (v[j].z * w.z + v[j].w * w.w); }
            a = wave_sum(a); if (lane == e) mylg = a + p.b_router[e]; }
        int idx[4]; float val[4];
#pragma unroll
        for (int j = 0; j < 4; ++j) { float bv = mylg; int bi = lane;
#pragma unroll
            for (int o = 1; o < 64; o <<= 1) { const float ov = __shfl_xor(bv, o); const int oi = __shfl_xor(bi, o); const bool tk = (ov > bv) || (ov == bv && oi < bi); bv = tk ? ov : bv; bi = tk ? oi : bi; }
            idx[j] = bi; val[j] = bv; if (lane == bi) mylg = -INFINITY; }
        const float e1 = expf(val[1] - val[0]), e2 = expf(val[2] - val[0]), e3 = expf(val[3] - val[0]); const float inv = 1.f / (1.f + e1 + e2 + e3);
        if (lane == 0) { p.rs2()[t] = rs;
            p.topi()[t * 4 + 0] = idx[0]; p.topi()[t * 4 + 1] = idx[1]; p.topi()[t * 4 + 2] = idx[2]; p.topi()[t * 4 + 3] = idx[3];
            p.topg()[t * 4 + 0] = inv; p.topg()[t * 4 + 1] = e1 * inv; p.topg()[t * 4 + 2] = e2 * inv; p.topg()[t * 4 + 3] = e3 * inv;
#pragma unroll
            for (int j = 0; j < 4; ++j) atomicAdd(p.ctl() + CW_COUNT + idx[j], 1u); }
    }
}
__device__ __forceinline__ void phase_dispatch(const P& p, int* ldsi, int bid, int nb) {
    const int tid = threadIdx.x, lane = tid & 63, gw = bid * NWAVES + (tid >> 6), NGW = nb * NWAVES;
    __syncthreads();
    if (tid == 0) { int off = 0; for (int e = 0; e < NE; ++e) { ldsi[e] = off; const int c = (int)p.ctl()[CW_COUNT + e]; const int nt = (c + 255) >> 8;
            if (bid == 0) for (int i = 0; i < nt; ++i) p.tilee()[(off >> 8) + i] = e;
            off += nt << 8; }
        if (bid == 0) p.tilee()[MAXMT] = off >> 8; }
    __syncthreads();
    for (int t = gw; t < M; t += NGW) {
        int slot = 0;
        if (lane < 4) { const int e = p.topi()[t * 4 + lane]; slot = ldsi[e] + (int)atomicAdd(p.ctl() + CW_CURSOR + e, 1u); p.slotof()[t * 4 + lane] = slot; p.gslot()[slot] = p.topg()[t * 4 + lane]; }
        const float rs = p.rs2()[t];
        const f32x4* xr = (const f32x4*)(p.x2() + (size_t)t * D) + lane; u32x2 w[4];
#pragma unroll
        for (int j = 0; j < 4; ++j) { const f32x4 v = xr[64 * j]; const f32x4 gg = *((const f32x4*)p.g_moe + lane + 64 * j);
            w[j].x = pk2(v.x * rs * gg.x, v.y * rs * gg.y); w[j].y = pk2(v.z * rs * gg.z, v.w * rs * gg.w); }
#pragma unroll
        for (int q = 0; q < 4; ++q) { const int sl = __shfl(slot, q); u32x2* o = (u32x2*)(p.xs() + (size_t)sl * D) + lane;
#pragma unroll
            for (int j = 0; j < 4; ++j) o[64 * j] = w[j]; }
    }
}
__device__ __forceinline__ void phase_final(const P& p, int bid, int nb) {
    const int lane = threadIdx.x & 63, gw = bid * NWAVES + (threadIdx.x >> 6), NGW = nb * NWAVES;
    for (int t = gw; t < M; t += NGW) {
        const f32x4* xr = (const f32x4*)(p.x2() + (size_t)t * D) + lane; f32x4 v[4];
#pragma unroll
        for (int j = 0; j < 4; ++j) v[j] = xr[64 * j];
#pragma unroll
        for (int q = 0; q < 4; ++q) { const int sl = p.slotof()[t * 4 + q]; const u32x2* yr = (const u32x2*)(p.y() + (size_t)sl * D) + lane;
#pragma unroll
            for (int j = 0; j < 4; ++j) { const u32x2 w = yr[64 * j]; v[j].x += bf_lo(w.x); v[j].y += bf_hi(w.x); v[j].z += bf_lo(w.y); v[j].w += bf_hi(w.y); } }
        float s = 0.f;
#pragma unroll
        for (int j = 0; j < 4; ++j) s += (v[j].x * v[j].x + v[j].y * v[j].y) + (v[j].z * v[j].z + v[j].w * v[j].w);
        const float rs = 1.0f / sqrtf(wave_sum(s) * (1.f / D) + EPS);
        f32x4* o = (f32x4*)(p.out + (size_t)t * D) + lane;
#pragma unroll
        for (int j = 0; j < 4; ++j) { const f32x4 gg = *((const f32x4*)p.g_final + lane + 64 * j); o[64 * j] = v[j] * rs * gg; }
    }
}

typedef short bf16x8 __attribute__((ext_vector_type(8)));
typedef float f32x16 __attribute__((ext_vector_type(16)));
template <int K>
__device__ __forceinline__ void mma_tile(f32x16& acc, const bf16* a, int pa, const bf16* b, int pb, int lane) {
    const int r = lane & 31, hf = lane >> 5;
#pragma unroll
    for (int k0 = 0; k0 < K; k0 += 16) { const bf16x8 av = *(const bf16x8*)(a + r * pa + k0 + 8 * hf); const bf16x8 bv = *(const bf16x8*)(b + r * pb + k0 + 8 * hf);
        acc = __builtin_amdgcn_mfma_f32_32x32x16_bf16(av, bv, acc, 0, 0, 0); }
}
__device__ __forceinline__ int crow(int reg, int hf) { return (reg & 3) + 8 * (reg >> 2) + 4 * hf; }
__device__ __forceinline__ f32x16 zero16() { f32x16 z;
#pragma unroll
    for (int i = 0; i < 16; ++i) z[i] = 0.f;
    return z; }
__device__ __forceinline__ float fast_logsigmoid(float x) { return fminf(x, 0.f) - __logf(1.f + __expf(-fabsf(x))); }

__device__ __forceinline__ void phase_pool2(const P& p, unsigned char* lds, int bid, int nb) {
    bf16* wpT = (bf16*)lds;
    float* ut = (float*)(lds + 34816);
    bf16* pt = (bf16*)(lds + 34816 + 40960);
    const int tid = threadIdx.x, lane = tid & 63, w = tid >> 6;
    int cur_g = -1;
    for (int u = bid; u < (M / 64) * 4; u += nb) {
        const int g = u & 3, t0 = (u >> 2) * 64, win = 2 << g, s0 = t0 & (SEQ - 1);
        __syncthreads();
        if (g != cur_g) { cur_g = g;
            for (int i = tid; i < 128 * 128; i += NTHREADS) { const int c = i >> 7, d = i & 127; wpT[d * 136 + c] = (bf16)f2bf(p.w_pool[(size_t)g * 16384 + i]); } }
        for (int c = tid; c < 80 * 16; c += NTHREADS) { const int r = c >> 4, ch = (c & 15) * 8; const int srel = s0 - 16 + r;
            f32x4 lo = {0.f, 0.f, 0.f, 0.f}, hi = {0.f, 0.f, 0.f, 0.f};
            if (srel >= 0) { const u32x4 v = *(const u32x4*)(p.z1() + (size_t)(t0 - 16 + r) * NZ + g * 128 + ch); lo = (f32x4){bf_lo(v.x), bf_hi(v.x), bf_lo(v.y), bf_hi(v.y)}; hi = (f32x4){bf_lo(v.z), bf_hi(v.z), bf_lo(v.w), bf_hi(v.w)}; }
            *(f32x4*)(ut + r * 128 + ch) = lo; *(f32x4*)(ut + r * 128 + ch + 4) = hi; }
        __syncthreads();
        { const int c = tid & 127, q = tid >> 7, i0 = 16 * q; float sum = 0.f;
          for (int d = 1; d < win; ++d) sum += ut[(16 + i0 - d) * 128 + c];
          for (int ii = 0; ii < 16; ++ii) { const int i = i0 + ii, s = s0 + i; const float uv = ut[(16 + i) * 128 + c]; sum += uv; const int cnt = (s + 1 < win) ? s + 1 : win;
              pt[i * 136 + c] = (bf16)f2bf(sum / (float)cnt - uv); sum -= ut[(16 + i - win + 1) * 128 + c]; } }
        __syncthreads();
        { const int db = w >> 1, ib = w & 1, r = lane & 31, hf = lane >> 5; f32x16 acc = zero16();
          mma_tile<128>(acc, wpT + (db * 32) * 136, 136, pt + (ib * 32) * 136, 136, lane);
          bf16* orow = p.mix() + (size_t)(t0 + ib * 32 + r) * D + g * 128 + db * 32;
#pragma unroll
          for (int rg = 0; rg < 4; ++rg) { const int d0 = 8 * rg + 4 * hf; const f32x4 sc = *(const f32x4*)(p.pool_scale + g * 128 + db * 32 + d0);
              u32x2 o; o.x = pk2(acc[4 * rg] * sc.x, acc[4 * rg + 1] * sc.y); o.y = pk2(acc[4 * rg + 2] * sc.z, acc[4 * rg + 3] * sc.w); *(u32x2*)(orow + d0) = o; } }
    }
}

__device__ __forceinline__ void gla_gc2(const P& p, float* glr, float* wtot, int t0, int h, float (&gcl)[8], float& tot) {
    const int tid = threadIdx.x, d = tid & 63, w = tid >> 6;
    __syncthreads();
    for (int i = tid; i < 64 * 16; i += NTHREADS) glr[i] = bf2f(p.z1()[(size_t)(t0 + (i >> 4)) * NZ + ZG + (i & 15)]);
    float wg[16];
#pragma unroll
    for (int r = 0; r < 16; ++r) wg[r] = p.w_gate_up[r * 256 + h * 64 + d];
    const float bias = p.b_gate_up[h * 64 + d];
    __syncthreads();
    float run = 0.f;
#pragma unroll
    for (int ii = 0; ii < 8; ++ii) { const float* gr = glr + (8 * w + ii) * 16; float s = bias;
#pragma unroll
        for (int r = 0; r < 16; ++r) s += gr[r] * wg[r];
        run += fast_logsigmoid(s) * (1.f / 16.f); gcl[ii] = run; }
    wtot[w * 64 + d] = run;
    __syncthreads();
    float pre = 0.f; tot = 0.f;
#pragma unroll
    for (int ww = 0; ww < 8; ++ww) { const float v = wtot[ww * 64 + d]; pre += (ww < w) ? v : 0.f; tot += v; }
#pragma unroll
    for (int ii = 0; ii < 8; ++ii) gcl[ii] += pre;
}
__device__ __forceinline__ void load_vT(const P& p, bf16* vT, int t0, int colbase) {
    const int tid = threadIdx.x, e = tid & 127, jb = tid >> 7; unsigned short v[16];
#pragma unroll
    for (int jj = 0; jj < 16; ++jj) v[jj] = p.z1()[(size_t)(t0 + 16 * jb + jj) * NZ + colbase + e];
    u32x4 a, b; a.x = v[0] | (v[1] << 16); a.y = v[2] | (v[3] << 16); a.z = v[4] | (v[5] << 16); a.w = v[6] | (v[7] << 16);
    b.x = v[8] | (v[9] << 16); b.y = v[10] | (v[11] << 16); b.z = v[12] | (v[13] << 16); b.w = v[14] | (v[15] << 16);
    *(u32x4*)(vT + e * 72 + 16 * jb) = a; *(u32x4*)(vT + e * 72 + 16 * jb + 8) = b;
}
__device__ __forceinline__ void phase_gla_a2(const P& p, unsigned char* lds, int bid, int nb) {
    float* glr = (float*)lds; float* wtot = (float*)(lds + 4096); bf16* kdT = (bf16*)(lds + 8192); bf16* vT = (bf16*)(lds + 8192 + 9216);
    const int tid = threadIdx.x, lane = tid & 63, w = tid >> 6, d = tid & 63;
    for (int u = bid; u < 8 * NCHUNK; u += nb) {
        const int bh = u / NCHUNK, n = u % NCHUNK, b = bh >> 2, h = bh & 3, t0 = b * SEQ + n * 64;
        float gcl[8], tot; gla_gc2(p, glr, wtot, t0, h, gcl, tot);
        { unsigned pk[4];
#pragma unroll
          for (int ii = 0; ii < 8; ii += 2) { const float k0 = bf2f(p.z1()[(size_t)(t0 + 8 * w + ii) * NZ + ZK + h * 64 + d]) * __expf(tot - gcl[ii]);
              const float k1 = bf2f(p.z1()[(size_t)(t0 + 8 * w + ii + 1) * NZ + ZK + h * 64 + d]) * __expf(tot - gcl[ii + 1]); pk[ii >> 1] = pk2(k0, k1); }
          *(u32x4*)(kdT + d * 72 + 8 * w) = (u32x4){pk[0], pk[1], pk[2], pk[3]}; }
        if (w == 0) p.dec()[(size_t)u * 64 + d] = __expf(tot);
        load_vT(p, vT, t0, ZV + h * 128);
        __syncthreads();
        { const int eb = w >> 1, db = w & 1, r = lane & 31, hf = lane >> 5; f32x16 acc = zero16();
          mma_tile<64>(acc, vT + (eb * 32) * 72, 72, kdT + (db * 32) * 72, 72, lane);
          float* o = p.ds() + (size_t)u * 8192 + db * 32 + r;
#pragma unroll
          for (int reg = 0; reg < 16; ++reg) o[(eb * 32 + crow(reg, hf)) * 64] = acc[reg]; }
    }
}
__device__ __forceinline__ void phase_scan2(const P& p, int bid, int nb) {
    bf16* sp = (bf16*)p.sprev();
    if (threadIdx.x < 256)
    for (int idx = bid * 256 + threadIdx.x; idx < 8 * 8192; idx += nb * 256) {
        const int bh = idx >> 13, ed = idx & 8191, d = ed & 63; float st = 0.f;
        for (int n0 = 0; n0 < NCHUNK; n0 += 8) { float dv[8], dc[8];
#pragma unroll
            for (int k = 0; k < 8; ++k) { const size_t u = (size_t)bh * NCHUNK + n0 + k; dv[k] = p.ds()[u * 8192 + ed]; dc[k] = p.dec()[u * 64 + d]; }
#pragma unroll
            for (int k = 0; k < 8; ++k) { const size_t u = (size_t)bh * NCHUNK + n0 + k; sp[u * 8192 + ed] = (bf16)f2bf(st); st = dc[k] * st + dv[k]; } }
    }
}
__device__ __forceinline__ void phase_gla_b2(const P& p, unsigned char* lds, int bid, int nb) {
    float* glr = (float*)lds; float* wtot = (float*)(lds + 4096); float* ssq = (float*)(lds + 6144);
    bf16* qe = (bf16*)(lds + 8192); bf16* ke = qe + 64 * 72; bf16* att = ke + 64 * 72; bf16* vT = att + 64 * 72; bf16* spT = vT + 128 * 72;
    const bf16* sp = (const bf16*)p.sprev();
    const int tid = threadIdx.x, lane = tid & 63, w = tid >> 6, d = tid & 63, r = lane & 31, hf = lane >> 5;
    for (int u = bid; u < 8 * NCHUNK; u += nb) {
        const int bh = u / NCHUNK, n = u % NCHUNK, b = bh >> 2, h = bh & 3, t0 = b * SEQ + n * 64;
        float gcl[8], tot; gla_gc2(p, glr, wtot, t0, h, gcl, tot);
#pragma unroll
        for (int ii = 0; ii < 8; ++ii) { const int i = 8 * w + ii; const size_t zo = (size_t)(t0 + i) * NZ + h * 64 + d;
            qe[i * 72 + d] = (bf16)f2bf(bf2f(p.z1()[zo + ZQ]) * 0.125f * __expf(gcl[ii])); ke[i * 72 + d] = (bf16)f2bf(bf2f(p.z1()[zo + ZK]) * __expf(-gcl[ii])); }
        load_vT(p, vT, t0, ZV + h * 128);
        for (int c = tid; c < 1024; c += NTHREADS) { const int e = c >> 3, d8 = (c & 7) * 8; *(u32x4*)(spT + e * 72 + d8) = *(const u32x4*)(sp + (size_t)u * 8192 + e * 64 + d8); }
        __syncthreads();
        if (w < 4) { const int ib = w & 1, jb = w >> 1; f32x16 acc = zero16();
            if (jb <= ib) mma_tile<64>(acc, qe + (ib * 32) * 72, 72, ke + (jb * 32) * 72, 72, lane);
#pragma unroll
            for (int reg = 0; reg < 16; ++reg) { const int i = ib * 32 + crow(reg, hf), j = jb * 32 + r; att[i * 72 + j] = (bf16)f2bf(j <= i ? acc[reg] : 0.f); } }
        __syncthreads();
        { const int eb = w >> 1, ib = w & 1, i = ib * 32 + r; f32x16 acc = zero16();
          mma_tile<64>(acc, vT + (eb * 32) * 72, 72, att + (ib * 32) * 72, 72, lane);
          mma_tile<64>(acc, spT + (eb * 32) * 72, 72, qe + (ib * 32) * 72, 72, lane);
          float ss = 0.f;
#pragma unroll
          for (int reg = 0; reg < 16; ++reg) ss += acc[reg] * acc[reg];
          ss += __shfl_xor(ss, 32);
          if (hf == 0) ssq[eb * 64 + i] = ss;
          __syncthreads();
          const float rs = 1.0f / sqrtf((ssq[i] + ssq[64 + i] + ssq[128 + i] + ssq[192 + i]) * (1.f / 128.f) + EPS);
          const bf16* rp = p.z1() + (size_t)(t0 + i) * NZ + ZR + h * 128 + eb * 32; bf16* op = p.mix() + (size_t)(t0 + i) * D + 512 + h * 128 + eb * 32;
#pragma unroll
          for (int rg = 0; rg < 4; ++rg) { const int e0 = 8 * rg + 4 * hf; const u32x2 rv = *(const u32x2*)(rp + e0); const f32x4 gg = *(const f32x4*)(p.gla_g + eb * 32 + e0);
              const float r0 = bf_lo(rv.x), r1 = bf_hi(rv.x), r2 = bf_lo(rv.y), r3 = bf_hi(rv.y);
              const float o0 = acc[4 * rg] * rs * gg.x * (r0 / (1.f + __expf(-r0))), o1 = acc[4 * rg + 1] * rs * gg.y * (r1 / (1.f + __expf(-r1)));
              const float o2 = acc[4 * rg + 2] * rs * gg.z * (r2 / (1.f + __expf(-r2))), o3 = acc[4 * rg + 3] * rs * gg.w * (r3 / (1.f + __expf(-r3)));
              u32x2 o; o.x = pk2(o0, o1); o.y = pk2(o2, o3); *(u32x2*)(op + e0) = o; } }
    }
}

__device__ __forceinline__ void phase_router2(const P& p, float* lds, int* blkcnt, int* wavebase, int bid, int nb) {
    const int tid = threadIdx.x, lane = tid & 63, w = tid >> 6;
    int* cntw = (int*)(lds + 32768);
    __syncthreads();
    for (int i = tid; i < D * NE; i += NTHREADS) lds[(i & 31) * D + (i >> 5)] = p.w_router[i];
    __syncthreads();
    const float bias = p.b_router[lane >> 1];
    for (int gidx = bid; gidx < M / 64; gidx += nb) {
        int cnt = 0;
        for (int ii = 0; ii < 8; ++ii) {
            const int t = gidx * 64 + w * 8 + ii;
            const f32x4* xr = (const f32x4*)(p.x2() + (size_t)t * D) + lane; f32x4 v[4]; float s = 0.f;
#pragma unroll
            for (int j = 0; j < 4; ++j) { v[j] = xr[64 * j]; s += (v[j].x * v[j].x + v[j].y * v[j].y) + (v[j].z * v[j].z + v[j].w * v[j].w); }
            const float rs = 1.0f / sqrtf(wave_sum(s) * (1.f / D) + EPS);
#pragma unroll
            for (int j = 0; j < 4; ++j) { const f32x4 gg = *((const f32x4*)p.g_moe + lane + 64 * j); v[j] = v[j] * rs * gg; }
            float a[NE];
#pragma unroll
            for (int e = 0; e < NE; ++e) { float acc = 0.f;
#pragma unroll
                for (int j = 0; j < 4; ++j) { const f32x4 wv = *((const f32x4*)(lds + e * D) + lane + 64 * j); acc += (v[j].x * wv.x + v[j].y * wv.y) + (v[j].z * wv.z + v[j].w * wv.w); }
                a[e] = acc; if ((e & 3) == 3) __builtin_amdgcn_sched_barrier(0); }
#pragma unroll
            for (int k = 0; k < 16; ++k) { const bool up = (lane & 32) != 0; const float send = up ? a[k] : a[k + 16]; const float keep = up ? a[k + 16] : a[k]; a[k] = keep + __shfl_xor(send, 32); }
#pragma unroll
            for (int k = 0; k < 8; ++k) { const bool up = (lane & 16) != 0; const float send = up ? a[k] : a[k + 8]; const float keep = up ? a[k + 8] : a[k]; a[k] = keep + __shfl_xor(send, 16); }
#pragma unroll
            for (int k = 0; k < 4; ++k) { const bool up = (lane & 8) != 0; const float send = up ? a[k] : a[k + 4]; const float keep = up ? a[k + 4] : a[k]; a[k] = keep + __shfl_xor(send, 8); }
#pragma unroll
            for (int k = 0; k < 2; ++k) { const bool up = (lane & 4) != 0; const float send = up ? a[k] : a[k + 2]; const float keep = up ? a[k + 2] : a[k]; a[k] = keep + __shfl_xor(send, 4); }
            { const bool up = (lane & 2) != 0; const float send = up ? a[0] : a[1]; const float keep = up ? a[1] : a[0]; a[0] = keep + __shfl_xor(send, 2); }
            float mylg = a[0] + __shfl_xor(a[0], 1) + bias; const int myidx = lane >> 1;
            int idx[4]; float val[4];
#pragma unroll
            for (int j = 0; j < 4; ++j) { float bv = mylg; int bi = myidx;
#pragma unroll
                for (int o = 1; o < 64; o <<= 1) { const float ov = __shfl_xor(bv, o); const int oi = __shfl_xor(bi, o); const bool tk = (ov > bv) || (ov == bv && oi < bi); bv = tk ? ov : bv; bi = tk ? oi : bi; }
                idx[j] = bi; val[j] = bv; if (myidx == bi) mylg = -INFINITY; cnt += (lane == bi) ? 1 : 0; }
            const float e1 = __expf(val[1] - val[0]), e2 = __expf(val[2] - val[0]), e3 = __expf(val[3] - val[0]); const float inv = 1.f / (1.f + e1 + e2 + e3);
            if (lane == 0) { p.rs2()[t] = rs;
                p.topi()[t * 4 + 0] = idx[0]; p.topi()[t * 4 + 1] = idx[1]; p.topi()[t * 4 + 2] = idx[2]; p.topi()[t * 4 + 3] = idx[3];
                p.topg()[t * 4 + 0] = inv; p.topg()[t * 4 + 1] = e1 * inv; p.topg()[t * 4 + 2] = e2 * inv; p.topg()[t * 4 + 3] = e3 * inv; }
        }
        __syncthreads();
        if (lane < 32) cntw[w * 32 + lane] = cnt;
        __syncthreads();
        if (tid < 32) { int run = 0;
#pragma unroll
            for (int ww = 0; ww < 8; ++ww) { wavebase[(gidx * 8 + ww) * 32 + tid] = run; run += cntw[ww * 32 + tid]; }
            blkcnt[gidx * 32 + tid] = run; }
    }
}
__device__ __forceinline__ void phase_dispatch2(const P& p, int* ldsi, const int* blkcnt, const int* wavebase, int bid, int nb) {
    const int tid = threadIdx.x, lane = tid & 63, w = tid >> 6;
    int* red_t = ldsi; int* red_p = ldsi + 512; int* base = ldsi + 1024;
    for (int gidx = bid; gidx < M / 64; gidx += nb) {
        __syncthreads();
        { const int e = tid & 31, part = tid >> 5; int tt = 0, pp = 0;
          for (int bb = part * 16; bb < part * 16 + 16; ++bb) { const int v = blkcnt[bb * 32 + e]; tt += v; pp += (bb < gidx) ? v : 0; }
          red_t[part * 32 + e] = tt; red_p[part * 32 + e] = pp; }
        __syncthreads();
        if (tid < 32) { int tt = 0, pp = 0;
#pragma unroll
            for (int q = 0; q < 16; ++q) { tt += red_t[q * 32 + tid]; pp += red_p[q * 32 + tid]; }
            red_t[tid] = tt; red_p[tid] = pp; }
        __syncthreads();
        if (tid == 0) { int off = 0; for (int e = 0; e < NE; ++e) { base[e] = off + red_p[e]; const int c = red_t[e]; const int nt = (c + 255) >> 8;
                if (gidx == 0) for (int i = 0; i < nt; ++i) p.tilee()[(off >> 8) + i] = e;
                off += nt << 8; }
            if (gidx == 0) p.tilee()[MAXMT] = off >> 8; }
        __syncthreads();
        int wb = (lane < 32) ? base[lane] + wavebase[(gidx * 8 + w) * 32 + lane] : 0;
        for (int ii = 0; ii < 8; ++ii) {
            const int t = gidx * 64 + w * 8 + ii;
            int slot = 0;
#pragma unroll
            for (int j = 0; j < 4; ++j) { const int e = p.topi()[t * 4 + j]; const int sj = __shfl(wb, e); if (lane == e) wb += 1; if (lane == j) slot = sj; }
            if (lane < 4) { p.slotof()[t * 4 + lane] = slot; p.gslot()[slot] = p.topg()[t * 4 + lane]; }
            const float rs = p.rs2()[t];
            if (MOE_FP8) {
                const f32x4* xr = (const f32x4*)(p.x2() + (size_t)t * D) + 4 * lane; const f32x4* gr = (const f32x4*)p.g_moe + 4 * lane; u32x4 o8;
                { const f32x4 v = xr[0] * rs * gr[0]; o8.x = pk4_fp8(v.x, v.y, v.z, v.w); } { const f32x4 v = xr[1] * rs * gr[1]; o8.y = pk4_fp8(v.x, v.y, v.z, v.w); }
                { const f32x4 v = xr[2] * rs * gr[2]; o8.z = pk4_fp8(v.x, v.y, v.z, v.w); } { const f32x4 v = xr[3] * rs * gr[3]; o8.w = pk4_fp8(v.x, v.y, v.z, v.w); }
#pragma unroll
                for (int q = 0; q < 4; ++q) { const int sl = __shfl(slot, q); *((u32x4*)((unsigned char*)p.xs() + (size_t)sl * D) + lane) = o8; }
            } else {
            const f32x4* xr = (const f32x4*)(p.x2() + (size_t)t * D) + lane; u32x2 wv[4];
#pragma unroll
            for (int j = 0; j < 4; ++j) { const f32x4 v = xr[64 * j]; const f32x4 gg = *((const f32x4*)p.g_moe + lane + 64 * j);
                wv[j].x = pk2(v.x * rs * gg.x, v.y * rs * gg.y); wv[j].y = pk2(v.z * rs * gg.z, v.w * rs * gg.w); }
#pragma unroll
            for (int q = 0; q < 4; ++q) { const int sl = __shfl(slot, q); u32x2* o = (u32x2*)(p.xs() + (size_t)sl * D) + lane;
#pragma unroll
                for (int j = 0; j < 4; ++j) o[64 * j] = wv[j]; }
            }
        }
    }
}

namespace pg {
typedef short bf16x8 __attribute__((ext_vector_type(8)));
constexpr int BM = 256, BK = 64, HALF = 128, HTB = HALF * BK * 2, STAGE_BYTES = 8 * HTB;
__device__ __forceinline__ int lds_byte(int r, int c) { const int st = (r >> 4) * 2 + (c >> 5), rr = r & 15, cc = c & 31, ob = rr * 64 + cc * 2; return st * 1024 + (ob ^ (((ob >> 9) & 1) << 5)); }
__device__ __forceinline__ void stage_rc(int b, int& R, int& C) { const int st = b / 1024, sb = b % 1024, swz = sb ^ (((sb >> 9) & 1) << 5); R = (st >> 1) * 16 + swz / 64; C = (st & 1) * 32 + (swz % 64) / 2; }
__device__ __forceinline__ int perm32(int rho) { const int n = rho >> 4, i = rho & 15; return 8 * (i >> 2) + 4 * n + (i & 3); }
struct Unit { int pm, pn, e; unsigned ao, bo; };
struct Gemm { int lda, ldb, K; };
__device__ __forceinline__ void map2d(int L, int nM, int nN, int& pm, int& pn) {
    const int nwg = nM * nN; int wgid = L;
    { const int q = nwg / 8, r = nwg % 8, xcd = wgid % 8, off = wgid / 8; wgid = (xcd < r ? xcd * (q + 1) : r * (q + 1) + (xcd - r) * q) + off; }
    const int nig = 8 * nN, gid = wgid / nig, fm = gid * 8, gsz = (nM - fm) < 8 ? (nM - fm) : 8;
    pm = fm + ((wgid % nig) % gsz); pn = (wgid % nig) / gsz;
}
struct Sched2D { unsigned aoff, boff, rowA, rowB; int nM, nN, G, c;
    __device__ __forceinline__ bool next(int i, Unit& u) const { const long L = (long)i * G + c; if (L >= (long)nM * nN) return false; map2d((int)L, nM, nN, u.pm, u.pn); u.e = 0;
        u.ao = aoff + (unsigned)u.pm * 256u * rowA; u.bo = boff + (unsigned)u.pn * 256u * rowB; return true; } };
struct SchedG1 { int G, c;
    __device__ __forceinline__ bool next(int i, Unit& u) const { const long L = (long)i * G + c; if (L >= 592) return false;
        const int Li = (int)L, l2 = Li - 576, l3 = Li - 584; int pm, pn; map2d(Li < 576 ? Li : 0, 64, 9, pm, pn);
        const int e = Li < 576 ? 0 : (Li < 584 ? 1 : 2);
        pm = e == 0 ? pm : (e == 1 ? (l2 >> 2) : (l3 >> 1)); pn = e == 0 ? pn : (e == 1 ? (l2 & 3) : (l3 & 1));
        const unsigned m1 = (unsigned)(e == 1), m2 = (unsigned)(e == 2);
        const unsigned ao = (unsigned)WS_XN + m1 * (unsigned)(WS_HM - WS_XN) + m2 * (unsigned)(WS_WT_XV - WS_XN), bo = (unsigned)WS_WT_IN + m1 * (unsigned)(WS_WT_XK - WS_WT_IN) + m2 * (unsigned)(WS_HM - WS_WT_IN);
        u.pm = pm; u.pn = pn; u.e = e; u.ao = ao + (unsigned)pm * 256u * D * 2u; u.bo = bo + (unsigned)pn * 256u * D * 2u; return true; } };
struct SchedAttn { unsigned aoff, boff, sBb, sBh; int G, c;
    __device__ __forceinline__ bool next(int i, Unit& u) const { const long L = (long)i * G + c; if (L >= 256) return false; const int bh = (int)L >> 5, b = bh >> 2, h = bh & 3;
        u.pm = b * 32 + ((int)L & 31); u.pn = h; u.e = 0; u.ao = aoff + ((unsigned)u.pm * 256u * D + h * 256u) * 2u; u.bo = boff + b * sBb + h * sBh; return true; } };
struct SchedMoE { unsigned aoff, boff; const int* tile_e; unsigned sBe, rowA, rowB; int nM, nN, G, c;
    __device__ __forceinline__ bool next(int i, Unit& u) const { const long L = (long)i * G + c; if (L >= (long)nM * nN) return false; map2d((int)L, nM, nN, u.pm, u.pn); u.e = __builtin_amdgcn_readfirstlane(tile_e[u.pm]);
        u.ao = aoff + (unsigned)u.pm * 256u * rowA; u.bo = boff + (unsigned)u.e * sBe + (unsigned)u.pn * 256u * rowB; return true; } };

typedef f32x4 Acc[2][2][4][2];
__device__ __forceinline__ u32x4 pack8(const f32x4 v0, const f32x4 v1) { u32x4 w; w.x = pk2(v0[0], v0[1]); w.y = pk2(v0[2], v0[3]); w.z = pk2(v1[0], v1[1]); w.w = pk2(v1[2], v1[3]); return w; }
struct EpiBf3 { static constexpr bool PERM = true; unsigned char* ws; size_t o0, o1, o2; int ld0, ld1, ld2;
    __device__ __forceinline__ void operator()(const Acc& acc, const Unit& u, int wr, int wc, int fr, int fq) const {
        const size_t m1 = (size_t)(u.e == 1), m2 = (size_t)(u.e == 2);
        bf16* base = (bf16*)(ws + o0 + m1 * (o1 - o0) + m2 * (o2 - o0)); const int ld = ld0 + (int)m1 * (ld1 - ld0) + (int)m2 * (ld2 - ld0);
        const int row0 = u.pm * BM + wr * 64 + fr, col0 = u.pn * BM + wc * 32 + 8 * fq;
#pragma unroll
        for (int ai = 0; ai < 2; ++ai)
#pragma unroll
            for (int m = 0; m < 4; ++m) { bf16* rowp = base + (size_t)(row0 + ai * HALF + m * 16) * ld + col0;
#pragma unroll
                for (int bj = 0; bj < 2; ++bj) *(u32x4*)(rowp + bj * HALF) = pack8(acc[ai][bj][m][0], acc[ai][bj][m][1]); } } };
struct EpiF { static constexpr bool PERM = false; float* C; int ldc;
    __device__ __forceinline__ void operator()(const Acc& acc, const Unit& u, int wr, int wc, int fr, int fq) const {
        const int row0 = u.pm * BM + wr * 64 + fr, col0 = u.pn * BM + wc * 32 + 4 * fq;
#pragma unroll
        for (int ai = 0; ai < 2; ++ai)
#pragma unroll
            for (int m = 0; m < 4; ++m) { float* rowp = C + (size_t)(row0 + ai * HALF + m * 16) * ldc + col0;
#pragma unroll
                for (int bj = 0; bj < 2; ++bj)
#pragma unroll
                    for (int n = 0; n < 2; ++n) *(f32x4*)(rowp + bj * HALF + n * 16) = acc[ai][bj][m][n]; } } };
struct EpiOutF { static constexpr bool PERM = false; const float* x; float* x1; bf16* a2; const float* g; float* rowsq;
    __device__ __forceinline__ void operator()(const Acc& acc, const Unit& u, int wr, int wc, int fr, int fq) const {
        const int row0 = u.pm * BM + wr * 64 + fr, col0 = u.pn * BM + wc * 32 + 4 * fq;
        f32x4 gv[2][2];
#pragma unroll
        for (int bj = 0; bj < 2; ++bj)
#pragma unroll
            for (int n = 0; n < 2; ++n) gv[bj][n] = *(const f32x4*)(g + col0 + bj * HALF + n * 16);
#pragma unroll
        for (int ai = 0; ai < 2; ++ai)
#pragma unroll
            for (int m = 0; m < 4; ++m) { const int row = row0 + ai * HALF + m * 16; const size_t off = (size_t)row * D + col0; float ss = 0.f;
#pragma unroll
                for (int bj = 0; bj < 2; ++bj)
#pragma unroll
                    for (int n = 0; n < 2; ++n) { const size_t o = off + bj * HALF + n * 16; const f32x4 v = *(const f32x4*)(x + o) + acc[ai][bj][m][n]; *(f32x4*)(x1 + o) = v;
                        const f32x4 t = v * gv[bj][n]; u32x2 w; w.x = pk2(t[0], t[1]); w.y = pk2(t[2], t[3]); *(u32x2*)(a2 + o) = w; ss += (v[0] * v[0] + v[1] * v[1]) + (v[2] * v[2] + v[3] * v[3]); }
                ss += __shfl_xor(ss, 16); ss += __shfl_xor(ss, 32);
                if (fq == 0) atomicAdd(rowsq + row, ss); } } };
struct EpiQF { static constexpr bool PERM = true; bf16* q; const float* rowsq;
    __device__ __forceinline__ void operator()(const Acc& acc, const Unit& u, int wr, int wc, int fr, int fq) const {
        const int row0 = u.pm * BM + wr * 64 + fr, col0 = u.pn * BM + wc * 32 + 8 * fq;
#pragma unroll
        for (int ai = 0; ai < 2; ++ai)
#pragma unroll
            for (int m = 0; m < 4; ++m) { const int row = row0 + ai * HALF + m * 16; const float s = 0.0625f / sqrtf(rowsq[row] * (1.f / D) + EPS); bf16* rowp = q + (size_t)row * D + col0;
#pragma unroll
                for (int bj = 0; bj < 2; ++bj) *(u32x4*)(rowp + bj * HALF) = pack8(acc[ai][bj][m][0] * s, acc[ai][bj][m][1] * s); } } };
struct EpiResF { static constexpr bool PERM = false; const float* base; float* o;
    __device__ __forceinline__ void operator()(const Acc& acc, const Unit& u, int wr, int wc, int fr, int fq) const {
        const int row0 = u.pm * BM + wr * 64 + fr, col0 = u.pn * BM + wc * 32 + 4 * fq;
#pragma unroll
        for (int ai = 0; ai < 2; ++ai)
#pragma unroll
            for (int m = 0; m < 4; ++m) { const size_t off = (size_t)(row0 + ai * HALF + m * 16) * D + col0;
#pragma unroll
                for (int bj = 0; bj < 2; ++bj)
#pragma unroll
                    for (int n = 0; n < 2; ++n) { const size_t o2 = off + bj * HALF + n * 16; *(f32x4*)(o + o2) = *(const f32x4*)(base + o2) + acc[ai][bj][m][n]; } } } };
struct EpiUpF { static constexpr bool PERM = true; bf16* h; const float* b_gu;
    __device__ __forceinline__ void operator()(const Acc& acc, const Unit& u, int wr, int wc, int fr, int fq) const {
        const int row0 = u.pm * BM + wr * 64 + fr, ff0 = u.pn * HALF + wc * 32 + 8 * fq; const float* bb = b_gu + (size_t)u.e * 2 * DFF + ff0;
        const f32x4 bg0 = *(const f32x4*)bb, bg1 = *(const f32x4*)(bb + 4), bu0 = *(const f32x4*)(bb + DFF), bu1 = *(const f32x4*)(bb + DFF + 4);
#pragma unroll
        for (int ai = 0; ai < 2; ++ai)
#pragma unroll
            for (int m = 0; m < 4; ++m) { const f32x4 g0 = acc[ai][0][m][0] + bg0, g1 = acc[ai][0][m][1] + bg1, u0 = acc[ai][1][m][0] + bu0, u1 = acc[ai][1][m][1] + bu1; f32x4 r0, r1;
#pragma unroll
                for (int i = 0; i < 4; ++i) { r0[i] = swiglu(g0[i], u0[i]); r1[i] = swiglu(g1[i], u1[i]); }
                *(u32x4*)(h + (size_t)(row0 + ai * HALF + m * 16) * DFF + ff0) = pack8(r0, r1); } } };
struct EpiDnF { static constexpr bool PERM = true; bf16* y; const float* b_dn; const float* gs;
    __device__ __forceinline__ void operator()(const Acc& acc, const Unit& u, int wr, int wc, int fr, int fq) const {
        const int row0 = u.pm * BM + wr * 64 + fr, col0 = u.pn * BM + wc * 32 + 8 * fq; const float* bb = b_dn + (size_t)u.e * D + col0;
        f32x4 bv[2][2];
#pragma unroll
        for (int bj = 0; bj < 2; ++bj)
#pragma unroll
            for (int n = 0; n < 2; ++n) bv[bj][n] = *(const f32x4*)(bb + bj * HALF + 4 * n);
#pragma unroll
        for (int ai = 0; ai < 2; ++ai)
#pragma unroll
            for (int m = 0; m < 4; ++m) { const int row = row0 + ai * HALF + m * 16; const float g = gs[row]; bf16* rowp = y + (size_t)row * D + col0;
#pragma unroll
                for (int bj = 0; bj < 2; ++bj) *(u32x4*)(rowp + bj * HALF) = pack8((acc[ai][bj][m][0] + bv[bj][0]) * g, (acc[ai][bj][m][1] + bv[bj][1]) * g); } } };

struct EpiUp8 { static constexpr bool PERM = true; unsigned char* h8; const float* b_gu;
    __device__ __forceinline__ void operator()(const Acc& acc, const Unit& u, int wr, int wc, int fr, int fq) const {
        const int row0 = u.pm * BM + wr * 64 + fr, ff0 = u.pn * HALF + wc * 32 + 8 * fq; const float* bb = b_gu + (size_t)u.e * 2 * DFF + ff0;
        const f32x4 bg0 = *(const f32x4*)bb, bg1 = *(const f32x4*)(bb + 4), bu0 = *(const f32x4*)(bb + DFF), bu1 = *(const f32x4*)(bb + DFF + 4);
#pragma unroll
        for (int ai = 0; ai < 2; ++ai)
#pragma unroll
            for (int m = 0; m < 4; ++m) { const f32x4 g0 = acc[ai][0][m][0] * W8_INV + bg0, g1 = acc[ai][0][m][1] * W8_INV + bg1, u0 = acc[ai][1][m][0] * W8_INV + bu0, u1 = acc[ai][1][m][1] * W8_INV + bu1; f32x4 r0, r1;
#pragma unroll
                for (int i = 0; i < 4; ++i) { r0[i] = swiglu(g0[i], u0[i]); r1[i] = swiglu(g1[i], u1[i]); }
                u32x2 o; o.x = pk4_fp8(r0[0], r0[1], r0[2], r0[3]); o.y = pk4_fp8(r1[0], r1[1], r1[2], r1[3]);
                *(u32x2*)(h8 + (size_t)(row0 + ai * HALF + m * 16) * DFF + ff0) = o; } } };
struct EpiDn8 { static constexpr bool PERM = true; bf16* y; const float* b_dn; const float* gs;
    __device__ __forceinline__ void operator()(const Acc& acc, const Unit& u, int wr, int wc, int fr, int fq) const {
        const int row0 = u.pm * BM + wr * 64 + fr, col0 = u.pn * BM + wc * 32 + 8 * fq; const float* bb = b_dn + (size_t)u.e * D + col0;
        f32x4 bv[2][2];
#pragma unroll
        for (int bj = 0; bj < 2; ++bj)
#pragma unroll
            for (int n = 0; n < 2; ++n) bv[bj][n] = *(const f32x4*)(bb + bj * HALF + 4 * n);
#pragma unroll
        for (int ai = 0; ai < 2; ++ai)
#pragma unroll
            for (int m = 0; m < 4; ++m) { const int row = row0 + ai * HALF + m * 16; const float g = gs[row]; bf16* rowp = y + (size_t)row * D + col0;
#pragma unroll
                for (int bj = 0; bj < 2; ++bj) *(u32x4*)(rowp + bj * HALF) = pack8((acc[ai][bj][m][0] * W8_INV + bv[bj][0]) * g, (acc[ai][bj][m][1] * W8_INV + bv[bj][1]) * g); } } };

typedef int i32x4 __attribute__((ext_vector_type(4)));
typedef int i32x8 __attribute__((ext_vector_type(8)));
__device__ __forceinline__ void mma8(const i32x8 bb, const i32x8 aa, f32x4& c) {
    asm volatile("v_mfma_f32_16x16x128_f8f6f4 %0, %1, %2, %0" : "+v"(c) : "v"(bb), "v"(aa));
}
__device__ __forceinline__ void mma8_drain() { asm volatile("s_nop 15\n\ts_nop 7" ::: "memory"); }
template <class Epi, class Sched, bool ALIGN_EPI, bool F8 = false>
__device__ __forceinline__ void gemm_phase(LAS unsigned char* lds, const unsigned char* ws, const Gemm g, const Sched& S, const Epi& E) {
    const __amdgpu_buffer_rsrc_t rsrc = __builtin_amdgcn_make_buffer_rsrc((void*)ws, 0, 0x7fffffff, 0x00020000);
    const int tid = threadIdx.x, wid = __builtin_amdgcn_readfirstlane(tid >> 6), lane = tid & 63, wr = wid >> 2, wc = wid & 3, fr = lane & 15, fq = lane >> 4;
    const int K = g.K, nt = K / BK;
    unsigned voffA[2], voffB[2];
#pragma unroll
    for (int i = 0; i < 2; ++i) { int R, C; stage_rc(tid * 16 + i * 8192, R, C); const int Rb = Epi::PERM ? ((R & ~31) + perm32(R & 31)) : R;
        voffA[i] = (unsigned)(R * g.lda + C) * 2u; voffB[i] = (unsigned)(Rb * g.ldb + C) * 2u; }
    const unsigned kstep = (unsigned)(BK * 2);
    const unsigned hstepA = (unsigned)HALF * g.lda * 2, hstepB = (unsigned)HALF * g.ldb * 2;
    const unsigned ldsw = (unsigned)wid * 1024u, ldsbase = (unsigned)(size_t)lds;
    const int aoff = F8 ? lds_byte(wr * 64 + fr, (fq >> 1) * 32 + (fq & 1) * 16) : lds_byte(wr * 64 + fr, fq * 8);
    const int boff = F8 ? lds_byte(wc * 32 + fr, (fq >> 1) * 32 + (fq & 1) * 16) : lds_byte(wc * 32 + fr, fq * 8);
#define PG_SA(b, h) (((b) * 2 + (h)) * HTB)
#define PG_SB(b, h) ((4 + (b) * 2 + (h)) * HTB)
#define PG_STAGE(bufoff, gbase, voff) do { _Pragma("unroll") for (int _i = 0; _i < 2; ++_i) \
        asm volatile("s_mov_b32 m0, %0\n\ts_nop 0\n\tbuffer_load_dwordx4 %1, %2, %3 offen lds" :: "s"(ldsbase + (unsigned)(bufoff) + ldsw + (unsigned)(_i * 8192)), "v"((voff)[_i]), "s"(rsrc), "s"((unsigned)(gbase)) : "m0", "memory"); } while (0)
#define PG_LDA(dst, b, h) do { _Pragma("unroll") for (int m = 0; m < 4; ++m) { if constexpr (F8) dst##8[m] = *(const LAS i32x8*)(lds + PG_SA(b, h) + aoff + m * 2048); \
        else { _Pragma("unroll") for (int k = 0; k < 2; ++k) dst[m][k] = *(const LAS bf16x8*)(lds + PG_SA(b, h) + aoff + m * 2048 + k * 1024); } } } while (0)
#define PG_LDB(dst, b, h) do { _Pragma("unroll") for (int n = 0; n < 2; ++n) { if constexpr (F8) dst##8[n] = *(const LAS i32x8*)(lds + PG_SB(b, h) + boff + n * 2048); \
        else { _Pragma("unroll") for (int k = 0; k < 2; ++k) dst[n][k] = *(const LAS bf16x8*)(lds + PG_SB(b, h) + boff + n * 2048 + k * 1024); } } } while (0)
#define PG_MMA(ai, bj, At, Bt) do { __builtin_amdgcn_s_setprio(1); _Pragma("unroll") for (int m = 0; m < 4; ++m) _Pragma("unroll") for (int n = 0; n < 2; ++n) { \
        if constexpr (F8) mma8(Bt##8[n], At##8[m], acc[ai][bj][m][n]); \
        else { _Pragma("unroll") for (int k = 0; k < 2; ++k) acc[ai][bj][m][n] = __builtin_amdgcn_mfma_f32_16x16x32_bf16(Bt[n][k], At[m][k], acc[ai][bj][m][n], 0, 0, 0); } } \
        __builtin_amdgcn_s_setprio(0); } while (0)
#define PG_WAIT_V(n) asm volatile("s_waitcnt vmcnt(" #n ")" ::: "memory")
#define PG_WAIT_L(n) asm volatile("s_waitcnt lgkmcnt(" #n ")" ::: "memory")
#define PG_BAR __builtin_amdgcn_s_barrier()
#define PG_SCHED __builtin_amdgcn_sched_barrier(0)
    Unit cur, nxt; int ui = 0;
    if (!S.next(0, cur)) return;
    f32x4 acc[2][2][4][2];
#pragma unroll
    for (int a = 0; a < 2; ++a)
#pragma unroll
        for (int b = 0; b < 2; ++b)
#pragma unroll
            for (int m = 0; m < 4; ++m)
#pragma unroll
                for (int n = 0; n < 2; ++n) acc[a][b][m][n] = (f32x4){0.f, 0.f, 0.f, 0.f};
    bf16x8 At[4][2], B0[2][2], B1[2][2]; i32x8 At8[4], B08[2], B18[2];
    unsigned cA = cur.ao, cB = cur.bo;
    asm volatile("s_nop 4" ::: "memory");
    PG_STAGE(PG_SB(0, 0), cB, voffB); PG_STAGE(PG_SB(0, 1), cB + hstepB, voffB); PG_STAGE(PG_SA(0, 0), cA, voffA); PG_STAGE(PG_SA(0, 1), cA + hstepA, voffA);
    if (wr == 1) PG_BAR;
    PG_WAIT_V(2); PG_BAR;
    PG_STAGE(PG_SB(1, 0), cB + kstep, voffB); PG_STAGE(PG_SA(1, 0), cA + kstep, voffA); PG_STAGE(PG_SB(1, 1), cB + hstepB + kstep, voffB);
    PG_WAIT_V(6); PG_BAR;
    for (;;) {
        const bool has_next = S.next(ui + 1, nxt);
        const unsigned nA = has_next ? nxt.ao : cA, nB = has_next ? nxt.bo : cB;
#pragma unroll 1
        for (int t = 0; t < nt; t += 2) {
            const bool last = (t == nt - 2);
            const unsigned a1 = cA + (unsigned)(t + 1) * kstep;
            const unsigned a2 = last ? nA : cA + (unsigned)(t + 2) * kstep, b2 = last ? nB : cB + (unsigned)(t + 2) * kstep;
            const unsigned a3 = a2 + kstep, b3 = b2 + kstep;
            PG_LDB(B0, 0, 0); PG_LDB(B1, 0, 1); PG_SCHED; PG_LDA(At, 0, 0); PG_STAGE(PG_SA(1, 1), a1 + hstepA, voffA);
            PG_WAIT_V(8); PG_WAIT_L(0); PG_BAR; PG_MMA(0, 0, At, B0); PG_MMA(0, 1, At, B1); PG_BAR; PG_SCHED;
            PG_LDA(At, 0, 1); PG_STAGE(PG_SB(0, 0), b2, voffB); PG_STAGE(PG_SB(0, 1), b2 + hstepB, voffB); PG_STAGE(PG_SA(0, 0), a2, voffA);
            PG_WAIT_V(8); PG_WAIT_L(0); PG_BAR; PG_MMA(1, 0, At, B0); PG_MMA(1, 1, At, B1); PG_BAR; PG_SCHED;
            PG_LDB(B0, 1, 0); PG_LDB(B1, 1, 1); PG_SCHED; PG_LDA(At, 1, 0); PG_STAGE(PG_SA(0, 1), a2 + hstepA, voffA);
            PG_WAIT_V(8); PG_WAIT_L(0); PG_BAR; PG_MMA(0, 0, At, B0); PG_MMA(0, 1, At, B1); PG_BAR; PG_SCHED;
            PG_LDA(At, 1, 1); PG_STAGE(PG_SB(1, 0), b3, voffB); PG_STAGE(PG_SB(1, 1), b3 + hstepB, voffB); PG_STAGE(PG_SA(1, 0), a3, voffA);
            PG_WAIT_V(8); PG_WAIT_L(0); PG_BAR; PG_MMA(1, 0, At, B0); PG_MMA(1, 1, At, B1); PG_BAR; PG_SCHED;
        }
        if constexpr (ALIGN_EPI) { if (wr == 0) PG_BAR; }
        if constexpr (F8) mma8_drain();
        { int t2 = threadIdx.x; asm volatile("" : "+v"(t2));
          const int l2 = t2 & 63; E(acc, cur, wr, wc, l2 & 15, l2 >> 4); }
        if (!has_next) break;
#pragma unroll
        for (int a = 0; a < 2; ++a)
#pragma unroll
            for (int b = 0; b < 2; ++b)
#pragma unroll
                for (int m = 0; m < 4; ++m)
#pragma unroll
                    for (int n = 0; n < 2; ++n) acc[a][b][m][n] = (f32x4){0.f, 0.f, 0.f, 0.f};
        cur = nxt; cA = nA; cB = nB; ++ui;
        if constexpr (ALIGN_EPI) { if (wr == 1) PG_BAR; }
    }
    PG_WAIT_V(0);
    if constexpr (!ALIGN_EPI) { if (wr == 0) PG_BAR; }
    PG_BAR;
#undef PG_SA
#undef PG_SB
#undef PG_STAGE
#undef PG_LDA
#undef PG_LDB
#undef PG_MMA
#undef PG_WAIT_V
#undef PG_WAIT_L
#undef PG_BAR
#undef PG_SCHED
}
}

#define XB_TMO      128
#define XB_XCNT(j)  (256  + 64 * (j))
#define XB_XSUB(j)  (1280 + 64 * (j))
#define XB_XGEN(j)  (2304 + 64 * (j))
#define XB_TOP      3328
#define XB_TOPGEN   3392
#define XCD_BAR_WORDS 3456
#define XB_SPIN_CAP (1u << 18)
__device__ __forceinline__ unsigned xb_ld(unsigned* p)              { return __hip_atomic_load(p, __ATOMIC_RELAXED, __HIP_MEMORY_SCOPE_AGENT); }
__device__ __forceinline__ unsigned xb_add(unsigned* p, unsigned v) { return __hip_atomic_fetch_add(p, v, __ATOMIC_RELAXED, __HIP_MEMORY_SCOPE_AGENT); }
__device__ __forceinline__ unsigned xb_xcc_id() { return (unsigned)__builtin_amdgcn_s_getreg((3 << 11) | 20) & 0xFu; }
#define XB_SPIN(cond, bar) do { unsigned _sp = 0; while (cond) { __builtin_amdgcn_s_sleep(1); \
    if ((++_sp & 255u) == 0u) { if (xb_ld(&(bar)[XB_TMO])) break; if (_sp > XB_SPIN_CAP) { atomicAdd(&(bar)[XB_TMO], 1u); break; } } } } while (0)
struct XcdBarrier { unsigned* bar; unsigned x; volatile LAS unsigned* st; };
__device__ __forceinline__ XcdBarrier xcd_barrier_post(unsigned* bar, volatile LAS unsigned* st) {
    XcdBarrier b; b.bar = bar; b.x = xb_xcc_id(); b.st = st;
    if (threadIdx.x == 0) (void)xb_add(&bar[XB_XCNT(b.x)], 1u);
    return b;
}
__device__ __forceinline__ void xcd_barrier_complete(unsigned* bar, unsigned x, unsigned& nloc, unsigned& nx) {
    const unsigned G = NBLOCKS;
    unsigned sum, cnt, mine, sp = 0u;
    for (;;) {
        sum = 0u; cnt = 0u; mine = 0u;
#pragma unroll
        for (unsigned j = 0; j < 16; ++j) { const unsigned c = xb_ld(&bar[XB_XCNT(j)]); sum += c; cnt += (c > 0u) ? 1u : 0u; mine = (j == x) ? c : mine; }
        if (sum == G) break;
        __builtin_amdgcn_s_sleep(1);
        if ((++sp & 255u) == 0u) { if (xb_ld(&bar[XB_TMO])) break; if (sp > XB_SPIN_CAP) { atomicAdd(&bar[XB_TMO], 1u); break; } }
    }
    nloc = mine > 0u ? mine : 1u; nx = cnt > 0u ? cnt : 1u;
}
__device__ __forceinline__ void xcd_barrier(unsigned* bar_, volatile LAS unsigned* st_) {
    asm volatile("s_waitcnt vmcnt(0)" ::: "memory");
    __syncthreads();
    if (threadIdx.x == 0) {
        XcdBarrier b; b.bar = bar_; b.x = xb_xcc_id(); b.st = st_;
        unsigned* bar = b.bar;
        __builtin_amdgcn_s_waitcnt(0);
        unsigned nloc = b.st[0], nx = b.st[1];
        if (nloc == 0u) { xcd_barrier_complete(bar, b.x, nloc, nx); b.st[0] = nloc; b.st[1] = nx; }
        const unsigned old = xb_add(&bar[XB_XSUB(b.x)], 1u);
        const unsigned gen = old / nloc;
        if (old + 1u == (gen + 1u) * nloc) {
            __builtin_amdgcn_fence(__ATOMIC_RELEASE, "agent");
            asm volatile("s_waitcnt vmcnt(0)" ::: "memory");
            const unsigned og = xb_add(&bar[XB_TOP], 1u);
            const unsigned tg = og / nx;
            if (og + 1u == (tg + 1u) * nx) xb_add(&bar[XB_TOPGEN], 1u);
            else XB_SPIN(xb_ld(&bar[XB_TOPGEN]) == tg, bar);
            __builtin_amdgcn_fence(__ATOMIC_ACQUIRE, "agent");
            xb_add(&bar[XB_XGEN(b.x)], 1u);
            asm volatile("s_waitcnt vmcnt(0)" ::: "memory");
        } else {
            XB_SPIN(xb_ld(&bar[XB_XGEN(b.x)]) == gen, bar);
            __builtin_amdgcn_fence(__ATOMIC_ACQUIRE, "agent");
            asm volatile("s_waitcnt vmcnt(0)" ::: "memory");
        }
    }
    __syncthreads();
}

constexpr int NPHASE = 16;
constexpr int LDS_BYTES = 147456, PT_OFF = LDS_BYTES - 512, MISC_OFF = LDS_BYTES - 128;
__device__ __forceinline__ const float* pt_load(const LAS unsigned* pt, int i) {
    const unsigned lo = __builtin_amdgcn_readfirstlane(pt[2 * i]), hi = __builtin_amdgcn_readfirstlane(pt[2 * i + 1]);
    return (const float*)(((unsigned long long)hi << 32) | lo);
}
__device__ __forceinline__ P make_p(const LAS unsigned* pt, float* out, unsigned char* ws) {
    P p;
    p.x = pt_load(pt, 0); p.mem = pt_load(pt, 1); p.g_mix = pt_load(pt, 2); p.w_in = pt_load(pt, 3); p.w_pool = pt_load(pt, 4); p.pool_scale = pt_load(pt, 5); p.w_gate_up = pt_load(pt, 6); p.b_gate_up = pt_load(pt, 7);
    p.gla_g = pt_load(pt, 8); p.w_out = pt_load(pt, 9); p.g_xattn = pt_load(pt, 10); p.g_mem = pt_load(pt, 11); p.w_xq = pt_load(pt, 12); p.w_xk = pt_load(pt, 13); p.w_xv = pt_load(pt, 14); p.w_xo = pt_load(pt, 15);
    p.g_moe = pt_load(pt, 16); p.w_router = pt_load(pt, 17); p.b_router = pt_load(pt, 18); p.w_gu = pt_load(pt, 19); p.b_gu = pt_load(pt, 20); p.w_dn = pt_load(pt, 21); p.b_dn = pt_load(pt, 22); p.g_final = pt_load(pt, 23);
    p.out = out; p.ws = ws; return p;
}
struct Args { const float* in[24]; float* out; unsigned char* ws; int ph_lo, ph_hi; };

__global__ void __launch_bounds__(NTHREADS, 2) mk_fwd(Args a) {
    extern __shared__ __attribute__((aligned(16))) unsigned char lds[];
    float* ldsf = (float*)lds;
    { volatile LAS unsigned long long* PT = (volatile LAS unsigned long long*)((LAS unsigned char*)lds + PT_OFF);
      if (threadIdx.x == 0) {
#define PTS(i) PT[i] = (unsigned long long)a.in[i];
          PTS(0) PTS(1) PTS(2) PTS(3) PTS(4) PTS(5) PTS(6) PTS(7) PTS(8) PTS(9) PTS(10) PTS(11) PTS(12) PTS(13) PTS(14) PTS(15) PTS(16) PTS(17) PTS(18) PTS(19) PTS(20) PTS(21) PTS(22) PTS(23)
#undef PTS
      } }
    const int bid = blockIdx.x; constexpr int nb = NBLOCKS;
#if defined(MK_PER_PHASE)
    const int lo = a.ph_lo, hi = a.ph_hi;
#else
    constexpr int lo = 0, hi = NPHASE;
#endif
#ifndef PH
#define PH -1
#endif
#ifndef REPMASK
#define REPMASK 0
#endif
#define REP(k) ((((REPMASK) >> (k)) & 1) ? 2 : 1)
#ifndef FASTMASK
#define FASTMASK 0x7FF
#endif
#define IN(k) ((PH < 0 || PH == (k)) && lo <= (k) && (k) < hi)
    LAS unsigned char* ldsl = (LAS unsigned char*)lds;
    volatile LAS unsigned* MISC = (volatile LAS unsigned*)(ldsl + MISC_OFF);
    if (threadIdx.x < 32) MISC[threadIdx.x] = 0u;
    __syncthreads();
    const bool fused = (hi - lo) > 1;
    if (fused) (void)xcd_barrier_post((unsigned*)(a.ws + WS_CTL) + CW_BAR, MISC + 8);
#define GRID_BAR() xcd_barrier((unsigned*)(a.ws + WS_CTL) + CW_BAR, (volatile LAS unsigned*)(ldsl + MISC_OFF) + 8)
#define SEAM(k) do { if (fused && IN(k) && IN((k) + 1)) GRID_BAR(); } while (0)
    if (IN(0)) for (int rep_ = 0; rep_ < REP(0); ++rep_) { if (rep_) GRID_BAR(); asm volatile("" ::: "memory"); P p = make_p((const LAS unsigned*)(ldsl + PT_OFF), a.out, a.ws); asm volatile("" : "+s"(p.ws)); unsigned char* const ws = p.ws; float* const rowsq1 = (float*)(p.ctl() + CW_ROWSQ1); (void)ws; (void)rowsq1;
    phase_prologue(p, ldsf, bid, nb);
    }
    SEAM(0);
    if (IN(1)) for (int rep_ = 0; rep_ < REP(1); ++rep_) { if (rep_) GRID_BAR(); asm volatile("" ::: "memory"); P p = make_p((const LAS unsigned*)(ldsl + PT_OFF), a.out, a.ws); asm volatile("" : "+s"(p.ws)); unsigned char* const ws = p.ws; float* const rowsq1 = (float*)(p.ctl() + CW_ROWSQ1); (void)ws; (void)rowsq1;
    {
        if (FASTMASK & 1) { pg::SchedG1 S{nb, bid}; pg::EpiBf3 E{ws, WS_Z1, WS_KX, WS_VXT, NZ, D, BATCH * MEMLEN};
            pg::gemm_phase<pg::EpiBf3, pg::SchedG1, true>(ldsl, ws, pg::Gemm{D, D, D}, S, E); }
        else {
        ngemm(NG{p.xn(), D, p.wt_in(), D, M, NZ, D, nullptr, 0}, EpiBf{p.z1(), NZ}, ldsf, bid, nb);
        ngemm(NG{p.hm(), D, p.wt_xk(), D, BATCH * MEMLEN, D, D, nullptr, 0}, EpiBf{p.kx(), D}, ldsf, bid, nb);
        ngemm(NG{p.wt_xv(), D, p.hm(), D, D, BATCH * MEMLEN, D, nullptr, 0}, EpiBf{p.vxt(), BATCH * MEMLEN}, ldsf, bid, nb); }
    }
    }
    SEAM(1);
    if (IN(2)) for (int rep_ = 0; rep_ < REP(2); ++rep_) { if (rep_) GRID_BAR(); asm volatile("" ::: "memory"); P p = make_p((const LAS unsigned*)(ldsl + PT_OFF), a.out, a.ws); asm volatile("" : "+s"(p.ws)); unsigned char* const ws = p.ws; float* const rowsq1 = (float*)(p.ctl() + CW_ROWSQ1); (void)ws; (void)rowsq1;
    { if (FASTMASK & 256) phase_pool2(p, lds, bid, nb); else phase_pool(p, ldsf, bid, nb);
      if (FASTMASK & 512) phase_gla_a2(p, lds, bid, nb); else phase_gla_a(p, ldsf, bid, nb); }
    }
    SEAM(2);
    if (IN(3)) for (int rep_ = 0; rep_ < REP(3); ++rep_) { if (rep_) GRID_BAR(); asm volatile("" ::: "memory"); P p = make_p((const LAS unsigned*)(ldsl + PT_OFF), a.out, a.ws); asm volatile("" : "+s"(p.ws)); unsigned char* const ws = p.ws; float* const rowsq1 = (float*)(p.ctl() + CW_ROWSQ1); (void)ws; (void)rowsq1;
    if (FASTMASK & 512) phase_scan2(p, bid, nb); else phase_scan(p, bid, nb);
    }
    SEAM(3);
    if (IN(4)) for (int rep_ = 0; rep_ < REP(4); ++rep_) { if (rep_) GRID_BAR(); asm volatile("" ::: "memory"); P p = make_p((const LAS unsigned*)(ldsl + PT_OFF), a.out, a.ws); asm volatile("" : "+s"(p.ws)); unsigned char* const ws = p.ws; float* const rowsq1 = (float*)(p.ctl() + CW_ROWSQ1); (void)ws; (void)rowsq1;
    if (FASTMASK & 512) phase_gla_b2(p, lds, bid, nb); else phase_gla_b(p, ldsf, bid, nb);
    }
    SEAM(4);
    if (IN(5)) for (int rep_ = 0; rep_ < REP(5); ++rep_) { if (rep_) GRID_BAR(); asm volatile("" ::: "memory"); P p = make_p((const LAS unsigned*)(ldsl + PT_OFF), a.out, a.ws); asm volatile("" : "+s"(p.ws)); unsigned char* const ws = p.ws; float* const rowsq1 = (float*)(p.ctl() + CW_ROWSQ1); (void)ws; (void)rowsq1;
    {
        if (FASTMASK & 2) { pg::Sched2D S{(unsigned)WS_MIX, (unsigned)WS_WT_OUT, D * 2, D * 2, M / 256, D / 256, nb, bid}; pg::EpiOutF E{p.x, p.x1(), p.a2(), p.g_xattn, rowsq1};
            pg::gemm_phase<pg::EpiOutF, pg::Sched2D, false>(ldsl, ws, pg::Gemm{D, D, D}, S, E); }
        else ngemm(NG{p.mix(), D, p.wt_out(), D, M, D, D, nullptr, 0}, EpiOut{p.x, p.x1(), p.a2(), p.g_xattn, rowsq1}, ldsf, bid, nb);
    }
    }
    SEAM(5);
    if (IN(6)) for (int rep_ = 0; rep_ < REP(6); ++rep_) { if (rep_) GRID_BAR(); asm volatile("" ::: "memory"); P p = make_p((const LAS unsigned*)(ldsl + PT_OFF), a.out, a.ws); asm volatile("" : "+s"(p.ws)); unsigned char* const ws = p.ws; float* const rowsq1 = (float*)(p.ctl() + CW_ROWSQ1); (void)ws; (void)rowsq1;
    {
        if (FASTMASK & 4) { pg::Sched2D S{(unsigned)WS_A2, (unsigned)WS_WT_XQ, D * 2, D * 2, M / 256, D / 256, nb, bid}; pg::EpiQF E{p.qx(), rowsq1};
            pg::gemm_phase<pg::EpiQF, pg::Sched2D, false>(ldsl, ws, pg::Gemm{D, D, D}, S, E); }
        else ngemm(NG{p.a2(), D, p.wt_xq(), D, M, D, D, nullptr, 0}, EpiQ{p.qx(), rowsq1}, ldsf, bid, nb);
    }
    }
    SEAM(6);
    if (IN(7)) for (int rep_ = 0; rep_ < REP(7); ++rep_) { if (rep_) GRID_BAR(); asm volatile("" ::: "memory"); P p = make_p((const LAS unsigned*)(ldsl + PT_OFF), a.out, a.ws); asm volatile("" : "+s"(p.ws)); unsigned char* const ws = p.ws; float* const rowsq1 = (float*)(p.ctl() + CW_ROWSQ1); (void)ws; (void)rowsq1;
    {
        if (FASTMASK & 8) { pg::SchedAttn S{(unsigned)WS_QX, (unsigned)WS_KX, MEMLEN * D * 2, 256 * 2, nb, bid}; pg::EpiF E{p.sc(), D};
            pg::gemm_phase<pg::EpiF, pg::SchedAttn, false>(ldsl, ws, pg::Gemm{D, D, 256}, S, E); }
        else for (int bh = 0; bh < 8; ++bh) { const int b = bh >> 2, h = bh & 3; const size_t o = (size_t)b * SEQ * D + h * 256;
            ngemm(NG{p.qx() + o, D, p.kx() + (size_t)b * MEMLEN * D + h * 256, D, SEQ, 256, 256, nullptr, 0}, EpiF32{p.sc() + o, D}, ldsf, bid, nb); }
    }
    }
    SEAM(7);
    if (IN(8)) for (int rep_ = 0; rep_ < REP(8); ++rep_) { if (rep_) GRID_BAR(); asm volatile("" ::: "memory"); P p = make_p((const LAS unsigned*)(ldsl + PT_OFF), a.out, a.ws); asm volatile("" : "+s"(p.ws)); unsigned char* const ws = p.ws; float* const rowsq1 = (float*)(p.ctl() + CW_ROWSQ1); (void)ws; (void)rowsq1;
    phase_softmax(p, bid, nb);
    }
    SEAM(8);
    if (IN(9)) for (int rep_ = 0; rep_ < REP(9); ++rep_) { if (rep_) GRID_BAR(); asm volatile("" ::: "memory"); P p = make_p((const LAS unsigned*)(ldsl + PT_OFF), a.out, a.ws); asm volatile("" : "+s"(p.ws)); unsigned char* const ws = p.ws; float* const rowsq1 = (float*)(p.ctl() + CW_ROWSQ1); (void)ws; (void)rowsq1;
    {
        if (FASTMASK & 16) { pg::SchedAttn S{(unsigned)WS_PX, (unsigned)WS_VXT, MEMLEN * 2, 256 * BATCH * MEMLEN * 2, nb, bid}; pg::EpiBf3 E{ws, WS_OX, WS_OX, WS_OX, D, D, D};
            pg::gemm_phase<pg::EpiBf3, pg::SchedAttn, false>(ldsl, ws, pg::Gemm{D, BATCH * MEMLEN, 256}, S, E); }
        else for (int bh = 0; bh < 8; ++bh) { const int b = bh >> 2, h = bh & 3; const size_t o = (size_t)b * SEQ * D + h * 256;
            ngemm(NG{p.px() + o, D, p.vxt() + (size_t)h * 256 * (BATCH * MEMLEN) + b * MEMLEN, BATCH * MEMLEN, SEQ, 256, 256, nullptr, 0}, EpiBf{p.ox() + o, D}, ldsf, bid, nb); }
    }
    }
    SEAM(9);
    if (IN(10)) for (int rep_ = 0; rep_ < REP(10); ++rep_) { if (rep_) GRID_BAR(); asm volatile("" ::: "memory"); P p = make_p((const LAS unsigned*)(ldsl + PT_OFF), a.out, a.ws); asm volatile("" : "+s"(p.ws)); unsigned char* const ws = p.ws; float* const rowsq1 = (float*)(p.ctl() + CW_ROWSQ1); (void)ws; (void)rowsq1;
    {
        if (FASTMASK & 32) { pg::Sched2D S{(unsigned)WS_OX, (unsigned)WS_WT_XO, D * 2, D * 2, M / 256, D / 256, nb, bid}; pg::EpiResF E{p.x1(), p.x2()};
            pg::gemm_phase<pg::EpiResF, pg::Sched2D, false>(ldsl, ws, pg::Gemm{D, D, D}, S, E); }
        else ngemm(NG{p.ox(), D, p.wt_xo(), D, M, D, D, nullptr, 0}, EpiRes{p.x1(), p.x2()}, ldsf, bid, nb);
    }
    }
    SEAM(10);
    if (IN(11)) for (int rep_ = 0; rep_ < REP(11); ++rep_) { if (rep_) GRID_BAR(); asm volatile("" ::: "memory"); P p = make_p((const LAS unsigned*)(ldsl + PT_OFF), a.out, a.ws); asm volatile("" : "+s"(p.ws)); unsigned char* const ws = p.ws; float* const rowsq1 = (float*)(p.ctl() + CW_ROWSQ1); (void)ws; (void)rowsq1;
    if (FASTMASK & 1024) phase_router2(p, ldsf, (int*)(ws + WS_BLKCNT), (int*)(ws + WS_WAVEBASE), bid, nb); else phase_router(p, ldsf, bid, nb);
    }
    SEAM(11);
    if (IN(12)) for (int rep_ = 0; rep_ < REP(12); ++rep_) { if (rep_) GRID_BAR(); asm volatile("" ::: "memory"); P p = make_p((const LAS unsigned*)(ldsl + PT_OFF), a.out, a.ws); asm volatile("" : "+s"(p.ws)); unsigned char* const ws = p.ws; float* const rowsq1 = (float*)(p.ctl() + CW_ROWSQ1); (void)ws; (void)rowsq1;
    if (FASTMASK & 1024) phase_dispatch2(p, (int*)lds, (const int*)(ws + WS_BLKCNT), (const int*)(ws + WS_WAVEBASE), bid, nb); else phase_dispatch(p, (int*)lds, bid, nb);
    }
    SEAM(12);
    if (IN(13)) for (int rep_ = 0; rep_ < REP(13); ++rep_) { if (rep_) GRID_BAR(); asm volatile("" ::: "memory"); P p = make_p((const LAS unsigned*)(ldsl + PT_OFF), a.out, a.ws); asm volatile("" : "+s"(p.ws)); unsigned char* const ws = p.ws; float* const rowsq1 = (float*)(p.ctl() + CW_ROWSQ1); (void)ws; (void)rowsq1;
    { const int nmt = __builtin_amdgcn_readfirstlane(p.tilee()[MAXMT]);
        if (MOE_FP8) { pg::SchedMoE S{(unsigned)WS_XS, (unsigned)WS_WT_GU, p.tilee(), 2 * DFF * D, D, D, nmt, 8, nb, bid}; pg::EpiUp8 E{(unsigned char*)p.h(), p.b_gu};
            pg::gemm_phase<pg::EpiUp8, pg::SchedMoE, true, true>(ldsl, ws, pg::Gemm{D / 2, D / 2, D / 2}, S, E); }
        else if (FASTMASK & 64) { pg::SchedMoE S{(unsigned)WS_XS, (unsigned)WS_WT_GU, p.tilee(), 2 * DFF * D * 2, D * 2, D * 2, nmt, 8, nb, bid}; pg::EpiUpF E{p.h(), p.b_gu};
            pg::gemm_phase<pg::EpiUpF, pg::SchedMoE, true>(ldsl, ws, pg::Gemm{D, D, D}, S, E); }
        else ngemm(NG{p.xs(), D, p.wt_gu(), D, nmt * 256, 2 * DFF, D, p.tilee(), (size_t)2 * DFF * D}, EpiUp{p.h(), p.b_gu}, ldsf, bid, nb); }
    }
    SEAM(13);
    if (IN(14)) for (int rep_ = 0; rep_ < REP(14); ++rep_) { if (rep_) GRID_BAR(); asm volatile("" ::: "memory"); P p = make_p((const LAS unsigned*)(ldsl + PT_OFF), a.out, a.ws); asm volatile("" : "+s"(p.ws)); unsigned char* const ws = p.ws; float* const rowsq1 = (float*)(p.ctl() + CW_ROWSQ1); (void)ws; (void)rowsq1;
    { const int nmt = __builtin_amdgcn_readfirstlane(p.tilee()[MAXMT]);
        if (MOE_FP8) { pg::SchedMoE S{(unsigned)WS_H, (unsigned)WS_WT_DN, p.tilee(), D * DFF, DFF, DFF, nmt, 4, nb, bid}; pg::EpiDn8 E{p.y(), p.b_dn, p.gslot()};
            pg::gemm_phase<pg::EpiDn8, pg::SchedMoE, true, true>(ldsl, ws, pg::Gemm{DFF / 2, DFF / 2, DFF / 2}, S, E); }
        else if (FASTMASK & 128) { pg::SchedMoE S{(unsigned)WS_H, (unsigned)WS_WT_DN, p.tilee(), D * DFF * 2, DFF * 2, DFF * 2, nmt, 4, nb, bid}; pg::EpiDnF E{p.y(), p.b_dn, p.gslot()};
            pg::gemm_phase<pg::EpiDnF, pg::SchedMoE, true>(ldsl, ws, pg::Gemm{DFF, DFF, DFF}, S, E); }
        else ngemm(NG{p.h(), DFF, p.wt_dn(), DFF, nmt * 256, D, DFF, p.tilee(), (size_t)D * DFF}, EpiDn{p.y(), p.b_dn, p.gslot()}, ldsf, bid, nb); }
    }
    SEAM(14);
    if (IN(15)) for (int rep_ = 0; rep_ < REP(15); ++rep_) { if (rep_) GRID_BAR(); asm volatile("" ::: "memory"); P p = make_p((const LAS unsigned*)(ldsl + PT_OFF), a.out, a.ws); asm volatile("" : "+s"(p.ws)); unsigned char* const ws = p.ws; float* const rowsq1 = (float*)(p.ctl() + CW_ROWSQ1); (void)ws; (void)rowsq1;
    phase_final(p, bid, nb);
    }
#undef IN
#undef SEAM
}

extern "C" void kernel_launch(void* const* d_in, const int* in_sizes, int n_in, void* d_out, int out_size, void* d_ws, size_t ws_size, hipStream_t stream) {
    static int grid = 0;
    if (grid == 0) {
        if (n_in != 24 || in_sizes[0] != M * D || out_size != M * D || ws_size < WS_END) { fprintf(stderr, "kernel_launch: unexpected shapes (n_in %d, in0 %d, out %d, ws %zu)\n", n_in, n_in > 0 ? in_sizes[0] : -1, out_size, ws_size); grid = -1; return; }
        int dev = 0, cus = 0;
        if (hipGetDevice(&dev) != hipSuccess || hipDeviceGetAttribute(&cus, hipDeviceAttributeMultiprocessorCount, dev) != hipSuccess) { grid = -1; return; }
        if (hipFuncSetAttribute((const void*)mk_fwd, hipFuncAttributeMaxDynamicSharedMemorySize, LDS_BYTES) != hipSuccess) { fprintf(stderr, "kernel_launch: hipFuncSetAttribute failed\n"); grid = -1; return; }
        if (cus != NBLOCKS) fprintf(stderr, "kernel_launch: device reports %d CUs; this kernel launches %d workgroups (one per CU of a 256-CU device)\n", cus, NBLOCKS);
        grid = NBLOCKS;
    }
    if (grid < 0) return;
    (void)hipMemsetAsync((char*)d_ws + WS_CTL, 0, CTL_BYTES, stream);
    Args a{};
    for (int i = 0; i < 24; ++i) a.in[i] = (const float*)d_in[i];
    a.out = (float*)d_out; a.ws = (unsigned char*)d_ws;
#if defined(MK_PER_PHASE)
    for (int ph = 0; ph < NPHASE; ++ph) { a.ph_lo = ph; a.ph_hi = ph + 1; hipLaunchKernelGGL(mk_fwd, dim3(grid), dim3(NTHREADS), LDS_BYTES, stream, a); }
#else
    a.ph_lo = 0; a.ph_hi = NPHASE; hipLaunchKernelGGL(mk_fwd, dim3(grid), dim3(NTHREADS), LDS_BYTES, stream, a);
#endif
}
```

```cpp
#include <hip/hip_runtime.h>
#include <cstdio>
#include <cstdint>

#define LAS __attribute__((address_space(3)))
typedef unsigned short bf16;
typedef float f32x4 __attribute__((ext_vector_type(4)));
typedef unsigned u32x4 __attribute__((ext_vector_type(4)));
typedef unsigned u32x2 __attribute__((ext_vector_type(2)));

constexpr int BATCH = 2, SEQ = 8192, M = BATCH * SEQ, D = 1024;
constexpr int IN_COLS = 2064, NZ = 2304;
constexpr int ZQ = 512, ZK = 768, ZV = 1024, ZR = 1536, ZG = 2048;
constexpr int NE = 32, TOPK = 4, DFF = 1024, MEMLEN = 256;
constexpr int NASSIGN = M * TOPK, MAXSLOT = NASSIGN + NE * 256, MAXMT = MAXSLOT / 256;
constexpr int NCHUNK = SEQ / 64;
constexpr float EPS = 1e-6f;
constexpr int NTHREADS = 512, NWAVES = 8, NBLOCKS = 256;

constexpr size_t MiB = 1u << 20;
constexpr size_t WS_CTL = 0, CTL_BYTES = 1 * MiB;
constexpr size_t WS_WT_OUT = 2 * MiB, WS_WT_XQ = 4 * MiB, WS_WT_XK = 6 * MiB, WS_WT_XV = 8 * MiB, WS_WT_XO = 10 * MiB, WS_WT_IN = 12 * MiB;
constexpr size_t WS_SMALL = 17 * MiB;
constexpr size_t WS_RS2 = WS_SMALL, WS_TOPI = WS_SMALL + 64 * 1024, WS_TOPG = WS_TOPI + 256 * 1024, WS_SLOTOF = WS_TOPG + 256 * 1024,
                 WS_GSLOT = WS_SLOTOF + 256 * 1024, WS_TILEE = WS_GSLOT + 320 * 1024, WS_BLKCNT = WS_TILEE + 4096, WS_WAVEBASE = WS_BLKCNT + 32768;
constexpr size_t WS_WT_GU = 20 * MiB, WS_WT_DN = 148 * MiB, WS_X2 = 212 * MiB, WS_B = 276 * MiB;
constexpr size_t WS_XN = WS_B, WS_HM = WS_B + 32 * MiB, WS_Z1 = WS_B + 33 * MiB, WS_MIX = WS_B + 121 * MiB, WS_SPREV = WS_B + 153 * MiB,
                 WS_DS = WS_B + 185 * MiB, WS_DEC = WS_B + 217 * MiB, WS_X1 = WS_B + 218 * MiB, WS_A2 = WS_B + 282 * MiB, WS_KX = WS_B + 314 * MiB, WS_VXT = WS_B + 315 * MiB;
constexpr size_t WS_QX = WS_Z1, WS_PX = WS_Z1 + 32 * MiB, WS_SC = WS_MIX, WS_OX = WS_DS;
constexpr size_t WS_XS = WS_B, WS_H = WS_B + 144 * MiB, WS_Y = WS_B + 288 * MiB, WS_END = WS_B + 432 * MiB;
constexpr int CW_BAR = 4096, CW_COUNT = 8192, CW_CURSOR = 8256, CW_ROWSQ1 = 16384;

__device__ __forceinline__ float bf_lo(unsigned w) { return __uint_as_float(w << 16); }
__device__ __forceinline__ float bf_hi(unsigned w) { return __uint_as_float(w & 0xffff0000u); }
__device__ __forceinline__ float bf2f(bf16 v) { return __uint_as_float((unsigned)v << 16); }
__device__ __forceinline__ unsigned f2bf(float f) { unsigned u = __float_as_uint(f); return (u + 0x7fffu + ((u >> 16) & 1u)) >> 16; }
__device__ __forceinline__ unsigned pk2(float lo, float hi) { return f2bf(lo) | (f2bf(hi) << 16); }
__device__ __forceinline__ float wave_sum(float v) {
#pragma unroll
    for (int o = 1; o < 64; o <<= 1) v += __shfl_xor(v, o);
    return v;
}
__device__ __forceinline__ float clamp8(float v) { return fminf(fmaxf(v, -448.f), 448.f); }
__device__ __forceinline__ unsigned pk4_fp8(float a, float b, float c, float d) { int w = __builtin_amdgcn_cvt_pk_fp8_f32(clamp8(a), clamp8(b), 0, false); w = __builtin_amdgcn_cvt_pk_fp8_f32(clamp8(c), clamp8(d), w, true); return (unsigned)w; }
constexpr float W8_SCALE = 32.f, W8_INV = 1.f / 32.f;
#ifndef MOE_FP8
#define MOE_FP8 1
#endif
__device__ __forceinline__ float logsigmoid(float x) { return fminf(x, 0.f) - log1pf(expf(-fabsf(x))); }

struct P {
    const float *x, *mem, *g_mix, *w_in, *w_pool, *pool_scale, *w_gate_up, *b_gate_up, *gla_g, *w_out, *g_xattn, *g_mem, *w_xq, *w_xk, *w_xv, *w_xo,
                *g_moe, *w_router, *b_router, *w_gu, *b_gu, *w_dn, *b_dn, *g_final;
    float* out; unsigned char* ws;
#define PACC(type, name, off) __device__ __forceinline__ type* name() const { return (type*)(ws + (off)); }
    PACC(unsigned, ctl, WS_CTL)
    PACC(bf16, wt_in, WS_WT_IN) PACC(bf16, wt_out, WS_WT_OUT) PACC(bf16, wt_xq, WS_WT_XQ) PACC(bf16, wt_xk, WS_WT_XK) PACC(bf16, wt_xv, WS_WT_XV) PACC(bf16, wt_xo, WS_WT_XO) PACC(bf16, wt_gu, WS_WT_GU) PACC(bf16, wt_dn, WS_WT_DN)
    PACC(bf16, xn, WS_XN) PACC(bf16, hm, WS_HM) PACC(bf16, z1, WS_Z1) PACC(bf16, mix, WS_MIX) PACC(bf16, a2, WS_A2) PACC(bf16, kx, WS_KX) PACC(bf16, vxt, WS_VXT)
    PACC(bf16, qx, WS_QX) PACC(bf16, px, WS_PX) PACC(bf16, ox, WS_OX) PACC(bf16, xs, WS_XS) PACC(bf16, h, WS_H) PACC(bf16, y, WS_Y)
    PACC(float, sprev, WS_SPREV) PACC(float, ds, WS_DS) PACC(float, dec, WS_DEC) PACC(float, x1, WS_X1) PACC(float, x2, WS_X2) PACC(float, sc, WS_SC)
    PACC(float, rs2, WS_RS2) PACC(float, topg, WS_TOPG) PACC(float, gslot, WS_GSLOT) PACC(int, topi, WS_TOPI) PACC(int, slotof, WS_SLOTOF) PACC(int, tilee, WS_TILEE)
#undef PACC
};

struct MapId { __device__ __forceinline__ int operator()(int n) const { return n; } };
struct MapIn { __device__ __forceinline__ int operator()(int n) const { return n < 1536 ? n : (n < 2048 ? 1552 + (n - 1536) : (n < 2064 ? 1536 + (n - 2048) : -1)); } };
struct MapGu { __device__ __forceinline__ int operator()(int n) const { const int pn = n >> 8, w = n & 255; return w < 128 ? pn * 128 + w : 1024 + pn * 128 + (w - 128); } };

template <class Map>
__device__ __forceinline__ void transpose_item(const float* W, int ldw, int K, bf16* WT, float* scr, int kb, int nb, int lane, Map map) {
    const int k0 = 64 * kb, n0 = 32 * nb;
    const int sc = map(n0 + (lane & 31));
#pragma unroll 8
    for (int i = 0; i < 32; ++i) { const int kk = 2 * i + (lane >> 5); scr[kk * 33 + (lane & 31)] = sc >= 0 ? W[(size_t)(k0 + kk) * ldw + sc] : 0.f; }
    __builtin_amdgcn_s_waitcnt(0xC07F); asm volatile("" ::: "memory");
    const int c = lane & 7;
#pragma unroll
    for (int j = 0; j < 4; ++j) { const int n = (lane >> 3) + 8 * j; const float* s = scr + (8 * c) * 33 + n;
        u32x4 o; o.x = pk2(s[0 * 33], s[1 * 33]); o.y = pk2(s[2 * 33], s[3 * 33]); o.z = pk2(s[4 * 33], s[5 * 33]); o.w = pk2(s[6 * 33], s[7 * 33]);
        *(u32x4*)(WT + (size_t)(n0 + n) * K + k0 + 8 * c) = o; }
    __builtin_amdgcn_s_waitcnt(0xC07F); asm volatile("" ::: "memory");
}
template <class Map>
__device__ __forceinline__ void transpose_item8(const float* W, int ldw, int K, unsigned char* WT, float* scr, int kb, int nb, int lane, Map map, float scale) {
    const int k0 = 128 * kb, n0 = 32 * nb;
    const int sc = map(n0 + (lane & 31));
#pragma unroll 8
    for (int i = 0; i < 64; ++i) { const int kk = 2 * i + (lane >> 5); scr[kk * 33 + (lane & 31)] = W[(size_t)(k0 + kk) * ldw + sc] * scale; }
    __builtin_amdgcn_s_waitcnt(0xC07F); asm volatile("" ::: "memory");
    const int c = lane & 7;
#pragma unroll
    for (int j = 0; j < 4; ++j) { const int n = (lane >> 3) + 8 * j; const float* s = scr + (16 * c) * 33 + n;
        u32x4 o; o.x = pk4_fp8(s[0 * 33], s[1 * 33], s[2 * 33], s[3 * 33]); o.y = pk4_fp8(s[4 * 33], s[5 * 33], s[6 * 33], s[7 * 33]);
        o.z = pk4_fp8(s[8 * 33], s[9 * 33], s[10 * 33], s[11 * 33]); o.w = pk4_fp8(s[12 * 33], s[13 * 33], s[14 * 33], s[15 * 33]);
        *(u32x4*)(WT + (size_t)(n0 + n) * K + k0 + 16 * c) = o; }
    __builtin_amdgcn_s_waitcnt(0xC07F); asm volatile("" ::: "memory");
}
template <class Dst, int MODE = 0>
__device__ __forceinline__ void conv8_item(const float* W, int ldw, int K, unsigned char* WT, unsigned char* tile, int kb, int nb, int lane, Dst dst, float scale) {
    const int k0 = 64 * kb, n0 = 256 * nb;
    const float* src = W + (size_t)k0 * ldw + n0 + 4 * lane;
#pragma unroll 1
    for (int c = 0; c < 4; c += 2) {
        f32x4 v[32];
#pragma unroll
        for (int i = 0; i < 32; ++i) { if (MODE == 2) v[i] = (f32x4){0.f, 0.f, 0.f, 0.f}; else v[i] = __builtin_nontemporal_load((const f32x4*)(src + (size_t)(16 * c + i) * ldw)); }
        if (MODE == 1) {
#pragma unroll
            for (int i = 0; i < 32; ++i) asm volatile("" :: "v"(v[i]));
            continue; }
#pragma unroll
        for (int h = 0; h < 2; ++h)
#pragma unroll
            for (int j = 0; j < 4; ++j) { u32x4 o;
                o.x = pk4_fp8(v[16 * h + 0][j] * scale, v[16 * h + 1][j] * scale, v[16 * h + 2][j] * scale, v[16 * h + 3][j] * scale);
                o.y = pk4_fp8(v[16 * h + 4][j] * scale, v[16 * h + 5][j] * scale, v[16 * h + 6][j] * scale, v[16 * h + 7][j] * scale);
                o.z = pk4_fp8(v[16 * h + 8][j] * scale, v[16 * h + 9][j] * scale, v[16 * h + 10][j] * scale, v[16 * h + 11][j] * scale);
                o.w = pk4_fp8(v[16 * h + 12][j] * scale, v[16 * h + 13][j] * scale, v[16 * h + 14][j] * scale, v[16 * h + 15][j] * scale);
                const int r = 4 * lane + j, pc = (c + h) ^ (lane & 3);
                *(u32x4*)(tile + r * 64 + pc * 16) = o; }
    }
    if (MODE == 1) return;
#pragma unroll 4
    for (int s = 0; s < 16; ++s) { const int r = 16 * s + (lane >> 2), pc = (lane & 3) ^ ((r >> 2) & 3);
        const u32x4 o = *(const u32x4*)(tile + r * 64 + pc * 16);
        *(u32x4*)(WT + (size_t)dst(n0 + r) * K + k0 + 16 * (lane & 3)) = o; }
}
struct DstId { __device__ __forceinline__ int operator()(int n) const { return n; } };
struct DstGu { __device__ __forceinline__ int operator()(int n) const { const int up = n >> 10, ff = n & 1023; return (ff >> 7) * 256 + up * 128 + (ff & 127); } };
template <int NR>
__device__ __forceinline__ void rms_rows_bf16(const float* xrow, const float* g, bf16* orow, size_t rstride, int lane) {
    f32x4 v[NR][4]; float s[NR];
#pragma unroll
    for (int r = 0; r < NR; ++r)
#pragma unroll
        for (int j = 0; j < 4; ++j) v[r][j] = *((const f32x4*)(xrow + r * rstride) + lane + 64 * j);
#pragma unroll
    for (int r = 0; r < NR; ++r) { s[r] = 0.f;
#pragma unroll
        for (int j = 0; j < 4; ++j) s[r] += (v[r][j].x * v[r][j].x + v[r][j].y * v[r][j].y) + (v[r][j].z * v[r][j].z + v[r][j].w * v[r][j].w); }
#pragma unroll
    for (int o = 1; o < 64; o <<= 1)
#pragma unroll
        for (int r = 0; r < NR; ++r) s[r] += __shfl_xor(s[r], o);
    const f32x4* gr = (const f32x4*)g + lane;
#pragma unroll
    for (int r = 0; r < NR; ++r) { const float rs = 1.0f / sqrtf(s[r] * (1.f / D) + EPS); u32x2* o8 = (u32x2*)(orow + r * rstride) + lane;
#pragma unroll
        for (int j = 0; j < 4; ++j) { const f32x4 gg = gr[64 * j]; u32x2 w; w.x = pk2(v[r][j].x * rs * gg.x, v[r][j].y * rs * gg.y); w.y = pk2(v[r][j].z * rs * gg.z, v[r][j].w * rs * gg.w); o8[64 * j] = w; } }
}
#ifndef PROBE_PRO
#define PROBE_PRO 0
#endif
__device__ __forceinline__ void phase_prologue(const P& p, float* ldsf, int bid, int nb) {
    const int tid = threadIdx.x, lane = tid & 63, wave = tid >> 6;
    float* scr = ldsf + wave * (128 * 33);
    const int gw = bid * NWAVES + wave, NGW = nb * NWAVES;
    constexpr int I_IN = 16 * (NZ / 32), I_SQ = 16 * 32, I_GU = MOE_FP8 ? 16 * 8 : 16 * 64, I_DN = MOE_FP8 ? 16 * 4 : 16 * 32;
    for (int rep = 0; rep < ((PROBE_PRO & 1) ? 2 : 1); ++rep)
    for (int it = gw; it < I_IN + 5 * I_SQ; it += NGW) {
        int r = it;
        if (r < I_IN) { transpose_item(p.w_in, IN_COLS, D, p.wt_in(), scr, r / (NZ / 32), r % (NZ / 32), lane, MapIn()); continue; } r -= I_IN;
        { const int w = r / I_SQ, q = r % I_SQ; const float* src = w == 0 ? p.w_out : w == 1 ? p.w_xq : w == 2 ? p.w_xk : w == 3 ? p.w_xv : p.w_xo;
            bf16* dst = w == 0 ? p.wt_out() : w == 1 ? p.wt_xq() : w == 2 ? p.wt_xk() : w == 3 ? p.wt_xv() : p.wt_xo();
            transpose_item(src, D, D, dst, scr, q / 32, q % 32, lane, MapId()); }
    }
    for (int rep = 0; rep < ((PROBE_PRO & 2) ? 2 : 1); ++rep)
    for (int it = gw; it < NE * (I_GU + I_DN); it += NGW) {
        int r = it;
        if (r < NE * I_GU) { const int e = r / I_GU, q = r % I_GU;
            if (MOE_FP8) conv8_item(p.w_gu + (size_t)e * D * 2 * DFF, 2 * DFF, D, (unsigned char*)p.wt_gu() + (size_t)e * 2 * DFF * D, (unsigned char*)scr, q / 8, q % 8, lane, DstGu(), W8_SCALE);
            else transpose_item(p.w_gu + (size_t)e * D * 2 * DFF, 2 * DFF, D, p.wt_gu() + (size_t)e * 2 * DFF * D, scr, q / 64, q % 64, lane, MapGu()); continue; } r -= NE * I_GU;
        { const int e = r / I_DN, q = r % I_DN;
            if (MOE_FP8) conv8_item(p.w_dn + (size_t)e * DFF * D, D, DFF, (unsigned char*)p.wt_dn() + (size_t)e * D * DFF, (unsigned char*)scr, q / 4, q % 4, lane, DstId(), W8_SCALE);
            else transpose_item(p.w_dn + (size_t)e * DFF * D, D, DFF, p.wt_dn() + (size_t)e * D * DFF, scr, q / 32, q % 32, lane, MapId()); }
    }
    if (PROBE_PRO & 24)
    for (int it = gw; it < NE * (I_GU + I_DN); it += NGW) {
        int r = it;
        if (r < NE * I_GU) { const int e = r / I_GU, q = r % I_GU;
            if (PROBE_PRO & 8) conv8_item<DstGu, 1>(p.w_gu + (size_t)e * D * 2 * DFF, 2 * DFF, D, (unsigned char*)p.wt_gu() + (size_t)e * 2 * DFF * D, (unsigned char*)scr, q / 8, q % 8, lane, DstGu(), W8_SCALE);
            else conv8_item<DstGu, 2>(p.w_gu + (size_t)e * D * 2 * DFF, 2 * DFF, D, p.ws + WS_END + (size_t)e * 2 * DFF * D, (unsigned char*)scr, q / 8, q % 8, lane, DstGu(), W8_SCALE); continue; } r -= NE * I_GU;
        { const int e = r / I_DN, q = r % I_DN;
            if (PROBE_PRO & 8) conv8_item<DstId, 1>(p.w_dn + (size_t)e * DFF * D, D, DFF, (unsigned char*)p.wt_dn() + (size_t)e * D * DFF, (unsigned char*)scr, q / 4, q % 4, lane, DstId(), W8_SCALE);
            else conv8_item<DstId, 2>(p.w_dn + (size_t)e * DFF * D, D, DFF, p.ws + WS_END + 64 * MiB + (size_t)e * D * DFF, (unsigned char*)scr, q / 4, q % 4, lane, DstId(), W8_SCALE); }
    }
    for (int rep = 0; rep < ((PROBE_PRO & 4) ? 2 : 1); ++rep) {
    for (int m = gw * 4; m < M; m += NGW * 4) rms_rows_bf16<4>(p.x + (size_t)m * D, p.g_mix, p.xn() + (size_t)m * D, D, lane);
    for (int m = gw; m < BATCH * MEMLEN; m += NGW) rms_rows_bf16<1>(p.mem + (size_t)m * D, p.g_mem, p.hm() + (size_t)m * D, D, lane);
    }
}

struct NG { const bf16* A; int lda; const bf16* Bt; int ldb; int Mr, N, K; const int* tile_e; size_t sBe; };
template <class Epi>
__device__ __forceinline__ void ngemm(const NG g, const Epi& E, float* lds, int bid, int nb) {
    float* As = lds; float* Bs = lds + 32 * 128;
    const int tid = threadIdx.x, tr = tid >> 4, tc = tid & 15;
    const int nMt = g.Mr / 128, nNt = g.N / 256;
    for (int u = bid; u < nMt * nNt; u += nb) {
        const int mt = u / nNt, nt = u % nNt, row0 = mt * 128, col0 = nt * 256;
        int e = 0; const bf16* Bt = g.Bt;
        if (g.tile_e) { e = g.tile_e[row0 >> 8]; Bt += (size_t)e * g.sBe; }
        float acc[4][16];
#pragma unroll
        for (int i = 0; i < 4; ++i)
#pragma unroll
            for (int j = 0; j < 16; ++j) acc[i][j] = 0.f;
        for (int k0 = 0; k0 < g.K; k0 += 32) {
            __syncthreads();
            { const int r = tid >> 2, kk = (tid & 3) * 8;
              const u32x4 v = *(const u32x4*)(g.A + (size_t)(row0 + r) * g.lda + k0 + kk);
              As[(kk + 0) * 128 + r] = bf_lo(v.x); As[(kk + 1) * 128 + r] = bf_hi(v.x); As[(kk + 2) * 128 + r] = bf_lo(v.y); As[(kk + 3) * 128 + r] = bf_hi(v.y);
              As[(kk + 4) * 128 + r] = bf_lo(v.z); As[(kk + 5) * 128 + r] = bf_hi(v.z); As[(kk + 6) * 128 + r] = bf_lo(v.w); As[(kk + 7) * 128 + r] = bf_hi(v.w);
#pragma unroll
              for (int h = 0; h < 2; ++h) { const int rb = r + 128 * h;
                const u32x4 w = *(const u32x4*)(Bt + (size_t)(col0 + rb) * g.ldb + k0 + kk);
                Bs[(kk + 0) * 256 + rb] = bf_lo(w.x); Bs[(kk + 1) * 256 + rb] = bf_hi(w.x); Bs[(kk + 2) * 256 + rb] = bf_lo(w.y); Bs[(kk + 3) * 256 + rb] = bf_hi(w.y);
                Bs[(kk + 4) * 256 + rb] = bf_lo(w.z); Bs[(kk + 5) * 256 + rb] = bf_hi(w.z); Bs[(kk + 6) * 256 + rb] = bf_lo(w.w); Bs[(kk + 7) * 256 + rb] = bf_hi(w.w); } }
            __syncthreads();
#pragma unroll 4
            for (int k = 0; k < 32; ++k) {
                const f32x4 a = *(const f32x4*)&As[k * 128 + 4 * tr];
                const f32x4 b0 = *(const f32x4*)&Bs[k * 256 + tc * 8], b1 = *(const f32x4*)&Bs[k * 256 + tc * 8 + 4];
                const f32x4 b2 = *(const f32x4*)&Bs[k * 256 + 128 + tc * 8], b3 = *(const f32x4*)&Bs[k * 256 + 128 + tc * 8 + 4];
#pragma unroll
                for (int i = 0; i < 4; ++i) {
#pragma unroll
                    for (int j = 0; j < 4; ++j) { acc[i][j] += a[i] * b0[j]; acc[i][4 + j] += a[i] * b1[j]; acc[i][8 + j] += a[i] * b2[j]; acc[i][12 + j] += a[i] * b3[j]; }
                }
            }
        }
#pragma unroll
        for (int i = 0; i < 4; ++i)
#pragma unroll
            for (int j = 0; j < 8; ++j) E(e, row0 + 4 * tr + i, col0 + tc * 8 + j, acc[i][j], acc[i][8 + j]);
    }
}
struct EpiBf { bf16* C; int ldc; __device__ __forceinline__ void operator()(int, int r, int c, float a, float b) const { C[(size_t)r * ldc + c] = (bf16)f2bf(a); C[(size_t)r * ldc + c + 128] = (bf16)f2bf(b); } };
struct EpiF32 { float* C; int ldc; __device__ __forceinline__ void operator()(int, int r, int c, float a, float b) const { C[(size_t)r * ldc + c] = a; C[(size_t)r * ldc + c + 128] = b; } };
struct EpiOut { const float* x; float* x1; bf16* a2; const float* g; float* rowsq;
    __device__ __forceinline__ void one(int r, int c, float a) const { const size_t o = (size_t)r * D + c; const float v = x[o] + a; x1[o] = v; a2[o] = (bf16)f2bf(v * g[c]); atomicAdd(rowsq + r, v * v); }
    __device__ __forceinline__ void operator()(int, int r, int c, float a, float b) const { one(r, c, a); one(r, c + 128, b); } };
struct EpiQ { bf16* q; const float* rowsq;
    __device__ __forceinline__ void operator()(int, int r, int c, float a, float b) const { const float s = 0.0625f / sqrtf(rowsq[r] * (1.f / D) + EPS); q[(size_t)r * D + c] = (bf16)f2bf(a * s); q[(size_t)r * D + c + 128] = (bf16)f2bf(b * s); } };
struct EpiRes { const float* base; float* o; __device__ __forceinline__ void operator()(int, int r, int c, float a, float b) const { const size_t i = (size_t)r * D + c; o[i] = base[i] + a; o[i + 128] = base[i + 128] + b; } };
__device__ __forceinline__ float swiglu(float g, float u) { g = fminf(g, 7.f); u = fminf(fmaxf(u, -7.f), 7.f); return g * (1.f / (1.f + expf(-1.702f * g))) * (u + 1.f); }
struct EpiUp { bf16* h; const float* b_gu;
    __device__ __forceinline__ void operator()(int e, int r, int c, float a, float b) const { const int ff = (c >> 8) * 128 + (c & 127); const float* bb = b_gu + (size_t)e * 2 * DFF;
        h[(size_t)r * DFF + ff] = (bf16)f2bf(swiglu(a + bb[ff], b + bb[DFF + ff])); } };
struct EpiDn { bf16* y; const float* b_dn; const float* gs;
    __device__ __forceinline__ void operator()(int e, int r, int c, float a, float b) const { const float g = gs[r]; const float* bb = b_dn + (size_t)e * D;
        y[(size_t)r * D + c] = (bf16)f2bf(g * (a + bb[c])); y[(size_t)r * D + c + 128] = (bf16)f2bf(g * (b + bb[c + 128])); } };

__device__ __forceinline__ void phase_pool(const P& p, float* lds, int bid, int nb) {
    float* pt = lds;
    float* wp = lds + 64 * 129;
    const int tid = threadIdx.x;
    for (int u = bid; u < (M / 64) * 4; u += nb) {
        const int g = u & 3, tt = u >> 2, t0 = tt * 64, w = 2 << g;
        __syncthreads();
        for (int i = tid; i < 128 * 128; i += NTHREADS) wp[i] = p.w_pool[(size_t)g * 128 * 128 + i];
        { const int i = tid >> 3, c0 = (tid & 7) * 16, t = t0 + i, s = t & (SEQ - 1);
          const int cnt = (s + 1 < w) ? s + 1 : w;
          float acc[16];
#pragma unroll
          for (int c = 0; c < 16; ++c) acc[c] = 0.f;
          for (int d = 0; d < cnt; ++d) { const bf16* up = p.z1() + (size_t)(t - d) * NZ + g * 128 + c0;
#pragma unroll
              for (int c = 0; c < 16; ++c) acc[c] += bf2f(up[c]); }
          const bf16* u0 = p.z1() + (size_t)t * NZ + g * 128 + c0; const float inv = 1.f / (float)cnt;
#pragma unroll
          for (int c = 0; c < 16; ++c) pt[i * 129 + c0 + c] = acc[c] * inv - bf2f(u0[c]); }
        __syncthreads();
        { const int i = tid >> 3, d0 = (tid & 7) * 16; float acc[16];
#pragma unroll
          for (int c = 0; c < 16; ++c) acc[c] = 0.f;
          for (int c = 0; c < 128; ++c) { const float pv = pt[i * 129 + c];
#pragma unroll
              for (int d = 0; d < 16; ++d) acc[d] += pv * wp[c * 128 + d0 + d]; }
          bf16* o = p.mix() + (size_t)(t0 + i) * D + g * 128 + d0;
#pragma unroll
          for (int d = 0; d < 16; ++d) o[d] = (bf16)f2bf(acc[d] * p.pool_scale[g * 128 + d0 + d]); }
    }
}

__device__ __forceinline__ void gla_gc(const P& p, float* glr, float* wgu, float* gc, int b, int h, int n) {
    const int tid = threadIdx.x, t0 = b * SEQ + n * 64;
    __syncthreads();
    for (int i = tid; i < 64 * 16; i += NTHREADS) glr[i] = bf2f(p.z1()[(size_t)(t0 + (i >> 4)) * NZ + ZG + (i & 15)]);
    for (int i = tid; i < 16 * 64; i += NTHREADS) wgu[i] = p.w_gate_up[(i >> 6) * 256 + h * 64 + (i & 63)];
    __syncthreads();
    for (int idx = tid; idx < 64 * 64; idx += NTHREADS) { const int i = idx >> 6, d = idx & 63; float s = p.b_gate_up[h * 64 + d];
#pragma unroll
        for (int r = 0; r < 16; ++r) s += glr[i * 16 + r] * wgu[r * 64 + d];
        gc[i * 65 + d] = logsigmoid(s) * (1.f / 16.f); }
    __syncthreads();
    if (tid < 64) { float run = 0.f; for (int i = 0; i < 64; ++i) { run += gc[i * 65 + tid]; gc[i * 65 + tid] = run; } }
    __syncthreads();
}
__device__ __forceinline__ void phase_gla_a(const P& p, float* lds, int bid, int nb) {
    float* glr = lds; float* wgu = lds + 1024; float* gc = lds + 2048; float* kd = gc + 64 * 65; float* vv = kd + 64 * 65;
    const int tid = threadIdx.x;
    for (int u = bid; u < 8 * NCHUNK; u += nb) {
        const int bh = u / NCHUNK, n = u % NCHUNK, b = bh >> 2, h = bh & 3, t0 = b * SEQ + n * 64;
        gla_gc(p, glr, wgu, gc, b, h, n);
        for (int idx = tid; idx < 64 * 64; idx += NTHREADS) { const int j = idx >> 6, d = idx & 63;
            kd[j * 65 + d] = bf2f(p.z1()[(size_t)(t0 + j) * NZ + ZK + h * 64 + d]) * expf(gc[63 * 65 + d] - gc[j * 65 + d]); }
        for (int idx = tid; idx < 64 * 128; idx += NTHREADS) { const int j = idx >> 7, e = idx & 127; vv[idx] = bf2f(p.z1()[(size_t)(t0 + j) * NZ + ZV + h * 128 + e]); }
        __syncthreads();
        { const int d = tid >> 3, e0 = (tid & 7) * 16; float acc[16];
#pragma unroll
          for (int e = 0; e < 16; ++e) acc[e] = 0.f;
          for (int j = 0; j < 64; ++j) { const float kv = kd[j * 65 + d];
#pragma unroll
              for (int e = 0; e < 16; ++e) acc[e] += kv * vv[j * 128 + e0 + e]; }
          float* o = p.ds() + ((size_t)u * 64 + d) * 128 + e0;
#pragma unroll
          for (int e = 0; e < 16; ++e) o[e] = acc[e]; }
        if (tid < 64) p.dec()[(size_t)u * 64 + tid] = expf(gc[63 * 65 + tid]);
    }
}
__device__ __forceinline__ void phase_scan(const P& p, int bid, int nb) {
    for (int idx = bid * NTHREADS + threadIdx.x; idx < 8 * 64 * 128; idx += nb * NTHREADS) {
        const int bh = idx >> 13, de = idx & 8191, d = de >> 7;
        float st = 0.f;
        for (int n = 0; n < NCHUNK; ++n) { const size_t u = (size_t)bh * NCHUNK + n;
            p.sprev()[u * 8192 + de] = st; st = p.dec()[u * 64 + d] * st + p.ds()[u * 8192 + de]; }
    }
}
__device__ __forceinline__ void phase_gla_b(const P& p, float* lds, int bid, int nb) {
    float* glr = lds; float* wgu = lds + 1024; float* gc = lds + 2048; float* qe = gc + 64 * 65; float* ke = qe + 64 * 65; float* vv = ke + 64 * 65; float* sp = vv + 64 * 128;
    float* att = gc;
    const int tid = threadIdx.x;
    for (int u = bid; u < 8 * NCHUNK; u += nb) {
        const int bh = u / NCHUNK, n = u % NCHUNK, b = bh >> 2, h = bh & 3, t0 = b * SEQ + n * 64;
        gla_gc(p, glr, wgu, gc, b, h, n);
        for (int idx = tid; idx < 64 * 64; idx += NTHREADS) { const int i = idx >> 6, d = idx & 63; const float g = gc[i * 65 + d];
            qe[i * 65 + d] = bf2f(p.z1()[(size_t)(t0 + i) * NZ + ZQ + h * 64 + d]) * 0.125f * expf(g);
            ke[i * 65 + d] = bf2f(p.z1()[(size_t)(t0 + i) * NZ + ZK + h * 64 + d]) * expf(-g); }
        for (int idx = tid; idx < 64 * 128; idx += NTHREADS) { const int j = idx >> 7, e = idx & 127; vv[idx] = bf2f(p.z1()[(size_t)(t0 + j) * NZ + ZV + h * 128 + e]); sp[idx] = p.sprev()[(size_t)u * 8192 + idx]; }
        __syncthreads();
        { const int i = tid >> 3, j0 = (tid & 7) * 8; float a[8];
#pragma unroll
          for (int j = 0; j < 8; ++j) a[j] = 0.f;
          for (int d = 0; d < 64; ++d) { const float qv = qe[i * 65 + d];
#pragma unroll
              for (int j = 0; j < 8; ++j) a[j] += qv * ke[(j0 + j) * 65 + d]; }
#pragma unroll
          for (int j = 0; j < 8; ++j) att[i * 65 + j0 + j] = (j0 + j <= i) ? a[j] : 0.f; }
        __syncthreads();
        { const int i = tid >> 3, e0 = (tid & 7) * 16; float o[16];
#pragma unroll
          for (int e = 0; e < 16; ++e) o[e] = 0.f;
          for (int j = 0; j < 64; ++j) { const float av = att[i * 65 + j];
#pragma unroll
              for (int e = 0; e < 16; ++e) o[e] += av * vv[j * 128 + e0 + e]; }
          for (int d = 0; d < 64; ++d) { const float qv = qe[i * 65 + d];
#pragma unroll
              for (int e = 0; e < 16; ++e) o[e] += qv * sp[d * 128 + e0 + e]; }
          float ss = 0.f;
#pragma unroll
          for (int e = 0; e < 16; ++e) ss += o[e] * o[e];
          ss += __shfl_xor(ss, 1); ss += __shfl_xor(ss, 2); ss += __shfl_xor(ss, 4);
          const float rs = 1.0f / sqrtf(ss * (1.f / 128.f) + EPS);
          const bf16* rp = p.z1() + (size_t)(t0 + i) * NZ + ZR + h * 128 + e0; bf16* op = p.mix() + (size_t)(t0 + i) * D + 512 + h * 128 + e0;
#pragma unroll
          for (int e = 0; e < 16; ++e) { const float r = bf2f(rp[e]); const float sl = r / (1.f + expf(-r)); op[e] = (bf16)f2bf(o[e] * rs * p.gla_g[e0 + e] * sl); } }
    }
}

__device__ __forceinline__ void phase_softmax(const P& p, int bid, int nb) {
    const int lane = threadIdx.x & 63, gw = bid * NWAVES + (threadIdx.x >> 6), NGW = nb * NWAVES;
    for (int it = gw; it < M * 4; it += NGW) {
        const f32x4 v = *((const f32x4*)(p.sc() + (size_t)it * 256) + lane);
        float m = fmaxf(fmaxf(v.x, v.y), fmaxf(v.z, v.w));
#pragma unroll
        for (int o = 1; o < 64; o <<= 1) m = fmaxf(m, __shfl_xor(m, o));
        const float e0 = expf(v.x - m), e1 = expf(v.y - m), e2 = expf(v.z - m), e3 = expf(v.w - m);
        const float inv = 1.f / wave_sum((e0 + e1) + (e2 + e3));
        u32x2 w; w.x = pk2(e0 * inv, e1 * inv); w.y = pk2(e2 * inv, e3 * inv);
        *((u32x2*)(p.px() + (size_t)it * 256) + lane) = w;
    }
}

__device__ __forceinline__ void phase_router(const P& p, float* lds, int bid, int nb) {
    const int tid = threadIdx.x, lane = tid & 63, gw = bid * NWAVES + (tid >> 6), NGW = nb * NWAVES;
    __syncthreads();
    for (int i = tid; i < D * NE; i += NTHREADS) lds[(i & 31) * D + (i >> 5)] = p.w_router[i];
    __syncthreads();
    for (int t = gw; t < M; t += NGW) {
        const f32x4* xr = (const f32x4*)(p.x2() + (size_t)t * D) + lane; f32x4 v[4]; float s = 0.f;
#pragma unroll
        for (int j = 0; j < 4; ++j) { v[j] = xr[64 * j]; s += (v[j].x * v[j].x + v[j].y * v[j].y) + (v[j].z * v[j].z + v[j].w * v[j].w); }
        const float rs = 1.0f / sqrtf(wave_sum(s) * (1.f / D) + EPS);
#pragma unroll
        for (int j = 0; j < 4; ++j) { const f32x4 gg = *((const f32x4*)p.g_moe + lane + 64 * j); v[j] = v[j] * rs * gg; }
        float mylg = -INFINITY;
#pragma unroll 2
        for (int e = 0; e < NE; ++e) { float a = 0.f;
#pragma unroll
            for (int j = 0; j < 4; ++j) { const f32x4 w = *((const f32x4*)(lds + e * D) + lane + 64 * j); a += (v[j].x * w.x + v[j].y * w.y) + (v[j].z * w.z + v[j].w * w.w); }
            a = wave_sum(a); if (lane == e) mylg = a + p.b_router[e]; }
        int idx[4]; float val[4];
#pragma unroll
        for (int j = 0; j < 4; ++j) { float bv = mylg; int bi = lane;
#pragma unroll
            for (int o = 1; o < 64; o <<= 1) { const float ov = __shfl_xor(bv, o); const int oi = __shfl_xor(bi, o); const bool tk = (ov > bv) || (ov == bv && oi < bi); bv = tk ? ov : bv; bi = tk ? oi : bi; }
            idx[j] = bi; val[j] = bv; if (lane == bi) mylg = -INFINITY; }
        const float e1 = expf(val[1] - val[0]), e2 = expf(val[2] - val[0]), e3 = expf(val[3] - val[0]); const float inv = 1.f / (1.f + e1 + e2 + e3);
        if (lane == 0) { p.rs2()[t] = rs;
            p.topi()[t * 4 + 0] = idx[0]; p.topi()[t * 4 + 1] = idx[1]; p.topi()[t * 4 + 2] = idx[2]; p.topi()[t * 4 + 3] = idx[3];
            p.topg()[t * 4 + 0] = inv; p.topg()[t * 4 + 1] = e1 * inv; p.topg()[t * 4 + 2] = e2 * inv; p.topg()[t * 4 + 3] = e3 * inv;
#pragma unroll
            for (int j = 0; j < 4; ++j) atomicAdd(p.ctl() + CW_COUNT + idx[j], 1u); }
    }
}
__device__ __forceinline__ void phase_dispatch(const P& p, int* ldsi, int bid, int nb) {
    const int tid = threadIdx.x, lane = tid & 63, gw = bid * NWAVES + (tid >> 6), NGW = nb * NWAVES;
    __syncthreads();
    if (tid == 0) { int off = 0; for (int e = 0; e < NE; ++e) { ldsi[e] = off; const int c = (int)p.ctl()[CW_COUNT + e]; const int nt = (c + 255) >> 8;
            if (bid == 0) for (int i = 0; i < nt; ++i) p.tilee()[(off >> 8) + i] = e;
            off += nt << 8; }
        if (bid == 0) p.tilee()[MAXMT] = off >> 8; }
    __syncthreads();
    for (int t = gw; t < M; t += NGW) {
        int slot = 0;
        if (lane < 4) { const int e = p.topi()[t * 4 + lane]; slot = ldsi[e] + (int)atomicAdd(p.ctl() + CW_CURSOR + e, 1u); p.slotof()[t * 4 + lane] = slot; p.gslot()[slot] = p.topg()[t * 4 + lane]; }
        const float rs = p.rs2()[t];
        const f32x4* xr = (const f32x4*)(p.x2() + (size_t)t * D) + lane; u32x2 w[4];
#pragma unroll
        for (int j = 0; j < 4; ++j) { const f32x4 v = xr[64 * j]; const f32x4 gg = *((const f32x4*)p.g_moe + lane + 64 * j);
            w[j].x = pk2(v.x * rs * gg.x, v.y * rs * gg.y); w[j].y = pk2(v.z * rs * gg.z, v.w * rs * gg.w); }
#pragma unroll
        for (int q = 0; q < 4; ++q) { const int sl = __shfl(slot, q); u32x2* o = (u32x2*)(p.xs() + (size_t)sl * D) + lane;
#pragma unroll
            for (int j = 0; j < 4; ++j) o[64 * j] = w[j]; }
    }
}
__device__ __forceinline__ void phase_final(const P& p, int bid, int nb) {
    const int lane = threadIdx.x & 63, gw = bid * NWAVES + (threadIdx.x >> 6), NGW = nb * NWAVES;
    for (int t = gw * 2; t < M; t += NGW * 2) {
        f32x4 v[2][4]; u32x2 yv[2][4][4];
#pragma unroll
        for (int q = 0; q < 2; ++q) { const f32x4* xr = (const f32x4*)(p.x2() + (size_t)(t + q) * D) + lane;
#pragma unroll
            for (int j = 0; j < 4; ++j) v[q][j] = xr[64 * j];
#pragma unroll
            for (int k = 0; k < 4; ++k) { const int sl = p.slotof()[(t + q) * 4 + k]; const u32x2* yr = (const u32x2*)(p.y() + (size_t)sl * D) + lane;
#pragma unroll
                for (int j = 0; j < 4; ++j) yv[q][k][j] = yr[64 * j]; } }
#pragma unroll
        for (int q = 0; q < 2; ++q) {
#pragma unroll
            for (int k = 0; k < 4; ++k)
#pragma unroll
                for (int j = 0; j < 4; ++j) { const u32x2 w = yv[q][k][j]; v[q][j].x += bf_lo(w.x); v[q][j].y += bf_hi(w.x); v[q][j].z += bf_lo(w.y); v[q][j].w += bf_hi(w.y); }
            float s = 0.f;
#pragma unroll
            for (int j = 0; j < 4; ++j) s += (v[q][j].x * v[q][j].x + v[q][j].y * v[q][j].y) + (v[q][j].z * v[q][j].z + v[q][j].w * v[q][j].w);
            const float rs = 1.0f / sqrtf(wave_sum(s) * (1.f / D) + EPS);
            f32x4* o = (f32x4*)(p.out + (size_t)(t + q) * D) + lane;
#pragma unroll
            for (int j = 0; j < 4; ++j) { const f32x4 gg = *((const f32x4*)p.g_final + lane + 64 * j); o[64 * j] = v[q][j] * rs * gg; }
        }
    }
}

typedef short bf16x8 __attribute__((ext_vector_type(8)));
typedef float f32x16 __attribute__((ext_vector_type(16)));
template <int K>
__device__ __forceinline__ void mma_tile(f32x16& acc, const bf16* a, int pa, const bf16* b, int pb, int lane) {
    const int r = lane & 31, hf = lane >> 5;
#pragma unroll
    for (int k0 = 0; k0 < K; k0 += 16) { const bf16x8 av = *(const bf16x8*)(a + r * pa + k0 + 8 * hf); const bf16x8 bv = *(const bf16x8*)(b + r * pb + k0 + 8 * hf);
        acc = __builtin_amdgcn_mfma_f32_32x32x16_bf16(av, bv, acc, 0, 0, 0); }
}
__device__ __forceinline__ int crow(int reg, int hf) { return (reg & 3) + 8 * (reg >> 2) + 4 * hf; }
__device__ __forceinline__ f32x16 zero16() { f32x16 z;
#pragma unroll
    for (int i = 0; i < 16; ++i) z[i] = 0.f;
    return z; }
__device__ __forceinline__ float fast_logsigmoid(float x) { return fminf(x, 0.f) - __logf(1.f + __expf(-fabsf(x))); }

__device__ __forceinline__ void phase_pool2(const P& p, unsigned char* lds, int bid, int nb) {
    bf16* wpT = (bf16*)lds;
    float* ut = (float*)(lds + 34816);
    bf16* pt = (bf16*)(lds + 34816 + 40960);
    const int tid = threadIdx.x, lane = tid & 63, w = tid >> 6;
    int cur_g = -1;
    for (int u = bid; u < (M / 64) * 4; u += nb) {
        const int g = u & 3, t0 = (u >> 2) * 64, win = 2 << g, s0 = t0 & (SEQ - 1);
        __syncthreads();
        if (g != cur_g) { cur_g = g;
            for (int i = tid; i < 128 * 128; i += NTHREADS) { const int c = i >> 7, d = i & 127; wpT[d * 136 + c] = (bf16)f2bf(p.w_pool[(size_t)g * 16384 + i]); } }
        for (int c = tid; c < 80 * 16; c += NTHREADS) { const int r = c >> 4, ch = (c & 15) * 8; const int srel = s0 - 16 + r;
            f32x4 lo = {0.f, 0.f, 0.f, 0.f}, hi = {0.f, 0.f, 0.f, 0.f};
            if (srel >= 0) { const u32x4 v = *(const u32x4*)(p.z1() + (size_t)(t0 - 16 + r) * NZ + g * 128 + ch); lo = (f32x4){bf_lo(v.x), bf_hi(v.x), bf_lo(v.y), bf_hi(v.y)}; hi = (f32x4){bf_lo(v.z), bf_hi(v.z), bf_lo(v.w), bf_hi(v.w)}; }
            *(f32x4*)(ut + r * 128 + ch) = lo; *(f32x4*)(ut + r * 128 + ch + 4) = hi; }
        __syncthreads();
        { const int c = tid & 127, q = tid >> 7, i0 = 16 * q; float sum = 0.f;
          for (int d = 1; d < win; ++d) sum += ut[(16 + i0 - d) * 128 + c];
          for (int ii = 0; ii < 16; ++ii) { const int i = i0 + ii, s = s0 + i; const float uv = ut[(16 + i) * 128 + c]; sum += uv; const int cnt = (s + 1 < win) ? s + 1 : win;
              pt[i * 136 + c] = (bf16)f2bf(sum / (float)cnt - uv); sum -= ut[(16 + i - win + 1) * 128 + c]; } }
        __syncthreads();
        { const int db = w >> 1, ib = w & 1, r = lane & 31, hf = lane >> 5; f32x16 acc = zero16();
          mma_tile<128>(acc, wpT + (db * 32) * 136, 136, pt + (ib * 32) * 136, 136, lane);
          bf16* orow = p.mix() + (size_t)(t0 + ib * 32 + r) * D + g * 128 + db * 32;
#pragma unroll
          for (int rg = 0; rg < 4; ++rg) { const int d0 = 8 * rg + 4 * hf; const f32x4 sc = *(const f32x4*)(p.pool_scale + g * 128 + db * 32 + d0);
              u32x2 o; o.x = pk2(acc[4 * rg] * sc.x, acc[4 * rg + 1] * sc.y); o.y = pk2(acc[4 * rg + 2] * sc.z, acc[4 * rg + 3] * sc.w); *(u32x2*)(orow + d0) = o; } }
    }
}

__device__ __forceinline__ void gla_gc2(const P& p, float* glr, float* wtot, int t0, int h, float (&gcl)[8], float& tot) {
    const int tid = threadIdx.x, d = tid & 63, w = tid >> 6;
    __syncthreads();
    for (int i = tid; i < 64 * 16; i += NTHREADS) glr[i] = bf2f(p.z1()[(size_t)(t0 + (i >> 4)) * NZ + ZG + (i & 15)]);
    float wg[16];
#pragma unroll
    for (int r = 0; r < 16; ++r) wg[r] = p.w_gate_up[r * 256 + h * 64 + d];
    const float bias = p.b_gate_up[h * 64 + d];
    __syncthreads();
    float run = 0.f;
#pragma unroll
    for (int ii = 0; ii < 8; ++ii) { const float* gr = glr + (8 * w + ii) * 16; float s = bias;
#pragma unroll
        for (int r = 0; r < 16; ++r) s += gr[r] * wg[r];
        run += fast_logsigmoid(s) * (1.f / 16.f); gcl[ii] = run; }
    wtot[w * 64 + d] = run;
    __syncthreads();
    float pre = 0.f; tot = 0.f;
#pragma unroll
    for (int ww = 0; ww < 8; ++ww) { const float v = wtot[ww * 64 + d]; pre += (ww < w) ? v : 0.f; tot += v; }
#pragma unroll
    for (int ii = 0; ii < 8; ++ii) gcl[ii] += pre;
}
__device__ __forceinline__ void load_vT(const P& p, bf16* vT, int t0, int colbase) {
    const int tid = threadIdx.x, e = tid & 127, jb = tid >> 7; unsigned short v[16];
#pragma unroll
    for (int jj = 0; jj < 16; ++jj) v[jj] = p.z1()[(size_t)(t0 + 16 * jb + jj) * NZ + colbase + e];
    u32x4 a, b; a.x = v[0] | (v[1] << 16); a.y = v[2] | (v[3] << 16); a.z = v[4] | (v[5] << 16); a.w = v[6] | (v[7] << 16);
    b.x = v[8] | (v[9] << 16); b.y = v[10] | (v[11] << 16); b.z = v[12] | (v[13] << 16); b.w = v[14] | (v[15] << 16);
    *(u32x4*)(vT + e * 72 + 16 * jb) = a; *(u32x4*)(vT + e * 72 + 16 * jb + 8) = b;
}
__device__ __forceinline__ void phase_gla_a2(const P& p, unsigned char* lds, int bid, int nb) {
    float* glr = (float*)lds; float* wtot = (float*)(lds + 4096); bf16* kdT = (bf16*)(lds + 8192); bf16* vT = (bf16*)(lds + 8192 + 9216);
    const int tid = threadIdx.x, lane = tid & 63, w = tid >> 6, d = tid & 63;
    for (int u = bid; u < 8 * NCHUNK; u += nb) {
        const int bh = u / NCHUNK, n = u % NCHUNK, b = bh >> 2, h = bh & 3, t0 = b * SEQ + n * 64;
        float gcl[8], tot; gla_gc2(p, glr, wtot, t0, h, gcl, tot);
        { unsigned pk[4];
#pragma unroll
          for (int ii = 0; ii < 8; ii += 2) { const float k0 = bf2f(p.z1()[(size_t)(t0 + 8 * w + ii) * NZ + ZK + h * 64 + d]) * __expf(tot - gcl[ii]);
              const float k1 = bf2f(p.z1()[(size_t)(t0 + 8 * w + ii + 1) * NZ + ZK + h * 64 + d]) * __expf(tot - gcl[ii + 1]); pk[ii >> 1] = pk2(k0, k1); }
          *(u32x4*)(kdT + d * 72 + 8 * w) = (u32x4){pk[0], pk[1], pk[2], pk[3]}; }
        if (w == 0) p.dec()[(size_t)u * 64 + d] = __expf(tot);
        load_vT(p, vT, t0, ZV + h * 128);
        __syncthreads();
        { const int eb = w >> 1, db = w & 1, r = lane & 31, hf = lane >> 5; f32x16 acc = zero16();
          mma_tile<64>(acc, vT + (eb * 32) * 72, 72, kdT + (db * 32) * 72, 72, lane);
          float* o = p.ds() + (size_t)u * 8192 + db * 32 + r;
#pragma unroll
          for (int reg = 0; reg < 16; ++reg) o[(eb * 32 + crow(reg, hf)) * 64] = acc[reg]; }
    }
}
__device__ __forceinline__ void phase_scan2(const P& p, int bid, int nb) {
    bf16* sp = (bf16*)p.sprev();
    if (threadIdx.x < 256)
    for (int idx = bid * 256 + threadIdx.x; idx < 8 * 8192; idx += nb * 256) {
        const int bh = idx >> 13, ed = idx & 8191, d = ed & 63; float st = 0.f;
        for (int n0 = 0; n0 < NCHUNK; n0 += 8) { float dv[8], dc[8];
#pragma unroll
            for (int k = 0; k < 8; ++k) { const size_t u = (size_t)bh * NCHUNK + n0 + k; dv[k] = p.ds()[u * 8192 + ed]; dc[k] = p.dec()[u * 64 + d]; }
#pragma unroll
            for (int k = 0; k < 8; ++k) { const size_t u = (size_t)bh * NCHUNK + n0 + k; sp[u * 8192 + ed] = (bf16)f2bf(st); st = dc[k] * st + dv[k]; } }
    }
}
__device__ __forceinline__ void phase_gla_b2(const P& p, unsigned char* lds, int bid, int nb) {
    float* glr = (float*)lds; float* wtot = (float*)(lds + 4096); float* ssq = (float*)(lds + 6144);
    bf16* qe = (bf16*)(lds + 8192); bf16* ke = qe + 64 * 72; bf16* att = ke + 64 * 72; bf16* vT = att + 64 * 72; bf16* spT = vT + 128 * 72;
    const bf16* sp = (const bf16*)p.sprev();
    const int tid = threadIdx.x, lane = tid & 63, w = tid >> 6, d = tid & 63, r = lane & 31, hf = lane >> 5;
    for (int u = bid; u < 8 * NCHUNK; u += nb) {
        const int bh = u / NCHUNK, n = u % NCHUNK, b = bh >> 2, h = bh & 3, t0 = b * SEQ + n * 64;
        float gcl[8], tot; gla_gc2(p, glr, wtot, t0, h, gcl, tot);
#pragma unroll
        for (int ii = 0; ii < 8; ++ii) { const int i = 8 * w + ii; const size_t zo = (size_t)(t0 + i) * NZ + h * 64 + d;
            qe[i * 72 + d] = (bf16)f2bf(bf2f(p.z1()[zo + ZQ]) * 0.125f * __expf(gcl[ii])); ke[i * 72 + d] = (bf16)f2bf(bf2f(p.z1()[zo + ZK]) * __expf(-gcl[ii])); }
        load_vT(p, vT, t0, ZV + h * 128);
        for (int c = tid; c < 1024; c += NTHREADS) { const int e = c >> 3, d8 = (c & 7) * 8; *(u32x4*)(spT + e * 72 + d8) = *(const u32x4*)(sp + (size_t)u * 8192 + e * 64 + d8); }
        __syncthreads();
        if (w < 4) { const int ib = w & 1, jb = w >> 1; f32x16 acc = zero16();
            if (jb <= ib) mma_tile<64>(acc, qe + (ib * 32) * 72, 72, ke + (jb * 32) * 72, 72, lane);
#pragma unroll
            for (int reg = 0; reg < 16; ++reg) { const int i = ib * 32 + crow(reg, hf), j = jb * 32 + r; att[i * 72 + j] = (bf16)f2bf(j <= i ? acc[reg] : 0.f); } }
        __syncthreads();
        { const int eb = w >> 1, ib = w & 1, i = ib * 32 + r; f32x16 acc = zero16();
          mma_tile<64>(acc, vT + (eb * 32) * 72, 72, att + (ib * 32) * 72, 72, lane);
          mma_tile<64>(acc, spT + (eb * 32) * 72, 72, qe + (ib * 32) * 72, 72, lane);
          float ss = 0.f;
#pragma unroll
          for (int reg = 0; reg < 16; ++reg) ss += acc[reg] * acc[reg];
          ss += __shfl_xor(ss, 32);
          if (hf == 0) ssq[eb * 64 + i] = ss;
          __syncthreads();
          const float rs = 1.0f / sqrtf((ssq[i] + ssq[64 + i] + ssq[128 + i] + ssq[192 + i]) * (1.f / 128.f) + EPS);
          const bf16* rp = p.z1() + (size_t)(t0 + i) * NZ + ZR + h * 128 + eb * 32; bf16* op = p.mix() + (size_t)(t0 + i) * D + 512 + h * 128 + eb * 32;
#pragma unroll
          for (int rg = 0; rg < 4; ++rg) { const int e0 = 8 * rg + 4 * hf; const u32x2 rv = *(const u32x2*)(rp + e0); const f32x4 gg = *(const f32x4*)(p.gla_g + eb * 32 + e0);
              const float r0 = bf_lo(rv.x), r1 = bf_hi(rv.x), r2 = bf_lo(rv.y), r3 = bf_hi(rv.y);
              const float o0 = acc[4 * rg] * rs * gg.x * (r0 / (1.f + __expf(-r0))), o1 = acc[4 * rg + 1] * rs * gg.y * (r1 / (1.f + __expf(-r1)));
              const float o2 = acc[4 * rg + 2] * rs * gg.z * (r2 / (1.f + __expf(-r2))), o3 = acc[4 * rg + 3] * rs * gg.w * (r3 / (1.f + __expf(-r3)));
              u32x2 o; o.x = pk2(o0, o1); o.y = pk2(o2, o3); *(u32x2*)(op + e0) = o; } }
    }
}

__device__ __forceinline__ void phase_router2(const P& p, float* lds, int* blkcnt, int* wavebase, int bid, int nb) {
    const int tid = threadIdx.x, lane = tid & 63, w = tid >> 6;
    constexpr int RP = D + 4;
    int* cntw = (int*)(lds + NE * RP);
    __syncthreads();
    for (int i = tid; i < D * NE; i += NTHREADS) lds[(i & 31) * RP + (i >> 5)] = p.w_router[i];
    __syncthreads();
    const float bias = p.b_router[lane >> 1];
    for (int gidx = bid; gidx < M / 64; gidx += nb) {
        int cnt = 0;
        for (int ii = 0; ii < 8; ++ii) {
            const int t = gidx * 64 + w * 8 + ii;
            const f32x4* xr = (const f32x4*)(p.x2() + (size_t)t * D) + lane; f32x4 v[4]; float s = 0.f;
#pragma unroll
            for (int j = 0; j < 4; ++j) { v[j] = xr[64 * j]; s += (v[j].x * v[j].x + v[j].y * v[j].y) + (v[j].z * v[j].z + v[j].w * v[j].w); }
            const float rs = 1.0f / sqrtf(wave_sum(s) * (1.f / D) + EPS);
#pragma unroll
            for (int j = 0; j < 4; ++j) { const f32x4 gg = *((const f32x4*)p.g_moe + lane + 64 * j); v[j] = v[j] * rs * gg; }
            float a[NE];
#pragma unroll
            for (int e = 0; e < NE; ++e) { float acc = 0.f;
#pragma unroll
                for (int j = 0; j < 4; ++j) { const f32x4 wv = *((const f32x4*)(lds + e * RP) + lane + 64 * j); acc += (v[j].x * wv.x + v[j].y * wv.y) + (v[j].z * wv.z + v[j].w * wv.w); }
                a[e] = acc; if ((e & 3) == 3) __builtin_amdgcn_sched_barrier(0); }
#pragma unroll
            for (int k = 0; k < 16; ++k) { const bool up = (lane & 32) != 0; const float send = up ? a[k] : a[k + 16]; const float keep = up ? a[k + 16] : a[k]; a[k] = keep + __shfl_xor(send, 32); }
#pragma unroll
            for (int k = 0; k < 8; ++k) { const bool up = (lane & 16) != 0; const float send = up ? a[k] : a[k + 8]; const float keep = up ? a[k + 8] : a[k]; a[k] = keep + __shfl_xor(send, 16); }
#pragma unroll
            for (int k = 0; k < 4; ++k) { const bool up = (lane & 8) != 0; const float send = up ? a[k] : a[k + 4]; const float keep = up ? a[k + 4] : a[k]; a[k] = keep + __shfl_xor(send, 8); }
#pragma unroll
            for (int k = 0; k < 2; ++k) { const bool up = (lane & 4) != 0; const float send = up ? a[k] : a[k + 2]; const float keep = up ? a[k + 2] : a[k]; a[k] = keep + __shfl_xor(send, 4); }
            { const bool up = (lane & 2) != 0; const float send = up ? a[0] : a[1]; const float keep = up ? a[1] : a[0]; a[0] = keep + __shfl_xor(send, 2); }
            float mylg = a[0] + __shfl_xor(a[0], 1) + bias; const int myidx = lane >> 1;
            int idx[4]; float val[4];
#pragma unroll
            for (int j = 0; j < 4; ++j) { float bv = mylg; int bi = myidx;
#pragma unroll
                for (int o = 1; o < 64; o <<= 1) { const float ov = __shfl_xor(bv, o); const int oi = __shfl_xor(bi, o); const bool tk = (ov > bv) || (ov == bv && oi < bi); bv = tk ? ov : bv; bi = tk ? oi : bi; }
                idx[j] = bi; val[j] = bv; if (myidx == bi) mylg = -INFINITY; cnt += (lane == bi) ? 1 : 0; }
            const float e1 = __expf(val[1] - val[0]), e2 = __expf(val[2] - val[0]), e3 = __expf(val[3] - val[0]); const float inv = 1.f / (1.f + e1 + e2 + e3);
            if (lane == 0) { p.rs2()[t] = rs;
                p.topi()[t * 4 + 0] = idx[0]; p.topi()[t * 4 + 1] = idx[1]; p.topi()[t * 4 + 2] = idx[2]; p.topi()[t * 4 + 3] = idx[3];
                p.topg()[t * 4 + 0] = inv; p.topg()[t * 4 + 1] = e1 * inv; p.topg()[t * 4 + 2] = e2 * inv; p.topg()[t * 4 + 3] = e3 * inv; }
        }
        __syncthreads();
        if (lane < 32) cntw[w * 32 + lane] = cnt;
        __syncthreads();
        if (tid < 32) { int run = 0;
#pragma unroll
            for (int ww = 0; ww < 8; ++ww) { wavebase[(gidx * 8 + ww) * 32 + tid] = run; run += cntw[ww * 32 + tid]; }
            blkcnt[gidx * 32 + tid] = run; }
    }
}
__device__ __forceinline__ void phase_dispatch2(const P& p, int* ldsi, const int* blkcnt, const int* wavebase, int bid, int nb) {
    const int tid = threadIdx.x, lane = tid & 63, w = tid >> 6;
    int* red_t = ldsi; int* red_p = ldsi + 512; int* base = ldsi + 1024;
    for (int gidx = bid; gidx < M / 64; gidx += nb) {
        __syncthreads();
        { const int e = tid & 31, part = tid >> 5; int tt = 0, pp = 0;
          for (int bb = part * 16; bb < part * 16 + 16; ++bb) { const int v = blkcnt[bb * 32 + e]; tt += v; pp += (bb < gidx) ? v : 0; }
          red_t[part * 32 + e] = tt; red_p[part * 32 + e] = pp; }
        __syncthreads();
        if (tid < 32) { int tt = 0, pp = 0;
#pragma unroll
            for (int q = 0; q < 16; ++q) { tt += red_t[q * 32 + tid]; pp += red_p[q * 32 + tid]; }
            red_t[tid] = tt; red_p[tid] = pp; }
        __syncthreads();
        if (tid == 0) { int off = 0; for (int e = 0; e < NE; ++e) { base[e] = off + red_p[e]; const int c = red_t[e]; const int nt = (c + 255) >> 8;
                if (gidx == 0) for (int i = 0; i < nt; ++i) p.tilee()[(off >> 8) + i] = e;
                off += nt << 8; }
            if (gidx == 0) p.tilee()[MAXMT] = off >> 8; }
        __syncthreads();
        int wb = (lane < 32) ? base[lane] + wavebase[(gidx * 8 + w) * 32 + lane] : 0;
        static_assert(MOE_FP8, "dispatch writes e4m3 activation rows");
        for (int ii = 0; ii < 8; ii += 2) {
            const int t = gidx * 64 + w * 8 + ii;
            f32x4 xv[2][4]; float rs[2]; int ti[2][4];
#pragma unroll
            for (int q = 0; q < 2; ++q) { const f32x4* xr = (const f32x4*)(p.x2() + (size_t)(t + q) * D) + 4 * lane;
#pragma unroll
                for (int j = 0; j < 4; ++j) xv[q][j] = xr[j];
                rs[q] = p.rs2()[t + q];
#pragma unroll
                for (int j = 0; j < 4; ++j) ti[q][j] = p.topi()[(t + q) * 4 + j]; }
            const f32x4* gr = (const f32x4*)p.g_moe + 4 * lane; const f32x4 g0 = gr[0], g1 = gr[1], g2 = gr[2], g3 = gr[3];
#pragma unroll
            for (int q = 0; q < 2; ++q) {
                int slot = 0;
#pragma unroll
                for (int j = 0; j < 4; ++j) { const int e = ti[q][j]; const int sj = __shfl(wb, e); if (lane == e) wb += 1; if (lane == j) slot = sj; }
                if (lane < 4) { p.slotof()[(t + q) * 4 + lane] = slot; p.gslot()[slot] = p.topg()[(t + q) * 4 + lane]; }
                u32x4 o8;
                { const f32x4 v = xv[q][0] * rs[q] * g0; o8.x = pk4_fp8(v.x, v.y, v.z, v.w); } { const f32x4 v = xv[q][1] * rs[q] * g1; o8.y = pk4_fp8(v.x, v.y, v.z, v.w); }
                { const f32x4 v = xv[q][2] * rs[q] * g2; o8.z = pk4_fp8(v.x, v.y, v.z, v.w); } { const f32x4 v = xv[q][3] * rs[q] * g3; o8.w = pk4_fp8(v.x, v.y, v.z, v.w); }
#pragma unroll
                for (int k = 0; k < 4; ++k) { const int sl = __shfl(slot, k); *((u32x4*)((unsigned char*)p.xs() + (size_t)sl * D) + lane) = o8; }
            }
        }
    }
}

namespace pg {
typedef short bf16x8 __attribute__((ext_vector_type(8)));
constexpr int BM = 256, BK = 64, HALF = 128, HTB = HALF * BK * 2, STAGE_BYTES = 8 * HTB;
__device__ __forceinline__ int lds_byte(int r, int c) { const int st = (r >> 4) * 2 + (c >> 5), rr = r & 15, cc = c & 31, ob = rr * 64 + cc * 2; return st * 1024 + (ob ^ (((ob >> 9) & 1) << 5)); }
__device__ __forceinline__ void stage_rc(int b, int& R, int& C) { const int st = b / 1024, sb = b % 1024, swz = sb ^ (((sb >> 9) & 1) << 5); R = (st >> 1) * 16 + swz / 64; C = (st & 1) * 32 + (swz % 64) / 2; }
__device__ __forceinline__ int perm32(int rho) { const int n = rho >> 4, i = rho & 15; return 8 * (i >> 2) + 4 * n + (i & 3); }
struct Unit { int pm, pn, e; unsigned ao, bo; };
struct Gemm { int lda, ldb, K; };
__device__ __forceinline__ void map2d(int L, int nM, int nN, int& pm, int& pn) {
    const int nwg = nM * nN; int wgid = L;
    { const int q = nwg / 8, r = nwg % 8, xcd = wgid % 8, off = wgid / 8; wgid = (xcd < r ? xcd * (q + 1) : r * (q + 1) + (xcd - r) * q) + off; }
    const int nig = 8 * nN, gid = wgid / nig, fm = gid * 8, gsz = (nM - fm) < 8 ? (nM - fm) : 8;
    pm = fm + ((wgid % nig) % gsz); pn = (wgid % nig) / gsz;
}
struct Sched2D { unsigned aoff, boff, rowA, rowB; int nM, nN, G, c;
    __device__ __forceinline__ bool next(int i, Unit& u) const { const long L = (long)i * G + c; if (L >= (long)nM * nN) return false; map2d((int)L, nM, nN, u.pm, u.pn); u.e = 0;
        u.ao = aoff + (unsigned)u.pm * 256u * rowA; u.bo = boff + (unsigned)u.pn * 256u * rowB; return true; } };
struct SchedG1 { int G, c;
    __device__ __forceinline__ bool next(int i, Unit& u) const { const long L = (long)i * G + c; if (L >= 592) return false;
        const int Li = (int)L, l2 = Li - 576, l3 = Li - 584; int pm, pn; map2d(Li < 576 ? Li : 0, 64, 9, pm, pn);
        const int e = Li < 576 ? 0 : (Li < 584 ? 1 : 2);
        pm = e == 0 ? pm : (e == 1 ? (l2 >> 2) : (l3 >> 1)); pn = e == 0 ? pn : (e == 1 ? (l2 & 3) : (l3 & 1));
        const unsigned m1 = (unsigned)(e == 1), m2 = (unsigned)(e == 2);
        const unsigned ao = (unsigned)WS_XN + m1 * (unsigned)(WS_HM - WS_XN) + m2 * (unsigned)(WS_WT_XV - WS_XN), bo = (unsigned)WS_WT_IN + m1 * (unsigned)(WS_WT_XK - WS_WT_IN) + m2 * (unsigned)(WS_HM - WS_WT_IN);
        u.pm = pm; u.pn = pn; u.e = e; u.ao = ao + (unsigned)pm * 256u * D * 2u; u.bo = bo + (unsigned)pn * 256u * D * 2u; return true; } };
struct SchedAttn { unsigned aoff, boff, sBb, sBh; int G, c;
    __device__ __forceinline__ bool next(int i, Unit& u) const { const long L = (long)i * G + c; if (L >= 256) return false; const int bh = (int)L >> 5, b = bh >> 2, h = bh & 3;
        u.pm = b * 32 + ((int)L & 31); u.pn = h; u.e = 0; u.ao = aoff + ((unsigned)u.pm * 256u * D + h * 256u) * 2u; u.bo = boff + b * sBb + h * sBh; return true; } };
struct SchedMoE { unsigned aoff, boff; const int* tile_e; unsigned sBe, rowA, rowB; int nM, nN, G, c;
    __device__ __forceinline__ bool next(int i, Unit& u) const { const long L = (long)i * G + c; if (L >= (long)nM * nN) return false; map2d((int)L, nM, nN, u.pm, u.pn); u.e = __builtin_amdgcn_readfirstlane(tile_e[u.pm]);
        u.ao = aoff + (unsigned)u.pm * 256u * rowA; u.bo = boff + (unsigned)u.e * sBe + (unsigned)u.pn * 256u * rowB; return true; } };

typedef f32x4 Acc[2][2][4][2];
__device__ __forceinline__ u32x4 pack8(const f32x4 v0, const f32x4 v1) { u32x4 w; w.x = pk2(v0[0], v0[1]); w.y = pk2(v0[2], v0[3]); w.z = pk2(v1[0], v1[1]); w.w = pk2(v1[2], v1[3]); return w; }
struct EpiBf3 { static constexpr bool PERM = true; unsigned char* ws; size_t o0, o1, o2; int ld0, ld1, ld2;
    __device__ __forceinline__ void operator()(const Acc& acc, const Unit& u, int wr, int wc, int fr, int fq) const {
        const size_t m1 = (size_t)(u.e == 1), m2 = (size_t)(u.e == 2);
        bf16* base = (bf16*)(ws + o0 + m1 * (o1 - o0) + m2 * (o2 - o0)); const int ld = ld0 + (int)m1 * (ld1 - ld0) + (int)m2 * (ld2 - ld0);
        const int row0 = u.pm * BM + wr * 64 + fr, col0 = u.pn * BM + wc * 32 + 8 * fq;
#pragma unroll
        for (int ai = 0; ai < 2; ++ai)
#pragma unroll
            for (int m = 0; m < 4; ++m) { bf16* rowp = base + (size_t)(row0 + ai * HALF + m * 16) * ld + col0;
#pragma unroll
                for (int bj = 0; bj < 2; ++bj) *(u32x4*)(rowp + bj * HALF) = pack8(acc[ai][bj][m][0], acc[ai][bj][m][1]); } } };
struct EpiF { static constexpr bool PERM = false; float* C; int ldc;
    __device__ __forceinline__ void operator()(const Acc& acc, const Unit& u, int wr, int wc, int fr, int fq) const {
        const int row0 = u.pm * BM + wr * 64 + fr, col0 = u.pn * BM + wc * 32 + 4 * fq;
#pragma unroll
        for (int ai = 0; ai < 2; ++ai)
#pragma unroll
            for (int m = 0; m < 4; ++m) { float* rowp = C + (size_t)(row0 + ai * HALF + m * 16) * ldc + col0;
#pragma unroll
                for (int bj = 0; bj < 2; ++bj)
#pragma unroll
                    for (int n = 0; n < 2; ++n) *(f32x4*)(rowp + bj * HALF + n * 16) = acc[ai][bj][m][n]; } } };
struct EpiOutF { static constexpr bool PERM = false; const float* x; float* x1; bf16* a2; const float* g; float* rowsq;
    __device__ __forceinline__ void operator()(const Acc& acc, const Unit& u, int wr, int wc, int fr, int fq) const {
        const int row0 = u.pm * BM + wr * 64 + fr, col0 = u.pn * BM + wc * 32 + 4 * fq;
        f32x4 gv[2][2];
#pragma unroll
        for (int bj = 0; bj < 2; ++bj)
#pragma unroll
            for (int n = 0; n < 2; ++n) gv[bj][n] = *(const f32x4*)(g + col0 + bj * HALF + n * 16);
#pragma unroll
        for (int ai = 0; ai < 2; ++ai)
#pragma unroll
            for (int m = 0; m < 4; ++m) { const int row = row0 + ai * HALF + m * 16; const size_t off = (size_t)row * D + col0; float ss = 0.f;
#pragma unroll
                for (int bj = 0; bj < 2; ++bj)
#pragma unroll
                    for (int n = 0; n < 2; ++n) { const size_t o = off + bj * HALF + n * 16; const f32x4 v = *(const f32x4*)(x + o) + acc[ai][bj][m][n]; *(f32x4*)(x1 + o) = v;
                        const f32x4 t = v * gv[bj][n]; u32x2 w; w.x = pk2(t[0], t[1]); w.y = pk2(t[2], t[3]); *(u32x2*)(a2 + o) = w; ss += (v[0] * v[0] + v[1] * v[1]) + (v[2] * v[2] + v[3] * v[3]); }
                ss += __shfl_xor(ss, 16); ss += __shfl_xor(ss, 32);
                if (fq == 0) atomicAdd(rowsq + row, ss); } } };
struct EpiQF { static constexpr bool PERM = true; bf16* q; const float* rowsq;
    __device__ __forceinline__ void operator()(const Acc& acc, const Unit& u, int wr, int wc, int fr, int fq) const {
        const int row0 = u.pm * BM + wr * 64 + fr, col0 = u.pn * BM + wc * 32 + 8 * fq;
#pragma unroll
        for (int ai = 0; ai < 2; ++ai)
#pragma unroll
            for (int m = 0; m < 4; ++m) { const int row = row0 + ai * HALF + m * 16; const float s = 0.0625f / sqrtf(rowsq[row] * (1.f / D) + EPS); bf16* rowp = q + (size_t)row * D + col0;
#pragma unroll
                for (int bj = 0; bj < 2; ++bj) *(u32x4*)(rowp + bj * HALF) = pack8(acc[ai][bj][m][0] * s, acc[ai][bj][m][1] * s); } } };
struct EpiResF { static constexpr bool PERM = false; const float* base; float* o;
    __device__ __forceinline__ void operator()(const Acc& acc, const Unit& u, int wr, int wc, int fr, int fq) const {
        const int row0 = u.pm * BM + wr * 64 + fr, col0 = u.pn * BM + wc * 32 + 4 * fq;
#pragma unroll
        for (int ai = 0; ai < 2; ++ai)
#pragma unroll
            for (int m = 0; m < 4; ++m) { const size_t off = (size_t)(row0 + ai * HALF + m * 16) * D + col0;
#pragma unroll
                for (int bj = 0; bj < 2; ++bj)
#pragma unroll
                    for (int n = 0; n < 2; ++n) { const size_t o2 = off + bj * HALF + n * 16; *(f32x4*)(o + o2) = *(const f32x4*)(base + o2) + acc[ai][bj][m][n]; } } } };
struct EpiUpF { static constexpr bool PERM = true; bf16* h; const float* b_gu;
    __device__ __forceinline__ void operator()(const Acc& acc, const Unit& u, int wr, int wc, int fr, int fq) const {
        const int row0 = u.pm * BM + wr * 64 + fr, ff0 = u.pn * HALF + wc * 32 + 8 * fq; const float* bb = b_gu + (size_t)u.e * 2 * DFF + ff0;
        const f32x4 bg0 = *(const f32x4*)bb, bg1 = *(const f32x4*)(bb + 4), bu0 = *(const f32x4*)(bb + DFF), bu1 = *(const f32x4*)(bb + DFF + 4);
#pragma unroll
        for (int ai = 0; ai < 2; ++ai)
#pragma unroll
            for (int m = 0; m < 4; ++m) { const f32x4 g0 = acc[ai][0][m][0] + bg0, g1 = acc[ai][0][m][1] + bg1, u0 = acc[ai][1][m][0] + bu0, u1 = acc[ai][1][m][1] + bu1; f32x4 r0, r1;
#pragma unroll
                for (int i = 0; i < 4; ++i) { r0[i] = swiglu(g0[i], u0[i]); r1[i] = swiglu(g1[i], u1[i]); }
                *(u32x4*)(h + (size_t)(row0 + ai * HALF + m * 16) * DFF + ff0) = pack8(r0, r1); } } };
struct EpiDnF { static constexpr bool PERM = true; bf16* y; const float* b_dn; const float* gs;
    __device__ __forceinline__ void operator()(const Acc& acc, const Unit& u, int wr, int wc, int fr, int fq) const {
        const int row0 = u.pm * BM + wr * 64 + fr, col0 = u.pn * BM + wc * 32 + 8 * fq; const float* bb = b_dn + (size_t)u.e * D + col0;
        f32x4 bv[2][2];
#pragma unroll
        for (int bj = 0; bj < 2; ++bj)
#pragma unroll
            for (int n = 0; n < 2; ++n) bv[bj][n] = *(const f32x4*)(bb + bj * HALF + 4 * n);
#pragma unroll
        for (int ai = 0; ai < 2; ++ai)
#pragma unroll
            for (int m = 0; m < 4; ++m) { const int row = row0 + ai * HALF + m * 16; const float g = gs[row]; bf16* rowp = y + (size_t)row * D + col0;
#pragma unroll
                for (int bj = 0; bj < 2; ++bj) *(u32x4*)(rowp + bj * HALF) = pack8((acc[ai][bj][m][0] + bv[bj][0]) * g, (acc[ai][bj][m][1] + bv[bj][1]) * g); } } };

struct EpiUp8 { static constexpr bool PERM = true; unsigned char* h8; const float* b_gu;
    __device__ __forceinline__ void operator()(const Acc& acc, const Unit& u, int wr, int wc, int fr, int fq) const {
        const int row0 = u.pm * BM + wr * 64 + fr, ff0 = u.pn * HALF + wc * 32 + 8 * fq; const float* bb = b_gu + (size_t)u.e * 2 * DFF + ff0;
        const f32x4 bg0 = *(const f32x4*)bb, bg1 = *(const f32x4*)(bb + 4), bu0 = *(const f32x4*)(bb + DFF), bu1 = *(const f32x4*)(bb + DFF + 4);
#pragma unroll
        for (int ai = 0; ai < 2; ++ai)
#pragma unroll
            for (int m = 0; m < 4; ++m) { const f32x4 g0 = acc[ai][0][m][0] * W8_INV + bg0, g1 = acc[ai][0][m][1] * W8_INV + bg1, u0 = acc[ai][1][m][0] * W8_INV + bu0, u1 = acc[ai][1][m][1] * W8_INV + bu1; f32x4 r0, r1;
#pragma unroll
                for (int i = 0; i < 4; ++i) { r0[i] = swiglu(g0[i], u0[i]); r1[i] = swiglu(g1[i], u1[i]); }
                u32x2 o; o.x = pk4_fp8(r0[0], r0[1], r0[2], r0[3]); o.y = pk4_fp8(r1[0], r1[1], r1[2], r1[3]);
                *(u32x2*)(h8 + (size_t)(row0 + ai * HALF + m * 16) * DFF + ff0) = o; } } };
struct EpiDn8 { static constexpr bool PERM = true; bf16* y; const float* b_dn; const float* gs;
    __device__ __forceinline__ void operator()(const Acc& acc, const Unit& u, int wr, int wc, int fr, int fq) const {
        const int row0 = u.pm * BM + wr * 64 + fr, col0 = u.pn * BM + wc * 32 + 8 * fq; const float* bb = b_dn + (size_t)u.e * D + col0;
        f32x4 bv[2][2];
#pragma unroll
        for (int bj = 0; bj < 2; ++bj)
#pragma unroll
            for (int n = 0; n < 2; ++n) bv[bj][n] = *(const f32x4*)(bb + bj * HALF + 4 * n);
#pragma unroll
        for (int ai = 0; ai < 2; ++ai)
#pragma unroll
            for (int m = 0; m < 4; ++m) { const int row = row0 + ai * HALF + m * 16; const float g = gs[row]; bf16* rowp = y + (size_t)row * D + col0;
#pragma unroll
                for (int bj = 0; bj < 2; ++bj) *(u32x4*)(rowp + bj * HALF) = pack8((acc[ai][bj][m][0] * W8_INV + bv[bj][0]) * g, (acc[ai][bj][m][1] * W8_INV + bv[bj][1]) * g); } } };

typedef int i32x4 __attribute__((ext_vector_type(4)));
typedef int i32x8 __attribute__((ext_vector_type(8)));
__device__ __forceinline__ void mma8(const i32x8 bb, const i32x8 aa, f32x4& c) {
    asm volatile("v_mfma_f32_16x16x128_f8f6f4 %0, %1, %2, %0" : "+v"(c) : "v"(bb), "v"(aa));
}
__device__ __forceinline__ void mma8_drain() { asm volatile("s_nop 15\n\ts_nop 7" ::: "memory"); }
template <class Epi, class Sched, bool ALIGN_EPI, bool F8 = false>
__device__ __forceinline__ void gemm_phase(LAS unsigned char* lds, const unsigned char* ws, const Gemm g, const Sched& S, const Epi& E) {
    const __amdgpu_buffer_rsrc_t rsrc = __builtin_amdgcn_make_buffer_rsrc((void*)ws, 0, 0x7fffffff, 0x00020000);
    const int tid = threadIdx.x, wid = __builtin_amdgcn_readfirstlane(tid >> 6), lane = tid & 63, wr = wid >> 2, wc = wid & 3, fr = lane & 15, fq = lane >> 4;
    const int K = g.K, nt = K / BK;
    unsigned voffA[2], voffB[2];
#pragma unroll
    for (int i = 0; i < 2; ++i) { int R, C; stage_rc(tid * 16 + i * 8192, R, C); const int Rb = Epi::PERM ? ((R & ~31) + perm32(R & 31)) : R;
        voffA[i] = (unsigned)(R * g.lda + C) * 2u; voffB[i] = (unsigned)(Rb * g.ldb + C) * 2u; }
    const unsigned kstep = (unsigned)(BK * 2);
    const unsigned hstepA = (unsigned)HALF * g.lda * 2, hstepB = (unsigned)HALF * g.ldb * 2;
    const unsigned ldsw = (unsigned)wid * 1024u, ldsbase = (unsigned)(size_t)lds;
    const int aoff = F8 ? lds_byte(wr * 64 + fr, (fq >> 1) * 32 + (fq & 1) * 16) : lds_byte(wr * 64 + fr, fq * 8);
    const int boff = F8 ? lds_byte(wc * 32 + fr, (fq >> 1) * 32 + (fq & 1) * 16) : lds_byte(wc * 32 + fr, fq * 8);
#define PG_SA(b, h) (((b) * 2 + (h)) * HTB)
#define PG_SB(b, h) ((4 + (b) * 2 + (h)) * HTB)
#define PG_STAGE(bufoff, gbase, voff) do { _Pragma("unroll") for (int _i = 0; _i < 2; ++_i) \
        asm volatile("s_mov_b32 m0, %0\n\ts_nop 0\n\tbuffer_load_dwordx4 %1, %2, %3 offen lds" :: "s"(ldsbase + (unsigned)(bufoff) + ldsw + (unsigned)(_i * 8192)), "v"((voff)[_i]), "s"(rsrc), "s"((unsigned)(gbase)) : "m0", "memory"); } while (0)
#define PG_LDA(dst, b, h) do { _Pragma("unroll") for (int m = 0; m < 4; ++m) { if constexpr (F8) dst##8[m] = *(const LAS i32x8*)(lds + PG_SA(b, h) + aoff + m * 2048); \
        else { _Pragma("unroll") for (int k = 0; k < 2; ++k) dst[m][k] = *(const LAS bf16x8*)(lds + PG_SA(b, h) + aoff + m * 2048 + k * 1024); } } } while (0)
#define PG_LDB(dst, b, h) do { _Pragma("unroll") for (int n = 0; n < 2; ++n) { if constexpr (F8) dst##8[n] = *(const LAS i32x8*)(lds + PG_SB(b, h) + boff + n * 2048); \
        else { _Pragma("unroll") for (int k = 0; k < 2; ++k) dst[n][k] = *(const LAS bf16x8*)(lds + PG_SB(b, h) + boff + n * 2048 + k * 1024); } } } while (0)
#define PG_MMA(ai, bj, At, Bt) do { __builtin_amdgcn_s_setprio(1); _Pragma("unroll") for (int m = 0; m < 4; ++m) _Pragma("unroll") for (int n = 0; n < 2; ++n) { \
        if constexpr (F8) mma8(Bt##8[n], At##8[m], acc[ai][bj][m][n]); \
        else { _Pragma("unroll") for (int k = 0; k < 2; ++k) acc[ai][bj][m][n] = __builtin_amdgcn_mfma_f32_16x16x32_bf16(Bt[n][k], At[m][k], acc[ai][bj][m][n], 0, 0, 0); } } \
        __builtin_amdgcn_s_setprio(0); } while (0)
#define PG_WAIT_V(n) asm volatile("s_waitcnt vmcnt(" #n ")" ::: "memory")
#define PG_WAIT_L(n) asm volatile("s_waitcnt lgkmcnt(" #n ")" ::: "memory")
#define PG_BAR __builtin_amdgcn_s_barrier()
#define PG_SCHED __builtin_amdgcn_sched_barrier(0)
    Unit cur, nxt; int ui = 0;
    if (!S.next(0, cur)) return;
    f32x4 acc[2][2][4][2];
#pragma unroll
    for (int a = 0; a < 2; ++a)
#pragma unroll
        for (int b = 0; b < 2; ++b)
#pragma unroll
            for (int m = 0; m < 4; ++m)
#pragma unroll
                for (int n = 0; n < 2; ++n) acc[a][b][m][n] = (f32x4){0.f, 0.f, 0.f, 0.f};
    bf16x8 At[4][2], B0[2][2], B1[2][2]; i32x8 At8[4], B08[2], B18[2];
    unsigned cA = cur.ao, cB = cur.bo;
    asm volatile("s_nop 4" ::: "memory");
    PG_STAGE(PG_SB(0, 0), cB, voffB); PG_STAGE(PG_SB(0, 1), cB + hstepB, voffB); PG_STAGE(PG_SA(0, 0), cA, voffA); PG_STAGE(PG_SA(0, 1), cA + hstepA, voffA);
    if (wr == 1) PG_BAR;
    PG_WAIT_V(2); PG_BAR;
    PG_STAGE(PG_SB(1, 0), cB + kstep, voffB); PG_STAGE(PG_SA(1, 0), cA + kstep, voffA); PG_STAGE(PG_SB(1, 1), cB + hstepB + kstep, voffB);
    PG_WAIT_V(6); PG_BAR;
    for (;;) {
        const bool has_next = S.next(ui + 1, nxt);
        const unsigned nA = has_next ? nxt.ao : cA, nB = has_next ? nxt.bo : cB;
#pragma unroll 1
        for (int t = 0; t < nt; t += 2) {
            const bool last = (t == nt - 2);
            const unsigned a1 = cA + (unsigned)(t + 1) * kstep;
            const unsigned a2 = last ? nA : cA + (unsigned)(t + 2) * kstep, b2 = last ? nB : cB + (unsigned)(t + 2) * kstep;
            const unsigned a3 = a2 + kstep, b3 = b2 + kstep;
            PG_LDB(B0, 0, 0); PG_LDB(B1, 0, 1); PG_SCHED; PG_LDA(At, 0, 0); PG_STAGE(PG_SA(1, 1), a1 + hstepA, voffA);
            PG_WAIT_V(8); PG_WAIT_L(0); PG_BAR; PG_MMA(0, 0, At, B0); PG_MMA(0, 1, At, B1); PG_BAR; PG_SCHED;
            PG_LDA(At, 0, 1); PG_STAGE(PG_SB(0, 0), b2, voffB); PG_STAGE(PG_SB(0, 1), b2 + hstepB, voffB); PG_STAGE(PG_SA(0, 0), a2, voffA);
            PG_WAIT_V(8); PG_WAIT_L(0); PG_BAR; PG_MMA(1, 0, At, B0); PG_MMA(1, 1, At, B1); PG_BAR; PG_SCHED;
            PG_LDB(B0, 1, 0); PG_LDB(B1, 1, 1); PG_SCHED; PG_LDA(At, 1, 0); PG_STAGE(PG_SA(0, 1), a2 + hstepA, voffA);
            PG_WAIT_V(8); PG_WAIT_L(0); PG_BAR; PG_MMA(0, 0, At, B0); PG_MMA(0, 1, At, B1); PG_BAR; PG_SCHED;
            PG_LDA(At, 1, 1); PG_STAGE(PG_SB(1, 0), b3, voffB); PG_STAGE(PG_SB(1, 1), b3 + hstepB, voffB); PG_STAGE(PG_SA(1, 0), a3, voffA);
            PG_WAIT_V(8); PG_WAIT_L(0); PG_BAR; PG_MMA(1, 0, At, B0); PG_MMA(1, 1, At, B1); PG_BAR; PG_SCHED;
        }
        if constexpr (ALIGN_EPI) { if (wr == 0) PG_BAR; }
        if constexpr (F8) mma8_drain();
        { int t2 = threadIdx.x; asm volatile("" : "+v"(t2));
          const int l2 = t2 & 63; E(acc, cur, wr, wc, l2 & 15, l2 >> 4); }
        if (!has_next) break;
#pragma unroll
        for (int a = 0; a < 2; ++a)
#pragma unroll
            for (int b = 0; b < 2; ++b)
#pragma unroll
                for (int m = 0; m < 4; ++m)
#pragma unroll
                    for (int n = 0; n < 2; ++n) acc[a][b][m][n] = (f32x4){0.f, 0.f, 0.f, 0.f};
        cur = nxt; cA = nA; cB = nB; ++ui;
        if constexpr (ALIGN_EPI) { if (wr == 1) PG_BAR; }
    }
    PG_WAIT_V(0);
    if constexpr (!ALIGN_EPI) { if (wr == 0) PG_BAR; }
    PG_BAR;
#undef PG_SA
#undef PG_SB
#undef PG_STAGE
#undef PG_LDA
#undef PG_LDB
#undef PG_MMA
#undef PG_WAIT_V
#undef PG_WAIT_L
#undef PG_BAR
#undef PG_SCHED
}
}

#define XB_TMO      128
#define XB_XCNT(j)  (256  + 64 * (j))
#define XB_XSUB(j)  (1280 + 64 * (j))
#define XB_XGEN(j)  (2304 + 64 * (j))
#define XB_TOP      3328
#define XB_TOPGEN   3392
#define XCD_BAR_WORDS 3456
#define XB_SPIN_CAP (1u << 18)
__device__ __forceinline__ unsigned xb_ld(unsigned* p)              { return __hip_atomic_load(p, __ATOMIC_RELAXED, __HIP_MEMORY_SCOPE_AGENT); }
__device__ __forceinline__ unsigned xb_add(unsigned* p, unsigned v) { return __hip_atomic_fetch_add(p, v, __ATOMIC_RELAXED, __HIP_MEMORY_SCOPE_AGENT); }
__device__ __forceinline__ unsigned xb_xcc_id() { return (unsigned)__builtin_amdgcn_s_getreg((3 << 11) | 20) & 0xFu; }
#define XB_SPIN(cond, bar) do { unsigned _sp = 0; while (cond) { __builtin_amdgcn_s_sleep(1); \
    if ((++_sp & 255u) == 0u) { if (xb_ld(&(bar)[XB_TMO])) break; if (_sp > XB_SPIN_CAP) { atomicAdd(&(bar)[XB_TMO], 1u); break; } } } } while (0)
struct XcdBarrier { unsigned* bar; unsigned x; volatile LAS unsigned* st; };
__device__ __forceinline__ XcdBarrier xcd_barrier_post(unsigned* bar, volatile LAS unsigned* st) {
    XcdBarrier b; b.bar = bar; b.x = xb_xcc_id(); b.st = st;
    if (threadIdx.x == 0) (void)xb_add(&bar[XB_XCNT(b.x)], 1u);
    return b;
}
__device__ __forceinline__ void xcd_barrier_complete(unsigned* bar, unsigned x, unsigned& nloc, unsigned& nx) {
    const unsigned G = NBLOCKS;
    unsigned sum, cnt, mine, sp = 0u;
    for (;;) {
        sum = 0u; cnt = 0u; mine = 0u;
#pragma unroll
        for (unsigned j = 0; j < 16; ++j) { const unsigned c = xb_ld(&bar[XB_XCNT(j)]); sum += c; cnt += (c > 0u) ? 1u : 0u; mine = (j == x) ? c : mine; }
        if (sum == G) break;
        __builtin_amdgcn_s_sleep(1);
        if ((++sp & 255u) == 0u) { if (xb_ld(&bar[XB_TMO])) break; if (sp > XB_SPIN_CAP) { atomicAdd(&bar[XB_TMO], 1u); break; } }
    }
    nloc = mine > 0u ? mine : 1u; nx = cnt > 0u ? cnt : 1u;
}
__device__ __forceinline__ void xcd_barrier(unsigned* bar_, volatile LAS unsigned* st_) {
    asm volatile("s_waitcnt vmcnt(0)" ::: "memory");
    __syncthreads();
    if (threadIdx.x == 0) {
        XcdBarrier b; b.bar = bar_; b.x = xb_xcc_id(); b.st = st_;
        unsigned* bar = b.bar;
        __builtin_amdgcn_s_waitcnt(0);
        unsigned nloc = b.st[0], nx = b.st[1];
        if (nloc == 0u) { xcd_barrier_complete(bar, b.x, nloc, nx); b.st[0] = nloc; b.st[1] = nx; }
        const unsigned old = xb_add(&bar[XB_XSUB(b.x)], 1u);
        const unsigned gen = old / nloc;
        if (old + 1u == (gen + 1u) * nloc) {
            __builtin_amdgcn_fence(__ATOMIC_RELEASE, "agent");
            asm volatile("s_waitcnt vmcnt(0)" ::: "memory");
            const unsigned og = xb_add(&bar[XB_TOP], 1u);
            const unsigned tg = og / nx;
            if (og + 1u == (tg + 1u) * nx) xb_add(&bar[XB_TOPGEN], 1u);
            else XB_SPIN(xb_ld(&bar[XB_TOPGEN]) == tg, bar);
            __builtin_amdgcn_fence(__ATOMIC_ACQUIRE, "agent");
            xb_add(&bar[XB_XGEN(b.x)], 1u);
            asm volatile("s_waitcnt vmcnt(0)" ::: "memory");
        } else {
            XB_SPIN(xb_ld(&bar[XB_XGEN(b.x)]) == gen, bar);
            __builtin_amdgcn_fence(__ATOMIC_ACQUIRE, "agent");
            asm volatile("s_waitcnt vmcnt(0)" ::: "memory");
        }
    }
    __syncthreads();
}

constexpr int NPHASE = 16;
constexpr int LDS_BYTES = 147456, PT_OFF = LDS_BYTES - 512, MISC_OFF = LDS_BYTES - 128;
__device__ __forceinline__ const float* pt_load(const LAS unsigned* pt, int i) {
    const unsigned lo = __builtin_amdgcn_readfirstlane(pt[2 * i]), hi = __builtin_amdgcn_readfirstlane(pt[2 * i + 1]);
    return (const float*)(((unsigned long long)hi << 32) | lo);
}
__device__ __forceinline__ P make_p(const LAS unsigned* pt, float* out, unsigned char* ws) {
    P p;
    p.x = pt_load(pt, 0); p.mem = pt_load(pt, 1); p.g_mix = pt_load(pt, 2); p.w_in = pt_load(pt, 3); p.w_pool = pt_load(pt, 4); p.pool_scale = pt_load(pt, 5); p.w_gate_up = pt_load(pt, 6); p.b_gate_up = pt_load(pt, 7);
    p.gla_g = pt_load(pt, 8); p.w_out = pt_load(pt, 9); p.g_xattn = pt_load(pt, 10); p.g_mem = pt_load(pt, 11); p.w_xq = pt_load(pt, 12); p.w_xk = pt_load(pt, 13); p.w_xv = pt_load(pt, 14); p.w_xo = pt_load(pt, 15);
    p.g_moe = pt_load(pt, 16); p.w_router = pt_load(pt, 17); p.b_router = pt_load(pt, 18); p.w_gu = pt_load(pt, 19); p.b_gu = pt_load(pt, 20); p.w_dn = pt_load(pt, 21); p.b_dn = pt_load(pt, 22); p.g_final = pt_load(pt, 23);
    p.out = out; p.ws = ws; return p;
}
struct Args { const float* in[24]; float* out; unsigned char* ws; int ph_lo, ph_hi; };

__global__ void __launch_bounds__(NTHREADS, 2) mk_fwd(Args a) {
    extern __shared__ __attribute__((aligned(16))) unsigned char lds[];
    float* ldsf = (float*)lds;
    { volatile LAS unsigned long long* PT = (volatile LAS unsigned long long*)((LAS unsigned char*)lds + PT_OFF);
      if (threadIdx.x == 0) {
#define PTS(i) PT[i] = (unsigned long long)a.in[i];
          PTS(0) PTS(1) PTS(2) PTS(3) PTS(4) PTS(5) PTS(6) PTS(7) PTS(8) PTS(9) PTS(10) PTS(11) PTS(12) PTS(13) PTS(14) PTS(15) PTS(16) PTS(17) PTS(18) PTS(19) PTS(20) PTS(21) PTS(22) PTS(23)
#undef PTS
      } }
    const int bid = blockIdx.x; constexpr int nb = NBLOCKS;
#if defined(MK_PER_PHASE)
    const int lo = a.ph_lo, hi = a.ph_hi;
#else
    constexpr int lo = 0, hi = NPHASE;
#endif
#ifndef PH
#define PH -1
#endif
#ifndef REPMASK
#define REPMASK 0
#endif
#define REP(k) ((((REPMASK) >> (k)) & 1) ? 2 : 1)
#ifndef FASTMASK
#define FASTMASK 0x7FF
#endif
#define IN(k) ((PH < 0 || PH == (k)) && lo <= (k) && (k) < hi)
    LAS unsigned char* ldsl = (LAS unsigned char*)lds;
    volatile LAS unsigned* MISC = (volatile LAS unsigned*)(ldsl + MISC_OFF);
    if (threadIdx.x < 32) MISC[threadIdx.x] = 0u;
    __syncthreads();
    const bool fused = (hi - lo) > 1;
    if (fused) (void)xcd_barrier_post((unsigned*)(a.ws + WS_CTL) + CW_BAR, MISC + 8);
#define GRID_BAR() xcd_barrier((unsigned*)(a.ws + WS_CTL) + CW_BAR, (volatile LAS unsigned*)(ldsl + MISC_OFF) + 8)
#define SEAM(k) do { if (fused && IN(k) && IN((k) + 1)) GRID_BAR(); } while (0)
    if (IN(0)) for (int rep_ = 0; rep_ < REP(0); ++rep_) { if (rep_) GRID_BAR(); asm volatile("" ::: "memory"); P p = make_p((const LAS unsigned*)(ldsl + PT_OFF), a.out, a.ws); asm volatile("" : "+s"(p.ws)); unsigned char* const ws = p.ws; float* const rowsq1 = (float*)(p.ctl() + CW_ROWSQ1); (void)ws; (void)rowsq1;
    phase_prologue(p, ldsf, bid, nb);
    }
    SEAM(0);
    if (IN(1)) for (int rep_ = 0; rep_ < REP(1); ++rep_) { if (rep_) GRID_BAR(); asm volatile("" ::: "memory"); P p = make_p((const LAS unsigned*)(ldsl + PT_OFF), a.out, a.ws); asm volatile("" : "+s"(p.ws)); unsigned char* const ws = p.ws; float* const rowsq1 = (float*)(p.ctl() + CW_ROWSQ1); (void)ws; (void)rowsq1;
    {
        if (FASTMASK & 1) { pg::SchedG1 S{nb, bid}; pg::EpiBf3 E{ws, WS_Z1, WS_KX, WS_VXT, NZ, D, BATCH * MEMLEN};
            pg::gemm_phase<pg::EpiBf3, pg::SchedG1, true>(ldsl, ws, pg::Gemm{D, D, D}, S, E); }
        else {
        ngemm(NG{p.xn(), D, p.wt_in(), D, M, NZ, D, nullptr, 0}, EpiBf{p.z1(), NZ}, ldsf, bid, nb);
        ngemm(NG{p.hm(), D, p.wt_xk(), D, BATCH * MEMLEN, D, D, nullptr, 0}, EpiBf{p.kx(), D}, ldsf, bid, nb);
        ngemm(NG{p.wt_xv(), D, p.hm(), D, D, BATCH * MEMLEN, D, nullptr, 0}, EpiBf{p.vxt(), BATCH * MEMLEN}, ldsf, bid, nb); }
    }
    }
    SEAM(1);
    if (IN(2)) for (int rep_ = 0; rep_ < REP(2); ++rep_) { if (rep_) GRID_BAR(); asm volatile("" ::: "memory"); P p = make_p((const LAS unsigned*)(ldsl + PT_OFF), a.out, a.ws); asm volatile("" : "+s"(p.ws)); unsigned char* const ws = p.ws; float* const rowsq1 = (float*)(p.ctl() + CW_ROWSQ1); (void)ws; (void)rowsq1;
    { if (FASTMASK & 256) phase_pool2(p, lds, bid, nb); else phase_pool(p, ldsf, bid, nb);
      if (FASTMASK & 512) phase_gla_a2(p, lds, bid, nb); else phase_gla_a(p, ldsf, bid, nb); }
    }
    SEAM(2);
    if (IN(3)) for (int rep_ = 0; rep_ < REP(3); ++rep_) { if (rep_) GRID_BAR(); asm volatile("" ::: "memory"); P p = make_p((const LAS unsigned*)(ldsl + PT_OFF), a.out, a.ws); asm volatile("" : "+s"(p.ws)); unsigned char* const ws = p.ws; float* const rowsq1 = (float*)(p.ctl() + CW_ROWSQ1); (void)ws; (void)rowsq1;
    if (FASTMASK & 512) phase_scan2(p, bid, nb); else phase_scan(p, bid, nb);
    }
    SEAM(3);
    if (IN(4)) for (int rep_ = 0; rep_ < REP(4); ++rep_) { if (rep_) GRID_BAR(); asm volatile("" ::: "memory"); P p = make_p((const LAS unsigned*)(ldsl + PT_OFF), a.out, a.ws); asm volatile("" : "+s"(p.ws)); unsigned char* const ws = p.ws; float* const rowsq1 = (float*)(p.ctl() + CW_ROWSQ1); (void)ws; (void)rowsq1;
    if (FASTMASK & 512) phase_gla_b2(p, lds, bid, nb); else phase_gla_b(p, ldsf, bid, nb);
    }
    SEAM(4);
    if (IN(5)) for (int rep_ = 0; rep_ < REP(5); ++rep_) { if (rep_) GRID_BAR(); asm volatile("" ::: "memory"); P p = make_p((const LAS unsigned*)(ldsl + PT_OFF), a.out, a.ws); asm volatile("" : "+s"(p.ws)); unsigned char* const ws = p.ws; float* const rowsq1 = (float*)(p.ctl() + CW_ROWSQ1); (void)ws; (void)rowsq1;
    {
        if (FASTMASK & 2) { pg::Sched2D S{(unsigned)WS_MIX, (unsigned)WS_WT_OUT, D * 2, D * 2, M / 256, D / 256, nb, bid}; pg::EpiOutF E{p.x, p.x1(), p.a2(), p.g_xattn, rowsq1};
            pg::gemm_phase<pg::EpiOutF, pg::Sched2D, false>(ldsl, ws, pg::Gemm{D, D, D}, S, E); }
        else ngemm(NG{p.mix(), D, p.wt_out(), D, M, D, D, nullptr, 0}, EpiOut{p.x, p.x1(), p.a2(), p.g_xattn, rowsq1}, ldsf, bid, nb);
    }
    }
    SEAM(5);
    if (IN(6)) for (int rep_ = 0; rep_ < REP(6); ++rep_) { if (rep_) GRID_BAR(); asm volatile("" ::: "memory"); P p = make_p((const LAS unsigned*)(ldsl + PT_OFF), a.out, a.ws); asm volatile("" : "+s"(p.ws)); unsigned char* const ws = p.ws; float* const rowsq1 = (float*)(p.ctl() + CW_ROWSQ1); (void)ws; (void)rowsq1;
    {
        if (FASTMASK & 4) { pg::Sched2D S{(unsigned)WS_A2, (unsigned)WS_WT_XQ, D * 2, D * 2, M / 256, D / 256, nb, bid}; pg::EpiQF E{p.qx(), rowsq1};
            pg::gemm_phase<pg::EpiQF, pg::Sched2D, false>(ldsl, ws, pg::Gemm{D, D, D}, S, E); }
        else ngemm(NG{p.a2(), D, p.wt_xq(), D, M, D, D, nullptr, 0}, EpiQ{p.qx(), rowsq1}, ldsf, bid, nb);
    }
    }
    SEAM(6);
    if (IN(7)) for (int rep_ = 0; rep_ < REP(7); ++rep_) { if (rep_) GRID_BAR(); asm volatile("" ::: "memory"); P p = make_p((const LAS unsigned*)(ldsl + PT_OFF), a.out, a.ws); asm volatile("" : "+s"(p.ws)); unsigned char* const ws = p.ws; float* const rowsq1 = (float*)(p.ctl() + CW_ROWSQ1); (void)ws; (void)rowsq1;
    {
        if (FASTMASK & 8) { pg::SchedAttn S{(unsigned)WS_QX, (unsigned)WS_KX, MEMLEN * D * 2, 256 * 2, nb, bid}; pg::EpiF E{p.sc(), D};
            pg::gemm_phase<pg::EpiF, pg::SchedAttn, false>(ldsl, ws, pg::Gemm{D, D, 256}, S, E); }
        else for (int bh = 0; bh < 8; ++bh) { const int b = bh >> 2, h = bh & 3; const size_t o = (size_t)b * SEQ * D + h * 256;
            ngemm(NG{p.qx() + o, D, p.kx() + (size_t)b * MEMLEN * D + h * 256, D, SEQ, 256, 256, nullptr, 0}, EpiF32{p.sc() + o, D}, ldsf, bid, nb); }
    }
    }
    SEAM(7);
    if (IN(8)) for (int rep_ = 0; rep_ < REP(8); ++rep_) { if (rep_) GRID_BAR(); asm volatile("" ::: "memory"); P p = make_p((const LAS unsigned*)(ldsl + PT_OFF), a.out, a.ws); asm volatile("" : "+s"(p.ws)); unsigned char* const ws = p.ws; float* const rowsq1 = (float*)(p.ctl() + CW_ROWSQ1); (void)ws; (void)rowsq1;
    phase_softmax(p, bid, nb);
    }
    SEAM(8);
    if (IN(9)) for (int rep_ = 0; rep_ < REP(9); ++rep_) { if (rep_) GRID_BAR(); asm volatile("" ::: "memory"); P p = make_p((const LAS unsigned*)(ldsl + PT_OFF), a.out, a.ws); asm volatile("" : "+s"(p.ws)); unsigned char* const ws = p.ws; float* const rowsq1 = (float*)(p.ctl() + CW_ROWSQ1); (void)ws; (void)rowsq1;
    {
        if (FASTMASK & 16) { pg::SchedAttn S{(unsigned)WS_PX, (unsigned)WS_VXT, MEMLEN * 2, 256 * BATCH * MEMLEN * 2, nb, bid}; pg::EpiBf3 E{ws, WS_OX, WS_OX, WS_OX, D, D, D};
            pg::gemm_phase<pg::EpiBf3, pg::SchedAttn, false>(ldsl, ws, pg::Gemm{D, BATCH * MEMLEN, 256}, S, E); }
        else for (int bh = 0; bh < 8; ++bh) { const int b = bh >> 2, h = bh & 3; const size_t o = (size_t)b * SEQ * D + h * 256;
            ngemm(NG{p.px() + o, D, p.vxt() + (size_t)h * 256 * (BATCH * MEMLEN) + b * MEMLEN, BATCH * MEMLEN, SEQ, 256, 256, nullptr, 0}, EpiBf{p.ox() + o, D}, ldsf, bid, nb); }
    }
    }
    SEAM(9);
    if (IN(10)) for (int rep_ = 0; rep_ < REP(10); ++rep_) { if (rep_) GRID_BAR(); asm volatile("" ::: "memory"); P p = make_p((const LAS unsigned*)(ldsl + PT_OFF), a.out, a.ws); asm volatile("" : "+s"(p.ws)); unsigned char* const ws = p.ws; float* const rowsq1 = (float*)(p.ctl() + CW_ROWSQ1); (void)ws; (void)rowsq1;
    {
        if (FASTMASK & 32) { pg::Sched2D S{(unsigned)WS_OX, (unsigned)WS_WT_XO, D * 2, D * 2, M / 256, D / 256, nb, bid}; pg::EpiResF E{p.x1(), p.x2()};
            pg::gemm_phase<pg::EpiResF, pg::Sched2D, false>(ldsl, ws, pg::Gemm{D, D, D}, S, E); }
        else ngemm(NG{p.ox(), D, p.wt_xo(), D, M, D, D, nullptr, 0}, EpiRes{p.x1(), p.x2()}, ldsf, bid, nb);
    }
    }
    SEAM(10);
    if (IN(11)) for (int rep_ = 0; rep_ < REP(11); ++rep_) { if (rep_) GRID_BAR(); asm volatile("" ::: "memory"); P p = make_p((const LAS unsigned*)(ldsl + PT_OFF), a.out, a.ws); asm volatile("" : "+s"(p.ws)); unsigned char* const ws = p.ws; float* const rowsq1 = (float*)(p.ctl() + CW_ROWSQ1); (void)ws; (void)rowsq1;
    if (FASTMASK & 1024) phase_router2(p, ldsf, (int*)(ws + WS_BLKCNT), (int*)(ws + WS_WAVEBASE), bid, nb); else phase_router(p, ldsf, bid, nb);
    }
    SEAM(11);
    if (IN(12)) for (int rep_ = 0; rep_ < REP(12); ++rep_) { if (rep_) GRID_BAR(); asm volatile("" ::: "memory"); P p = make_p((const LAS unsigned*)(ldsl + PT_OFF), a.out, a.ws); asm volatile("" : "+s"(p.ws)); unsigned char* const ws = p.ws; float* const rowsq1 = (float*)(p.ctl() + CW_ROWSQ1); (void)ws; (void)rowsq1;
    if (FASTMASK & 1024) phase_dispatch2(p, (int*)lds, (const int*)(ws + WS_BLKCNT), (const int*)(ws + WS_WAVEBASE), bid, nb); else phase_dispatch(p, (int*)lds, bid, nb);
    }
    SEAM(12);
    if (IN(13)) for (int rep_ = 0; rep_ < REP(13); ++rep_) { if (rep_) GRID_BAR(); asm volatile("" ::: "memory"); P p = make_p((const LAS unsigned*)(ldsl + PT_OFF), a.out, a.ws); asm volatile("" : "+s"(p.ws)); unsigned char* const ws = p.ws; float* const rowsq1 = (float*)(p.ctl() + CW_ROWSQ1); (void)ws; (void)rowsq1;
    { const int nmt = __builtin_amdgcn_readfirstlane(p.tilee()[MAXMT]);
        if (MOE_FP8) { pg::SchedMoE S{(unsigned)WS_XS, (unsigned)WS_WT_GU, p.tilee(), 2 * DFF * D, D, D, nmt, 8, nb, bid}; pg::EpiUp8 E{(unsigned char*)p.h(), p.b_gu};
            pg::gemm_phase<pg::EpiUp8, pg::SchedMoE, true, true>(ldsl, ws, pg::Gemm{D / 2, D / 2, D / 2}, S, E); }
        else if (FASTMASK & 64) { pg::SchedMoE S{(unsigned)WS_XS, (unsigned)WS_WT_GU, p.tilee(), 2 * DFF * D * 2, D * 2, D * 2, nmt, 8, nb, bid}; pg::EpiUpF E{p.h(), p.b_gu};
            pg::gemm_phase<pg::EpiUpF, pg::SchedMoE, true>(ldsl, ws, pg::Gemm{D, D, D}, S, E); }
        else ngemm(NG{p.xs(), D, p.wt_gu(), D, nmt * 256, 2 * DFF, D, p.tilee(), (size_t)2 * DFF * D}, EpiUp{p.h(), p.b_gu}, ldsf, bid, nb); }
    }
    SEAM(13);
    if (IN(14)) for (int rep_ = 0; rep_ < REP(14); ++rep_) { if (rep_) GRID_BAR(); asm volatile("" ::: "memory"); P p = make_p((const LAS unsigned*)(ldsl + PT_OFF), a.out, a.ws); asm volatile("" : "+s"(p.ws)); unsigned char* const ws = p.ws; float* const rowsq1 = (float*)(p.ctl() + CW_ROWSQ1); (void)ws; (void)rowsq1;
    { const int nmt = __builtin_amdgcn_readfirstlane(p.tilee()[MAXMT]);
        if (MOE_FP8) { pg::SchedMoE S{(unsigned)WS_H, (unsigned)WS_WT_DN, p.tilee(), D * DFF, DFF, DFF, nmt, 4, nb, bid}; pg::EpiDn8 E{p.y(), p.b_dn, p.gslot()};
            pg::gemm_phase<pg::EpiDn8, pg::SchedMoE, true, true>(ldsl, ws, pg::Gemm{DFF / 2, DFF / 2, DFF / 2}, S, E); }
        else if (FASTMASK & 128) { pg::SchedMoE S{(unsigned)WS_H, (unsigned)WS_WT_DN, p.tilee(), D * DFF * 2, DFF * 2, DFF * 2, nmt, 4, nb, bid}; pg::EpiDnF E{p.y(), p.b_dn, p.gslot()};
            pg::gemm_phase<pg::EpiDnF, pg::SchedMoE, true>(ldsl, ws, pg::Gemm{DFF, DFF, DFF}, S, E); }
        else ngemm(NG{p.h(), DFF, p.wt_dn(), DFF, nmt * 256, D, DFF, p.tilee(), (size_t)D * DFF}, EpiDn{p.y(), p.b_dn, p.gslot()}, ldsf, bid, nb); }
    }
    SEAM(14);
    if (IN(15)) for (int rep_ = 0; rep_ < REP(15); ++rep_) { if (rep_) GRID_BAR(); asm volatile("" ::: "memory"); P p = make_p((const LAS unsigned*)(ldsl + PT_OFF), a.out, a.ws); asm volatile("" : "+s"(p.ws)); unsigned char* const ws = p.ws; float* const rowsq1 = (float*)(p.ctl() + CW_ROWSQ1); (void)ws; (void)rowsq1;
    phase_final(p, bid, nb);
    }
#undef IN
#undef SEAM
}

extern "C" void kernel_launch(void* const* d_in, const int* in_sizes, int n_in, void* d_out, int out_size, void* d_ws, size_t ws_size, hipStream_t stream) {
    static int grid = 0;
    if (grid == 0) {
        if (n_in != 24 || in_sizes[0] != M * D || out_size != M * D || ws_size < WS_END) { fprintf(stderr, "kernel_launch: unexpected shapes (n_in %d, in0 %d, out %d, ws %zu)\n", n_in, n_in > 0 ? in_sizes[0] : -1, out_size, ws_size); grid = -1; return; }
        int dev = 0, cus = 0;
        if (hipGetDevice(&dev) != hipSuccess || hipDeviceGetAttribute(&cus, hipDeviceAttributeMultiprocessorCount, dev) != hipSuccess) { grid = -1; return; }
        if (hipFuncSetAttribute((const void*)mk_fwd, hipFuncAttributeMaxDynamicSharedMemorySize, LDS_BYTES) != hipSuccess) { fprintf(stderr, "kernel_launch: hipFuncSetAttribute failed\n"); grid = -1; return; }
        if (cus != NBLOCKS) fprintf(stderr, "kernel_launch: device reports %d CUs; this kernel launches %d workgroups (one per CU of a 256-CU device)\n", cus, NBLOCKS);
        grid = NBLOCKS;
    }
    if (grid < 0) return;
    (void)hipMemsetAsync((char*)d_ws + WS_CTL, 0, CTL_BYTES, stream);
    Args a{};
    for (int i = 0; i < 24; ++i) a.in[i] = (const float*)d_in[i];
    a.out = (float*)d_out; a.ws = (unsigned char*)d_ws;
#if defined(MK_PER_PHASE)
    for (int ph = 0; ph < NPHASE; ++ph) { a.ph_lo = ph; a.ph_hi = ph + 1; hipLaunchKernelGGL(mk_fwd, dim3(grid), dim3(NTHREADS), LDS_BYTES, stream, a); }
#else
    a.ph_lo = 0; a.ph_hi = NPHASE; hipLaunchKernelGGL(mk_fwd, dim3(grid), dim3(NTHREADS), LDS_BYTES, stream, a);
#endif
}
```

```cpp
#include <hip/hip_runtime.h>
#include <cstdio>
#include <cstdint>

#define LAS __attribute__((address_space(3)))
typedef unsigned short bf16;
typedef float f32x4 __attribute__((ext_vector_type(4)));
typedef unsigned u32x4 __attribute__((ext_vector_type(4)));
typedef unsigned u32x2 __attribute__((ext_vector_type(2)));
typedef int i32x4g __attribute__((ext_vector_type(4)));

constexpr int BATCH = 2, SEQ = 8192, M = BATCH * SEQ, D = 1024;
constexpr int IN_COLS = 2064, NZ = 2304;
constexpr int ZQ = 512, ZK = 768, ZV = 1024, ZR = 1536, ZG = 2048;
constexpr int NE = 32, TOPK = 4, DFF = 1024, MEMLEN = 256;
constexpr int NASSIGN = M * TOPK, MAXSLOT = NASSIGN + NE * 256, MAXMT = MAXSLOT / 256;
constexpr int NCHUNK = SEQ / 64;
constexpr float EPS = 1e-6f;
constexpr int NTHREADS = 512, NWAVES = 8, NBLOCKS = 256;

constexpr size_t MiB = 1u << 20;
constexpr size_t WS_CTL = 0, CTL_BYTES = 1 * MiB;
constexpr size_t WS_WT_OUT = 2 * MiB, WS_WT_XQ = 4 * MiB, WS_WT_XK = 6 * MiB, WS_WT_XV = 8 * MiB, WS_WT_XO = 10 * MiB, WS_WT_IN = 12 * MiB;
constexpr size_t WS_SMALL = 17 * MiB;
constexpr size_t WS_RS2 = WS_SMALL, WS_TOPI = WS_SMALL + 64 * 1024, WS_TOPG = WS_TOPI + 256 * 1024, WS_SLOTOF = WS_TOPG + 256 * 1024,
                 WS_GSLOT = WS_SLOTOF + 256 * 1024, WS_TILEE = WS_GSLOT + 320 * 1024, WS_BLKCNT = WS_TILEE + 4096, WS_WAVEBASE = WS_BLKCNT + 32768;
constexpr size_t WS_WT_GU = 20 * MiB, WS_WT_DN = 148 * MiB, WS_X2 = 212 * MiB, WS_B = 276 * MiB;
constexpr size_t WS_XN = WS_B, WS_HM = WS_B + 32 * MiB, WS_Z1 = WS_B + 33 * MiB, WS_MIX = WS_B + 121 * MiB, WS_SPREV = WS_B + 153 * MiB,
                 WS_DS = WS_B + 185 * MiB, WS_DEC = WS_B + 217 * MiB, WS_X1 = WS_B + 218 * MiB, WS_A2 = WS_B + 282 * MiB, WS_KX = WS_B + 314 * MiB, WS_VXT = WS_B + 315 * MiB;
constexpr size_t WS_QX = WS_Z1, WS_PX = WS_Z1 + 32 * MiB, WS_SC = WS_MIX, WS_OX = WS_DS;
constexpr size_t WS_XS = WS_B, WS_H = WS_B + 144 * MiB, WS_Y = WS_B + 288 * MiB, WS_END = WS_B + 432 * MiB;
constexpr int CW_BAR = 4096, CW_COUNT = 8192, CW_CURSOR = 8256, CW_ROWSQ1 = 16384;

__device__ __forceinline__ float bf_lo(unsigned w) { return __uint_as_float(w << 16); }
__device__ __forceinline__ float bf_hi(unsigned w) { return __uint_as_float(w & 0xffff0000u); }
__device__ __forceinline__ float bf2f(bf16 v) { return __uint_as_float((unsigned)v << 16); }
__device__ __forceinline__ unsigned f2bf(float f) { unsigned u = __float_as_uint(f); return (u + 0x7fffu + ((u >> 16) & 1u)) >> 16; }
typedef float f32x2_t __attribute__((ext_vector_type(2)));
typedef __bf16 bf16x2_t __attribute__((ext_vector_type(2)));
__device__ __forceinline__ unsigned pk2(float lo, float hi) { const f32x2_t v = {lo, hi}; return __builtin_bit_cast(unsigned, __builtin_convertvector(v, bf16x2_t)); }
__device__ __forceinline__ float wave_sum(float v) {
#pragma unroll
    for (int o = 1; o < 64; o <<= 1) v += __shfl_xor(v, o);
    return v;
}
__device__ __forceinline__ float clamp8(float v) { return fminf(fmaxf(v, -448.f), 448.f); }
__device__ __forceinline__ unsigned pk4_fp8(float a, float b, float c, float d) { int w = __builtin_amdgcn_cvt_pk_fp8_f32(clamp8(a), clamp8(b), 0, false); w = __builtin_amdgcn_cvt_pk_fp8_f32(clamp8(c), clamp8(d), w, true); return (unsigned)w; }
constexpr float W8_SCALE = 32.f, W8_INV = 1.f / 32.f;
#ifndef MOE_FP8
#define MOE_FP8 1
#endif
__device__ __forceinline__ float logsigmoid(float x) { return fminf(x, 0.f) - log1pf(expf(-fabsf(x))); }

struct P {
    const float *x, *mem, *g_mix, *w_in, *w_pool, *pool_scale, *w_gate_up, *b_gate_up, *gla_g, *w_out, *g_xattn, *g_mem, *w_xq, *w_xk, *w_xv, *w_xo,
                *g_moe, *w_router, *b_router, *w_gu, *b_gu, *w_dn, *b_dn, *g_final;
    float* out; unsigned char* ws;
#define PACC(type, name, off) __device__ __forceinline__ type* name() const { return (type*)(ws + (off)); }
    PACC(unsigned, ctl, WS_CTL)
    PACC(bf16, wt_in, WS_WT_IN) PACC(bf16, wt_out, WS_WT_OUT) PACC(bf16, wt_xq, WS_WT_XQ) PACC(bf16, wt_xk, WS_WT_XK) PACC(bf16, wt_xv, WS_WT_XV) PACC(bf16, wt_xo, WS_WT_XO) PACC(bf16, wt_gu, WS_WT_GU) PACC(bf16, wt_dn, WS_WT_DN)
    PACC(bf16, xn, WS_XN) PACC(bf16, hm, WS_HM) PACC(bf16, z1, WS_Z1) PACC(bf16, mix, WS_MIX) PACC(bf16, a2, WS_A2) PACC(bf16, kx, WS_KX) PACC(bf16, vxt, WS_VXT)
    PACC(bf16, qx, WS_QX) PACC(bf16, px, WS_PX) PACC(bf16, ox, WS_OX) PACC(bf16, xs, WS_XS) PACC(bf16, h, WS_H) PACC(bf16, y, WS_Y)
    PACC(float, sprev, WS_SPREV) PACC(float, ds, WS_DS) PACC(float, dec, WS_DEC) PACC(float, x1, WS_X1) PACC(float, x2, WS_X2) PACC(float, sc, WS_SC)
    PACC(float, rs2, WS_RS2) PACC(float, topg, WS_TOPG) PACC(float, gslot, WS_GSLOT) PACC(int, topi, WS_TOPI) PACC(int, slotof, WS_SLOTOF) PACC(int, tilee, WS_TILEE)
#undef PACC
};

struct MapId { __device__ __forceinline__ int operator()(int n) const { return n; } };
struct MapIn { __device__ __forceinline__ int operator()(int n) const { return n < 1536 ? n : (n < 2048 ? 1552 + (n - 1536) : (n < 2064 ? 1536 + (n - 2048) : -1)); } };
struct MapGu { __device__ __forceinline__ int operator()(int n) const { const int pn = n >> 8, w = n & 255; return w < 128 ? pn * 128 + w : 1024 + pn * 128 + (w - 128); } };

template <class Map>
__device__ __forceinline__ void transpose_item(const float* W, int ldw, int K, bf16* WT, float* scr, int kb, int nb, int lane, Map map) {
    const int k0 = 64 * kb, n0 = 32 * nb;
    const int sc = map(n0 + (lane & 31));
#pragma unroll 8
    for (int i = 0; i < 32; ++i) { const int kk = 2 * i + (lane >> 5); scr[kk * 33 + (lane & 31)] = sc >= 0 ? W[(size_t)(k0 + kk) * ldw + sc] : 0.f; }
    __builtin_amdgcn_s_waitcnt(0xC07F); asm volatile("" ::: "memory");
    const int c = lane & 7;
#pragma unroll
    for (int j = 0; j < 4; ++j) { const int n = (lane >> 3) + 8 * j; const float* s = scr + (8 * c) * 33 + n;
        u32x4 o; o.x = pk2(s[0 * 33], s[1 * 33]); o.y = pk2(s[2 * 33], s[3 * 33]); o.z = pk2(s[4 * 33], s[5 * 33]); o.w = pk2(s[6 * 33], s[7 * 33]);
        *(u32x4*)(WT + (size_t)(n0 + n) * K + k0 + 8 * c) = o; }
    __builtin_amdgcn_s_waitcnt(0xC07F); asm volatile("" ::: "memory");
}
template <class Map>
__device__ __forceinline__ void transpose_item8(const float* W, int ldw, int K, unsigned char* WT, float* scr, int kb, int nb, int lane, Map map, float scale) {
    const int k0 = 128 * kb, n0 = 32 * nb;
    const int sc = map(n0 + (lane & 31));
#pragma unroll 8
    for (int i = 0; i < 64; ++i) { const int kk = 2 * i + (lane >> 5); scr[kk * 33 + (lane & 31)] = W[(size_t)(k0 + kk) * ldw + sc] * scale; }
    __builtin_amdgcn_s_waitcnt(0xC07F); asm volatile("" ::: "memory");
    const int c = lane & 7;
#pragma unroll
    for (int j = 0; j < 4; ++j) { const int n = (lane >> 3) + 8 * j; const float* s = scr + (16 * c) * 33 + n;
        u32x4 o; o.x = pk4_fp8(s[0 * 33], s[1 * 33], s[2 * 33], s[3 * 33]); o.y = pk4_fp8(s[4 * 33], s[5 * 33], s[6 * 33], s[7 * 33]);
        o.z = pk4_fp8(s[8 * 33], s[9 * 33], s[10 * 33], s[11 * 33]); o.w = pk4_fp8(s[12 * 33], s[13 * 33], s[14 * 33], s[15 * 33]);
        *(u32x4*)(WT + (size_t)(n0 + n) * K + k0 + 16 * c) = o; }
    __builtin_amdgcn_s_waitcnt(0xC07F); asm volatile("" ::: "memory");
}
template <class Dst, int MODE = 0>
__device__ __forceinline__ void conv8_item(const float* W, int ldw, int K, unsigned char* WT, unsigned char* tile, int kb, int nb, int lane, Dst dst, float scale) {
    const int k0 = 64 * kb, n0 = 256 * nb;
    const float* src = W + (size_t)k0 * ldw + n0 + 4 * lane;
#pragma unroll 1
    for (int c = 0; c < 4; c += 2) {
        f32x4 v[32];
#pragma unroll
        for (int i = 0; i < 32; ++i) { if (MODE == 2) v[i] = (f32x4){0.f, 0.f, 0.f, 0.f}; else v[i] = __builtin_nontemporal_load((const f32x4*)(src + (size_t)(16 * c + i) * ldw)); }
        if (MODE == 1) {
#pragma unroll
            for (int i = 0; i < 32; ++i) asm volatile("" :: "v"(v[i]));
            continue; }
#pragma unroll
        for (int h = 0; h < 2; ++h)
#pragma unroll
            for (int j = 0; j < 4; ++j) { u32x4 o;
                o.x = pk4_fp8(v[16 * h + 0][j] * scale, v[16 * h + 1][j] * scale, v[16 * h + 2][j] * scale, v[16 * h + 3][j] * scale);
                o.y = pk4_fp8(v[16 * h + 4][j] * scale, v[16 * h + 5][j] * scale, v[16 * h + 6][j] * scale, v[16 * h + 7][j] * scale);
                o.z = pk4_fp8(v[16 * h + 8][j] * scale, v[16 * h + 9][j] * scale, v[16 * h + 10][j] * scale, v[16 * h + 11][j] * scale);
                o.w = pk4_fp8(v[16 * h + 12][j] * scale, v[16 * h + 13][j] * scale, v[16 * h + 14][j] * scale, v[16 * h + 15][j] * scale);
                const int r = 4 * lane + j, pc = (c + h) ^ (lane & 3);
                *(u32x4*)(tile + r * 64 + pc * 16) = o; }
    }
    if (MODE == 1) return;
#pragma unroll 4
    for (int s = 0; s < 16; ++s) { const int r = 16 * s + (lane >> 2), pc = (lane & 3) ^ ((r >> 2) & 3);
        const u32x4 o = *(const u32x4*)(tile + r * 64 + pc * 16);
        *(u32x4*)(WT + (size_t)dst(n0 + r) * K + k0 + 16 * (lane & 3)) = o; }
}
struct DstId { __device__ __forceinline__ int operator()(int n) const { return n; } };
struct DstGu { __device__ __forceinline__ int operator()(int n) const { const int up = n >> 10, ff = n & 1023; return (ff >> 7) * 256 + up * 128 + (ff & 127); } };
template <int NR>
__device__ __forceinline__ void rms_rows_bf16(const float* xrow, const float* g, bf16* orow, size_t rstride, int lane) {
    f32x4 v[NR][4]; float s[NR];
#pragma unroll
    for (int r = 0; r < NR; ++r)
#pragma unroll
        for (int j = 0; j < 4; ++j) v[r][j] = *((const f32x4*)(xrow + r * rstride) + lane + 64 * j);
#pragma unroll
    for (int r = 0; r < NR; ++r) { s[r] = 0.f;
#pragma unroll
        for (int j = 0; j < 4; ++j) s[r] += (v[r][j].x * v[r][j].x + v[r][j].y * v[r][j].y) + (v[r][j].z * v[r][j].z + v[r][j].w * v[r][j].w); }
#pragma unroll
    for (int o = 1; o < 64; o <<= 1)
#pragma unroll
        for (int r = 0; r < NR; ++r) s[r] += __shfl_xor(s[r], o);
    const f32x4* gr = (const f32x4*)g + lane;
#pragma unroll
    for (int r = 0; r < NR; ++r) { const float rs = 1.0f / sqrtf(s[r] * (1.f / D) + EPS); u32x2* o8 = (u32x2*)(orow + r * rstride) + lane;
#pragma unroll
        for (int j = 0; j < 4; ++j) { const f32x4 gg = gr[64 * j]; u32x2 w; w.x = pk2(v[r][j].x * rs * gg.x, v[r][j].y * rs * gg.y); w.y = pk2(v[r][j].z * rs * gg.z, v[r][j].w * rs * gg.w); o8[64 * j] = w; } }
}
#ifndef PROBE_PRO
#define PROBE_PRO 0
#endif
__device__ __forceinline__ void phase_prologue(const P& p, float* ldsf, int bid, int nb) {
    const int tid = threadIdx.x, lane = tid & 63, wave = tid >> 6;
    float* scr = ldsf + wave * (128 * 33);
    const int gw = bid * NWAVES + wave, NGW = nb * NWAVES;
    constexpr int I_IN = 16 * (NZ / 32), I_SQ = 16 * 32, I_GU = MOE_FP8 ? 16 * 8 : 16 * 64, I_DN = MOE_FP8 ? 16 * 4 : 16 * 32;
    for (int rep = 0; rep < ((PROBE_PRO & 1) ? 2 : 1); ++rep)
    for (int it = gw; it < I_IN + 5 * I_SQ; it += NGW) {
        int r = it;
        if (r < I_IN) { transpose_item(p.w_in, IN_COLS, D, p.wt_in(), scr, r / (NZ / 32), r % (NZ / 32), lane, MapIn()); continue; } r -= I_IN;
        { const int w = r / I_SQ, q = r % I_SQ; const float* src = w == 0 ? p.w_out : w == 1 ? p.w_xq : w == 2 ? p.w_xk : w == 3 ? p.w_xv : p.w_xo;
            bf16* dst = w == 0 ? p.wt_out() : w == 1 ? p.wt_xq() : w == 2 ? p.wt_xk() : w == 3 ? p.wt_xv() : p.wt_xo();
            transpose_item(src, D, D, dst, scr, q / 32, q % 32, lane, MapId()); }
    }
    for (int rep = 0; rep < ((PROBE_PRO & 2) ? 2 : 1); ++rep)
    for (int it = gw; it < NE * (I_GU + I_DN); it += NGW) {
        int r = it;
        if (r < NE * I_GU) { const int e = r / I_GU, q = r % I_GU;
            if (MOE_FP8) conv8_item(p.w_gu + (size_t)e * D * 2 * DFF, 2 * DFF, D, (unsigned char*)p.wt_gu() + (size_t)e * 2 * DFF * D, (unsigned char*)scr, q / 8, q % 8, lane, DstGu(), W8_SCALE);
            else transpose_item(p.w_gu + (size_t)e * D * 2 * DFF, 2 * DFF, D, p.wt_gu() + (size_t)e * 2 * DFF * D, scr, q / 64, q % 64, lane, MapGu()); continue; } r -= NE * I_GU;
        { const int e = r / I_DN, q = r % I_DN;
            if (MOE_FP8) conv8_item(p.w_dn + (size_t)e * DFF * D, D, DFF, (unsigned char*)p.wt_dn() + (size_t)e * D * DFF, (unsigned char*)scr, q / 4, q % 4, lane, DstId(), W8_SCALE);
            else transpose_item(p.w_dn + (size_t)e * DFF * D, D, DFF, p.wt_dn() + (size_t)e * D * DFF, scr, q / 32, q % 32, lane, MapId()); }
    }
    if (PROBE_PRO & 24)
    for (int it = gw; it < NE * (I_GU + I_DN); it += NGW) {
        int r = it;
        if (r < NE * I_GU) { const int e = r / I_GU, q = r % I_GU;
            if (PROBE_PRO & 8) conv8_item<DstGu, 1>(p.w_gu + (size_t)e * D * 2 * DFF, 2 * DFF, D, (unsigned char*)p.wt_gu() + (size_t)e * 2 * DFF * D, (unsigned char*)scr, q / 8, q % 8, lane, DstGu(), W8_SCALE);
            else conv8_item<DstGu, 2>(p.w_gu + (size_t)e * D * 2 * DFF, 2 * DFF, D, p.ws + WS_END + (size_t)e * 2 * DFF * D, (unsigned char*)scr, q / 8, q % 8, lane, DstGu(), W8_SCALE); continue; } r -= NE * I_GU;
        { const int e = r / I_DN, q = r % I_DN;
            if (PROBE_PRO & 8) conv8_item<DstId, 1>(p.w_dn + (size_t)e * DFF * D, D, DFF, (unsigned char*)p.wt_dn() + (size_t)e * D * DFF, (unsigned char*)scr, q / 4, q % 4, lane, DstId(), W8_SCALE);
            else conv8_item<DstId, 2>(p.w_dn + (size_t)e * DFF * D, D, DFF, p.ws + WS_END + 64 * MiB + (size_t)e * D * DFF, (unsigned char*)scr, q / 4, q % 4, lane, DstId(), W8_SCALE); }
    }
    for (int rep = 0; rep < ((PROBE_PRO & 4) ? 2 : 1); ++rep) {
    for (int m = gw * 4; m < M; m += NGW * 4) rms_rows_bf16<4>(p.x + (size_t)m * D, p.g_mix, p.xn() + (size_t)m * D, D, lane);
    for (int m = gw; m < BATCH * MEMLEN; m += NGW) rms_rows_bf16<1>(p.mem + (size_t)m * D, p.g_mem, p.hm() + (size_t)m * D, D, lane);
    }
}

struct NG { const bf16* A; int lda; const bf16* Bt; int ldb; int Mr, N, K; const int* tile_e; size_t sBe; };
template <class Epi>
__device__ __forceinline__ void ngemm(const NG g, const Epi& E, float* lds, int bid, int nb) {
    float* As = lds; float* Bs = lds + 32 * 128;
    const int tid = threadIdx.x, tr = tid >> 4, tc = tid & 15;
    const int nMt = g.Mr / 128, nNt = g.N / 256;
    for (int u = bid; u < nMt * nNt; u += nb) {
        const int mt = u / nNt, nt = u % nNt, row0 = mt * 128, col0 = nt * 256;
        int e = 0; const bf16* Bt = g.Bt;
        if (g.tile_e) { e = g.tile_e[row0 >> 8]; Bt += (size_t)e * g.sBe; }
        float acc[4][16];
#pragma unroll
        for (int i = 0; i < 4; ++i)
#pragma unroll
            for (int j = 0; j < 16; ++j) acc[i][j] = 0.f;
        for (int k0 = 0; k0 < g.K; k0 += 32) {
            __syncthreads();
            { const int r = tid >> 2, kk = (tid & 3) * 8;
              const u32x4 v = *(const u32x4*)(g.A + (size_t)(row0 + r) * g.lda + k0 + kk);
              As[(kk + 0) * 128 + r] = bf_lo(v.x); As[(kk + 1) * 128 + r] = bf_hi(v.x); As[(kk + 2) * 128 + r] = bf_lo(v.y); As[(kk + 3) * 128 + r] = bf_hi(v.y);
              As[(kk + 4) * 128 + r] = bf_lo(v.z); As[(kk + 5) * 128 + r] = bf_hi(v.z); As[(kk + 6) * 128 + r] = bf_lo(v.w); As[(kk + 7) * 128 + r] = bf_hi(v.w);
#pragma unroll
              for (int h = 0; h < 2; ++h) { const int rb = r + 128 * h;
                const u32x4 w = *(const u32x4*)(Bt + (size_t)(col0 + rb) * g.ldb + k0 + kk);
                Bs[(kk + 0) * 256 + rb] = bf_lo(w.x); Bs[(kk + 1) * 256 + rb] = bf_hi(w.x); Bs[(kk + 2) * 256 + rb] = bf_lo(w.y); Bs[(kk + 3) * 256 + rb] = bf_hi(w.y);
                Bs[(kk + 4) * 256 + rb] = bf_lo(w.z); Bs[(kk + 5) * 256 + rb] = bf_hi(w.z); Bs[(kk + 6) * 256 + rb] = bf_lo(w.w); Bs[(kk + 7) * 256 + rb] = bf_hi(w.w); } }
            __syncthreads();
#pragma unroll 4
            for (int k = 0; k < 32; ++k) {
                const f32x4 a = *(const f32x4*)&As[k * 128 + 4 * tr];
                const f32x4 b0 = *(const f32x4*)&Bs[k * 256 + tc * 8], b1 = *(const f32x4*)&Bs[k * 256 + tc * 8 + 4];
                const f32x4 b2 = *(const f32x4*)&Bs[k * 256 + 128 + tc * 8], b3 = *(const f32x4*)&Bs[k * 256 + 128 + tc * 8 + 4];
#pragma unroll
                for (int i = 0; i < 4; ++i) {
#pragma unroll
                    for (int j = 0; j < 4; ++j) { acc[i][j] += a[i] * b0[j]; acc[i][4 + j] += a[i] * b1[j]; acc[i][8 + j] += a[i] * b2[j]; acc[i][12 + j] += a[i] * b3[j]; }
                }
            }
        }
#pragma unroll
        for (int i = 0; i < 4; ++i)
#pragma unroll
            for (int j = 0; j < 8; ++j) E(e, row0 + 4 * tr + i, col0 + tc * 8 + j, acc[i][j], acc[i][8 + j]);
    }
}
struct EpiBf { bf16* C; int ldc; __device__ __forceinline__ void operator()(int, int r, int c, float a, float b) const { C[(size_t)r * ldc + c] = (bf16)f2bf(a); C[(size_t)r * ldc + c + 128] = (bf16)f2bf(b); } };
struct EpiF32 { float* C; int ldc; __device__ __forceinline__ void operator()(int, int r, int c, float a, float b) const { C[(size_t)r * ldc + c] = a; C[(size_t)r * ldc + c + 128] = b; } };
struct EpiOut { const float* x; float* x1; bf16* a2; const float* g; float* rowsq;
    __device__ __forceinline__ void one(int r, int c, float a) const { const size_t o = (size_t)r * D + c; const float v = x[o] + a; x1[o] = v; a2[o] = (bf16)f2bf(v * g[c]); atomicAdd(rowsq + r, v * v); }
    __device__ __forceinline__ void operator()(int, int r, int c, float a, float b) const { one(r, c, a); one(r, c + 128, b); } };
struct EpiQ { bf16* q; const float* rowsq;
    __device__ __forceinline__ void operator()(int, int r, int c, float a, float b) const { const float s = 0.0625f / sqrtf(rowsq[r] * (1.f / D) + EPS); q[(size_t)r * D + c] = (bf16)f2bf(a * s); q[(size_t)r * D + c + 128] = (bf16)f2bf(b * s); } };
struct EpiRes { const float* base; float* o; __device__ __forceinline__ void operator()(int, int r, int c, float a, float b) const { const size_t i = (size_t)r * D + c; o[i] = base[i] + a; o[i + 128] = base[i + 128] + b; } };
__device__ __forceinline__ float swiglu(float g, float u) { g = fminf(g, 7.f); u = fminf(fmaxf(u, -7.f), 7.f);
    return g * __builtin_amdgcn_rcpf(1.f + __builtin_amdgcn_exp2f(-1.702f * 1.44269504089f * g)) * (u + 1.f); }
struct EpiUp { bf16* h; const float* b_gu;
    __device__ __forceinline__ void operator()(int e, int r, int c, float a, float b) const { const int ff = (c >> 8) * 128 + (c & 127); const float* bb = b_gu + (size_t)e * 2 * DFF;
        h[(size_t)r * DFF + ff] = (bf16)f2bf(swiglu(a + bb[ff], b + bb[DFF + ff])); } };
struct EpiDn { bf16* y; const float* b_dn; const float* gs;
    __device__ __forceinline__ void operator()(int e, int r, int c, float a, float b) const { const float g = gs[r]; const float* bb = b_dn + (size_t)e * D;
        y[(size_t)r * D + c] = (bf16)f2bf(g * (a + bb[c])); y[(size_t)r * D + c + 128] = (bf16)f2bf(g * (b + bb[c + 128])); } };

__device__ __forceinline__ void phase_pool(const P& p, float* lds, int bid, int nb) {
    float* pt = lds;
    float* wp = lds + 64 * 129;
    const int tid = threadIdx.x;
    for (int u = bid; u < (M / 64) * 4; u += nb) {
        const int g = u & 3, tt = u >> 2, t0 = tt * 64, w = 2 << g;
        __syncthreads();
        for (int i = tid; i < 128 * 128; i += NTHREADS) wp[i] = p.w_pool[(size_t)g * 128 * 128 + i];
        { const int i = tid >> 3, c0 = (tid & 7) * 16, t = t0 + i, s = t & (SEQ - 1);
          const int cnt = (s + 1 < w) ? s + 1 : w;
          float acc[16];
#pragma unroll
          for (int c = 0; c < 16; ++c) acc[c] = 0.f;
          for (int d = 0; d < cnt; ++d) { const bf16* up = p.z1() + (size_t)(t - d) * NZ + g * 128 + c0;
#pragma unroll
              for (int c = 0; c < 16; ++c) acc[c] += bf2f(up[c]); }
          const bf16* u0 = p.z1() + (size_t)t * NZ + g * 128 + c0; const float inv = 1.f / (float)cnt;
#pragma unroll
          for (int c = 0; c < 16; ++c) pt[i * 129 + c0 + c] = acc[c] * inv - bf2f(u0[c]); }
        __syncthreads();
        { const int i = tid >> 3, d0 = (tid & 7) * 16; float acc[16];
#pragma unroll
          for (int c = 0; c < 16; ++c) acc[c] = 0.f;
          for (int c = 0; c < 128; ++c) { const float pv = pt[i * 129 + c];
#pragma unroll
              for (int d = 0; d < 16; ++d) acc[d] += pv * wp[c * 128 + d0 + d]; }
          bf16* o = p.mix() + (size_t)(t0 + i) * D + g * 128 + d0;
#pragma unroll
          for (int d = 0; d < 16; ++d) o[d] = (bf16)f2bf(acc[d] * p.pool_scale[g * 128 + d0 + d]); }
    }
}

__device__ __forceinline__ void gla_gc(const P& p, float* glr, float* wgu, float* gc, int b, int h, int n) {
    const int tid = threadIdx.x, t0 = b * SEQ + n * 64;
    __syncthreads();
    for (int i = tid; i < 64 * 16; i += NTHREADS) glr[i] = bf2f(p.z1()[(size_t)(t0 + (i >> 4)) * NZ + ZG + (i & 15)]);
    for (int i = tid; i < 16 * 64; i += NTHREADS) wgu[i] = p.w_gate_up[(i >> 6) * 256 + h * 64 + (i & 63)];
    __syncthreads();
    for (int idx = tid; idx < 64 * 64; idx += NTHREADS) { const int i = idx >> 6, d = idx & 63; float s = p.b_gate_up[h * 64 + d];
#pragma unroll
        for (int r = 0; r < 16; ++r) s += glr[i * 16 + r] * wgu[r * 64 + d];
        gc[i * 65 + d] = logsigmoid(s) * (1.f / 16.f); }
    __syncthreads();
    if (tid < 64) { float run = 0.f; for (int i = 0; i < 64; ++i) { run += gc[i * 65 + tid]; gc[i * 65 + tid] = run; } }
    __syncthreads();
}
__device__ __forceinline__ void phase_gla_a(const P& p, float* lds, int bid, int nb) {
    float* glr = lds; float* wgu = lds + 1024; float* gc = lds + 2048; float* kd = gc + 64 * 65; float* vv = kd + 64 * 65;
    const int tid = threadIdx.x;
    for (int u = bid; u < 8 * NCHUNK; u += nb) {
        const int bh = u / NCHUNK, n = u % NCHUNK, b = bh >> 2, h = bh & 3, t0 = b * SEQ + n * 64;
        gla_gc(p, glr, wgu, gc, b, h, n);
        for (int idx = tid; idx < 64 * 64; idx += NTHREADS) { const int j = idx >> 6, d = idx & 63;
            kd[j * 65 + d] = bf2f(p.z1()[(size_t)(t0 + j) * NZ + ZK + h * 64 + d]) * expf(gc[63 * 65 + d] - gc[j * 65 + d]); }
        for (int idx = tid; idx < 64 * 128; idx += NTHREADS) { const int j = idx >> 7, e = idx & 127; vv[idx] = bf2f(p.z1()[(size_t)(t0 + j) * NZ + ZV + h * 128 + e]); }
        __syncthreads();
        { const int d = tid >> 3, e0 = (tid & 7) * 16; float acc[16];
#pragma unroll
          for (int e = 0; e < 16; ++e) acc[e] = 0.f;
          for (int j = 0; j < 64; ++j) { const float kv = kd[j * 65 + d];
#pragma unroll
              for (int e = 0; e < 16; ++e) acc[e] += kv * vv[j * 128 + e0 + e]; }
          float* o = p.ds() + ((size_t)u * 64 + d) * 128 + e0;
#pragma unroll
          for (int e = 0; e < 16; ++e) o[e] = acc[e]; }
        if (tid < 64) p.dec()[(size_t)u * 64 + tid] = expf(gc[63 * 65 + tid]);
    }
}
__device__ __forceinline__ void phase_scan(const P& p, int bid, int nb) {
    for (int idx = bid * NTHREADS + threadIdx.x; idx < 8 * 64 * 128; idx += nb * NTHREADS) {
        const int bh = idx >> 13, de = idx & 8191, d = de >> 7;
        float st = 0.f;
        for (int n = 0; n < NCHUNK; ++n) { const size_t u = (size_t)bh * NCHUNK + n;
            p.sprev()[u * 8192 + de] = st; st = p.dec()[u * 64 + d] * st + p.ds()[u * 8192 + de]; }
    }
}
__device__ __forceinline__ void phase_gla_b(const P& p, float* lds, int bid, int nb) {
    float* glr = lds; float* wgu = lds + 1024; float* gc = lds + 2048; float* qe = gc + 64 * 65; float* ke = qe + 64 * 65; float* vv = ke + 64 * 65; float* sp = vv + 64 * 128;
    float* att = gc;
    const int tid = threadIdx.x;
    for (int u = bid; u < 8 * NCHUNK; u += nb) {
        const int bh = u / NCHUNK, n = u % NCHUNK, b = bh >> 2, h = bh & 3, t0 = b * SEQ + n * 64;
        gla_gc(p, glr, wgu, gc, b, h, n);
        for (int idx = tid; idx < 64 * 64; idx += NTHREADS) { const int i = idx >> 6, d = idx & 63; const float g = gc[i * 65 + d];
            qe[i * 65 + d] = bf2f(p.z1()[(size_t)(t0 + i) * NZ + ZQ + h * 64 + d]) * 0.125f * expf(g);
            ke[i * 65 + d] = bf2f(p.z1()[(size_t)(t0 + i) * NZ + ZK + h * 64 + d]) * expf(-g); }
        for (int idx = tid; idx < 64 * 128; idx += NTHREADS) { const int j = idx >> 7, e = idx & 127; vv[idx] = bf2f(p.z1()[(size_t)(t0 + j) * NZ + ZV + h * 128 + e]); sp[idx] = p.sprev()[(size_t)u * 8192 + idx]; }
        __syncthreads();
        { const int i = tid >> 3, j0 = (tid & 7) * 8; float a[8];
#pragma unroll
          for (int j = 0; j < 8; ++j) a[j] = 0.f;
          for (int d = 0; d < 64; ++d) { const float qv = qe[i * 65 + d];
#pragma unroll
              for (int j = 0; j < 8; ++j) a[j] += qv * ke[(j0 + j) * 65 + d]; }
#pragma unroll
          for (int j = 0; j < 8; ++j) att[i * 65 + j0 + j] = (j0 + j <= i) ? a[j] : 0.f; }
        __syncthreads();
        { const int i = tid >> 3, e0 = (tid & 7) * 16; float o[16];
#pragma unroll
          for (int e = 0; e < 16; ++e) o[e] = 0.f;
          for (int j = 0; j < 64; ++j) { const float av = att[i * 65 + j];
#pragma unroll
              for (int e = 0; e < 16; ++e) o[e] += av * vv[j * 128 + e0 + e]; }
          for (int d = 0; d < 64; ++d) { const float qv = qe[i * 65 + d];
#pragma unroll
              for (int e = 0; e < 16; ++e) o[e] += qv * sp[d * 128 + e0 + e]; }
          float ss = 0.f;
#pragma unroll
          for (int e = 0; e < 16; ++e) ss += o[e] * o[e];
          ss += __shfl_xor(ss, 1); ss += __shfl_xor(ss, 2); ss += __shfl_xor(ss, 4);
          const float rs = 1.0f / sqrtf(ss * (1.f / 128.f) + EPS);
          const bf16* rp = p.z1() + (size_t)(t0 + i) * NZ + ZR + h * 128 + e0; bf16* op = p.mix() + (size_t)(t0 + i) * D + 512 + h * 128 + e0;
#pragma unroll
          for (int e = 0; e < 16; ++e) { const float r = bf2f(rp[e]); const float sl = r / (1.f + expf(-r)); op[e] = (bf16)f2bf(o[e] * rs * p.gla_g[e0 + e] * sl); } }
    }
}

__device__ __forceinline__ void phase_softmax(const P& p, int bid, int nb) {
    const int lane = threadIdx.x & 63, gw = bid * NWAVES + (threadIdx.x >> 6), NGW = nb * NWAVES;
    for (int it = gw; it < M * 4; it += NGW) {
        const f32x4 v = *((const f32x4*)(p.sc() + (size_t)it * 256) + lane);
        float m = fmaxf(fmaxf(v.x, v.y), fmaxf(v.z, v.w));
#pragma unroll
        for (int o = 1; o < 64; o <<= 1) m = fmaxf(m, __shfl_xor(m, o));
        const float e0 = expf(v.x - m), e1 = expf(v.y - m), e2 = expf(v.z - m), e3 = expf(v.w - m);
        const float inv = 1.f / wave_sum((e0 + e1) + (e2 + e3));
        u32x2 w; w.x = pk2(e0 * inv, e1 * inv); w.y = pk2(e2 * inv, e3 * inv);
        *((u32x2*)(p.px() + (size_t)it * 256) + lane) = w;
    }
}

__device__ __forceinline__ void phase_router(const P& p, float* lds, int bid, int nb) {
    const int tid = threadIdx.x, lane = tid & 63, gw = bid * NWAVES + (tid >> 6), NGW = nb * NWAVES;
    __syncthreads();
    for (int i = tid; i < D * NE; i += NTHREADS) lds[(i & 31) * D + (i >> 5)] = p.w_router[i];
    __syncthreads();
    for (int t = gw; t < M; t += NGW) {
        const f32x4* xr = (const f32x4*)(p.x2() + (size_t)t * D) + lane; f32x4 v[4]; float s = 0.f;
#pragma unroll
        for (int j = 0; j < 4; ++j) { v[j] = xr[64 * j]; s += (v[j].x * v[j].x + v[j].y * v[j].y) + (v[j].z * v[j].z + v[j].w * v[j].w); }
        const float rs = 1.0f / sqrtf(wave_sum(s) * (1.f / D) + EPS);
#pragma unroll
        for (int j = 0; j < 4; ++j) { const f32x4 gg = *((const f32x4*)p.g_moe + lane + 64 * j); v[j] = v[j] * rs * gg; }
        float mylg = -INFINITY;
#pragma unroll 2
        for (int e = 0; e < NE; ++e) { float a = 0.f;
#pragma unroll
            for (int j = 0; j < 4; ++j) { const f32x4 w = *((const f32x4*)(lds + e * D) + lane + 64 * j); a += (v[j].x * w.x + v[j].y * w.y) + (v[j].z * w.z + v[j].w * w.w); }
            a = wave_sum(a); if (lane == e) mylg = a + p.b_router[e]; }
        int idx[4]; float val[4];
#pragma unroll
        for (int j = 0; j < 4; ++j) { float bv = mylg; int bi = lane;
#pragma unroll
            for (int o = 1; o < 64; o <<= 1) { const float ov = __shfl_xor(bv, o); const int oi = __shfl_xor(bi, o); const bool tk = (ov > bv) || (ov == bv && oi < bi); bv = tk ? ov : bv; bi = tk ? oi : bi; }
            idx[j] = bi; val[j] = bv; if (lane == bi) mylg = -INFINITY; }
        const float e1 = expf(val[1] - val[0]), e2 = expf(val[2] - val[0]), e3 = expf(val[3] - val[0]); const float inv = 1.f / (1.f + e1 + e2 + e3);
        if (lane == 0) { p.rs2()[t] = rs;
            p.topi()[t * 4 + 0] = idx[0]; p.topi()[t * 4 + 1] = idx[1]; p.topi()[t * 4 + 2] = idx[2]; p.topi()[t * 4 + 3] = idx[3];
            p.topg()[t * 4 + 0] = inv; p.topg()[t * 4 + 1] = e1 * inv; p.topg()[t * 4 + 2] = e2 * inv; p.topg()[t * 4 + 3] = e3 * inv;
#pragma unroll
            for (int j = 0; j < 4; ++j) atomicAdd(p.ctl() + CW_COUNT + idx[j], 1u); }
    }
}
__device__ __forceinline__ void phase_dispatch(const P& p, int* ldsi, int bid, int nb) {
    const int tid = threadIdx.x, lane = tid & 63, gw = bid * NWAVES + (tid >> 6), NGW = nb * NWAVES;
    __syncthreads();
    if (tid == 0) { int off = 0; for (int e = 0; e < NE; ++e) { ldsi[e] = off; const int c = (int)p.ctl()[CW_COUNT + e]; const int nt = (c + 255) >> 8;
            if (bid == 0) for (int i = 0; i < nt; ++i) p.tilee()[(off >> 8) + i] = e;
            off += nt << 8; }
        if (bid == 0) p.tilee()[MAXMT] = off >> 8; }
    __syncthreads();
    for (int t = gw; t < M; t += NGW) {
        int slot = 0;
        if (lane < 4) { const int e = p.topi()[t * 4 + lane]; slot = ldsi[e] + (int)atomicAdd(p.ctl() + CW_CURSOR + e, 1u); p.slotof()[t * 4 + lane] = slot; p.gslot()[slot] = p.topg()[t * 4 + lane]; }
        const float rs = p.rs2()[t];
        const f32x4* xr = (const f32x4*)(p.x2() + (size_t)t * D) + lane; u32x2 w[4];
#pragma unroll
        for (int j = 0; j < 4; ++j) { const f32x4 v = xr[64 * j]; const f32x4 gg = *((const f32x4*)p.g_moe + lane + 64 * j);
            w[j].x = pk2(v.x * rs * gg.x, v.y * rs * gg.y); w[j].y = pk2(v.z * rs * gg.z, v.w * rs * gg.w); }
#pragma unroll
        for (int q = 0; q < 4; ++q) { const int sl = __shfl(slot, q); u32x2* o = (u32x2*)(p.xs() + (size_t)sl * D) + lane;
#pragma unroll
            for (int j = 0; j < 4; ++j) o[64 * j] = w[j]; }
    }
}
__device__ __forceinline__ void phase_final(const P& p, int bid, int nb) {
    const int lane = threadIdx.x & 63, gw = bid * NWAVES + (threadIdx.x >> 6), NGW = nb * NWAVES;
    for (int t = gw * 2; t < M; t += NGW * 2) {
        f32x4 v[2][4]; u32x2 yv[2][4][4];
#pragma unroll
        for (int q = 0; q < 2; ++q) { const f32x4* xr = (const f32x4*)(p.x2() + (size_t)(t + q) * D) + lane;
#pragma unroll
            for (int j = 0; j < 4; ++j) v[q][j] = xr[64 * j];
#pragma unroll
            for (int k = 0; k < 4; ++k) { const int sl = p.slotof()[(t + q) * 4 + k]; const u32x2* yr = (const u32x2*)(p.y() + (size_t)sl * D) + lane;
#pragma unroll
                for (int j = 0; j < 4; ++j) yv[q][k][j] = yr[64 * j]; } }
#pragma unroll
        for (int q = 0; q < 2; ++q) {
#pragma unroll
            for (int k = 0; k < 4; ++k)
#pragma unroll
                for (int j = 0; j < 4; ++j) { const u32x2 w = yv[q][k][j]; v[q][j].x += bf_lo(w.x); v[q][j].y += bf_hi(w.x); v[q][j].z += bf_lo(w.y); v[q][j].w += bf_hi(w.y); }
            float s = 0.f;
#pragma unroll
            for (int j = 0; j < 4; ++j) s += (v[q][j].x * v[q][j].x + v[q][j].y * v[q][j].y) + (v[q][j].z * v[q][j].z + v[q][j].w * v[q][j].w);
            const float rs = 1.0f / sqrtf(wave_sum(s) * (1.f / D) + EPS);
            f32x4* o = (f32x4*)(p.out + (size_t)(t + q) * D) + lane;
#pragma unroll
            for (int j = 0; j < 4; ++j) { const f32x4 gg = *((const f32x4*)p.g_final + lane + 64 * j); o[64 * j] = v[q][j] * rs * gg; }
        }
    }
}

typedef short bf16x8 __attribute__((ext_vector_type(8)));
typedef float f32x16 __attribute__((ext_vector_type(16)));
template <int K>
__device__ __forceinline__ void mma_tile(f32x16& acc, const bf16* a, int pa, const bf16* b, int pb, int lane) {
    const int r = lane & 31, hf = lane >> 5;
#pragma unroll
    for (int k0 = 0; k0 < K; k0 += 16) { const bf16x8 av = *(const bf16x8*)(a + r * pa + k0 + 8 * hf); const bf16x8 bv = *(const bf16x8*)(b + r * pb + k0 + 8 * hf);
        acc = __builtin_amdgcn_mfma_f32_32x32x16_bf16(av, bv, acc, 0, 0, 0); }
}
__device__ __forceinline__ int crow(int reg, int hf) { return (reg & 3) + 8 * (reg >> 2) + 4 * hf; }
__device__ __forceinline__ f32x16 zero16() { f32x16 z;
#pragma unroll
    for (int i = 0; i < 16; ++i) z[i] = 0.f;
    return z; }
__device__ __forceinline__ float fast_logsigmoid(float x) { return fminf(x, 0.f) - __logf(1.f + __expf(-fabsf(x))); }

__device__ __forceinline__ void phase_pool2(const P& p, unsigned char* lds, int bid, int nb) {
    bf16* wpT = (bf16*)lds;
    float* ut = (float*)(lds + 34816);
    bf16* pt = (bf16*)(lds + 34816 + 40960);
    const int tid = threadIdx.x, lane = tid & 63, w = tid >> 6;
    int cur_g = -1;
    for (int u = bid; u < (M / 64) * 4; u += nb) {
        const int g = u & 3, t0 = (u >> 2) * 64, win = 2 << g, s0 = t0 & (SEQ - 1);
        __syncthreads();
        if (g != cur_g) { cur_g = g;
            for (int i = tid; i < 128 * 128; i += NTHREADS) { const int c = i >> 7, d = i & 127; wpT[d * 136 + c] = (bf16)f2bf(p.w_pool[(size_t)g * 16384 + i]); } }
        for (int c = tid; c < 80 * 16; c += NTHREADS) { const int r = c >> 4, ch = (c & 15) * 8; const int srel = s0 - 16 + r;
            f32x4 lo = {0.f, 0.f, 0.f, 0.f}, hi = {0.f, 0.f, 0.f, 0.f};
            if (srel >= 0) { const u32x4 v = *(const u32x4*)(p.z1() + (size_t)(t0 - 16 + r) * NZ + g * 128 + ch); lo = (f32x4){bf_lo(v.x), bf_hi(v.x), bf_lo(v.y), bf_hi(v.y)}; hi = (f32x4){bf_lo(v.z), bf_hi(v.z), bf_lo(v.w), bf_hi(v.w)}; }
            *(f32x4*)(ut + r * 128 + ch) = lo; *(f32x4*)(ut + r * 128 + ch + 4) = hi; }
        __syncthreads();
        { const int c = tid & 127, q = tid >> 7, i0 = 16 * q; float sum = 0.f;
          for (int d = 1; d < win; ++d) sum += ut[(16 + i0 - d) * 128 + c];
          for (int ii = 0; ii < 16; ++ii) { const int i = i0 + ii, s = s0 + i; const float uv = ut[(16 + i) * 128 + c]; sum += uv; const int cnt = (s + 1 < win) ? s + 1 : win;
              pt[i * 136 + c] = (bf16)f2bf(sum / (float)cnt - uv); sum -= ut[(16 + i - win + 1) * 128 + c]; } }
        __syncthreads();
        { const int db = w >> 1, ib = w & 1, r = lane & 31, hf = lane >> 5; f32x16 acc = zero16();
          mma_tile<128>(acc, wpT + (db * 32) * 136, 136, pt + (ib * 32) * 136, 136, lane);
          bf16* orow = p.mix() + (size_t)(t0 + ib * 32 + r) * D + g * 128 + db * 32;
#pragma unroll
          for (int rg = 0; rg < 4; ++rg) { const int d0 = 8 * rg + 4 * hf; const f32x4 sc = *(const f32x4*)(p.pool_scale + g * 128 + db * 32 + d0);
              u32x2 o; o.x = pk2(acc[4 * rg] * sc.x, acc[4 * rg + 1] * sc.y); o.y = pk2(acc[4 * rg + 2] * sc.z, acc[4 * rg + 3] * sc.w); *(u32x2*)(orow + d0) = o; } }
    }
}

__device__ __forceinline__ void gla_gc2(const P& p, float* glr, float* wtot, int t0, int h, float (&gcl)[8], float& tot) {
    const int tid = threadIdx.x, d = tid & 63, w = tid >> 6;
    __syncthreads();
    for (int i = tid; i < 64 * 16; i += NTHREADS) glr[i] = bf2f(p.z1()[(size_t)(t0 + (i >> 4)) * NZ + ZG + (i & 15)]);
    float wg[16];
#pragma unroll
    for (int r = 0; r < 16; ++r) wg[r] = p.w_gate_up[r * 256 + h * 64 + d];
    const float bias = p.b_gate_up[h * 64 + d];
    __syncthreads();
    float run = 0.f;
#pragma unroll
    for (int ii = 0; ii < 8; ++ii) { const float* gr = glr + (8 * w + ii) * 16; float s = bias;
#pragma unroll
        for (int r = 0; r < 16; ++r) s += gr[r] * wg[r];
        run += fast_logsigmoid(s) * (1.f / 16.f); gcl[ii] = run; }
    wtot[w * 64 + d] = run;
    __syncthreads();
    float pre = 0.f; tot = 0.f;
#pragma unroll
    for (int ww = 0; ww < 8; ++ww) { const float v = wtot[ww * 64 + d]; pre += (ww < w) ? v : 0.f; tot += v; }
#pragma unroll
    for (int ii = 0; ii < 8; ++ii) gcl[ii] += pre;
}
__device__ __forceinline__ void load_vT(const P& p, bf16* vT, int t0, int colbase) {
    const int tid = threadIdx.x, e = tid & 127, jb = tid >> 7; unsigned short v[16];
#pragma unroll
    for (int jj = 0; jj < 16; ++jj) v[jj] = p.z1()[(size_t)(t0 + 16 * jb + jj) * NZ + colbase + e];
    u32x4 a, b; a.x = v[0] | (v[1] << 16); a.y = v[2] | (v[3] << 16); a.z = v[4] | (v[5] << 16); a.w = v[6] | (v[7] << 16);
    b.x = v[8] | (v[9] << 16); b.y = v[10] | (v[11] << 16); b.z = v[12] | (v[13] << 16); b.w = v[14] | (v[15] << 16);
    *(u32x4*)(vT + e * 72 + 16 * jb) = a; *(u32x4*)(vT + e * 72 + 16 * jb + 8) = b;
}
__device__ __forceinline__ void phase_gla_a2(const P& p, unsigned char* lds, int bid, int nb) {
    float* glr = (float*)lds; float* wtot = (float*)(lds + 4096); bf16* kdT = (bf16*)(lds + 8192); bf16* vT = (bf16*)(lds + 8192 + 9216);
    const int tid = threadIdx.x, lane = tid & 63, w = tid >> 6, d = tid & 63;
    for (int u = bid; u < 8 * NCHUNK; u += nb) {
        const int bh = u / NCHUNK, n = u % NCHUNK, b = bh >> 2, h = bh & 3, t0 = b * SEQ + n * 64;
        float gcl[8], tot; gla_gc2(p, glr, wtot, t0, h, gcl, tot);
        { unsigned pk[4];
#pragma unroll
          for (int ii = 0; ii < 8; ii += 2) { const float k0 = bf2f(p.z1()[(size_t)(t0 + 8 * w + ii) * NZ + ZK + h * 64 + d]) * __expf(tot - gcl[ii]);
              const float k1 = bf2f(p.z1()[(size_t)(t0 + 8 * w + ii + 1) * NZ + ZK + h * 64 + d]) * __expf(tot - gcl[ii + 1]); pk[ii >> 1] = pk2(k0, k1); }
          *(u32x4*)(kdT + d * 72 + 8 * w) = (u32x4){pk[0], pk[1], pk[2], pk[3]}; }
        if (w == 0) p.dec()[(size_t)u * 64 + d] = __expf(tot);
        load_vT(p, vT, t0, ZV + h * 128);
        __syncthreads();
        { const int eb = w >> 1, db = w & 1, r = lane & 31, hf = lane >> 5; f32x16 acc = zero16();
          mma_tile<64>(acc, vT + (eb * 32) * 72, 72, kdT + (db * 32) * 72, 72, lane);
          float* o = p.ds() + (size_t)u * 8192 + db * 32 + r;
#pragma unroll
          for (int reg = 0; reg < 16; ++reg) o[(eb * 32 + crow(reg, hf)) * 64] = acc[reg]; }
    }
}
__device__ __forceinline__ void phase_scan2(const P& p, int bid, int nb) {
    bf16* sp = (bf16*)p.sprev();
    if (threadIdx.x < 256)
    for (int idx = bid * 256 + threadIdx.x; idx < 8 * 8192; idx += nb * 256) {
        const int bh = idx >> 13, ed = idx & 8191, d = ed & 63; float st = 0.f;
        for (int n0 = 0; n0 < NCHUNK; n0 += 8) { float dv[8], dc[8];
#pragma unroll
            for (int k = 0; k < 8; ++k) { const size_t u = (size_t)bh * NCHUNK + n0 + k; dv[k] = p.ds()[u * 8192 + ed]; dc[k] = p.dec()[u * 64 + d]; }
#pragma unroll
            for (int k = 0; k < 8; ++k) { const size_t u = (size_t)bh * NCHUNK + n0 + k; sp[u * 8192 + ed] = (bf16)f2bf(st); st = dc[k] * st + dv[k]; } }
    }
}
__device__ __forceinline__ void phase_gla_b2(const P& p, unsigned char* lds, int bid, int nb) {
    float* glr = (float*)lds; float* wtot = (float*)(lds + 4096); float* ssq = (float*)(lds + 6144);
    bf16* qe = (bf16*)(lds + 8192); bf16* ke = qe + 64 * 72; bf16* att = ke + 64 * 72; bf16* vT = att + 64 * 72; bf16* spT = vT + 128 * 72;
    const bf16* sp = (const bf16*)p.sprev();
    const int tid = threadIdx.x, lane = tid & 63, w = tid >> 6, d = tid & 63, r = lane & 31, hf = lane >> 5;
    for (int u = bid; u < 8 * NCHUNK; u += nb) {
        const int bh = u / NCHUNK, n = u % NCHUNK, b = bh >> 2, h = bh & 3, t0 = b * SEQ + n * 64;
        float gcl[8], tot; gla_gc2(p, glr, wtot, t0, h, gcl, tot);
#pragma unroll
        for (int ii = 0; ii < 8; ++ii) { const int i = 8 * w + ii; const size_t zo = (size_t)(t0 + i) * NZ + h * 64 + d;
            qe[i * 72 + d] = (bf16)f2bf(bf2f(p.z1()[zo + ZQ]) * 0.125f * __expf(gcl[ii])); ke[i * 72 + d] = (bf16)f2bf(bf2f(p.z1()[zo + ZK]) * __expf(-gcl[ii])); }
        load_vT(p, vT, t0, ZV + h * 128);
        for (int c = tid; c < 1024; c += NTHREADS) { const int e = c >> 3, d8 = (c & 7) * 8; *(u32x4*)(spT + e * 72 + d8) = *(const u32x4*)(sp + (size_t)u * 8192 + e * 64 + d8); }
        __syncthreads();
        if (w < 4) { const int ib = w & 1, jb = w >> 1; f32x16 acc = zero16();
            if (jb <= ib) mma_tile<64>(acc, qe + (ib * 32) * 72, 72, ke + (jb * 32) * 72, 72, lane);
#pragma unroll
            for (int reg = 0; reg < 16; ++reg) { const int i = ib * 32 + crow(reg, hf), j = jb * 32 + r; att[i * 72 + j] = (bf16)f2bf(j <= i ? acc[reg] : 0.f); } }
        __syncthreads();
        { const int eb = w >> 1, ib = w & 1, i = ib * 32 + r; f32x16 acc = zero16();
          mma_tile<64>(acc, vT + (eb * 32) * 72, 72, att + (ib * 32) * 72, 72, lane);
          mma_tile<64>(acc, spT + (eb * 32) * 72, 72, qe + (ib * 32) * 72, 72, lane);
          float ss = 0.f;
#pragma unroll
          for (int reg = 0; reg < 16; ++reg) ss += acc[reg] * acc[reg];
          ss += __shfl_xor(ss, 32);
          if (hf == 0) ssq[eb * 64 + i] = ss;
          __syncthreads();
          const float rs = 1.0f / sqrtf((ssq[i] + ssq[64 + i] + ssq[128 + i] + ssq[192 + i]) * (1.f / 128.f) + EPS);
          const bf16* rp = p.z1() + (size_t)(t0 + i) * NZ + ZR + h * 128 + eb * 32; bf16* op = p.mix() + (size_t)(t0 + i) * D + 512 + h * 128 + eb * 32;
#pragma unroll
          for (int rg = 0; rg < 4; ++rg) { const int e0 = 8 * rg + 4 * hf; const u32x2 rv = *(const u32x2*)(rp + e0); const f32x4 gg = *(const f32x4*)(p.gla_g + eb * 32 + e0);
              const float r0 = bf_lo(rv.x), r1 = bf_hi(rv.x), r2 = bf_lo(rv.y), r3 = bf_hi(rv.y);
              const float o0 = acc[4 * rg] * rs * gg.x * (r0 / (1.f + __expf(-r0))), o1 = acc[4 * rg + 1] * rs * gg.y * (r1 / (1.f + __expf(-r1)));
              const float o2 = acc[4 * rg + 2] * rs * gg.z * (r2 / (1.f + __expf(-r2))), o3 = acc[4 * rg + 3] * rs * gg.w * (r3 / (1.f + __expf(-r3)));
              u32x2 o; o.x = pk2(o0, o1); o.y = pk2(o2, o3); *(u32x2*)(op + e0) = o; } }
    }
}

__device__ __forceinline__ void phase_router2(const P& p, float* lds, int* blkcnt, int* wavebase, int bid, int nb) {
    const int tid = threadIdx.x, lane = tid & 63, w = tid >> 6;
    constexpr int RP = D + 4;
    int* cntw = (int*)(lds + NE * RP);
    __syncthreads();
    for (int i = tid; i < D * NE; i += NTHREADS) lds[(i & 31) * RP + (i >> 5)] = p.w_router[i];
    __syncthreads();
    const float bias = p.b_router[lane >> 1];
    for (int gidx = bid; gidx < M / 64; gidx += nb) {
        int cnt = 0;
        for (int ii = 0; ii < 8; ++ii) {
            const int t = gidx * 64 + w * 8 + ii;
            const f32x4* xr = (const f32x4*)(p.x2() + (size_t)t * D) + lane; f32x4 v[4]; float s = 0.f;
#pragma unroll
            for (int j = 0; j < 4; ++j) { v[j] = xr[64 * j]; s += (v[j].x * v[j].x + v[j].y * v[j].y) + (v[j].z * v[j].z + v[j].w * v[j].w); }
            const float rs = 1.0f / sqrtf(wave_sum(s) * (1.f / D) + EPS);
#pragma unroll
            for (int j = 0; j < 4; ++j) { const f32x4 gg = *((const f32x4*)p.g_moe + lane + 64 * j); v[j] = v[j] * rs * gg; }
            float a[NE];
#pragma unroll
            for (int e = 0; e < NE; ++e) { float acc = 0.f;
#pragma unroll
                for (int j = 0; j < 4; ++j) { const f32x4 wv = *((const f32x4*)(lds + e * RP) + lane + 64 * j); acc += (v[j].x * wv.x + v[j].y * wv.y) + (v[j].z * wv.z + v[j].w * wv.w); }
                a[e] = acc; if ((e & 3) == 3) __builtin_amdgcn_sched_barrier(0); }
#pragma unroll
            for (int k = 0; k < 16; ++k) { const bool up = (lane & 32) != 0; const float send = up ? a[k] : a[k + 16]; const float keep = up ? a[k + 16] : a[k]; a[k] = keep + __shfl_xor(send, 32); }
#pragma unroll
            for (int k = 0; k < 8; ++k) { const bool up = (lane & 16) != 0; const float send = up ? a[k] : a[k + 8]; const float keep = up ? a[k + 8] : a[k]; a[k] = keep + __shfl_xor(send, 16); }
#pragma unroll
            for (int k = 0; k < 4; ++k) { const bool up = (lane & 8) != 0; const float send = up ? a[k] : a[k + 4]; const float keep = up ? a[k + 4] : a[k]; a[k] = keep + __shfl_xor(send, 8); }
#pragma unroll
            for (int k = 0; k < 2; ++k) { const bool up = (lane & 4) != 0; const float send = up ? a[k] : a[k + 2]; const float keep = up ? a[k + 2] : a[k]; a[k] = keep + __shfl_xor(send, 4); }
            { const bool up = (lane & 2) != 0; const float send = up ? a[0] : a[1]; const float keep = up ? a[1] : a[0]; a[0] = keep + __shfl_xor(send, 2); }
            float mylg = a[0] + __shfl_xor(a[0], 1) + bias; const int myidx = lane >> 1;
            int idx[4]; float val[4];
#pragma unroll
            for (int j = 0; j < 4; ++j) { float bv = mylg; int bi = myidx;
#pragma unroll
                for (int o = 1; o < 64; o <<= 1) { const float ov = __shfl_xor(bv, o); const int oi = __shfl_xor(bi, o); const bool tk = (ov > bv) || (ov == bv && oi < bi); bv = tk ? ov : bv; bi = tk ? oi : bi; }
                idx[j] = bi; val[j] = bv; if (myidx == bi) mylg = -INFINITY; cnt += (lane == bi) ? 1 : 0; }
            const float e1 = __expf(val[1] - val[0]), e2 = __expf(val[2] - val[0]), e3 = __expf(val[3] - val[0]); const float inv = 1.f / (1.f + e1 + e2 + e3);
            if (lane == 0) { p.rs2()[t] = rs;
                p.topi()[t * 4 + 0] = idx[0]; p.topi()[t * 4 + 1] = idx[1]; p.topi()[t * 4 + 2] = idx[2]; p.topi()[t * 4 + 3] = idx[3];
                p.topg()[t * 4 + 0] = inv; p.topg()[t * 4 + 1] = e1 * inv; p.topg()[t * 4 + 2] = e2 * inv; p.topg()[t * 4 + 3] = e3 * inv; }
        }
        __syncthreads();
        if (lane < 32) cntw[w * 32 + lane] = cnt;
        __syncthreads();
        if (tid < 32) { int run = 0;
#pragma unroll
            for (int ww = 0; ww < 8; ++ww) { wavebase[(gidx * 8 + ww) * 32 + tid] = run; run += cntw[ww * 32 + tid]; }
            blkcnt[gidx * 32 + tid] = run; }
    }
}
__device__ __forceinline__ void phase_dispatch2(const P& p, int* ldsi, const int* blkcnt, const int* wavebase, int bid, int nb) {
    const int tid = threadIdx.x, lane = tid & 63, w = tid >> 6;
    int* red_t = ldsi; int* red_p = ldsi + 512; int* base = ldsi + 1024;
    for (int gidx = bid; gidx < M / 64; gidx += nb) {
        __syncthreads();
        { const int e = tid & 31, part = tid >> 5; int tt = 0, pp = 0;
          for (int bb = part * 16; bb < part * 16 + 16; ++bb) { const int v = blkcnt[bb * 32 + e]; tt += v; pp += (bb < gidx) ? v : 0; }
          red_t[part * 32 + e] = tt; red_p[part * 32 + e] = pp; }
        __syncthreads();
        if (tid < 32) { int tt = 0, pp = 0;
#pragma unroll
            for (int q = 0; q < 16; ++q) { tt += red_t[q * 32 + tid]; pp += red_p[q * 32 + tid]; }
            red_t[tid] = tt; red_p[tid] = pp; }
        __syncthreads();
        if (tid == 0) { int off = 0; for (int e = 0; e < NE; ++e) { base[e] = off + red_p[e]; const int c = red_t[e]; const int nt = (c + 255) >> 8;
                if (gidx == 0) for (int i = 0; i < nt; ++i) p.tilee()[(off >> 8) + i] = e;
                off += nt << 8; }
            if (gidx == 0) p.tilee()[MAXMT] = off >> 8; }
        __syncthreads();
        int wb = (lane < 32) ? base[lane] + wavebase[(gidx * 8 + w) * 32 + lane] : 0;
        static_assert(MOE_FP8, "dispatch writes e4m3 activation rows");
        for (int ii = 0; ii < 8; ii += 2) {
            const int t = gidx * 64 + w * 8 + ii;
            f32x4 xv[2][4]; float rs[2]; int ti[2][4];
#pragma unroll
            for (int q = 0; q < 2; ++q) { const f32x4* xr = (const f32x4*)(p.x2() + (size_t)(t + q) * D) + 4 * lane;
#pragma unroll
                for (int j = 0; j < 4; ++j) xv[q][j] = xr[j];
                rs[q] = p.rs2()[t + q];
#pragma unroll
                for (int j = 0; j < 4; ++j) ti[q][j] = p.topi()[(t + q) * 4 + j]; }
            const f32x4* gr = (const f32x4*)p.g_moe + 4 * lane; const f32x4 g0 = gr[0], g1 = gr[1], g2 = gr[2], g3 = gr[3];
#pragma unroll
            for (int q = 0; q < 2; ++q) {
                int slot = 0;
#pragma unroll
                for (int j = 0; j < 4; ++j) { const int e = ti[q][j]; const int sj = __shfl(wb, e); if (lane == e) wb += 1; if (lane == j) slot = sj; }
                if (lane < 4) { p.slotof()[(t + q) * 4 + lane] = slot; p.gslot()[slot] = p.topg()[(t + q) * 4 + lane]; }
                u32x4 o8;
                { const f32x4 v = xv[q][0] * rs[q] * g0; o8.x = pk4_fp8(v.x, v.y, v.z, v.w); } { const f32x4 v = xv[q][1] * rs[q] * g1; o8.y = pk4_fp8(v.x, v.y, v.z, v.w); }
                { const f32x4 v = xv[q][2] * rs[q] * g2; o8.z = pk4_fp8(v.x, v.y, v.z, v.w); } { const f32x4 v = xv[q][3] * rs[q] * g3; o8.w = pk4_fp8(v.x, v.y, v.z, v.w); }
#pragma unroll
                for (int k = 0; k < 4; ++k) { const int sl = __shfl(slot, k); *((u32x4*)((unsigned char*)p.xs() + (size_t)sl * D) + lane) = o8; }
            }
        }
    }
}

__device__ __forceinline__ bf16x8 split_hi(const f32x4 a, const f32x4 b, f32x4& ra, f32x4& rb) {
    u32x4 h; h.x = pk2(a.x, a.y); h.y = pk2(a.z, a.w); h.z = pk2(b.x, b.y); h.w = pk2(b.z, b.w);
    ra = (f32x4){a.x - bf_lo(h.x), a.y - bf_hi(h.x), a.z - bf_lo(h.y), a.w - bf_hi(h.y)}; rb = (f32x4){b.x - bf_lo(h.z), b.y - bf_hi(h.z), b.z - bf_lo(h.w), b.w - bf_hi(h.w)};
    return __builtin_bit_cast(bf16x8, h);
}
__device__ __forceinline__ bf16x8 pack_bf8(const f32x4 a, const f32x4 b) { u32x4 h; h.x = pk2(a.x, a.y); h.y = pk2(a.z, a.w); h.z = pk2(b.x, b.y); h.w = pk2(b.z, b.w); return __builtin_bit_cast(bf16x8, h); }
__device__ __forceinline__ void phase_router3(const P& p, float* lds, int* blkcnt, int* rank, int bid, int nb) {
    const int tid = threadIdx.x, lane = tid & 63, w = tid >> 6, r = lane & 31, hf = lane >> 5;
    float* part = lds;
    float* ssqp = lds + 16384;
    float* lgt = lds + 16384 + 512;
    bf16x8 bh[8], bl[8];
#pragma unroll
    for (int s = 0; s < 8; ++s) { const int k0 = 128 * w + 16 * s + 8 * hf; f32x4 a, b, ra, rb;
#pragma unroll
        for (int j = 0; j < 4; ++j) { a[j] = p.w_router[(k0 + j) * NE + r] * p.g_moe[k0 + j]; b[j] = p.w_router[(k0 + 4 + j) * NE + r] * p.g_moe[k0 + 4 + j]; }
        bh[s] = split_hi(a, b, ra, rb); bl[s] = pack_bf8(ra, rb); }
    for (int gidx = bid; gidx < M / 64; gidx += nb) {
        const int t0 = gidx * 64;
        __syncthreads();
#pragma unroll
        for (int mt = 0; mt < 2; ++mt) {
            const float* xr = p.x2() + (size_t)(t0 + 32 * mt + r) * D + 128 * w + 8 * hf;
            f32x4 xa[8], xb[8];
#pragma unroll
            for (int s = 0; s < 8; ++s) { xa[s] = *(const f32x4*)(xr + 16 * s); xb[s] = *(const f32x4*)(xr + 16 * s + 4); }
            f32x16 acc = zero16(); float ss = 0.f;
#pragma unroll
            for (int s = 0; s < 8; ++s) { f32x4 ra, rb; ss += (xa[s].x * xa[s].x + xa[s].y * xa[s].y) + (xa[s].z * xa[s].z + xa[s].w * xa[s].w) + (xb[s].x * xb[s].x + xb[s].y * xb[s].y) + (xb[s].z * xb[s].z + xb[s].w * xb[s].w);
                const bf16x8 ah = split_hi(xa[s], xb[s], ra, rb); const bf16x8 al = pack_bf8(ra, rb);
                acc = __builtin_amdgcn_mfma_f32_32x32x16_bf16(bh[s], ah, acc, 0, 0, 0);
                acc = __builtin_amdgcn_mfma_f32_32x32x16_bf16(bh[s], al, acc, 0, 0, 0);
                acc = __builtin_amdgcn_mfma_f32_32x32x16_bf16(bl[s], ah, acc, 0, 0, 0); }
            ss += __shfl_xor(ss, 32);
            if (hf == 0) ssqp[w * 64 + 32 * mt + r] = ss;
            float* po = part + (w * 64 + 32 * mt + r) * 32;
#pragma unroll
            for (int rg = 0; rg < 4; ++rg) *(f32x4*)(po + 8 * rg + 4 * hf) = (f32x4){acc[4 * rg], acc[4 * rg + 1], acc[4 * rg + 2], acc[4 * rg + 3]};
        }
        __syncthreads();
        { const int tk = tid >> 3, e4 = (tid & 7) * 4; f32x4 s4 = {0.f, 0.f, 0.f, 0.f}; float sq = 0.f;
#pragma unroll
          for (int ww = 0; ww < 8; ++ww) { s4 += *(const f32x4*)(part + (ww * 64 + tk) * 32 + e4); sq += ssqp[ww * 64 + tk]; }
          const float rs = 1.0f / sqrtf(sq * (1.f / D) + EPS); const f32x4 bb = *(const f32x4*)(p.b_router + e4);
          lgt[tk * 33 + e4] = s4.x * rs + bb.x; lgt[tk * 33 + e4 + 1] = s4.y * rs + bb.y; lgt[tk * 33 + e4 + 2] = s4.z * rs + bb.z; lgt[tk * 33 + e4 + 3] = s4.w * rs + bb.w;
          if ((tid & 7) == 0) p.rs2()[t0 + tk] = rs; }
        __syncthreads();
        if (w == 0) {
            float lg[NE];
#pragma unroll
            for (int e = 0; e < NE; ++e) lg[e] = lgt[lane * 33 + e];
            int idx[4]; float val[4];
#pragma unroll
            for (int j = 0; j < 4; ++j) { float best = lg[0]; int bi = 0;
#pragma unroll
                for (int e = 1; e < NE; ++e) { const bool tk = lg[e] > best; best = tk ? lg[e] : best; bi = tk ? e : bi; }
                idx[j] = bi; val[j] = best;
#pragma unroll
                for (int e = 0; e < NE; ++e) lg[e] = (e == bi) ? -INFINITY : lg[e]; }
            const float e1 = __expf(val[1] - val[0]), e2 = __expf(val[2] - val[0]), e3 = __expf(val[3] - val[0]); const float inv = 1.f / (1.f + e1 + e2 + e3);
            int rk[4] = {0, 0, 0, 0}; int mycnt = 0; const unsigned long long lt = (1ull << lane) - 1ull;
#pragma unroll 4
            for (int e = 0; e < NE; ++e) { const bool h0 = idx[0] == e, h1 = idx[1] == e, h2 = idx[2] == e, h3 = idx[3] == e; const unsigned long long m = __ballot(h0 || h1 || h2 || h3);
                const int below = __popcll(m & lt); rk[0] = h0 ? below : rk[0]; rk[1] = h1 ? below : rk[1]; rk[2] = h2 ? below : rk[2]; rk[3] = h3 ? below : rk[3];
                mycnt = (lane == e) ? __popcll(m) : mycnt; }
            const int t = t0 + lane;
            *(i32x4g*)(p.topi() + t * 4) = (i32x4g){idx[0], idx[1], idx[2], idx[3]};
            *(f32x4*)(p.topg() + t * 4) = (f32x4){inv, e1 * inv, e2 * inv, e3 * inv};
            *(i32x4g*)(rank + t * 4) = (i32x4g){rk[0], rk[1], rk[2], rk[3]};
            if (lane < NE) blkcnt[gidx * NE + lane] = mycnt;
        }
    }
}
__device__ __forceinline__ void phase_dispatch3(const P& p, int* ldsi, const int* blkcnt, const int* rank, int bid, int nb) {
    const int tid = threadIdx.x, lane = tid & 63, w = tid >> 6;
    int* red_t = ldsi; int* red_p = ldsi + 512; int* base = ldsi + 1024;
    static_assert(MOE_FP8, "dispatch writes e4m3 activation rows");
    for (int gidx = bid; gidx < M / 64; gidx += nb) {
        __syncthreads();
        { const int e = tid & 31, part = tid >> 5; int tt = 0, pp = 0;
          for (int bb = part * 16; bb < part * 16 + 16; ++bb) { const int v = blkcnt[bb * 32 + e]; tt += v; pp += (bb < gidx) ? v : 0; }
          red_t[part * 32 + e] = tt; red_p[part * 32 + e] = pp; }
        __syncthreads();
        if (tid < 32) { int tt = 0, pp = 0;
#pragma unroll
            for (int q = 0; q < 16; ++q) { tt += red_t[q * 32 + tid]; pp += red_p[q * 32 + tid]; }
            red_t[tid] = tt; red_p[tid] = pp; }
        __syncthreads();
        if (tid == 0) { int off = 0; for (int e = 0; e < NE; ++e) { base[e] = off + red_p[e]; const int c = red_t[e]; const int nt = (c + 255) >> 8;
                if (gidx == 0) for (int i = 0; i < nt; ++i) p.tilee()[(off >> 8) + i] = e;
                off += nt << 8; }
            if (gidx == 0) p.tilee()[MAXMT] = off >> 8; }
        __syncthreads();
        for (int ii = 0; ii < 8; ii += 2) {
            const int t = gidx * 64 + w * 8 + ii;
            f32x4 xv[2][4]; float rs[2]; int slot[2];
#pragma unroll
            for (int q = 0; q < 2; ++q) { const f32x4* xr = (const f32x4*)(p.x2() + (size_t)(t + q) * D) + 4 * lane;
#pragma unroll
                for (int j = 0; j < 4; ++j) xv[q][j] = xr[j];
                rs[q] = p.rs2()[t + q];
                slot[q] = 0; if (lane < 4) slot[q] = base[p.topi()[(t + q) * 4 + lane]] + rank[(t + q) * 4 + lane]; }
            const f32x4* gr = (const f32x4*)p.g_moe + 4 * lane; const f32x4 g0 = gr[0], g1 = gr[1], g2 = gr[2], g3 = gr[3];
#pragma unroll
            for (int q = 0; q < 2; ++q) {
                if (lane < 4) { p.slotof()[(t + q) * 4 + lane] = slot[q]; p.gslot()[slot[q]] = p.topg()[(t + q) * 4 + lane]; }
                u32x4 o8;
                { const f32x4 v = xv[q][0] * rs[q] * g0; o8.x = pk4_fp8(v.x, v.y, v.z, v.w); } { const f32x4 v = xv[q][1] * rs[q] * g1; o8.y = pk4_fp8(v.x, v.y, v.z, v.w); }
                { const f32x4 v = xv[q][2] * rs[q] * g2; o8.z = pk4_fp8(v.x, v.y, v.z, v.w); } { const f32x4 v = xv[q][3] * rs[q] * g3; o8.w = pk4_fp8(v.x, v.y, v.z, v.w); }
#pragma unroll
                for (int k = 0; k < 4; ++k) { const int sl = __shfl(slot[q], k); *((u32x4*)((unsigned char*)p.xs() + (size_t)sl * D) + lane) = o8; }
            }
        }
    }
}

namespace pg {
typedef short bf16x8 __attribute__((ext_vector_type(8)));
constexpr int BM = 256, BK = 64, HALF = 128, HTB = HALF * BK * 2, STAGE_BYTES = 8 * HTB;
__device__ __forceinline__ int lds_byte(int r, int c) { const int st = (r >> 4) * 2 + (c >> 5), rr = r & 15, cc = c & 31, ob = rr * 64 + cc * 2; return st * 1024 + (ob ^ (((ob >> 9) & 1) << 5)); }
__device__ __forceinline__ void stage_rc(int b, int& R, int& C) { const int st = b / 1024, sb = b % 1024, swz = sb ^ (((sb >> 9) & 1) << 5); R = (st >> 1) * 16 + swz / 64; C = (st & 1) * 32 + (swz % 64) / 2; }
__device__ __forceinline__ int perm32(int rho) { const int n = rho >> 4, i = rho & 15; return 8 * (i >> 2) + 4 * n + (i & 3); }
struct Unit { int pm, pn, e; unsigned ao, bo; };
struct Gemm { int lda, ldb, K; };
__device__ __forceinline__ void map2d(int L, int nM, int nN, int& pm, int& pn) {
    const int nwg = nM * nN; int wgid = L;
    { const int q = nwg / 8, r = nwg % 8, xcd = wgid % 8, off = wgid / 8; wgid = (xcd < r ? xcd * (q + 1) : r * (q + 1) + (xcd - r) * q) + off; }
    const int nig = 8 * nN, gid = wgid / nig, fm = gid * 8, gsz = (nM - fm) < 8 ? (nM - fm) : 8;
    pm = fm + ((wgid % nig) % gsz); pn = (wgid % nig) / gsz;
}
struct Sched2D { unsigned aoff, boff, rowA, rowB; int nM, nN, G, c;
    __device__ __forceinline__ bool next(int i, Unit& u) const { const long L = (long)i * G + c; if (L >= (long)nM * nN) return false; map2d((int)L, nM, nN, u.pm, u.pn); u.e = 0;
        u.ao = aoff + (unsigned)u.pm * 256u * rowA; u.bo = boff + (unsigned)u.pn * 256u * rowB; return true; } };
struct SchedG1 { int G, c;
    __device__ __forceinline__ bool next(int i, Unit& u) const { const long L = (long)i * G + c; if (L >= 592) return false;
        const int Li = (int)L, l2 = Li - 576, l3 = Li - 584; int pm, pn; map2d(Li < 576 ? Li : 0, 64, 9, pm, pn);
        const int e = Li < 576 ? 0 : (Li < 584 ? 1 : 2);
        pm = e == 0 ? pm : (e == 1 ? (l2 >> 2) : (l3 >> 1)); pn = e == 0 ? pn : (e == 1 ? (l2 & 3) : (l3 & 1));
        const unsigned m1 = (unsigned)(e == 1), m2 = (unsigned)(e == 2);
        const unsigned ao = (unsigned)WS_XN + m1 * (unsigned)(WS_HM - WS_XN) + m2 * (unsigned)(WS_WT_XV - WS_XN), bo = (unsigned)WS_WT_IN + m1 * (unsigned)(WS_WT_XK - WS_WT_IN) + m2 * (unsigned)(WS_HM - WS_WT_IN);
        u.pm = pm; u.pn = pn; u.e = e; u.ao = ao + (unsigned)pm * 256u * D * 2u; u.bo = bo + (unsigned)pn * 256u * D * 2u; return true; } };
struct SchedAttn { unsigned aoff, boff, sBb, sBh; int G, c;
    __device__ __forceinline__ bool next(int i, Unit& u) const { const long L = (long)i * G + c; if (L >= 256) return false; const int bh = (int)L >> 5, b = bh >> 2, h = bh & 3;
        u.pm = b * 32 + ((int)L & 31); u.pn = h; u.e = 0; u.ao = aoff + ((unsigned)u.pm * 256u * D + h * 256u) * 2u; u.bo = boff + b * sBb + h * sBh; return true; } };
struct SchedMoE { unsigned aoff, boff; const LAS int* tile_e; unsigned sBe, rowA, rowB; int nM, nN, G, c;
    __device__ __forceinline__ bool next(int i, Unit& u) const { const long L = (long)i * G + c; if (L >= (long)nM * nN) return false; map2d((int)L, nM, nN, u.pm, u.pn); u.e = __builtin_amdgcn_readfirstlane(tile_e[u.pm]);
        u.ao = aoff + (unsigned)u.pm * 256u * rowA; u.bo = boff + (unsigned)u.e * sBe + (unsigned)u.pn * 256u * rowB; return true; } };

typedef f32x4 Acc[2][2][4][2];
__device__ __forceinline__ u32x4 pack8(const f32x4 v0, const f32x4 v1) { u32x4 w; w.x = pk2(v0[0], v0[1]); w.y = pk2(v0[2], v0[3]); w.z = pk2(v1[0], v1[1]); w.w = pk2(v1[2], v1[3]); return w; }
struct EpiBf3 { static constexpr bool PERM = true; unsigned char* ws; size_t o0, o1, o2; int ld0, ld1, ld2;
    __device__ __forceinline__ void operator()(const Acc& acc, const Unit& u, int wr, int wc, int fr, int fq) const {
        const size_t m1 = (size_t)(u.e == 1), m2 = (size_t)(u.e == 2);
        bf16* base = (bf16*)(ws + o0 + m1 * (o1 - o0) + m2 * (o2 - o0)); const int ld = ld0 + (int)m1 * (ld1 - ld0) + (int)m2 * (ld2 - ld0);
        const int row0 = u.pm * BM + wr * 64 + fr, col0 = u.pn * BM + wc * 32 + 8 * fq;
#pragma unroll
        for (int ai = 0; ai < 2; ++ai)
#pragma unroll
            for (int m = 0; m < 4; ++m) { bf16* rowp = base + (size_t)(row0 + ai * HALF + m * 16) * ld + col0;
#pragma unroll
                for (int bj = 0; bj < 2; ++bj) *(u32x4*)(rowp + bj * HALF) = pack8(acc[ai][bj][m][0], acc[ai][bj][m][1]); } } };
struct EpiF { static constexpr bool PERM = false; float* C; int ldc;
    __device__ __forceinline__ void operator()(const Acc& acc, const Unit& u, int wr, int wc, int fr, int fq) const {
        const int row0 = u.pm * BM + wr * 64 + fr, col0 = u.pn * BM + wc * 32 + 4 * fq;
#pragma unroll
        for (int ai = 0; ai < 2; ++ai)
#pragma unroll
            for (int m = 0; m < 4; ++m) { float* rowp = C + (size_t)(row0 + ai * HALF + m * 16) * ldc + col0;
#pragma unroll
                for (int bj = 0; bj < 2; ++bj)
#pragma unroll
                    for (int n = 0; n < 2; ++n) *(f32x4*)(rowp + bj * HALF + n * 16) = acc[ai][bj][m][n]; } } };
struct EpiOutF { static constexpr bool PERM = false; const float* x; float* x1; bf16* a2; const float* g; float* rowsq;
    __device__ __forceinline__ void operator()(const Acc& acc, const Unit& u, int wr, int wc, int fr, int fq) const {
        const int row0 = u.pm * BM + wr * 64 + fr, col0 = u.pn * BM + wc * 32 + 4 * fq;
        f32x4 gv[2][2];
#pragma unroll
        for (int bj = 0; bj < 2; ++bj)
#pragma unroll
            for (int n = 0; n < 2; ++n) gv[bj][n] = *(const f32x4*)(g + col0 + bj * HALF + n * 16);
#pragma unroll
        for (int ai = 0; ai < 2; ++ai)
#pragma unroll
            for (int m = 0; m < 4; ++m) { const int row = row0 + ai * HALF + m * 16; const size_t off = (size_t)row * D + col0; float ss = 0.f;
#pragma unroll
                for (int bj = 0; bj < 2; ++bj)
#pragma unroll
                    for (int n = 0; n < 2; ++n) { const size_t o = off + bj * HALF + n * 16; const f32x4 v = *(const f32x4*)(x + o) + acc[ai][bj][m][n]; *(f32x4*)(x1 + o) = v;
                        const f32x4 t = v * gv[bj][n]; u32x2 w; w.x = pk2(t[0], t[1]); w.y = pk2(t[2], t[3]); *(u32x2*)(a2 + o) = w; ss += (v[0] * v[0] + v[1] * v[1]) + (v[2] * v[2] + v[3] * v[3]); }
                ss += __shfl_xor(ss, 16); ss += __shfl_xor(ss, 32);
                if (fq == 0) atomicAdd(rowsq + row, ss); } } };
struct EpiQF { static constexpr bool PERM = true; bf16* q; const float* rowsq;
    __device__ __forceinline__ void operator()(const Acc& acc, const Unit& u, int wr, int wc, int fr, int fq) const {
        const int row0 = u.pm * BM + wr * 64 + fr, col0 = u.pn * BM + wc * 32 + 8 * fq;
#pragma unroll
        for (int ai = 0; ai < 2; ++ai)
#pragma unroll
            for (int m = 0; m < 4; ++m) { const int row = row0 + ai * HALF + m * 16; const float s = 0.0625f / sqrtf(rowsq[row] * (1.f / D) + EPS); bf16* rowp = q + (size_t)row * D + col0;
#pragma unroll
                for (int bj = 0; bj < 2; ++bj) *(u32x4*)(rowp + bj * HALF) = pack8(acc[ai][bj][m][0] * s, acc[ai][bj][m][1] * s); } } };
struct EpiResF { static constexpr bool PERM = false; const float* base; float* o;
    __device__ __forceinline__ void operator()(const Acc& acc, const Unit& u, int wr, int wc, int fr, int fq) const {
        const int row0 = u.pm * BM + wr * 64 + fr, col0 = u.pn * BM + wc * 32 + 4 * fq;
#pragma unroll
        for (int ai = 0; ai < 2; ++ai)
#pragma unroll
            for (int m = 0; m < 4; ++m) { const size_t off = (size_t)(row0 + ai * HALF + m * 16) * D + col0;
#pragma unroll
                for (int bj = 0; bj < 2; ++bj)
#pragma unroll
                    for (int n = 0; n < 2; ++n) { const size_t o2 = off + bj * HALF + n * 16; *(f32x4*)(o + o2) = *(const f32x4*)(base + o2) + acc[ai][bj][m][n]; } } } };
struct EpiUpF { static constexpr bool PERM = true; bf16* h; const float* b_gu;
    __device__ __forceinline__ void operator()(const Acc& acc, const Unit& u, int wr, int wc, int fr, int fq) const {
        const int row0 = u.pm * BM + wr * 64 + fr, ff0 = u.pn * HALF + wc * 32 + 8 * fq; const float* bb = b_gu + (size_t)u.e * 2 * DFF + ff0;
        const f32x4 bg0 = *(const f32x4*)bb, bg1 = *(const f32x4*)(bb + 4), bu0 = *(const f32x4*)(bb + DFF), bu1 = *(const f32x4*)(bb + DFF + 4);
#pragma unroll
        for (int ai = 0; ai < 2; ++ai)
#pragma unroll
            for (int m = 0; m < 4; ++m) { const f32x4 g0 = acc[ai][0][m][0] + bg0, g1 = acc[ai][0][m][1] + bg1, u0 = acc[ai][1][m][0] + bu0, u1 = acc[ai][1][m][1] + bu1; f32x4 r0, r1;
#pragma unroll
                for (int i = 0; i < 4; ++i) { r0[i] = swiglu(g0[i], u0[i]); r1[i] = swiglu(g1[i], u1[i]); }
                *(u32x4*)(h + (size_t)(row0 + ai * HALF + m * 16) * DFF + ff0) = pack8(r0, r1); } } };
struct EpiDnF { static constexpr bool PERM = true; bf16* y; const float* b_dn; const float* gs;
    __device__ __forceinline__ void operator()(const Acc& acc, const Unit& u, int wr, int wc, int fr, int fq) const {
        const int row0 = u.pm * BM + wr * 64 + fr, col0 = u.pn * BM + wc * 32 + 8 * fq; const float* bb = b_dn + (size_t)u.e * D + col0;
        f32x4 bv[2][2];
#pragma unroll
        for (int bj = 0; bj < 2; ++bj)
#pragma unroll
            for (int n = 0; n < 2; ++n) bv[bj][n] = *(const f32x4*)(bb + bj * HALF + 4 * n);
#pragma unroll
        for (int ai = 0; ai < 2; ++ai)
#pragma unroll
            for (int m = 0; m < 4; ++m) { const int row = row0 + ai * HALF + m * 16; const float g = gs[row]; bf16* rowp = y + (size_t)row * D + col0;
#pragma unroll
                for (int bj = 0; bj < 2; ++bj) *(u32x4*)(rowp + bj * HALF) = pack8((acc[ai][bj][m][0] + bv[bj][0]) * g, (acc[ai][bj][m][1] + bv[bj][1]) * g); } } };

struct EpiUp8 { static constexpr bool PERM = true; unsigned char* h8; const float* b_gu;
    __device__ __forceinline__ void operator()(const Acc& acc, const Unit& u, int wr, int wc, int fr, int fq) const {
        const int row0 = u.pm * BM + wr * 64 + fr, ff0 = u.pn * HALF + wc * 32 + 8 * fq; const float* bb = b_gu + (size_t)u.e * 2 * DFF + ff0;
        const f32x4 bg0 = *(const f32x4*)bb, bg1 = *(const f32x4*)(bb + 4), bu0 = *(const f32x4*)(bb + DFF), bu1 = *(const f32x4*)(bb + DFF + 4);
#pragma unroll
        for (int ai = 0; ai < 2; ++ai)
#pragma unroll
            for (int m = 0; m < 4; ++m) { const f32x4 g0 = acc[ai][0][m][0] * W8_INV + bg0, g1 = acc[ai][0][m][1] * W8_INV + bg1, u0 = acc[ai][1][m][0] * W8_INV + bu0, u1 = acc[ai][1][m][1] * W8_INV + bu1; f32x4 r0, r1;
#pragma unroll
                for (int i = 0; i < 4; ++i) { r0[i] = swiglu(g0[i], u0[i]); r1[i] = swiglu(g1[i], u1[i]); }
                u32x2 o; o.x = pk4_fp8(r0[0], r0[1], r0[2], r0[3]); o.y = pk4_fp8(r1[0], r1[1], r1[2], r1[3]);
                *(u32x2*)(h8 + (size_t)(row0 + ai * HALF + m * 16) * DFF + ff0) = o; } } };
struct EpiDn8 { static constexpr bool PERM = true; bf16* y; const float* b_dn; const float* gs;
    __device__ __forceinline__ void operator()(const Acc& acc, const Unit& u, int wr, int wc, int fr, int fq) const {
        const int row0 = u.pm * BM + wr * 64 + fr, col0 = u.pn * BM + wc * 32 + 8 * fq; const float* bb = b_dn + (size_t)u.e * D + col0;
        f32x4 bv[2][2];
#pragma unroll
        for (int bj = 0; bj < 2; ++bj)
#pragma unroll
            for (int n = 0; n < 2; ++n) bv[bj][n] = *(const f32x4*)(bb + bj * HALF + 4 * n);
#pragma unroll
        for (int ai = 0; ai < 2; ++ai)
#pragma unroll
            for (int m = 0; m < 4; ++m) { const int row = row0 + ai * HALF + m * 16; const float g = gs[row]; bf16* rowp = y + (size_t)row * D + col0;
#pragma unroll
                for (int bj = 0; bj < 2; ++bj) *(u32x4*)(rowp + bj * HALF) = pack8((acc[ai][bj][m][0] * W8_INV + bv[bj][0]) * g, (acc[ai][bj][m][1] * W8_INV + bv[bj][1]) * g); } } };

typedef int i32x4 __attribute__((ext_vector_type(4)));
typedef int i32x8 __attribute__((ext_vector_type(8)));
__device__ __forceinline__ void mma8(const i32x8 bb, const i32x8 aa, f32x4& c) {
    asm volatile("v_mfma_f32_16x16x128_f8f6f4 %0, %1, %2, %0" : "+v"(c) : "v"(bb), "v"(aa));
}
__device__ __forceinline__ void mma8_drain() { asm volatile("s_nop 15\n\ts_nop 7" ::: "memory"); }
template <class Epi, class Sched, bool ALIGN_EPI, bool F8 = false>
__device__ __forceinline__ void gemm_phase(LAS unsigned char* lds, const unsigned char* ws, const Gemm g, const Sched& S, const Epi& E) {
    const __amdgpu_buffer_rsrc_t rsrc = __builtin_amdgcn_make_buffer_rsrc((void*)ws, 0, 0x7fffffff, 0x00020000);
    const int tid = threadIdx.x, wid = __builtin_amdgcn_readfirstlane(tid >> 6), lane = tid & 63, wr = wid >> 2, wc = wid & 3, fr = lane & 15, fq = lane >> 4;
    const int K = g.K, nt = K / BK;
    unsigned voffA[2], voffB[2];
#pragma unroll
    for (int i = 0; i < 2; ++i) { int R, C; stage_rc(tid * 16 + i * 8192, R, C); const int Rb = Epi::PERM ? ((R & ~31) + perm32(R & 31)) : R;
        voffA[i] = (unsigned)(R * g.lda + C) * 2u; voffB[i] = (unsigned)(Rb * g.ldb + C) * 2u; }
    const unsigned kstep = (unsigned)(BK * 2);
    const unsigned hstepA = (unsigned)HALF * g.lda * 2, hstepB = (unsigned)HALF * g.ldb * 2;
    const unsigned ldsw = (unsigned)wid * 1024u, ldsbase = (unsigned)(size_t)lds;
    const int aoff = lds_byte(wr * 64 + fr, fq * 8), boff = lds_byte(wc * 32 + fr, fq * 8);
#define PG_SA(b, h) (((b) * 2 + (h)) * HTB)
#define PG_SB(b, h) ((4 + (b) * 2 + (h)) * HTB)
#define PG_STAGE(bufoff, gbase, voff) do { _Pragma("unroll") for (int _i = 0; _i < 2; ++_i) \
        asm volatile("s_mov_b32 m0, %0\n\ts_nop 0\n\tbuffer_load_dwordx4 %1, %2, %3 offen lds" :: "s"(ldsbase + (unsigned)(bufoff) + ldsw + (unsigned)(_i * 8192)), "v"((voff)[_i]), "s"(rsrc), "s"((unsigned)(gbase)) : "m0", "memory"); } while (0)
#define PG_LD8(base) __builtin_shufflevector(*(const LAS i32x4*)(lds + (base)), *(const LAS i32x4*)(lds + (base) + 1024), 0, 1, 2, 3, 4, 5, 6, 7)
#define PG_LDA(dst, b, h) do { _Pragma("unroll") for (int m = 0; m < 4; ++m) { if constexpr (F8) dst##8[m] = PG_LD8(PG_SA(b, h) + aoff + m * 2048); \
        else { _Pragma("unroll") for (int k = 0; k < 2; ++k) dst[m][k] = *(const LAS bf16x8*)(lds + PG_SA(b, h) + aoff + m * 2048 + k * 1024); } } } while (0)
#define PG_LDB(dst, b, h) do { _Pragma("unroll") for (int n = 0; n < 2; ++n) { if constexpr (F8) dst##8[n] = PG_LD8(PG_SB(b, h) + boff + n * 2048); \
        else { _Pragma("unroll") for (int k = 0; k < 2; ++k) dst[n][k] = *(const LAS bf16x8*)(lds + PG_SB(b, h) + boff + n * 2048 + k * 1024); } } } while (0)
#define PG_MMA(ai, bj, At, Bt) do { __builtin_amdgcn_s_setprio(1); _Pragma("unroll") for (int m = 0; m < 4; ++m) _Pragma("unroll") for (int n = 0; n < 2; ++n) { \
        if constexpr (F8) mma8(Bt##8[n], At##8[m], acc[ai][bj][m][n]); \
        else { _Pragma("unroll") for (int k = 0; k < 2; ++k) acc[ai][bj][m][n] = __builtin_amdgcn_mfma_f32_16x16x32_bf16(Bt[n][k], At[m][k], acc[ai][bj][m][n], 0, 0, 0); } } \
        __builtin_amdgcn_s_setprio(0); } while (0)
#define PG_WAIT_V(n) asm volatile("s_waitcnt vmcnt(" #n ")" ::: "memory")
#define PG_WAIT_L(n) asm volatile("s_waitcnt lgkmcnt(" #n ")" ::: "memory")
#define PG_BAR __builtin_amdgcn_s_barrier()
#define PG_SCHED __builtin_amdgcn_sched_barrier(0)
    Unit cur, nxt; int ui = 0;
    if (!S.next(0, cur)) return;
    f32x4 acc[2][2][4][2];
#pragma unroll
    for (int a = 0; a < 2; ++a)
#pragma unroll
        for (int b = 0; b < 2; ++b)
#pragma unroll
            for (int m = 0; m < 4; ++m)
#pragma unroll
                for (int n = 0; n < 2; ++n) acc[a][b][m][n] = (f32x4){0.f, 0.f, 0.f, 0.f};
    bf16x8 At[4][2], B0[2][2], B1[2][2]; i32x8 At8[4], B08[2], B18[2];
    unsigned cA = cur.ao, cB = cur.bo;
    asm volatile("s_nop 4" ::: "memory");
    PG_STAGE(PG_SB(0, 0), cB, voffB); PG_STAGE(PG_SB(0, 1), cB + hstepB, voffB); PG_STAGE(PG_SA(0, 0), cA, voffA); PG_STAGE(PG_SA(0, 1), cA + hstepA, voffA);
    if (wr == 1) PG_BAR;
    PG_WAIT_V(2); PG_BAR;
    PG_STAGE(PG_SB(1, 0), cB + kstep, voffB); PG_STAGE(PG_SA(1, 0), cA + kstep, voffA); PG_STAGE(PG_SB(1, 1), cB + hstepB + kstep, voffB);
    PG_WAIT_V(6); PG_BAR;
    for (;;) {
        const bool has_next = S.next(ui + 1, nxt);
        const unsigned nA = has_next ? nxt.ao : cA, nB = has_next ? nxt.bo : cB;
#pragma unroll 1
        for (int t = 0; t < nt; t += 2) {
            const bool last = (t == nt - 2);
            const unsigned a1 = cA + (unsigned)(t + 1) * kstep;
            const unsigned a2 = last ? nA : cA + (unsigned)(t + 2) * kstep, b2 = last ? nB : cB + (unsigned)(t + 2) * kstep;
            const unsigned a3 = a2 + kstep, b3 = b2 + kstep;
            PG_LDB(B0, 0, 0); PG_LDB(B1, 0, 1); PG_SCHED; PG_LDA(At, 0, 0); PG_STAGE(PG_SA(1, 1), a1 + hstepA, voffA);
            PG_WAIT_V(8); PG_WAIT_L(0); PG_BAR; PG_MMA(0, 0, At, B0); PG_MMA(0, 1, At, B1); PG_BAR; PG_SCHED;
            PG_LDA(At, 0, 1); PG_STAGE(PG_SB(0, 0), b2, voffB); PG_STAGE(PG_SB(0, 1), b2 + hstepB, voffB); PG_STAGE(PG_SA(0, 0), a2, voffA);
            PG_WAIT_V(8); PG_WAIT_L(0); PG_BAR; PG_MMA(1, 0, At, B0); PG_MMA(1, 1, At, B1); PG_BAR; PG_SCHED;
            PG_LDB(B0, 1, 0); PG_LDB(B1, 1, 1); PG_SCHED; PG_LDA(At, 1, 0); PG_STAGE(PG_SA(0, 1), a2 + hstepA, voffA);
            PG_WAIT_V(8); PG_WAIT_L(0); PG_BAR; PG_MMA(0, 0, At, B0); PG_MMA(0, 1, At, B1); PG_BAR; PG_SCHED;
            PG_LDA(At, 1, 1); PG_STAGE(PG_SB(1, 0), b3, voffB); PG_STAGE(PG_SB(1, 1), b3 + hstepB, voffB); PG_STAGE(PG_SA(1, 0), a3, voffA);
            PG_WAIT_V(8); PG_WAIT_L(0); PG_BAR; PG_MMA(1, 0, At, B0); PG_MMA(1, 1, At, B1); PG_BAR; PG_SCHED;
        }
        if constexpr (ALIGN_EPI) { if (wr == 0) PG_BAR; }
        if constexpr (F8) mma8_drain();
        { int t2 = threadIdx.x; asm volatile("" : "+v"(t2));
          const int l2 = t2 & 63; E(acc, cur, wr, wc, l2 & 15, l2 >> 4); }
        if (!has_next) break;
#pragma unroll
        for (int a = 0; a < 2; ++a)
#pragma unroll
            for (int b = 0; b < 2; ++b)
#pragma unroll
                for (int m = 0; m < 4; ++m)
#pragma unroll
                    for (int n = 0; n < 2; ++n) acc[a][b][m][n] = (f32x4){0.f, 0.f, 0.f, 0.f};
        cur = nxt; cA = nA; cB = nB; ++ui;
        if constexpr (ALIGN_EPI) { if (wr == 1) PG_BAR; }
    }
    PG_WAIT_V(0);
    if constexpr (!ALIGN_EPI) { if (wr == 0) PG_BAR; }
    PG_BAR;
#undef PG_SA
#undef PG_SB
#undef PG_STAGE
#undef PG_LDA
#undef PG_LDB
#undef PG_MMA
#undef PG_WAIT_V
#undef PG_WAIT_L
#undef PG_BAR
#undef PG_SCHED
}
}

#define XB_TMO      128
#define XB_XCNT(j)  (256  + 64 * (j))
#define XB_XSUB(j)  (1280 + 64 * (j))
#define XB_XGEN(j)  (2304 + 64 * (j))
#define XB_TOP      3328
#define XB_TOPGEN   3392
#define XCD_BAR_WORDS 3456
#define XB_SPIN_CAP (1u << 18)
__device__ __forceinline__ unsigned xb_ld(unsigned* p)              { return __hip_atomic_load(p, __ATOMIC_RELAXED, __HIP_MEMORY_SCOPE_AGENT); }
__device__ __forceinline__ unsigned xb_add(unsigned* p, unsigned v) { return __hip_atomic_fetch_add(p, v, __ATOMIC_RELAXED, __HIP_MEMORY_SCOPE_AGENT); }
__device__ __forceinline__ unsigned xb_xcc_id() { return (unsigned)__builtin_amdgcn_s_getreg((3 << 11) | 20) & 0xFu; }
#define XB_SPIN(cond, bar) do { unsigned _sp = 0; while (cond) { __builtin_amdgcn_s_sleep(1); \
    if ((++_sp & 255u) == 0u) { if (xb_ld(&(bar)[XB_TMO])) break; if (_sp > XB_SPIN_CAP) { atomicAdd(&(bar)[XB_TMO], 1u); break; } } } } while (0)
struct XcdBarrier { unsigned* bar; unsigned x; volatile LAS unsigned* st; };
__device__ __forceinline__ XcdBarrier xcd_barrier_post(unsigned* bar, volatile LAS unsigned* st) {
    XcdBarrier b; b.bar = bar; b.x = xb_xcc_id(); b.st = st;
    if (threadIdx.x == 0) (void)xb_add(&bar[XB_XCNT(b.x)], 1u);
    return b;
}
__device__ __forceinline__ void xcd_barrier_complete(unsigned* bar, unsigned x, unsigned& nloc, unsigned& nx) {
    const unsigned G = NBLOCKS;
    unsigned sum, cnt, mine, sp = 0u;
    for (;;) {
        sum = 0u; cnt = 0u; mine = 0u;
#pragma unroll
        for (unsigned j = 0; j < 16; ++j) { const unsigned c = xb_ld(&bar[XB_XCNT(j)]); sum += c; cnt += (c > 0u) ? 1u : 0u; mine = (j == x) ? c : mine; }
        if (sum == G) break;
        __builtin_amdgcn_s_sleep(1);
        if ((++sp & 255u) == 0u) { if (xb_ld(&bar[XB_TMO])) break; if (sp > XB_SPIN_CAP) { atomicAdd(&bar[XB_TMO], 1u); break; } }
    }
    nloc = mine > 0u ? mine : 1u; nx = cnt > 0u ? cnt : 1u;
}
__device__ __forceinline__ void xcd_barrier(unsigned* bar_, volatile LAS unsigned* st_) {
    asm volatile("s_waitcnt vmcnt(0)" ::: "memory");
    __syncthreads();
    if (threadIdx.x == 0) {
        XcdBarrier b; b.bar = bar_; b.x = xb_xcc_id(); b.st = st_;
        unsigned* bar = b.bar;
        __builtin_amdgcn_s_waitcnt(0);
        unsigned nloc = b.st[0], nx = b.st[1];
        if (nloc == 0u) { xcd_barrier_complete(bar, b.x, nloc, nx); b.st[0] = nloc; b.st[1] = nx; }
        const unsigned old = xb_add(&bar[XB_XSUB(b.x)], 1u);
        const unsigned gen = old / nloc;
        if (old + 1u == (gen + 1u) * nloc) {
            __builtin_amdgcn_fence(__ATOMIC_RELEASE, "agent");
            asm volatile("s_waitcnt vmcnt(0)" ::: "memory");
            const unsigned og = xb_add(&bar[XB_TOP], 1u);
            const unsigned tg = og / nx;
            if (og + 1u == (tg + 1u) * nx) xb_add(&bar[XB_TOPGEN], 1u);
            else XB_SPIN(xb_ld(&bar[XB_TOPGEN]) == tg, bar);
            __builtin_amdgcn_fence(__ATOMIC_ACQUIRE, "agent");
            xb_add(&bar[XB_XGEN(b.x)], 1u);
            asm volatile("s_waitcnt vmcnt(0)" ::: "memory");
        } else {
            XB_SPIN(xb_ld(&bar[XB_XGEN(b.x)]) == gen, bar);
            __builtin_amdgcn_fence(__ATOMIC_ACQUIRE, "agent");
            asm volatile("s_waitcnt vmcnt(0)" ::: "memory");
        }
    }
    __syncthreads();
}

constexpr int NPHASE = 16;
constexpr int TILE_OFF = 131072;
constexpr int LDS_BYTES = 147456, PT_OFF = LDS_BYTES - 512, MISC_OFF = LDS_BYTES - 128;
__device__ __forceinline__ const float* pt_load(const LAS unsigned* pt, int i) {
    const unsigned lo = __builtin_amdgcn_readfirstlane(pt[2 * i]), hi = __builtin_amdgcn_readfirstlane(pt[2 * i + 1]);
    return (const float*)(((unsigned long long)hi << 32) | lo);
}
__device__ __forceinline__ P make_p(const LAS unsigned* pt, float* out, unsigned char* ws) {
    P p;
    p.x = pt_load(pt, 0); p.mem = pt_load(pt, 1); p.g_mix = pt_load(pt, 2); p.w_in = pt_load(pt, 3); p.w_pool = pt_load(pt, 4); p.pool_scale = pt_load(pt, 5); p.w_gate_up = pt_load(pt, 6); p.b_gate_up = pt_load(pt, 7);
    p.gla_g = pt_load(pt, 8); p.w_out = pt_load(pt, 9); p.g_xattn = pt_load(pt, 10); p.g_mem = pt_load(pt, 11); p.w_xq = pt_load(pt, 12); p.w_xk = pt_load(pt, 13); p.w_xv = pt_load(pt, 14); p.w_xo = pt_load(pt, 15);
    p.g_moe = pt_load(pt, 16); p.w_router = pt_load(pt, 17); p.b_router = pt_load(pt, 18); p.w_gu = pt_load(pt, 19); p.b_gu = pt_load(pt, 20); p.w_dn = pt_load(pt, 21); p.b_dn = pt_load(pt, 22); p.g_final = pt_load(pt, 23);
    p.out = out; p.ws = ws; return p;
}
struct Args { const float* in[24]; float* out; unsigned char* ws; int ph_lo, ph_hi; };

__global__ void __launch_bounds__(NTHREADS, 2) mk_fwd(Args a) {
    extern __shared__ __attribute__((aligned(16))) unsigned char lds[];
    float* ldsf = (float*)lds;
    { volatile LAS unsigned long long* PT = (volatile LAS unsigned long long*)((LAS unsigned char*)lds + PT_OFF);
      if (threadIdx.x == 0) {
#define PTS(i) PT[i] = (unsigned long long)a.in[i];
          PTS(0) PTS(1) PTS(2) PTS(3) PTS(4) PTS(5) PTS(6) PTS(7) PTS(8) PTS(9) PTS(10) PTS(11) PTS(12) PTS(13) PTS(14) PTS(15) PTS(16) PTS(17) PTS(18) PTS(19) PTS(20) PTS(21) PTS(22) PTS(23)
#undef PTS
      } }
    const int bid = blockIdx.x; constexpr int nb = NBLOCKS;
#if defined(MK_PER_PHASE)
    const int lo = a.ph_lo, hi = a.ph_hi;
#else
    constexpr int lo = 0, hi = NPHASE;
#endif
#ifndef PH
#define PH -1
#endif
#ifndef REPMASK
#define REPMASK 0
#endif
#define REP(k) ((((REPMASK) >> (k)) & 1) ? 2 : 1)
#ifndef FASTMASK
#define FASTMASK 0xFFF
#endif
#define IN(k) ((PH < 0 || PH == (k)) && lo <= (k) && (k) < hi)
    LAS unsigned char* ldsl = (LAS unsigned char*)lds;
    volatile LAS unsigned* MISC = (volatile LAS unsigned*)(ldsl + MISC_OFF);
    if (threadIdx.x < 32) MISC[threadIdx.x] = 0u;
    __syncthreads();
    const bool fused = (hi - lo) > 1;
    if (fused) (void)xcd_barrier_post((unsigned*)(a.ws + WS_CTL) + CW_BAR, MISC + 8);
#define GRID_BAR() xcd_barrier((unsigned*)(a.ws + WS_CTL) + CW_BAR, (volatile LAS unsigned*)(ldsl + MISC_OFF) + 8)
#define SEAM(k) do { if (fused && IN(k) && IN((k) + 1)) GRID_BAR(); } while (0)
    if (IN(0)) for (int rep_ = 0; rep_ < REP(0); ++rep_) { if (rep_) GRID_BAR(); asm volatile("" ::: "memory"); P p = make_p((const LAS unsigned*)(ldsl + PT_OFF), a.out, a.ws); asm volatile("" : "+s"(p.ws)); unsigned char* const ws = p.ws; float* const rowsq1 = (float*)(p.ctl() + CW_ROWSQ1); (void)ws; (void)rowsq1;
    phase_prologue(p, ldsf, bid, nb);
    }
    SEAM(0);
    if (IN(1)) for (int rep_ = 0; rep_ < REP(1); ++rep_) { if (rep_) GRID_BAR(); asm volatile("" ::: "memory"); P p = make_p((const LAS unsigned*)(ldsl + PT_OFF), a.out, a.ws); asm volatile("" : "+s"(p.ws)); unsigned char* const ws = p.ws; float* const rowsq1 = (float*)(p.ctl() + CW_ROWSQ1); (void)ws; (void)rowsq1;
    {
        if (FASTMASK & 1) { pg::SchedG1 S{nb, bid}; pg::EpiBf3 E{ws, WS_Z1, WS_KX, WS_VXT, NZ, D, BATCH * MEMLEN};
            pg::gemm_phase<pg::EpiBf3, pg::SchedG1, true>(ldsl, ws, pg::Gemm{D, D, D}, S, E); }
        else {
        ngemm(NG{p.xn(), D, p.wt_in(), D, M, NZ, D, nullptr, 0}, EpiBf{p.z1(), NZ}, ldsf, bid, nb);
        ngemm(NG{p.hm(), D, p.wt_xk(), D, BATCH * MEMLEN, D, D, nullptr, 0}, EpiBf{p.kx(), D}, ldsf, bid, nb);
        ngemm(NG{p.wt_xv(), D, p.hm(), D, D, BATCH * MEMLEN, D, nullptr, 0}, EpiBf{p.vxt(), BATCH * MEMLEN}, ldsf, bid, nb); }
    }
    }
    SEAM(1);
    if (IN(2)) for (int rep_ = 0; rep_ < REP(2); ++rep_) { if (rep_) GRID_BAR(); asm volatile("" ::: "memory"); P p = make_p((const LAS unsigned*)(ldsl + PT_OFF), a.out, a.ws); asm volatile("" : "+s"(p.ws)); unsigned char* const ws = p.ws; float* const rowsq1 = (float*)(p.ctl() + CW_ROWSQ1); (void)ws; (void)rowsq1;
    { if (FASTMASK & 256) phase_pool2(p, lds, bid, nb); else phase_pool(p, ldsf, bid, nb);
      if (FASTMASK & 512) phase_gla_a2(p, lds, bid, nb); else phase_gla_a(p, ldsf, bid, nb); }
    }
    SEAM(2);
    if (IN(3)) for (int rep_ = 0; rep_ < REP(3); ++rep_) { if (rep_) GRID_BAR(); asm volatile("" ::: "memory"); P p = make_p((const LAS unsigned*)(ldsl + PT_OFF), a.out, a.ws); asm volatile("" : "+s"(p.ws)); unsigned char* const ws = p.ws; float* const rowsq1 = (float*)(p.ctl() + CW_ROWSQ1); (void)ws; (void)rowsq1;
    if (FASTMASK & 512) phase_scan2(p, bid, nb); else phase_scan(p, bid, nb);
    }
    SEAM(3);
    if (IN(4)) for (int rep_ = 0; rep_ < REP(4); ++rep_) { if (rep_) GRID_BAR(); asm volatile("" ::: "memory"); P p = make_p((const LAS unsigned*)(ldsl + PT_OFF), a.out, a.ws); asm volatile("" : "+s"(p.ws)); unsigned char* const ws = p.ws; float* const rowsq1 = (float*)(p.ctl() + CW_ROWSQ1); (void)ws; (void)rowsq1;
    if (FASTMASK & 512) phase_gla_b2(p, lds, bid, nb); else phase_gla_b(p, ldsf, bid, nb);
    }
    SEAM(4);
    if (IN(5)) for (int rep_ = 0; rep_ < REP(5); ++rep_) { if (rep_) GRID_BAR(); asm volatile("" ::: "memory"); P p = make_p((const LAS unsigned*)(ldsl + PT_OFF), a.out, a.ws); asm volatile("" : "+s"(p.ws)); unsigned char* const ws = p.ws; float* const rowsq1 = (float*)(p.ctl() + CW_ROWSQ1); (void)ws; (void)rowsq1;
    {
        if (FASTMASK & 2) { pg::Sched2D S{(unsigned)WS_MIX, (unsigned)WS_WT_OUT, D * 2, D * 2, M / 256, D / 256, nb, bid}; pg::EpiOutF E{p.x, p.x1(), p.a2(), p.g_xattn, rowsq1};
            pg::gemm_phase<pg::EpiOutF, pg::Sched2D, false>(ldsl, ws, pg::Gemm{D, D, D}, S, E); }
        else ngemm(NG{p.mix(), D, p.wt_out(), D, M, D, D, nullptr, 0}, EpiOut{p.x, p.x1(), p.a2(), p.g_xattn, rowsq1}, ldsf, bid, nb);
    }
    }
    SEAM(5);
    if (IN(6)) for (int rep_ = 0; rep_ < REP(6); ++rep_) { if (rep_) GRID_BAR(); asm volatile("" ::: "memory"); P p = make_p((const LAS unsigned*)(ldsl + PT_OFF), a.out, a.ws); asm volatile("" : "+s"(p.ws)); unsigned char* const ws = p.ws; float* const rowsq1 = (float*)(p.ctl() + CW_ROWSQ1); (void)ws; (void)rowsq1;
    {
        if (FASTMASK & 4) { pg::Sched2D S{(unsigned)WS_A2, (unsigned)WS_WT_XQ, D * 2, D * 2, M / 256, D / 256, nb, bid}; pg::EpiQF E{p.qx(), rowsq1};
            pg::gemm_phase<pg::EpiQF, pg::Sched2D, false>(ldsl, ws, pg::Gemm{D, D, D}, S, E); }
        else ngemm(NG{p.a2(), D, p.wt_xq(), D, M, D, D, nullptr, 0}, EpiQ{p.qx(), rowsq1}, ldsf, bid, nb);
    }
    }
    SEAM(6);
    if (IN(7)) for (int rep_ = 0; rep_ < REP(7); ++rep_) { if (rep_) GRID_BAR(); asm volatile("" ::: "memory"); P p = make_p((const LAS unsigned*)(ldsl + PT_OFF), a.out, a.ws); asm volatile("" : "+s"(p.ws)); unsigned char* const ws = p.ws; float* const rowsq1 = (float*)(p.ctl() + CW_ROWSQ1); (void)ws; (void)rowsq1;
    {
        if (FASTMASK & 8) { pg::SchedAttn S{(unsigned)WS_QX, (unsigned)WS_KX, MEMLEN * D * 2, 256 * 2, nb, bid}; pg::EpiF E{p.sc(), D};
            pg::gemm_phase<pg::EpiF, pg::SchedAttn, false>(ldsl, ws, pg::Gemm{D, D, 256}, S, E); }
        else for (int bh = 0; bh < 8; ++bh) { const int b = bh >> 2, h = bh & 3; const size_t o = (size_t)b * SEQ * D + h * 256;
            ngemm(NG{p.qx() + o, D, p.kx() + (size_t)b * MEMLEN * D + h * 256, D, SEQ, 256, 256, nullptr, 0}, EpiF32{p.sc() + o, D}, ldsf, bid, nb); }
    }
    }
    SEAM(7);
    if (IN(8)) for (int rep_ = 0; rep_ < REP(8); ++rep_) { if (rep_) GRID_BAR(); asm volatile("" ::: "memory"); P p = make_p((const LAS unsigned*)(ldsl + PT_OFF), a.out, a.ws); asm volatile("" : "+s"(p.ws)); unsigned char* const ws = p.ws; float* const rowsq1 = (float*)(p.ctl() + CW_ROWSQ1); (void)ws; (void)rowsq1;
    phase_softmax(p, bid, nb);
    }
    SEAM(8);
    if (IN(9)) for (int rep_ = 0; rep_ < REP(9); ++rep_) { if (rep_) GRID_BAR(); asm volatile("" ::: "memory"); P p = make_p((const LAS unsigned*)(ldsl + PT_OFF), a.out, a.ws); asm volatile("" : "+s"(p.ws)); unsigned char* const ws = p.ws; float* const rowsq1 = (float*)(p.ctl() + CW_ROWSQ1); (void)ws; (void)rowsq1;
    {
        if (FASTMASK & 16) { pg::SchedAttn S{(unsigned)WS_PX, (unsigned)WS_VXT, MEMLEN * 2, 256 * BATCH * MEMLEN * 2, nb, bid}; pg::EpiBf3 E{ws, WS_OX, WS_OX, WS_OX, D, D, D};
            pg::gemm_phase<pg::EpiBf3, pg::SchedAttn, false>(ldsl, ws, pg::Gemm{D, BATCH * MEMLEN, 256}, S, E); }
        else for (int bh = 0; bh < 8; ++bh) { const int b = bh >> 2, h = bh & 3; const size_t o = (size_t)b * SEQ * D + h * 256;
            ngemm(NG{p.px() + o, D, p.vxt() + (size_t)h * 256 * (BATCH * MEMLEN) + b * MEMLEN, BATCH * MEMLEN, SEQ, 256, 256, nullptr, 0}, EpiBf{p.ox() + o, D}, ldsf, bid, nb); }
    }
    }
    SEAM(9);
    if (IN(10)) for (int rep_ = 0; rep_ < REP(10); ++rep_) { if (rep_) GRID_BAR(); asm volatile("" ::: "memory"); P p = make_p((const LAS unsigned*)(ldsl + PT_OFF), a.out, a.ws); asm volatile("" : "+s"(p.ws)); unsigned char* const ws = p.ws; float* const rowsq1 = (float*)(p.ctl() + CW_ROWSQ1); (void)ws; (void)rowsq1;
    {
        if (FASTMASK & 32) { pg::Sched2D S{(unsigned)WS_OX, (unsigned)WS_WT_XO, D * 2, D * 2, M / 256, D / 256, nb, bid}; pg::EpiResF E{p.x1(), p.x2()};
            pg::gemm_phase<pg::EpiResF, pg::Sched2D, false>(ldsl, ws, pg::Gemm{D, D, D}, S, E); }
        else ngemm(NG{p.ox(), D, p.wt_xo(), D, M, D, D, nullptr, 0}, EpiRes{p.x1(), p.x2()}, ldsf, bid, nb);
    }
    }
    SEAM(10);
    if (IN(11)) for (int rep_ = 0; rep_ < REP(11); ++rep_) { if (rep_) GRID_BAR(); asm volatile("" ::: "memory"); P p = make_p((const LAS unsigned*)(ldsl + PT_OFF), a.out, a.ws); asm volatile("" : "+s"(p.ws)); unsigned char* const ws = p.ws; float* const rowsq1 = (float*)(p.ctl() + CW_ROWSQ1); (void)ws; (void)rowsq1;
    if (FASTMASK & 2048) phase_router3(p, ldsf, (int*)(ws + WS_BLKCNT), (int*)(ws + WS_WAVEBASE), bid, nb); else if (FASTMASK & 1024) phase_router2(p, ldsf, (int*)(ws + WS_BLKCNT), (int*)(ws + WS_WAVEBASE), bid, nb); else phase_router(p, ldsf, bid, nb);
    }
    SEAM(11);
    if (IN(12)) for (int rep_ = 0; rep_ < REP(12); ++rep_) { if (rep_) GRID_BAR(); asm volatile("" ::: "memory"); P p = make_p((const LAS unsigned*)(ldsl + PT_OFF), a.out, a.ws); asm volatile("" : "+s"(p.ws)); unsigned char* const ws = p.ws; float* const rowsq1 = (float*)(p.ctl() + CW_ROWSQ1); (void)ws; (void)rowsq1;
    if (FASTMASK & 2048) phase_dispatch3(p, (int*)lds, (const int*)(ws + WS_BLKCNT), (const int*)(ws + WS_WAVEBASE), bid, nb); else if (FASTMASK & 1024) phase_dispatch2(p, (int*)lds, (const int*)(ws + WS_BLKCNT), (const int*)(ws + WS_WAVEBASE), bid, nb); else phase_dispatch(p, (int*)lds, bid, nb);
    }
    SEAM(12);
    if (IN(13)) for (int rep_ = 0; rep_ < REP(13); ++rep_) { if (rep_) GRID_BAR(); asm volatile("" ::: "memory"); P p = make_p((const LAS unsigned*)(ldsl + PT_OFF), a.out, a.ws); asm volatile("" : "+s"(p.ws)); unsigned char* const ws = p.ws; float* const rowsq1 = (float*)(p.ctl() + CW_ROWSQ1); (void)ws; (void)rowsq1;
    { const int nmt = __builtin_amdgcn_readfirstlane(p.tilee()[MAXMT]);
        LAS int* tl = (LAS int*)(ldsl + TILE_OFF); for (int i = threadIdx.x; i < MAXMT; i += NTHREADS) tl[i] = p.tilee()[i]; __syncthreads();
        if (MOE_FP8) { pg::SchedMoE S{(unsigned)WS_XS, (unsigned)WS_WT_GU, tl, 2 * DFF * D, D, D, nmt, 8, nb, bid}; pg::EpiUp8 E{(unsigned char*)p.h(), p.b_gu};
            pg::gemm_phase<pg::EpiUp8, pg::SchedMoE, true, true>(ldsl, ws, pg::Gemm{D / 2, D / 2, D / 2}, S, E); }
        else if (FASTMASK & 64) { pg::SchedMoE S{(unsigned)WS_XS, (unsigned)WS_WT_GU, tl, 2 * DFF * D * 2, D * 2, D * 2, nmt, 8, nb, bid}; pg::EpiUpF E{p.h(), p.b_gu};
            pg::gemm_phase<pg::EpiUpF, pg::SchedMoE, true>(ldsl, ws, pg::Gemm{D, D, D}, S, E); }
        else ngemm(NG{p.xs(), D, p.wt_gu(), D, nmt * 256, 2 * DFF, D, p.tilee(), (size_t)2 * DFF * D}, EpiUp{p.h(), p.b_gu}, ldsf, bid, nb); }
    }
    SEAM(13);
    if (IN(14)) for (int rep_ = 0; rep_ < REP(14); ++rep_) { if (rep_) GRID_BAR(); asm volatile("" ::: "memory"); P p = make_p((const LAS unsigned*)(ldsl + PT_OFF), a.out, a.ws); asm volatile("" : "+s"(p.ws)); unsigned char* const ws = p.ws; float* const rowsq1 = (float*)(p.ctl() + CW_ROWSQ1); (void)ws; (void)rowsq1;
    { const int nmt = __builtin_amdgcn_readfirstlane(p.tilee()[MAXMT]);
        LAS int* tl = (LAS int*)(ldsl + TILE_OFF); for (int i = threadIdx.x; i < MAXMT; i += NTHREADS) tl[i] = p.tilee()[i]; __syncthreads();
        if (MOE_FP8) { pg::SchedMoE S{(unsigned)WS_H, (unsigned)WS_WT_DN, tl, D * DFF, DFF, DFF, nmt, 4, nb, bid}; pg::EpiDn8 E{p.y(), p.b_dn, p.gslot()};
            pg::gemm_phase<pg::EpiDn8, pg::SchedMoE, true, true>(ldsl, ws, pg::Gemm{DFF / 2, DFF / 2, DFF / 2}, S, E); }
        else if (FASTMASK & 128) { pg::SchedMoE S{(unsigned)WS_H, (unsigned)WS_WT_DN, tl, D * DFF * 2, DFF * 2, DFF * 2, nmt, 4, nb, bid}; pg::EpiDnF E{p.y(), p.b_dn, p.gslot()};
            pg::gemm_phase<pg::EpiDnF, pg::SchedMoE, true>(ldsl, ws, pg::Gemm{DFF, DFF, DFF}, S, E); }
        else ngemm(NG{p.h(), DFF, p.wt_dn(), DFF, nmt * 256, D, DFF, p.tilee(), (size_t)D * DFF}, EpiDn{p.y(), p.b_dn, p.gslot()}, ldsf, bid, nb); }
    }
    SEAM(14);
    if (IN(15)) for (int rep_ = 0; rep_ < REP(15); ++rep_) { if (rep_) GRID_BAR(); asm volatile("" ::: "memory"); P p = make_p((const LAS unsigned*)(ldsl + PT_OFF), a.out, a.ws); asm volatile("" : "+s"(p.ws)); unsigned char* const ws = p.ws; float* const rowsq1 = (float*)(p.ctl() + CW_ROWSQ1); (void)ws; (void)rowsq1;
    phase_final(p, bid, nb);
    }
#undef IN
#undef SEAM
}

extern "C" void kernel_launch(void* const* d_in, const int* in_sizes, int n_in, void* d_out, int out_size, void* d_ws, size_t ws_size, hipStream_t stream) {
    static int grid = 0;
    if (grid == 0) {
        if (n_in != 24 || in_sizes[0] != M * D || out_size != M * D || ws_size < WS_END) { fprintf(stderr, "kernel_launch: unexpected shapes (n_in %d, in0 %d, out %d, ws %zu)\n", n_in, n_in > 0 ? in_sizes[0] : -1, out_size, ws_size); grid = -1; return; }
        int dev = 0, cus = 0;
        if (hipGetDevice(&dev) != hipSuccess || hipDeviceGetAttribute(&cus, hipDeviceAttributeMultiprocessorCount, dev) != hipSuccess) { grid = -1; return; }
        if (hipFuncSetAttribute((const void*)mk_fwd, hipFuncAttributeMaxDynamicSharedMemorySize, LDS_BYTES) != hipSuccess) { fprintf(stderr, "kernel_launch: hipFuncSetAttribute failed\n"); grid = -1; return; }
        if (cus != NBLOCKS) fprintf(stderr, "kernel_launch: device reports %d CUs; this kernel launches %d workgroups (one per CU of a 256-CU device)\n", cus, NBLOCKS);
        grid = NBLOCKS;
    }
    if (grid < 0) return;
    (void)hipMemsetAsync((char*)d_ws + WS_CTL, 0, CTL_BYTES, stream);
    Args a{};
    for (int i = 0; i < 24; ++i) a.in[i] = (const float*)d_in[i];
    a.out = (float*)d_out; a.ws = (unsigned char*)d_ws;
#if defined(MK_PER_PHASE)
    for (int ph = 0; ph < NPHASE; ++ph) { a.ph_lo = ph; a.ph_hi = ph + 1; hipLaunchKernelGGL(mk_fwd, dim3(grid), dim3(NTHREADS), LDS_BYTES, stream, a); }
#else
    a.ph_lo = 0; a.ph_hi = NPHASE; hipLaunchKernelGGL(mk_fwd, dim3(grid), dim3(NTHREADS), LDS_BYTES, stream, a);
#endif
}
```

```cpp
#include <hip/hip_runtime.h>
#include <cstdio>
#include <cstdint>

#define LAS __attribute__((address_space(3)))
typedef unsigned short bf16;
typedef float f32x4 __attribute__((ext_vector_type(4)));
typedef unsigned u32x4 __attribute__((ext_vector_type(4)));
typedef unsigned u32x2 __attribute__((ext_vector_type(2)));
typedef int i32x4g __attribute__((ext_vector_type(4)));

constexpr int BATCH = 2, SEQ = 8192, M = BATCH * SEQ, D = 1024;
constexpr int IN_COLS = 2064, NZ = 2048;
constexpr int ZQ = 512, ZK = 768, ZV = 1024, ZR = 1536, GLR_COL0 = 1536;
constexpr int NE = 32, TOPK = 4, DFF = 1024, MEMLEN = 256;
constexpr int NASSIGN = M * TOPK, MAXSLOT = NASSIGN + NE * 256, MAXMT = MAXSLOT / 256;
constexpr int NCHUNK = SEQ / 64;
constexpr float EPS = 1e-6f;
constexpr int NTHREADS = 512, NWAVES = 8, NBLOCKS = 256;

constexpr size_t MiB = 1u << 20;
constexpr size_t WS_CTL = 0, CTL_BYTES = 1 * MiB;
constexpr size_t WS_WT_OUT = 2 * MiB, WS_WT_XQ = 4 * MiB, WS_WT_XK = 6 * MiB, WS_WT_XV = 8 * MiB, WS_WT_XO = 10 * MiB, WS_WT_IN = 12 * MiB;
constexpr size_t WS_GLR = 16 * MiB, WS_SMALL = 17 * MiB;
constexpr size_t WS_RS2 = WS_SMALL, WS_TOPI = WS_SMALL + 64 * 1024, WS_TOPG = WS_TOPI + 256 * 1024, WS_SLOTOF = WS_TOPG + 256 * 1024,
                 WS_GSLOT = WS_SLOTOF + 256 * 1024, WS_TILEE = WS_GSLOT + 320 * 1024, WS_BLKCNT = WS_TILEE + 4096, WS_WAVEBASE = WS_BLKCNT + 32768;
constexpr size_t WS_WT_GU = 20 * MiB, WS_WT_DN = 148 * MiB, WS_X2 = 212 * MiB, WS_B = 276 * MiB;
constexpr size_t WS_XN = WS_B, WS_HM = WS_B + 32 * MiB, WS_Z1 = WS_B + 33 * MiB, WS_MIX = WS_B + 121 * MiB, WS_SPREV = WS_B + 153 * MiB,
                 WS_DS = WS_B + 185 * MiB, WS_DEC = WS_B + 217 * MiB, WS_X1 = WS_B + 218 * MiB, WS_A2 = WS_B + 282 * MiB, WS_KX = WS_B + 314 * MiB, WS_VXT = WS_B + 315 * MiB;
constexpr size_t WS_QX = WS_Z1, WS_PX = WS_Z1 + 32 * MiB, WS_SC = WS_MIX, WS_OX = WS_DS;
constexpr size_t WS_XS = WS_B, WS_H = WS_B + 144 * MiB, WS_Y = WS_B + 288 * MiB, WS_END = WS_B + 432 * MiB;
constexpr int CW_BAR = 4096, CW_COUNT = 8192, CW_CURSOR = 8256, CW_ROWSQ1 = 16384;

__device__ __forceinline__ float bf_lo(unsigned w) { return __uint_as_float(w << 16); }
__device__ __forceinline__ float bf_hi(unsigned w) { return __uint_as_float(w & 0xffff0000u); }
__device__ __forceinline__ float bf2f(bf16 v) { return __uint_as_float((unsigned)v << 16); }
__device__ __forceinline__ unsigned f2bf(float f) { unsigned u = __float_as_uint(f); return (u + 0x7fffu + ((u >> 16) & 1u)) >> 16; }
typedef float f32x2_t __attribute__((ext_vector_type(2)));
typedef __bf16 bf16x2_t __attribute__((ext_vector_type(2)));
__device__ __forceinline__ unsigned pk2(float lo, float hi) { const f32x2_t v = {lo, hi}; return __builtin_bit_cast(unsigned, __builtin_convertvector(v, bf16x2_t)); }
__device__ __forceinline__ int otid() { int t = threadIdx.x; asm volatile("" : "+v"(t)); return t; }
__device__ __forceinline__ float wave_sum(float v) {
#pragma unroll
    for (int o = 1; o < 64; o <<= 1) v += __shfl_xor(v, o);
    return v;
}
__device__ __forceinline__ float clamp8(float v) { return fminf(fmaxf(v, -448.f), 448.f); }
__device__ __forceinline__ unsigned pk4_fp8(float a, float b, float c, float d) { int w = __builtin_amdgcn_cvt_pk_fp8_f32(clamp8(a), clamp8(b), 0, false); w = __builtin_amdgcn_cvt_pk_fp8_f32(clamp8(c), clamp8(d), w, true); return (unsigned)w; }
constexpr float W8_SCALE = 32.f, W8_INV = 1.f / 32.f;
#ifndef MOE_FP8
#define MOE_FP8 1
#endif
__device__ __forceinline__ float logsigmoid(float x) { return fminf(x, 0.f) - log1pf(expf(-fabsf(x))); }

struct P {
    const float *x, *mem, *g_mix, *w_in, *w_pool, *pool_scale, *w_gate_up, *b_gate_up, *gla_g, *w_out, *g_xattn, *g_mem, *w_xq, *w_xk, *w_xv, *w_xo,
                *g_moe, *w_router, *b_router, *w_gu, *b_gu, *w_dn, *b_dn, *g_final;
    float* out; unsigned char* ws;
#define PACC(type, name, off) __device__ __forceinline__ type* name() const { return (type*)(ws + (off)); }
    PACC(unsigned, ctl, WS_CTL) PACC(float, glr, WS_GLR)
    PACC(bf16, wt_in, WS_WT_IN) PACC(bf16, wt_out, WS_WT_OUT) PACC(bf16, wt_xq, WS_WT_XQ) PACC(bf16, wt_xk, WS_WT_XK) PACC(bf16, wt_xv, WS_WT_XV) PACC(bf16, wt_xo, WS_WT_XO) PACC(bf16, wt_gu, WS_WT_GU) PACC(bf16, wt_dn, WS_WT_DN)
    PACC(bf16, xn, WS_XN) PACC(bf16, hm, WS_HM) PACC(bf16, z1, WS_Z1) PACC(bf16, mix, WS_MIX) PACC(bf16, a2, WS_A2) PACC(bf16, kx, WS_KX) PACC(bf16, vxt, WS_VXT)
    PACC(bf16, qx, WS_QX) PACC(bf16, px, WS_PX) PACC(bf16, ox, WS_OX) PACC(bf16, xs, WS_XS) PACC(bf16, h, WS_H) PACC(bf16, y, WS_Y)
    PACC(float, sprev, WS_SPREV) PACC(float, ds, WS_DS) PACC(float, dec, WS_DEC) PACC(float, x1, WS_X1) PACC(float, x2, WS_X2) PACC(float, sc, WS_SC)
    PACC(float, rs2, WS_RS2) PACC(float, topg, WS_TOPG) PACC(float, gslot, WS_GSLOT) PACC(int, topi, WS_TOPI) PACC(int, slotof, WS_SLOTOF) PACC(int, tilee, WS_TILEE)
#undef PACC
};

struct MapId { __device__ __forceinline__ int operator()(int n) const { return n; } };
struct MapIn { __device__ __forceinline__ int operator()(int n) const { return n < 1536 ? n : 1552 + (n - 1536); } };
struct MapGu { __device__ __forceinline__ int operator()(int n) const { const int pn = n >> 8, w = n & 255; return w < 128 ? pn * 128 + w : 1024 + pn * 128 + (w - 128); } };

template <class Map>
__device__ __forceinline__ void transpose_item(const float* W, int ldw, int K, bf16* WT, float* scr, int kb, int nb, int lane, Map map) {
    const int k0 = 64 * kb, n0 = 32 * nb;
    const int sc = map(n0 + (lane & 31));
#pragma unroll 8
    for (int i = 0; i < 32; ++i) { const int kk = 2 * i + (lane >> 5); scr[kk * 33 + (lane & 31)] = sc >= 0 ? W[(size_t)(k0 + kk) * ldw + sc] : 0.f; }
    __builtin_amdgcn_s_waitcnt(0xC07F); asm volatile("" ::: "memory");
    const int c = lane & 7;
#pragma unroll
    for (int j = 0; j < 4; ++j) { const int n = (lane >> 3) + 8 * j; const float* s = scr + (8 * c) * 33 + n;
        u32x4 o; o.x = pk2(s[0 * 33], s[1 * 33]); o.y = pk2(s[2 * 33], s[3 * 33]); o.z = pk2(s[4 * 33], s[5 * 33]); o.w = pk2(s[6 * 33], s[7 * 33]);
        *(u32x4*)(WT + (size_t)(n0 + n) * K + k0 + 8 * c) = o; }
    __builtin_amdgcn_s_waitcnt(0xC07F); asm volatile("" ::: "memory");
}
template <class Map>
__device__ __forceinline__ void transpose_item8(const float* W, int ldw, int K, unsigned char* WT, float* scr, int kb, int nb, int lane, Map map, float scale) {
    const int k0 = 128 * kb, n0 = 32 * nb;
    const int sc = map(n0 + (lane & 31));
#pragma unroll 8
    for (int i = 0; i < 64; ++i) { const int kk = 2 * i + (lane >> 5); scr[kk * 33 + (lane & 31)] = W[(size_t)(k0 + kk) * ldw + sc] * scale; }
    __builtin_amdgcn_s_waitcnt(0xC07F); asm volatile("" ::: "memory");
    const int c = lane & 7;
#pragma unroll
    for (int j = 0; j < 4; ++j) { const int n = (lane >> 3) + 8 * j; const float* s = scr + (16 * c) * 33 + n;
        u32x4 o; o.x = pk4_fp8(s[0 * 33], s[1 * 33], s[2 * 33], s[3 * 33]); o.y = pk4_fp8(s[4 * 33], s[5 * 33], s[6 * 33], s[7 * 33]);
        o.z = pk4_fp8(s[8 * 33], s[9 * 33], s[10 * 33], s[11 * 33]); o.w = pk4_fp8(s[12 * 33], s[13 * 33], s[14 * 33], s[15 * 33]);
        *(u32x4*)(WT + (size_t)(n0 + n) * K + k0 + 16 * c) = o; }
    __builtin_amdgcn_s_waitcnt(0xC07F); asm volatile("" ::: "memory");
}
template <class Dst, int MODE = 0>
__device__ __forceinline__ void conv8_item(const float* W, int ldw, int K, unsigned char* WT, unsigned char* tile, int kb, int nb, int lane, Dst dst, float scale) {
    const int k0 = 64 * kb, n0 = 256 * nb;
    const float* src = W + (size_t)k0 * ldw + n0 + 4 * lane;
#pragma unroll 1
    for (int c = 0; c < 4; c += 2) {
        f32x4 v[32];
#pragma unroll
        for (int i = 0; i < 32; ++i) { if (MODE == 2) v[i] = (f32x4){0.f, 0.f, 0.f, 0.f}; else v[i] = __builtin_nontemporal_load((const f32x4*)(src + (size_t)(16 * c + i) * ldw)); }
        if (MODE == 1) {
#pragma unroll
            for (int i = 0; i < 32; ++i) asm volatile("" :: "v"(v[i]));
            continue; }
#pragma unroll
        for (int h = 0; h < 2; ++h)
#pragma unroll
            for (int j = 0; j < 4; ++j) { u32x4 o;
                o.x = pk4_fp8(v[16 * h + 0][j] * scale, v[16 * h + 1][j] * scale, v[16 * h + 2][j] * scale, v[16 * h + 3][j] * scale);
                o.y = pk4_fp8(v[16 * h + 4][j] * scale, v[16 * h + 5][j] * scale, v[16 * h + 6][j] * scale, v[16 * h + 7][j] * scale);
                o.z = pk4_fp8(v[16 * h + 8][j] * scale, v[16 * h + 9][j] * scale, v[16 * h + 10][j] * scale, v[16 * h + 11][j] * scale);
                o.w = pk4_fp8(v[16 * h + 12][j] * scale, v[16 * h + 13][j] * scale, v[16 * h + 14][j] * scale, v[16 * h + 15][j] * scale);
                const int r = 4 * lane + j, pc = (c + h) ^ (lane & 3);
                *(u32x4*)(tile + r * 64 + pc * 16) = o; }
    }
    if (MODE == 1) return;
#pragma unroll 4
    for (int s = 0; s < 16; ++s) { const int r = 16 * s + (lane >> 2), pc = (lane & 3) ^ ((r >> 2) & 3);
        const u32x4 o = *(const u32x4*)(tile + r * 64 + pc * 16);
        *(u32x4*)(WT + (size_t)dst(n0 + r) * K + k0 + 16 * (lane & 3)) = o; }
}
struct DstId { __device__ __forceinline__ int operator()(int n) const { return n; } };
struct DstGu { __device__ __forceinline__ int operator()(int n) const { const int up = n >> 10, ff = n & 1023; return (ff >> 7) * 256 + up * 128 + (ff & 127); } };
template <int NR>
__device__ __forceinline__ void rms_rows_bf16(const float* xrow, const float* g, bf16* orow, size_t rstride, int lane) {
    f32x4 v[NR][4]; float s[NR];
#pragma unroll
    for (int r = 0; r < NR; ++r)
#pragma unroll
        for (int j = 0; j < 4; ++j) v[r][j] = *((const f32x4*)(xrow + r * rstride) + lane + 64 * j);
#pragma unroll
    for (int r = 0; r < NR; ++r) { s[r] = 0.f;
#pragma unroll
        for (int j = 0; j < 4; ++j) s[r] += (v[r][j].x * v[r][j].x + v[r][j].y * v[r][j].y) + (v[r][j].z * v[r][j].z + v[r][j].w * v[r][j].w); }
#pragma unroll
    for (int o = 1; o < 64; o <<= 1)
#pragma unroll
        for (int r = 0; r < NR; ++r) s[r] += __shfl_xor(s[r], o);
    const f32x4* gr = (const f32x4*)g + lane;
#pragma unroll
    for (int r = 0; r < NR; ++r) { const float rs = 1.0f / sqrtf(s[r] * (1.f / D) + EPS); u32x2* o8 = (u32x2*)(orow + r * rstride) + lane;
#pragma unroll
        for (int j = 0; j < 4; ++j) { const f32x4 gg = gr[64 * j]; u32x2 w; w.x = pk2(v[r][j].x * rs * gg.x, v[r][j].y * rs * gg.y); w.y = pk2(v[r][j].z * rs * gg.z, v[r][j].w * rs * gg.w); o8[64 * j] = w; } }
}
__device__ __forceinline__ void rms_rows4_glr(const float* xrow, const float* g, bf16* orow, float* glr_out, const float* wgt, int lane) {
    f32x4 v[4][4]; float s[4];
#pragma unroll
    for (int r = 0; r < 4; ++r)
#pragma unroll
        for (int j = 0; j < 4; ++j) v[r][j] = *((const f32x4*)(xrow + r * D) + lane + 64 * j);
#pragma unroll
    for (int r = 0; r < 4; ++r) { s[r] = 0.f;
#pragma unroll
        for (int j = 0; j < 4; ++j) s[r] += (v[r][j].x * v[r][j].x + v[r][j].y * v[r][j].y) + (v[r][j].z * v[r][j].z + v[r][j].w * v[r][j].w); }
#pragma unroll
    for (int o = 1; o < 64; o <<= 1)
#pragma unroll
        for (int r = 0; r < 4; ++r) s[r] += __shfl_xor(s[r], o);
    float acc[64];
#pragma unroll
    for (int i = 0; i < 64; ++i) acc[i] = 0.f;
    const f32x4* gr = (const f32x4*)g + lane;
#pragma unroll
    for (int j = 0; j < 4; ++j) { const f32x4 gg = gr[64 * j]; f32x4 xn[4];
#pragma unroll
        for (int r = 0; r < 4; ++r) { const float rs = 1.0f / sqrtf(s[r] * (1.f / D) + EPS); xn[r] = v[r][j] * rs * gg;
            u32x2 w; w.x = pk2(xn[r].x, xn[r].y); w.y = pk2(xn[r].z, xn[r].w); *((u32x2*)(orow + r * D) + lane + 64 * j) = w; }
#pragma unroll
        for (int i = 0; i < 4; ++i) { const int kp = i * 256 + lane + 64 * j, sw = (kp >> 2) & 3; const float* wr = wgt + kp * 16;
#pragma unroll
            for (int c4 = 0; c4 < 4; ++c4) { const f32x4 w = *(const f32x4*)(wr + ((c4 ^ sw) << 2));
#pragma unroll
                for (int r = 0; r < 4; ++r) { const float x = xn[r][i]; acc[r * 16 + c4 * 4 + 0] += x * w.x; acc[r * 16 + c4 * 4 + 1] += x * w.y; acc[r * 16 + c4 * 4 + 2] += x * w.z; acc[r * 16 + c4 * 4 + 3] += x * w.w; } } } }
#pragma unroll
    for (int k = 0; k < 32; ++k) { const bool up = (lane & 32) != 0; const float send = up ? acc[k] : acc[k + 32]; const float keep = up ? acc[k + 32] : acc[k]; acc[k] = keep + __shfl_xor(send, 32); }
#pragma unroll
    for (int k = 0; k < 16; ++k) { const bool up = (lane & 16) != 0; const float send = up ? acc[k] : acc[k + 16]; const float keep = up ? acc[k + 16] : acc[k]; acc[k] = keep + __shfl_xor(send, 16); }
#pragma unroll
    for (int k = 0; k < 8; ++k) { const bool up = (lane & 8) != 0; const float send = up ? acc[k] : acc[k + 8]; const float keep = up ? acc[k + 8] : acc[k]; acc[k] = keep + __shfl_xor(send, 8); }
#pragma unroll
    for (int k = 0; k < 4; ++k) { const bool up = (lane & 4) != 0; const float send = up ? acc[k] : acc[k + 4]; const float keep = up ? acc[k + 4] : acc[k]; acc[k] = keep + __shfl_xor(send, 4); }
#pragma unroll
    for (int k = 0; k < 2; ++k) { const bool up = (lane & 2) != 0; const float send = up ? acc[k] : acc[k + 2]; const float keep = up ? acc[k + 2] : acc[k]; acc[k] = keep + __shfl_xor(send, 2); }
    { const bool up = (lane & 1) != 0; const float send = up ? acc[0] : acc[1]; const float keep = up ? acc[1] : acc[0]; acc[0] = keep + __shfl_xor(send, 1); }
    glr_out[lane] = acc[0];
}
#ifndef PROBE_PRO
#define PROBE_PRO 0
#endif
__device__ __forceinline__ void phase_prologue(const P& p, float* ldsf, int bid, int nb) {
    const int tid = otid(), lane = tid & 63, wave = tid >> 6;
    float* scr = ldsf + wave * (128 * 33);
    const int gw = bid * NWAVES + wave, NGW = nb * NWAVES;
    constexpr int I_IN = 16 * (NZ / 32), I_SQ = 16 * 32, I_GU = MOE_FP8 ? 16 * 8 : 16 * 64, I_DN = MOE_FP8 ? 16 * 4 : 16 * 32;
    for (int rep = 0; rep < ((PROBE_PRO & 1) ? 2 : 1); ++rep)
    for (int it = gw; it < I_IN + 5 * I_SQ; it += NGW) {
        int r = it;
        if (r < I_IN) { transpose_item(p.w_in, IN_COLS, D, p.wt_in(), scr, r / (NZ / 32), r % (NZ / 32), lane, MapIn()); continue; } r -= I_IN;
        { const int w = r / I_SQ, q = r % I_SQ; const float* src = w == 0 ? p.w_out : w == 1 ? p.w_xq : w == 2 ? p.w_xk : w == 3 ? p.w_xv : p.w_xo;
            bf16* dst = w == 0 ? p.wt_out() : w == 1 ? p.wt_xq() : w == 2 ? p.wt_xk() : w == 3 ? p.wt_xv() : p.wt_xo();
            transpose_item(src, D, D, dst, scr, q / 32, q % 32, lane, MapId()); }
    }
    for (int rep = 0; rep < ((PROBE_PRO & 2) ? 2 : 1); ++rep)
    for (int it = gw; it < NE * (I_GU + I_DN); it += NGW) {
        int r = it;
        if (r < NE * I_GU) { const int e = r / I_GU, q = r % I_GU;
            if (MOE_FP8) conv8_item(p.w_gu + (size_t)e * D * 2 * DFF, 2 * DFF, D, (unsigned char*)p.wt_gu() + (size_t)e * 2 * DFF * D, (unsigned char*)scr, q / 8, q % 8, lane, DstGu(), W8_SCALE);
            else transpose_item(p.w_gu + (size_t)e * D * 2 * DFF, 2 * DFF, D, p.wt_gu() + (size_t)e * 2 * DFF * D, scr, q / 64, q % 64, lane, MapGu()); continue; } r -= NE * I_GU;
        { const int e = r / I_DN, q = r % I_DN;
            if (MOE_FP8) conv8_item(p.w_dn + (size_t)e * DFF * D, D, DFF, (unsigned char*)p.wt_dn() + (size_t)e * D * DFF, (unsigned char*)scr, q / 4, q % 4, lane, DstId(), W8_SCALE);
            else transpose_item(p.w_dn + (size_t)e * DFF * D, D, DFF, p.wt_dn() + (size_t)e * D * DFF, scr, q / 32, q % 32, lane, MapId()); }
    }
    if (PROBE_PRO & 24)
    for (int it = gw; it < NE * (I_GU + I_DN); it += NGW) {
        int r = it;
        if (r < NE * I_GU) { const int e = r / I_GU, q = r % I_GU;
            if (PROBE_PRO & 8) conv8_item<DstGu, 1>(p.w_gu + (size_t)e * D * 2 * DFF, 2 * DFF, D, (unsigned char*)p.wt_gu() + (size_t)e * 2 * DFF * D, (unsigned char*)scr, q / 8, q % 8, lane, DstGu(), W8_SCALE);
            else conv8_item<DstGu, 2>(p.w_gu + (size_t)e * D * 2 * DFF, 2 * DFF, D, p.ws + WS_END + (size_t)e * 2 * DFF * D, (unsigned char*)scr, q / 8, q % 8, lane, DstGu(), W8_SCALE); continue; } r -= NE * I_GU;
        { const int e = r / I_DN, q = r % I_DN;
            if (PROBE_PRO & 8) conv8_item<DstId, 1>(p.w_dn + (size_t)e * DFF * D, D, DFF, (unsigned char*)p.wt_dn() + (size_t)e * D * DFF, (unsigned char*)scr, q / 4, q % 4, lane, DstId(), W8_SCALE);
            else conv8_item<DstId, 2>(p.w_dn + (size_t)e * DFF * D, D, DFF, p.ws + WS_END + 64 * MiB + (size_t)e * D * DFF, (unsigned char*)scr, q / 4, q % 4, lane, DstId(), W8_SCALE); }
    }
    for (int rep = 0; rep < ((PROBE_PRO & 4) ? 2 : 1); ++rep) {
    __syncthreads();
    for (int i = tid; i < D * 4; i += NTHREADS) { const int k = i >> 2, c4 = i & 3, kp = (k & 3) * 256 + (k >> 2);
        *(f32x4*)(ldsf + kp * 16 + ((c4 ^ ((kp >> 2) & 3)) << 2)) = *(const f32x4*)(p.w_in + (size_t)k * IN_COLS + GLR_COL0 + 4 * c4); }
    __syncthreads();
    for (int m = gw * 4; m < M; m += NGW * 4) rms_rows4_glr(p.x + (size_t)m * D, p.g_mix, p.xn() + (size_t)m * D, p.glr() + (size_t)m * 16, ldsf, lane);
    for (int m = gw; m < BATCH * MEMLEN; m += NGW) rms_rows_bf16<1>(p.mem + (size_t)m * D, p.g_mem, p.hm() + (size_t)m * D, D, lane);
    }
}

__device__ __forceinline__ float swiglu(float g, float u) { g = fminf(g, 7.f); u = fminf(fmaxf(u, -7.f), 7.f);
    return g * __builtin_amdgcn_rcpf(1.f + __builtin_amdgcn_exp2f(-1.702f * 1.44269504089f * g)) * (u + 1.f); }

__device__ __forceinline__ void phase_softmax(const P& p, int bid, int nb) {
    const int tid = otid(), lane = tid & 63, gw = bid * NWAVES + (tid >> 6), NGW = nb * NWAVES;
    for (int it = gw; it < M * 4; it += NGW) {
        const f32x4 v = *((const f32x4*)(p.sc() + (size_t)it * 256) + lane);
        float m = fmaxf(fmaxf(v.x, v.y), fmaxf(v.z, v.w));
#pragma unroll
        for (int o = 1; o < 64; o <<= 1) m = fmaxf(m, __shfl_xor(m, o));
        const float e0 = expf(v.x - m), e1 = expf(v.y - m), e2 = expf(v.z - m), e3 = expf(v.w - m);
        const float inv = 1.f / wave_sum((e0 + e1) + (e2 + e3));
        u32x2 w; w.x = pk2(e0 * inv, e1 * inv); w.y = pk2(e2 * inv, e3 * inv);
        *((u32x2*)(p.px() + (size_t)it * 256) + lane) = w;
    }
}

__device__ __forceinline__ void phase_final(const P& p, int bid, int nb) {
    const int tid = otid(), lane = tid & 63, gw = bid * NWAVES + (tid >> 6), NGW = nb * NWAVES;
    for (int t = gw * 2; t < M; t += NGW * 2) {
        f32x4 v[2][4]; u32x2 yv[2][4][4];
#pragma unroll
        for (int q = 0; q < 2; ++q) { const f32x4* xr = (const f32x4*)(p.x2() + (size_t)(t + q) * D) + lane;
#pragma unroll
            for (int j = 0; j < 4; ++j) v[q][j] = xr[64 * j];
#pragma unroll
            for (int k = 0; k < 4; ++k) { const int sl = p.slotof()[(t + q) * 4 + k]; const u32x2* yr = (const u32x2*)(p.y() + (size_t)sl * D) + lane;
#pragma unroll
                for (int j = 0; j < 4; ++j) yv[q][k][j] = yr[64 * j]; } }
#pragma unroll
        for (int q = 0; q < 2; ++q) {
#pragma unroll
            for (int k = 0; k < 4; ++k)
#pragma unroll
                for (int j = 0; j < 4; ++j) { const u32x2 w = yv[q][k][j]; v[q][j].x += bf_lo(w.x); v[q][j].y += bf_hi(w.x); v[q][j].z += bf_lo(w.y); v[q][j].w += bf_hi(w.y); }
            float s = 0.f;
#pragma unroll
            for (int j = 0; j < 4; ++j) s += (v[q][j].x * v[q][j].x + v[q][j].y * v[q][j].y) + (v[q][j].z * v[q][j].z + v[q][j].w * v[q][j].w);
            const float rs = 1.0f / sqrtf(wave_sum(s) * (1.f / D) + EPS);
            f32x4* o = (f32x4*)(p.out + (size_t)(t + q) * D) + lane;
#pragma unroll
            for (int j = 0; j < 4; ++j) { const f32x4 gg = *((const f32x4*)p.g_final + lane + 64 * j); o[64 * j] = v[q][j] * rs * gg; }
        }
    }
}

typedef short bf16x8 __attribute__((ext_vector_type(8)));
typedef float f32x16 __attribute__((ext_vector_type(16)));
template <int K>
__device__ __forceinline__ void mma_tile(f32x16& acc, const bf16* a, int pa, const bf16* b, int pb, int lane) {
    const int r = lane & 31, hf = lane >> 5;
#pragma unroll
    for (int k0 = 0; k0 < K; k0 += 16) { const bf16x8 av = *(const bf16x8*)(a + r * pa + k0 + 8 * hf); const bf16x8 bv = *(const bf16x8*)(b + r * pb + k0 + 8 * hf);
        acc = __builtin_amdgcn_mfma_f32_32x32x16_bf16(av, bv, acc, 0, 0, 0); }
}
__device__ __forceinline__ int crow(int reg, int hf) { return (reg & 3) + 8 * (reg >> 2) + 4 * hf; }
__device__ __forceinline__ f32x16 zero16() { f32x16 z;
#pragma unroll
    for (int i = 0; i < 16; ++i) z[i] = 0.f;
    return z; }
__device__ __forceinline__ float fast_logsigmoid(float x) { return fminf(x, 0.f) - __logf(1.f + __expf(-fabsf(x))); }

__device__ __forceinline__ void phase_pool2(const P& p, unsigned char* lds, int bid, int nb) {
    bf16* wpT = (bf16*)lds;
    float* ut = (float*)(lds + 34816);
    bf16* pt = (bf16*)(lds + 34816 + 40960);
    const int tid = otid(), lane = tid & 63, w = tid >> 6;
    int cur_g = -1;
    for (int u = bid; u < (M / 64) * 4; u += nb) {
        const int g = u & 3, t0 = (u >> 2) * 64, win = 2 << g, s0 = t0 & (SEQ - 1);
        __syncthreads();
        if (g != cur_g) { cur_g = g;
            for (int i = tid; i < 128 * 128; i += NTHREADS) { const int c = i >> 7, d = i & 127; wpT[d * 136 + c] = (bf16)f2bf(p.w_pool[(size_t)g * 16384 + i]); } }
        for (int c = tid; c < 80 * 16; c += NTHREADS) { const int r = c >> 4, ch = (c & 15) * 8; const int srel = s0 - 16 + r;
            f32x4 lo = {0.f, 0.f, 0.f, 0.f}, hi = {0.f, 0.f, 0.f, 0.f};
            if (srel >= 0) { const u32x4 v = *(const u32x4*)(p.z1() + (size_t)(t0 - 16 + r) * NZ + g * 128 + ch); lo = (f32x4){bf_lo(v.x), bf_hi(v.x), bf_lo(v.y), bf_hi(v.y)}; hi = (f32x4){bf_lo(v.z), bf_hi(v.z), bf_lo(v.w), bf_hi(v.w)}; }
            *(f32x4*)(ut + r * 128 + ch) = lo; *(f32x4*)(ut + r * 128 + ch + 4) = hi; }
        __syncthreads();
        { const int c = tid & 127, q = tid >> 7, i0 = 16 * q; float sum = 0.f;
          for (int d = 1; d < win; ++d) sum += ut[(16 + i0 - d) * 128 + c];
          for (int ii = 0; ii < 16; ++ii) { const int i = i0 + ii, s = s0 + i; const float uv = ut[(16 + i) * 128 + c]; sum += uv; const int cnt = (s + 1 < win) ? s + 1 : win;
              pt[i * 136 + c] = (bf16)f2bf(sum / (float)cnt - uv); sum -= ut[(16 + i - win + 1) * 128 + c]; } }
        __syncthreads();
        { const int db = w >> 1, ib = w & 1, r = lane & 31, hf = lane >> 5; f32x16 acc = zero16();
          mma_tile<128>(acc, wpT + (db * 32) * 136, 136, pt + (ib * 32) * 136, 136, lane);
          bf16* orow = p.mix() + (size_t)(t0 + ib * 32 + r) * D + g * 128 + db * 32;
#pragma unroll
          for (int rg = 0; rg < 4; ++rg) { const int d0 = 8 * rg + 4 * hf; const f32x4 sc = *(const f32x4*)(p.pool_scale + g * 128 + db * 32 + d0);
              u32x2 o; o.x = pk2(acc[4 * rg] * sc.x, acc[4 * rg + 1] * sc.y); o.y = pk2(acc[4 * rg + 2] * sc.z, acc[4 * rg + 3] * sc.w); *(u32x2*)(orow + d0) = o; } }
    }
}

__device__ __forceinline__ void gla_gc2(const P& p, float* glr, float* wtot, int t0, int h, float (&gcl)[8], float& tot) {
    const int tid = otid(), d = tid & 63, w = tid >> 6;
    __syncthreads();
    for (int i = tid; i < 64 * 16; i += NTHREADS) glr[i] = p.glr()[(size_t)t0 * 16 + i];
    float wg[16];
#pragma unroll
    for (int r = 0; r < 16; ++r) wg[r] = p.w_gate_up[r * 256 + h * 64 + d];
    const float bias = p.b_gate_up[h * 64 + d];
    __syncthreads();
    float run = 0.f;
#pragma unroll
    for (int ii = 0; ii < 8; ++ii) { const float* gr = glr + (8 * w + ii) * 16; float s = bias;
#pragma unroll
        for (int r = 0; r < 16; ++r) s += gr[r] * wg[r];
        run += fast_logsigmoid(s) * (1.f / 16.f); gcl[ii] = run; }
    wtot[w * 64 + d] = run;
    __syncthreads();
    float pre = 0.f; tot = 0.f;
#pragma unroll
    for (int ww = 0; ww < 8; ++ww) { const float v = wtot[ww * 64 + d]; pre += (ww < w) ? v : 0.f; tot += v; }
#pragma unroll
    for (int ii = 0; ii < 8; ++ii) gcl[ii] += pre;
}
__device__ __forceinline__ void load_vT(const P& p, bf16* vT, int t0, int colbase) {
    const int tid = otid(), e = tid & 127, jb = tid >> 7; unsigned short v[16];
#pragma unroll
    for (int jj = 0; jj < 16; ++jj) v[jj] = p.z1()[(size_t)(t0 + 16 * jb + jj) * NZ + colbase + e];
    u32x4 a, b; a.x = v[0] | (v[1] << 16); a.y = v[2] | (v[3] << 16); a.z = v[4] | (v[5] << 16); a.w = v[6] | (v[7] << 16);
    b.x = v[8] | (v[9] << 16); b.y = v[10] | (v[11] << 16); b.z = v[12] | (v[13] << 16); b.w = v[14] | (v[15] << 16);
    *(u32x4*)(vT + e * 72 + 16 * jb) = a; *(u32x4*)(vT + e * 72 + 16 * jb + 8) = b;
}
__device__ __forceinline__ void phase_gla_a2(const P& p, unsigned char* lds, int bid, int nb) {
    float* glr = (float*)lds; float* wtot = (float*)(lds + 4096); bf16* kdT = (bf16*)(lds + 8192); bf16* vT = (bf16*)(lds + 8192 + 9216);
    const int tid = otid(), lane = tid & 63, w = tid >> 6, d = tid & 63;
    for (int u = bid; u < 8 * NCHUNK; u += nb) {
        const int bh = u / NCHUNK, n = u % NCHUNK, b = bh >> 2, h = bh & 3, t0 = b * SEQ + n * 64;
        float gcl[8], tot; gla_gc2(p, glr, wtot, t0, h, gcl, tot);
        { unsigned pk[4];
#pragma unroll
          for (int ii = 0; ii < 8; ii += 2) { const float k0 = bf2f(p.z1()[(size_t)(t0 + 8 * w + ii) * NZ + ZK + h * 64 + d]) * __expf(tot - gcl[ii]);
              const float k1 = bf2f(p.z1()[(size_t)(t0 + 8 * w + ii + 1) * NZ + ZK + h * 64 + d]) * __expf(tot - gcl[ii + 1]); pk[ii >> 1] = pk2(k0, k1); }
          *(u32x4*)(kdT + d * 72 + 8 * w) = (u32x4){pk[0], pk[1], pk[2], pk[3]}; }
        if (w == 0) p.dec()[(size_t)u * 64 + d] = __expf(tot);
        load_vT(p, vT, t0, ZV + h * 128);
        __syncthreads();
        { const int eb = w >> 1, db = w & 1, r = lane & 31, hf = lane >> 5; f32x16 acc = zero16();
          mma_tile<64>(acc, vT + (eb * 32) * 72, 72, kdT + (db * 32) * 72, 72, lane);
          float* o = p.ds() + (size_t)u * 8192 + db * 32 + r;
#pragma unroll
          for (int reg = 0; reg < 16; ++reg) o[(eb * 32 + crow(reg, hf)) * 64] = acc[reg]; }
    }
}
__device__ __forceinline__ void kv_tile(const P& p, int bid, int q, int lane) {
    const int job = bid >> 7, b7 = bid & 127, r = lane & 31, hf = lane >> 5;
    const int rb = job ? (b7 >> 3) : (b7 >> 4), cb = job ? (b7 & 7) : (b7 & 15), ld = job ? BATCH * MEMLEN : D;
    const bf16* A = job ? p.wt_xv() : p.hm(); const bf16* Bt = job ? p.hm() : p.wt_xk(); bf16* O = job ? p.vxt() : p.kx();
    const int row0 = rb * 64 + (q >> 1) * 32, col0 = cb * 64 + (q & 1) * 32;
    const bf16* ap = A + (size_t)(row0 + r) * D + 8 * hf; const bf16* bp = Bt + (size_t)(col0 + r) * D + 8 * hf;
    f32x16 acc = zero16();
#pragma unroll 8
    for (int k0 = 0; k0 < D; k0 += 16) acc = __builtin_amdgcn_mfma_f32_32x32x16_bf16(*(const bf16x8*)(ap + k0), *(const bf16x8*)(bp + k0), acc, 0, 0, 0);
#pragma unroll
    for (int reg = 0; reg < 16; ++reg) O[(size_t)(row0 + crow(reg, hf)) * ld + col0 + r] = (bf16)f2bf(acc[reg]);
}
__device__ __forceinline__ void phase_scan2(const P& p, int bid, int nb) {
    bf16* sp = (bf16*)p.sprev();
    const int tid = otid();
    if (tid < 256)
    for (int idx = bid * 256 + tid; idx < 8 * 8192; idx += nb * 256) {
        const int bh = idx >> 13, ed = idx & 8191, d = ed & 63; float st = 0.f;
        for (int n0 = 0; n0 < NCHUNK; n0 += 8) { float dv[8], dc[8];
#pragma unroll
            for (int k = 0; k < 8; ++k) { const size_t u = (size_t)bh * NCHUNK + n0 + k; dv[k] = p.ds()[u * 8192 + ed]; dc[k] = p.dec()[u * 64 + d]; }
#pragma unroll
            for (int k = 0; k < 8; ++k) { const size_t u = (size_t)bh * NCHUNK + n0 + k; sp[u * 8192 + ed] = (bf16)f2bf(st); st = dc[k] * st + dv[k]; } }
    }
}
__device__ __forceinline__ void phase_gla_b2(const P& p, unsigned char* lds, int bid, int nb) {
    float* glr = (float*)lds; float* wtot = (float*)(lds + 4096); float* ssq = (float*)(lds + 6144);
    bf16* qe = (bf16*)(lds + 8192); bf16* ke = qe + 64 * 72; bf16* att = ke + 64 * 72; bf16* vT = att + 64 * 72; bf16* spT = vT + 128 * 72;
    const bf16* sp = (const bf16*)p.sprev();
    const int tid = otid(), lane = tid & 63, w = tid >> 6, d = tid & 63, r = lane & 31, hf = lane >> 5;
    for (int u = bid; u < 8 * NCHUNK; u += nb) {
        const int bh = u / NCHUNK, n = u % NCHUNK, b = bh >> 2, h = bh & 3, t0 = b * SEQ + n * 64;
        float gcl[8], tot; gla_gc2(p, glr, wtot, t0, h, gcl, tot);
#pragma unroll
        for (int ii = 0; ii < 8; ++ii) { const int i = 8 * w + ii; const size_t zo = (size_t)(t0 + i) * NZ + h * 64 + d;
            qe[i * 72 + d] = (bf16)f2bf(bf2f(p.z1()[zo + ZQ]) * 0.125f * __expf(gcl[ii])); ke[i * 72 + d] = (bf16)f2bf(bf2f(p.z1()[zo + ZK]) * __expf(-gcl[ii])); }
        load_vT(p, vT, t0, ZV + h * 128);
        for (int c = tid; c < 1024; c += NTHREADS) { const int e = c >> 3, d8 = (c & 7) * 8; *(u32x4*)(spT + e * 72 + d8) = *(const u32x4*)(sp + (size_t)u * 8192 + e * 64 + d8); }
        __syncthreads();
        if (w < 4) { const int ib = w & 1, jb = w >> 1; f32x16 acc = zero16();
            if (jb <= ib) mma_tile<64>(acc, qe + (ib * 32) * 72, 72, ke + (jb * 32) * 72, 72, lane);
#pragma unroll
            for (int reg = 0; reg < 16; ++reg) { const int i = ib * 32 + crow(reg, hf), j = jb * 32 + r; att[i * 72 + j] = (bf16)f2bf(j <= i ? acc[reg] : 0.f); } }
        __syncthreads();
        { const int eb = w >> 1, ib = w & 1, i = ib * 32 + r; f32x16 acc = zero16();
          mma_tile<64>(acc, vT + (eb * 32) * 72, 72, att + (ib * 32) * 72, 72, lane);
          mma_tile<64>(acc, spT + (eb * 32) * 72, 72, qe + (ib * 32) * 72, 72, lane);
          float ss = 0.f;
#pragma unroll
          for (int reg = 0; reg < 16; ++reg) ss += acc[reg] * acc[reg];
          ss += __shfl_xor(ss, 32);
          if (hf == 0) ssq[eb * 64 + i] = ss;
          __syncthreads();
          const float rs = 1.0f / sqrtf((ssq[i] + ssq[64 + i] + ssq[128 + i] + ssq[192 + i]) * (1.f / 128.f) + EPS);
          const bf16* rp = p.z1() + (size_t)(t0 + i) * NZ + ZR + h * 128 + eb * 32; bf16* op = p.mix() + (size_t)(t0 + i) * D + 512 + h * 128 + eb * 32;
#pragma unroll
          for (int rg = 0; rg < 4; ++rg) { const int e0 = 8 * rg + 4 * hf; const u32x2 rv = *(const u32x2*)(rp + e0); const f32x4 gg = *(const f32x4*)(p.gla_g + eb * 32 + e0);
              const float r0 = bf_lo(rv.x), r1 = bf_hi(rv.x), r2 = bf_lo(rv.y), r3 = bf_hi(rv.y);
              const float o0 = acc[4 * rg] * rs * gg.x * (r0 / (1.f + __expf(-r0))), o1 = acc[4 * rg + 1] * rs * gg.y * (r1 / (1.f + __expf(-r1)));
              const float o2 = acc[4 * rg + 2] * rs * gg.z * (r2 / (1.f + __expf(-r2))), o3 = acc[4 * rg + 3] * rs * gg.w * (r3 / (1.f + __expf(-r3)));
              u32x2 o; o.x = pk2(o0, o1); o.y = pk2(o2, o3); *(u32x2*)(op + e0) = o; } }
    }
}

__device__ __forceinline__ bf16x8 split_hi(const f32x4 a, const f32x4 b, f32x4& ra, f32x4& rb) {
    u32x4 h; h.x = pk2(a.x, a.y); h.y = pk2(a.z, a.w); h.z = pk2(b.x, b.y); h.w = pk2(b.z, b.w);
    ra = (f32x4){a.x - bf_lo(h.x), a.y - bf_hi(h.x), a.z - bf_lo(h.y), a.w - bf_hi(h.y)}; rb = (f32x4){b.x - bf_lo(h.z), b.y - bf_hi(h.z), b.z - bf_lo(h.w), b.w - bf_hi(h.w)};
    return __builtin_bit_cast(bf16x8, h);
}
__device__ __forceinline__ bf16x8 pack_bf8(const f32x4 a, const f32x4 b) { u32x4 h; h.x = pk2(a.x, a.y); h.y = pk2(a.z, a.w); h.z = pk2(b.x, b.y); h.w = pk2(b.z, b.w); return __builtin_bit_cast(bf16x8, h); }
__device__ __forceinline__ void phase_router3(const P& p, float* lds, int* blkcnt, int* rank, int bid, int nb) {
    const int tid = otid(), lane = tid & 63, w = tid >> 6, r = lane & 31, hf = lane >> 5;
    float* part = lds;
    float* ssqp = lds + 16384;
    float* lgt = lds + 16384 + 512;
    bf16x8 bh[8], bl[8];
#pragma unroll
    for (int s = 0; s < 8; ++s) { const int k0 = 128 * w + 16 * s + 8 * hf; f32x4 a, b, ra, rb;
#pragma unroll
        for (int j = 0; j < 4; ++j) { a[j] = p.w_router[(k0 + j) * NE + r] * p.g_moe[k0 + j]; b[j] = p.w_router[(k0 + 4 + j) * NE + r] * p.g_moe[k0 + 4 + j]; }
        bh[s] = split_hi(a, b, ra, rb); bl[s] = pack_bf8(ra, rb); }
    for (int gidx = bid; gidx < M / 64; gidx += nb) {
        const int t0 = gidx * 64;
        __syncthreads();
#pragma unroll
        for (int mt = 0; mt < 2; ++mt) {
            const float* xr = p.x2() + (size_t)(t0 + 32 * mt + r) * D + 128 * w + 8 * hf;
            f32x4 xa[8], xb[8];
#pragma unroll
            for (int s = 0; s < 8; ++s) { xa[s] = *(const f32x4*)(xr + 16 * s); xb[s] = *(const f32x4*)(xr + 16 * s + 4); }
            f32x16 acc = zero16(); float ss = 0.f;
#pragma unroll
            for (int s = 0; s < 8; ++s) { f32x4 ra, rb; ss += (xa[s].x * xa[s].x + xa[s].y * xa[s].y) + (xa[s].z * xa[s].z + xa[s].w * xa[s].w) + (xb[s].x * xb[s].x + xb[s].y * xb[s].y) + (xb[s].z * xb[s].z + xb[s].w * xb[s].w);
                const bf16x8 ah = split_hi(xa[s], xb[s], ra, rb); const bf16x8 al = pack_bf8(ra, rb);
                acc = __builtin_amdgcn_mfma_f32_32x32x16_bf16(bh[s], ah, acc, 0, 0, 0);
                acc = __builtin_amdgcn_mfma_f32_32x32x16_bf16(bh[s], al, acc, 0, 0, 0);
                acc = __builtin_amdgcn_mfma_f32_32x32x16_bf16(bl[s], ah, acc, 0, 0, 0); }
            ss += __shfl_xor(ss, 32);
            if (hf == 0) ssqp[w * 64 + 32 * mt + r] = ss;
            float* po = part + (w * 64 + 32 * mt + r) * 32;
#pragma unroll
            for (int rg = 0; rg < 4; ++rg) *(f32x4*)(po + 8 * rg + 4 * hf) = (f32x4){acc[4 * rg], acc[4 * rg + 1], acc[4 * rg + 2], acc[4 * rg + 3]};
        }
        __syncthreads();
        { const int tk = tid >> 3, e4 = (tid & 7) * 4; f32x4 s4 = {0.f, 0.f, 0.f, 0.f}; float sq = 0.f;
#pragma unroll
          for (int ww = 0; ww < 8; ++ww) { s4 += *(const f32x4*)(part + (ww * 64 + tk) * 32 + e4); sq += ssqp[ww * 64 + tk]; }
          const float rs = 1.0f / sqrtf(sq * (1.f / D) + EPS); const f32x4 bb = *(const f32x4*)(p.b_router + e4);
          lgt[tk * 33 + e4] = s4.x * rs + bb.x; lgt[tk * 33 + e4 + 1] = s4.y * rs + bb.y; lgt[tk * 33 + e4 + 2] = s4.z * rs + bb.z; lgt[tk * 33 + e4 + 3] = s4.w * rs + bb.w;
          if ((tid & 7) == 0) p.rs2()[t0 + tk] = rs; }
        __syncthreads();
        if (w == 0) {
            float lg[NE];
#pragma unroll
            for (int e = 0; e < NE; ++e) lg[e] = lgt[lane * 33 + e];
            int idx[4]; float val[4];
#pragma unroll
            for (int j = 0; j < 4; ++j) { float best = lg[0]; int bi = 0;
#pragma unroll
                for (int e = 1; e < NE; ++e) { const bool tk = lg[e] > best; best = tk ? lg[e] : best; bi = tk ? e : bi; }
                idx[j] = bi; val[j] = best;
#pragma unroll
                for (int e = 0; e < NE; ++e) lg[e] = (e == bi) ? -INFINITY : lg[e]; }
            const float e1 = __expf(val[1] - val[0]), e2 = __expf(val[2] - val[0]), e3 = __expf(val[3] - val[0]); const float inv = 1.f / (1.f + e1 + e2 + e3);
            int rk[4] = {0, 0, 0, 0}; int mycnt = 0; const unsigned long long lt = (1ull << lane) - 1ull;
#pragma unroll 4
            for (int e = 0; e < NE; ++e) { const bool h0 = idx[0] == e, h1 = idx[1] == e, h2 = idx[2] == e, h3 = idx[3] == e; const unsigned long long m = __ballot(h0 || h1 || h2 || h3);
                const int below = __popcll(m & lt); rk[0] = h0 ? below : rk[0]; rk[1] = h1 ? below : rk[1]; rk[2] = h2 ? below : rk[2]; rk[3] = h3 ? below : rk[3];
                mycnt = (lane == e) ? __popcll(m) : mycnt; }
            const int t = t0 + lane;
            *(i32x4g*)(p.topi() + t * 4) = (i32x4g){idx[0], idx[1], idx[2], idx[3]};
            *(f32x4*)(p.topg() + t * 4) = (f32x4){inv, e1 * inv, e2 * inv, e3 * inv};
            *(i32x4g*)(rank + t * 4) = (i32x4g){rk[0], rk[1], rk[2], rk[3]};
            if (lane < NE) blkcnt[gidx * NE + lane] = mycnt;
        }
    }
}
__device__ __forceinline__ void phase_dispatch3(const P& p, int* ldsi, const int* blkcnt, const int* rank, int bid, int nb) {
    const int tid = otid(), lane = tid & 63, w = tid >> 6;
    int* red_t = ldsi; int* red_p = ldsi + 512; int* base = ldsi + 1024;
    static_assert(MOE_FP8, "dispatch writes e4m3 activation rows");
    for (int gidx = bid; gidx < M / 64; gidx += nb) {
        __syncthreads();
        { const int e = tid & 31, part = tid >> 5; int tt = 0, pp = 0;
          for (int bb = part * 16; bb < part * 16 + 16; ++bb) { const int v = blkcnt[bb * 32 + e]; tt += v; pp += (bb < gidx) ? v : 0; }
          red_t[part * 32 + e] = tt; red_p[part * 32 + e] = pp; }
        __syncthreads();
        if (tid < 32) { int tt = 0, pp = 0;
#pragma unroll
            for (int q = 0; q < 16; ++q) { tt += red_t[q * 32 + tid]; pp += red_p[q * 32 + tid]; }
            red_t[tid] = tt; red_p[tid] = pp; }
        __syncthreads();
        if (tid == 0) { int off = 0; for (int e = 0; e < NE; ++e) { base[e] = off + red_p[e]; const int c = red_t[e]; const int nt = (c + 255) >> 8;
                if (gidx == 0) for (int i = 0; i < nt; ++i) p.tilee()[(off >> 8) + i] = e;
                off += nt << 8; }
            if (gidx == 0) p.tilee()[MAXMT] = off >> 8; }
        __syncthreads();
        for (int ii = 0; ii < 8; ii += 2) {
            const int t = gidx * 64 + w * 8 + ii;
            f32x4 xv[2][4]; float rs[2]; int slot[2];
#pragma unroll
            for (int q = 0; q < 2; ++q) { const f32x4* xr = (const f32x4*)(p.x2() + (size_t)(t + q) * D) + 4 * lane;
#pragma unroll
                for (int j = 0; j < 4; ++j) xv[q][j] = xr[j];
                rs[q] = p.rs2()[t + q];
                slot[q] = 0; if (lane < 4) slot[q] = base[p.topi()[(t + q) * 4 + lane]] + rank[(t + q) * 4 + lane]; }
            const f32x4* gr = (const f32x4*)p.g_moe + 4 * lane; const f32x4 g0 = gr[0], g1 = gr[1], g2 = gr[2], g3 = gr[3];
#pragma unroll
            for (int q = 0; q < 2; ++q) {
                if (lane < 4) { p.slotof()[(t + q) * 4 + lane] = slot[q]; p.gslot()[slot[q]] = p.topg()[(t + q) * 4 + lane]; }
                u32x4 o8;
                { const f32x4 v = xv[q][0] * rs[q] * g0; o8.x = pk4_fp8(v.x, v.y, v.z, v.w); } { const f32x4 v = xv[q][1] * rs[q] * g1; o8.y = pk4_fp8(v.x, v.y, v.z, v.w); }
                { const f32x4 v = xv[q][2] * rs[q] * g2; o8.z = pk4_fp8(v.x, v.y, v.z, v.w); } { const f32x4 v = xv[q][3] * rs[q] * g3; o8.w = pk4_fp8(v.x, v.y, v.z, v.w); }
#pragma unroll
                for (int k = 0; k < 4; ++k) { const int sl = __shfl(slot[q], k); *((u32x4*)((unsigned char*)p.xs() + (size_t)sl * D) + lane) = o8; }
            }
        }
    }
}

namespace pg {
typedef short bf16x8 __attribute__((ext_vector_type(8)));
constexpr int BM = 256, BK = 64, HALF = 128, HTB = HALF * BK * 2, STAGE_BYTES = 8 * HTB;
__device__ __forceinline__ int lds_byte(int r, int c) { const int st = (r >> 4) * 2 + (c >> 5), rr = r & 15, cc = c & 31, ob = rr * 64 + cc * 2; return st * 1024 + (ob ^ (((ob >> 9) & 1) << 5)); }
__device__ __forceinline__ void stage_rc(int b, int& R, int& C) { const int st = b / 1024, sb = b % 1024, swz = sb ^ (((sb >> 9) & 1) << 5); R = (st >> 1) * 16 + swz / 64; C = (st & 1) * 32 + (swz % 64) / 2; }
__device__ __forceinline__ int perm32(int rho) { const int n = rho >> 4, i = rho & 15; return 8 * (i >> 2) + 4 * n + (i & 3); }
struct Unit { int pm, pn, e; unsigned ao, bo; };
struct Gemm { int lda, ldb, K; };
__device__ __forceinline__ void map2d(int L, int nM, int nN, int& pm, int& pn) {
    const int nwg = nM * nN; int wgid = L;
    { const int q = nwg / 8, r = nwg % 8, xcd = wgid % 8, off = wgid / 8; wgid = (xcd < r ? xcd * (q + 1) : r * (q + 1) + (xcd - r) * q) + off; }
    const int nig = 8 * nN, gid = wgid / nig, fm = gid * 8, gsz = (nM - fm) < 8 ? (nM - fm) : 8;
    pm = fm + ((wgid % nig) % gsz); pn = (wgid % nig) / gsz;
}
struct Sched2D { unsigned aoff, boff, rowA, rowB; int nM, nN, G, c;
    __device__ __forceinline__ bool next(int i, Unit& u) const { const long L = (long)i * G + c; if (L >= (long)nM * nN) return false; map2d((int)L, nM, nN, u.pm, u.pn); u.e = 0;
        u.ao = aoff + (unsigned)u.pm * 256u * rowA; u.bo = boff + (unsigned)u.pn * 256u * rowB; return true; } };
struct SchedG1 { int G, c;
    __device__ __forceinline__ bool next(int i, Unit& u) const { const long L = (long)i * G + c; if (L >= 592) return false;
        const int Li = (int)L, l2 = Li - 576, l3 = Li - 584; int pm, pn; map2d(Li < 576 ? Li : 0, 64, 9, pm, pn);
        const int e = Li < 576 ? 0 : (Li < 584 ? 1 : 2);
        pm = e == 0 ? pm : (e == 1 ? (l2 >> 2) : (l3 >> 1)); pn = e == 0 ? pn : (e == 1 ? (l2 & 3) : (l3 & 1));
        const unsigned m1 = (unsigned)(e == 1), m2 = (unsigned)(e == 2);
        const unsigned ao = (unsigned)WS_XN + m1 * (unsigned)(WS_HM - WS_XN) + m2 * (unsigned)(WS_WT_XV - WS_XN), bo = (unsigned)WS_WT_IN + m1 * (unsigned)(WS_WT_XK - WS_WT_IN) + m2 * (unsigned)(WS_HM - WS_WT_IN);
        u.pm = pm; u.pn = pn; u.e = e; u.ao = ao + (unsigned)pm * 256u * D * 2u; u.bo = bo + (unsigned)pn * 256u * D * 2u; return true; } };
struct SchedAttn { unsigned aoff, boff, sBb, sBh; int G, c;
    __device__ __forceinline__ bool next(int i, Unit& u) const { const long L = (long)i * G + c; if (L >= 256) return false; const int bh = (int)L >> 5, b = bh >> 2, h = bh & 3;
        u.pm = b * 32 + ((int)L & 31); u.pn = h; u.e = 0; u.ao = aoff + ((unsigned)u.pm * 256u * D + h * 256u) * 2u; u.bo = boff + b * sBb + h * sBh; return true; } };
struct SchedMoE { unsigned aoff, boff; const LAS int* tile_e; unsigned sBe, rowA, rowB; int nM, nN, G, c;
    __device__ __forceinline__ bool next(int i, Unit& u) const { const long L = (long)i * G + c; if (L >= (long)nM * nN) return false; map2d((int)L, nM, nN, u.pm, u.pn); u.e = __builtin_amdgcn_readfirstlane(tile_e[u.pm]);
        u.ao = aoff + (unsigned)u.pm * 256u * rowA; u.bo = boff + (unsigned)u.e * sBe + (unsigned)u.pn * 256u * rowB; return true; } };

typedef f32x4 Acc[2][2][4][2];
__device__ __forceinline__ u32x4 pack8(const f32x4 v0, const f32x4 v1) { u32x4 w; w.x = pk2(v0[0], v0[1]); w.y = pk2(v0[2], v0[3]); w.z = pk2(v1[0], v1[1]); w.w = pk2(v1[2], v1[3]); return w; }
struct EpiBf3 { static constexpr bool AFTER_DRAIN = false, PERM = true; unsigned char* ws; size_t o0, o1, o2; int ld0, ld1, ld2;
    __device__ __forceinline__ void operator()(const Acc& acc, const Unit& u, int wr, int wc, int fr, int fq) const {
        const size_t m1 = (size_t)(u.e == 1), m2 = (size_t)(u.e == 2);
        bf16* base = (bf16*)(ws + o0 + m1 * (o1 - o0) + m2 * (o2 - o0)); const int ld = ld0 + (int)m1 * (ld1 - ld0) + (int)m2 * (ld2 - ld0);
        const int row0 = u.pm * BM + wr * 64 + fr, col0 = u.pn * BM + wc * 32 + 8 * fq;
#pragma unroll
        for (int ai = 0; ai < 2; ++ai)
#pragma unroll
            for (int m = 0; m < 4; ++m) { bf16* rowp = base + (size_t)(row0 + ai * HALF + m * 16) * ld + col0;
#pragma unroll
                for (int bj = 0; bj < 2; ++bj) *(u32x4*)(rowp + bj * HALF) = pack8(acc[ai][bj][m][0], acc[ai][bj][m][1]); } } };
struct EpiF { static constexpr bool AFTER_DRAIN = false, PERM = false; float* C; int ldc;
    __device__ __forceinline__ void operator()(const Acc& acc, const Unit& u, int wr, int wc, int fr, int fq) const {
        const int row0 = u.pm * BM + wr * 64 + fr, col0 = u.pn * BM + wc * 32 + 4 * fq;
#pragma unroll
        for (int ai = 0; ai < 2; ++ai)
#pragma unroll
            for (int m = 0; m < 4; ++m) { float* rowp = C + (size_t)(row0 + ai * HALF + m * 16) * ldc + col0;
#pragma unroll
                for (int bj = 0; bj < 2; ++bj)
#pragma unroll
                    for (int n = 0; n < 2; ++n) *(f32x4*)(rowp + bj * HALF + n * 16) = acc[ai][bj][m][n]; } } };
struct EpiOutF { static constexpr bool AFTER_DRAIN = false, PERM = false; const float* x; float* x1; bf16* a2; const float* g; float* rowsq;
    __device__ __forceinline__ void operator()(const Acc& acc, const Unit& u, int wr, int wc, int fr, int fq) const {
        const int row0 = u.pm * BM + wr * 64 + fr, col0 = u.pn * BM + wc * 32 + 4 * fq;
        f32x4 gv[2][2];
#pragma unroll
        for (int bj = 0; bj < 2; ++bj)
#pragma unroll
            for (int n = 0; n < 2; ++n) gv[bj][n] = *(const f32x4*)(g + col0 + bj * HALF + n * 16);
#pragma unroll
        for (int ai = 0; ai < 2; ++ai)
#pragma unroll
            for (int m = 0; m < 4; ++m) { const int row = row0 + ai * HALF + m * 16; const size_t off = (size_t)row * D + col0; float ss = 0.f;
#pragma unroll
                for (int bj = 0; bj < 2; ++bj)
#pragma unroll
                    for (int n = 0; n < 2; ++n) { const size_t o = off + bj * HALF + n * 16; const f32x4 v = *(const f32x4*)(x + o) + acc[ai][bj][m][n]; *(f32x4*)(x1 + o) = v;
                        const f32x4 t = v * gv[bj][n]; u32x2 w; w.x = pk2(t[0], t[1]); w.y = pk2(t[2], t[3]); *(u32x2*)(a2 + o) = w; ss += (v[0] * v[0] + v[1] * v[1]) + (v[2] * v[2] + v[3] * v[3]); }
                ss += __shfl_xor(ss, 16); ss += __shfl_xor(ss, 32);
                if (fq == 0) atomicAdd(rowsq + row, ss); } } };
struct EpiQF { static constexpr bool AFTER_DRAIN = false, PERM = true; bf16* q; const float* rowsq;
    __device__ __forceinline__ void operator()(const Acc& acc, const Unit& u, int wr, int wc, int fr, int fq) const {
        const int row0 = u.pm * BM + wr * 64 + fr, col0 = u.pn * BM + wc * 32 + 8 * fq;
#pragma unroll
        for (int ai = 0; ai < 2; ++ai)
#pragma unroll
            for (int m = 0; m < 4; ++m) { const int row = row0 + ai * HALF + m * 16; const float s = 0.0625f / sqrtf(rowsq[row] * (1.f / D) + EPS); bf16* rowp = q + (size_t)row * D + col0;
#pragma unroll
                for (int bj = 0; bj < 2; ++bj) *(u32x4*)(rowp + bj * HALF) = pack8(acc[ai][bj][m][0] * s, acc[ai][bj][m][1] * s); } } };
struct EpiResF { static constexpr bool AFTER_DRAIN = false, PERM = false; const float* base; float* o;
    __device__ __forceinline__ void operator()(const Acc& acc, const Unit& u, int wr, int wc, int fr, int fq) const {
        const int row0 = u.pm * BM + wr * 64 + fr, col0 = u.pn * BM + wc * 32 + 4 * fq;
#pragma unroll
        for (int ai = 0; ai < 2; ++ai)
#pragma unroll
            for (int m = 0; m < 4; ++m) { const size_t off = (size_t)(row0 + ai * HALF + m * 16) * D + col0;
#pragma unroll
                for (int bj = 0; bj < 2; ++bj)
#pragma unroll
                    for (int n = 0; n < 2; ++n) { const size_t o2 = off + bj * HALF + n * 16; *(f32x4*)(o + o2) = *(const f32x4*)(base + o2) + acc[ai][bj][m][n]; } } } };
struct EpiUpF { static constexpr bool AFTER_DRAIN = false, PERM = true; bf16* h; const float* b_gu;
    __device__ __forceinline__ void operator()(const Acc& acc, const Unit& u, int wr, int wc, int fr, int fq) const {
        const int row0 = u.pm * BM + wr * 64 + fr, ff0 = u.pn * HALF + wc * 32 + 8 * fq; const float* bb = b_gu + (size_t)u.e * 2 * DFF + ff0;
        const f32x4 bg0 = *(const f32x4*)bb, bg1 = *(const f32x4*)(bb + 4), bu0 = *(const f32x4*)(bb + DFF), bu1 = *(const f32x4*)(bb + DFF + 4);
#pragma unroll
        for (int ai = 0; ai < 2; ++ai)
#pragma unroll
            for (int m = 0; m < 4; ++m) { const f32x4 g0 = acc[ai][0][m][0] + bg0, g1 = acc[ai][0][m][1] + bg1, u0 = acc[ai][1][m][0] + bu0, u1 = acc[ai][1][m][1] + bu1; f32x4 r0, r1;
#pragma unroll
                for (int i = 0; i < 4; ++i) { r0[i] = swiglu(g0[i], u0[i]); r1[i] = swiglu(g1[i], u1[i]); }
                *(u32x4*)(h + (size_t)(row0 + ai * HALF + m * 16) * DFF + ff0) = pack8(r0, r1); } } };
struct EpiDnF { static constexpr bool AFTER_DRAIN = false, PERM = true; bf16* y; const float* b_dn; const float* gs;
    __device__ __forceinline__ void operator()(const Acc& acc, const Unit& u, int wr, int wc, int fr, int fq) const {
        const int row0 = u.pm * BM + wr * 64 + fr, col0 = u.pn * BM + wc * 32 + 8 * fq; const float* bb = b_dn + (size_t)u.e * D + col0;
        f32x4 bv[2][2];
#pragma unroll
        for (int bj = 0; bj < 2; ++bj)
#pragma unroll
            for (int n = 0; n < 2; ++n) bv[bj][n] = *(const f32x4*)(bb + bj * HALF + 4 * n);
#pragma unroll
        for (int ai = 0; ai < 2; ++ai)
#pragma unroll
            for (int m = 0; m < 4; ++m) { const int row = row0 + ai * HALF + m * 16; const float g = gs[row]; bf16* rowp = y + (size_t)row * D + col0;
#pragma unroll
                for (int bj = 0; bj < 2; ++bj) *(u32x4*)(rowp + bj * HALF) = pack8((acc[ai][bj][m][0] + bv[bj][0]) * g, (acc[ai][bj][m][1] + bv[bj][1]) * g); } } };

struct EpiUp8 { static constexpr bool AFTER_DRAIN = false, PERM = true; unsigned char* h8; const float* b_gu;
    __device__ __forceinline__ void operator()(const Acc& acc, const Unit& u, int wr, int wc, int fr, int fq) const {
        const int row0 = u.pm * BM + wr * 64 + fr, ff0 = u.pn * HALF + wc * 32 + 8 * fq; const float* bb = b_gu + (size_t)u.e * 2 * DFF + ff0;
        const f32x4 bg0 = *(const f32x4*)bb, bg1 = *(const f32x4*)(bb + 4), bu0 = *(const f32x4*)(bb + DFF), bu1 = *(const f32x4*)(bb + DFF + 4);
#pragma unroll
        for (int ai = 0; ai < 2; ++ai)
#pragma unroll
            for (int m = 0; m < 4; ++m) { const f32x4 g0 = acc[ai][0][m][0] * W8_INV + bg0, g1 = acc[ai][0][m][1] * W8_INV + bg1, u0 = acc[ai][1][m][0] * W8_INV + bu0, u1 = acc[ai][1][m][1] * W8_INV + bu1; f32x4 r0, r1;
#pragma unroll
                for (int i = 0; i < 4; ++i) { r0[i] = swiglu(g0[i], u0[i]); r1[i] = swiglu(g1[i], u1[i]); }
                u32x2 o; o.x = pk4_fp8(r0[0], r0[1], r0[2], r0[3]); o.y = pk4_fp8(r1[0], r1[1], r1[2], r1[3]);
                *(u32x2*)(h8 + (size_t)(row0 + ai * HALF + m * 16) * DFF + ff0) = o; } } };
struct EpiDn8 { static constexpr bool AFTER_DRAIN = false, PERM = true; bf16* y; const float* b_dn; const float* gs;
    __device__ __forceinline__ void operator()(const Acc& acc, const Unit& u, int wr, int wc, int fr, int fq) const {
        const int row0 = u.pm * BM + wr * 64 + fr, col0 = u.pn * BM + wc * 32 + 8 * fq; const float* bb = b_dn + (size_t)u.e * D + col0;
        f32x4 bv[2][2];
#pragma unroll
        for (int bj = 0; bj < 2; ++bj)
#pragma unroll
            for (int n = 0; n < 2; ++n) bv[bj][n] = *(const f32x4*)(bb + bj * HALF + 4 * n);
#pragma unroll
        for (int ai = 0; ai < 2; ++ai)
#pragma unroll
            for (int m = 0; m < 4; ++m) { const int row = row0 + ai * HALF + m * 16; const float g = gs[row]; bf16* rowp = y + (size_t)row * D + col0;
#pragma unroll
                for (int bj = 0; bj < 2; ++bj) *(u32x4*)(rowp + bj * HALF) = pack8((acc[ai][bj][m][0] * W8_INV + bv[bj][0]) * g, (acc[ai][bj][m][1] * W8_INV + bv[bj][1]) * g); } } };

__device__ __forceinline__ void tiles_store(LAS unsigned char* lds, const Acc& v, int wr, int wc, int fr, int fq) {
#pragma unroll
    for (int ai = 0; ai < 2; ++ai)
#pragma unroll
        for (int bj = 0; bj < 2; ++bj)
#pragma unroll
            for (int m = 0; m < 4; ++m) { const int t = 2 * bj + (wc >> 1);
                *(LAS u32x4*)(lds + (t * 2 + ai) * HTB + lds_byte(64 * wr + 16 * m + fr, (wc & 1) * 32 + 8 * fq)) = pack8(v[ai][bj][m][0], v[ai][bj][m][1]); }
}
__device__ __forceinline__ void mm_ldsA_globB(Acc& acc, LAS unsigned char* lds, const bf16* Bg, int ldb, int wr, int wc, int fr, int fq) {
    const int aoff = lds_byte(wr * 64 + fr, fq * 8);
    unsigned bo[2][2];
#pragma unroll
    for (int bj = 0; bj < 2; ++bj)
#pragma unroll
        for (int n = 0; n < 2; ++n) bo[bj][n] = (unsigned)(128 * bj + 32 * wc + perm32(16 * n + fr)) * (unsigned)ldb + 8u * fq;
    bf16x8 B0[2][2][2], B1[2][2][2];
#define MM_LOADB(dst, t) do { _Pragma("unroll") for (int bj = 0; bj < 2; ++bj) _Pragma("unroll") for (int n = 0; n < 2; ++n) _Pragma("unroll") for (int k = 0; k < 2; ++k) \
        dst[bj][n][k] = *(const bf16x8*)(Bg + bo[bj][n] + (t) * 64 + k * 32); } while (0)
#define MM_TILE(Bt, t) do { _Pragma("unroll") for (int ai = 0; ai < 2; ++ai) _Pragma("unroll") for (int mh = 0; mh < 2; ++mh) { bf16x8 At[2][2]; \
        _Pragma("unroll") for (int m = 0; m < 2; ++m) _Pragma("unroll") for (int k = 0; k < 2; ++k) At[m][k] = *(const LAS bf16x8*)(lds + ((t) * 2 + ai) * HTB + aoff + (2 * mh + m) * 2048 + k * 1024); \
        _Pragma("unroll") for (int bj = 0; bj < 2; ++bj) _Pragma("unroll") for (int m = 0; m < 2; ++m) _Pragma("unroll") for (int n = 0; n < 2; ++n) _Pragma("unroll") for (int k = 0; k < 2; ++k) \
            acc[ai][bj][2 * mh + m][n] = __builtin_amdgcn_mfma_f32_16x16x32_bf16(Bt[bj][n][k], At[m][k], acc[ai][bj][2 * mh + m][n], 0, 0, 0); \
        __builtin_amdgcn_sched_barrier(0); } } while (0)
    MM_LOADB(B0, 0);
#pragma unroll 1
    for (int t = 0; t < 4; t += 2) {
        MM_LOADB(B1, t + 1); __builtin_amdgcn_sched_barrier(0);
        MM_TILE(B0, t);
        if (t < 2) MM_LOADB(B0, t + 2);
        __builtin_amdgcn_sched_barrier(0);
        MM_TILE(B1, t + 1);
    }
#undef MM_LOADB
#undef MM_TILE
}
struct EpiQAttn { static constexpr bool AFTER_DRAIN = true, PERM = true; const float* rowsq; const bf16* kx; const bf16* vxt; bf16* ox;
    __device__ __forceinline__ void fused(Acc& acc, const Unit& u, int wr, int wc, int fr, int fq, LAS unsigned char* lds) const {
        const int b = u.pm >> 5, h = u.pn;
        LAS float* st = (LAS float*)(lds + STAGE_BYTES);
#pragma unroll
        for (int ai = 0; ai < 2; ++ai)
#pragma unroll
            for (int m = 0; m < 4; ++m) { const float s = 0.0625f / sqrtf(rowsq[u.pm * BM + 128 * ai + 64 * wr + 16 * m + fr] * (1.f / D) + EPS);
#pragma unroll
                for (int bj = 0; bj < 2; ++bj)
#pragma unroll
                    for (int n = 0; n < 2; ++n) acc[ai][bj][m][n] = acc[ai][bj][m][n] * s; }
        tiles_store(lds, acc, wr, wc, fr, fq);
        __syncthreads();
#pragma unroll
        for (int ai = 0; ai < 2; ++ai)
#pragma unroll
            for (int bj = 0; bj < 2; ++bj)
#pragma unroll
                for (int m = 0; m < 4; ++m)
#pragma unroll
                    for (int n = 0; n < 2; ++n) acc[ai][bj][m][n] = (f32x4){0.f, 0.f, 0.f, 0.f};
        mm_ldsA_globB(acc, lds, kx + (size_t)(b * MEMLEN) * D + h * 256, D, wr, wc, fr, fq);
        float wm[2][4];
#pragma unroll
        for (int ai = 0; ai < 2; ++ai)
#pragma unroll
            for (int m = 0; m < 4; ++m) { float mx = -INFINITY;
#pragma unroll
                for (int bj = 0; bj < 2; ++bj)
#pragma unroll
                    for (int n = 0; n < 2; ++n) { const f32x4 v = acc[ai][bj][m][n]; mx = fmaxf(mx, fmaxf(fmaxf(v[0], v[1]), fmaxf(v[2], v[3]))); }
                mx = fmaxf(mx, __shfl_xor(mx, 16)); mx = fmaxf(mx, __shfl_xor(mx, 32)); wm[ai][m] = mx; float sm = 0.f;
#pragma unroll
                for (int bj = 0; bj < 2; ++bj)
#pragma unroll
                    for (int n = 0; n < 2; ++n) { f32x4 v = acc[ai][bj][m][n];
#pragma unroll
                        for (int i = 0; i < 4; ++i) { v[i] = __builtin_amdgcn_exp2f((v[i] - mx) * 1.44269504089f); sm += v[i]; }
                        acc[ai][bj][m][n] = v; }
                sm += __shfl_xor(sm, 16); sm += __shfl_xor(sm, 32);
                if (fq == 0) { const int row = 128 * ai + 64 * wr + 16 * m + fr; st[(row * 4 + wc) * 2] = mx; st[(row * 4 + wc) * 2 + 1] = sm; } }
        __syncthreads();
#pragma unroll
        for (int ai = 0; ai < 2; ++ai)
#pragma unroll
            for (int m = 0; m < 4; ++m) { const int row = 128 * ai + 64 * wr + 16 * m + fr; const LAS f32x4* sp = (const LAS f32x4*)(st + row * 8); const f32x4 s0 = sp[0], s1 = sp[1];
                const float gm = fmaxf(fmaxf(s0[0], s0[2]), fmaxf(s1[0], s1[2]));
                const float f = __builtin_amdgcn_exp2f((wm[ai][m] - gm) * 1.44269504089f);
#pragma unroll
                for (int bj = 0; bj < 2; ++bj)
#pragma unroll
                    for (int n = 0; n < 2; ++n) acc[ai][bj][m][n] = acc[ai][bj][m][n] * f; }
        tiles_store(lds, acc, wr, wc, fr, fq);
        __syncthreads();
#pragma unroll
        for (int ai = 0; ai < 2; ++ai)
#pragma unroll
            for (int bj = 0; bj < 2; ++bj)
#pragma unroll
                for (int m = 0; m < 4; ++m)
#pragma unroll
                    for (int n = 0; n < 2; ++n) acc[ai][bj][m][n] = (f32x4){0.f, 0.f, 0.f, 0.f};
        mm_ldsA_globB(acc, lds, vxt + (size_t)(h * 256) * (BATCH * MEMLEN) + b * MEMLEN, BATCH * MEMLEN, wr, wc, fr, fq);
        int t3 = threadIdx.x; asm volatile("" : "+v"(t3));
        const int fr3 = t3 & 15, fq3 = (t3 >> 4) & 3;
        const int row0 = u.pm * BM + wr * 64 + fr3, col0 = h * 256 + wc * 32 + 8 * fq3;
#pragma unroll
        for (int ai = 0; ai < 2; ++ai)
#pragma unroll
            for (int m = 0; m < 4; ++m) { bf16* rowp = ox + (size_t)(row0 + ai * HALF + m * 16) * D + col0;
                const int row = 128 * ai + 64 * wr + 16 * m + fr3; const LAS f32x4* sp = (const LAS f32x4*)(st + row * 8); const f32x4 s0 = sp[0], s1 = sp[1];
                const float gm = fmaxf(fmaxf(s0[0], s0[2]), fmaxf(s1[0], s1[2]));
                const float tot = s0[1] * __builtin_amdgcn_exp2f((s0[0] - gm) * 1.44269504089f) + s0[3] * __builtin_amdgcn_exp2f((s0[2] - gm) * 1.44269504089f)
                                + s1[1] * __builtin_amdgcn_exp2f((s1[0] - gm) * 1.44269504089f) + s1[3] * __builtin_amdgcn_exp2f((s1[2] - gm) * 1.44269504089f);
                const float inv = 1.f / tot;
#pragma unroll
                for (int bj = 0; bj < 2; ++bj) *(u32x4*)(rowp + bj * HALF) = pack8(acc[ai][bj][m][0] * inv, acc[ai][bj][m][1] * inv); }
    }
};

typedef int i32x4 __attribute__((ext_vector_type(4)));
typedef int i32x8 __attribute__((ext_vector_type(8)));
__device__ __forceinline__ void mma8(const i32x8 bb, const i32x8 aa, f32x4& c) {
    asm volatile("v_mfma_f32_16x16x128_f8f6f4 %0, %1, %2, %0" : "+v"(c) : "v"(bb), "v"(aa));
}
__device__ __forceinline__ void mma8_drain() { asm volatile("s_nop 15\n\ts_nop 7" ::: "memory"); }
template <class Epi, class Sched, bool ALIGN_EPI, bool F8 = false>
__device__ __forceinline__ void gemm_phase(LAS unsigned char* lds, const unsigned char* ws, const Gemm g, const Sched& S, const Epi& E) {
    const __amdgpu_buffer_rsrc_t rsrc = __builtin_amdgcn_make_buffer_rsrc((void*)ws, 0, 0x7fffffff, 0x00020000);
    const int tid = otid(), wid = __builtin_amdgcn_readfirstlane(tid >> 6), lane = tid & 63, wr = wid >> 2, wc = wid & 3, fr = lane & 15, fq = lane >> 4;
    const int K = g.K, nt = K / BK;
    unsigned voffA[2], voffB[2];
#pragma unroll
    for (int i = 0; i < 2; ++i) { int R, C; stage_rc(tid * 16 + i * 8192, R, C); const int Rb = Epi::PERM ? ((R & ~31) + perm32(R & 31)) : R;
        voffA[i] = (unsigned)(R * g.lda + C) * 2u; voffB[i] = (unsigned)(Rb * g.ldb + C) * 2u; }
    const unsigned kstep = (unsigned)(BK * 2);
    const unsigned hstepA = (unsigned)HALF * g.lda * 2, hstepB = (unsigned)HALF * g.ldb * 2;
    const unsigned ldsw = (unsigned)wid * 1024u, ldsbase = (unsigned)(size_t)lds;
    const int aoff = lds_byte(wr * 64 + fr, fq * 8), boff = lds_byte(wc * 32 + fr, fq * 8);
#define PG_SA(b, h) (((b) * 2 + (h)) * HTB)
#define PG_SB(b, h) ((4 + (b) * 2 + (h)) * HTB)
#define PG_STAGE(bufoff, gbase, voff) do { _Pragma("unroll") for (int _i = 0; _i < 2; ++_i) \
        asm volatile("s_mov_b32 m0, %0\n\ts_nop 0\n\tbuffer_load_dwordx4 %1, %2, %3 offen lds" :: "s"(ldsbase + (unsigned)(bufoff) + ldsw + (unsigned)(_i * 8192)), "v"((voff)[_i]), "s"(rsrc), "s"((unsigned)(gbase)) : "m0", "memory"); } while (0)
#define PG_LD8(base) __builtin_shufflevector(*(const LAS i32x4*)(lds + (base)), *(const LAS i32x4*)(lds + (base) + 1024), 0, 1, 2, 3, 4, 5, 6, 7)
#define PG_LDA(dst, b, h) do { _Pragma("unroll") for (int m = 0; m < 4; ++m) { if constexpr (F8) dst##8[m] = PG_LD8(PG_SA(b, h) + aoff + m * 2048); \
        else { _Pragma("unroll") for (int k = 0; k < 2; ++k) dst[m][k] = *(const LAS bf16x8*)(lds + PG_SA(b, h) + aoff + m * 2048 + k * 1024); } } } while (0)
#define PG_LDB(dst, b, h) do { _Pragma("unroll") for (int n = 0; n < 2; ++n) { if constexpr (F8) dst##8[n] = PG_LD8(PG_SB(b, h) + boff + n * 2048); \
        else { _Pragma("unroll") for (int k = 0; k < 2; ++k) dst[n][k] = *(const LAS bf16x8*)(lds + PG_SB(b, h) + boff + n * 2048 + k * 1024); } } } while (0)
#define PG_MMA(ai, bj, At, Bt) do { __builtin_amdgcn_s_setprio(1); _Pragma("unroll") for (int m = 0; m < 4; ++m) _Pragma("unroll") for (int n = 0; n < 2; ++n) { \
        if constexpr (F8) mma8(Bt##8[n], At##8[m], acc[ai][bj][m][n]); \
        else { _Pragma("unroll") for (int k = 0; k < 2; ++k) acc[ai][bj][m][n] = __builtin_amdgcn_mfma_f32_16x16x32_bf16(Bt[n][k], At[m][k], acc[ai][bj][m][n], 0, 0, 0); } } \
        __builtin_amdgcn_s_setprio(0); } while (0)
#define PG_WAIT_V(n) asm volatile("s_waitcnt vmcnt(" #n ")" ::: "memory")
#define PG_WAIT_L(n) asm volatile("s_waitcnt lgkmcnt(" #n ")" ::: "memory")
#define PG_BAR __builtin_amdgcn_s_barrier()
#define PG_SCHED __builtin_amdgcn_sched_barrier(0)
    Unit cur, nxt; int ui = 0;
    if (!S.next(0, cur)) return;
    f32x4 acc[2][2][4][2];
#pragma unroll
    for (int a = 0; a < 2; ++a)
#pragma unroll
        for (int b = 0; b < 2; ++b)
#pragma unroll
            for (int m = 0; m < 4; ++m)
#pragma unroll
                for (int n = 0; n < 2; ++n) acc[a][b][m][n] = (f32x4){0.f, 0.f, 0.f, 0.f};
    bf16x8 At[4][2], B0[2][2], B1[2][2]; i32x8 At8[4], B08[2], B18[2];
    unsigned cA = cur.ao, cB = cur.bo;
    asm volatile("s_nop 4" ::: "memory");
    PG_STAGE(PG_SB(0, 0), cB, voffB); PG_STAGE(PG_SB(0, 1), cB + hstepB, voffB); PG_STAGE(PG_SA(0, 0), cA, voffA); PG_STAGE(PG_SA(0, 1), cA + hstepA, voffA);
    if (wr == 1) PG_BAR;
    PG_WAIT_V(2); PG_BAR;
    PG_STAGE(PG_SB(1, 0), cB + kstep, voffB); PG_STAGE(PG_SA(1, 0), cA + kstep, voffA); PG_STAGE(PG_SB(1, 1), cB + hstepB + kstep, voffB);
    PG_WAIT_V(6); PG_BAR;
    for (;;) {
        const bool has_next = S.next(ui + 1, nxt);
        const unsigned nA = has_next ? nxt.ao : cA, nB = has_next ? nxt.bo : cB;
#pragma unroll 1
        for (int t = 0; t < nt; t += 2) {
            const bool last = (t == nt - 2);
            const unsigned a1 = cA + (unsigned)(t + 1) * kstep;
            const unsigned a2 = last ? nA : cA + (unsigned)(t + 2) * kstep, b2 = last ? nB : cB + (unsigned)(t + 2) * kstep;
            const unsigned a3 = a2 + kstep, b3 = b2 + kstep;
            PG_LDB(B0, 0, 0); PG_LDB(B1, 0, 1); PG_SCHED; PG_LDA(At, 0, 0); PG_STAGE(PG_SA(1, 1), a1 + hstepA, voffA);
            PG_WAIT_V(8); PG_WAIT_L(0); PG_BAR; PG_MMA(0, 0, At, B0); PG_MMA(0, 1, At, B1); PG_BAR; PG_SCHED;
            PG_LDA(At, 0, 1); PG_STAGE(PG_SB(0, 0), b2, voffB); PG_STAGE(PG_SB(0, 1), b2 + hstepB, voffB); PG_STAGE(PG_SA(0, 0), a2, voffA);
            PG_WAIT_V(8); PG_WAIT_L(0); PG_BAR; PG_MMA(1, 0, At, B0); PG_MMA(1, 1, At, B1); PG_BAR; PG_SCHED;
            PG_LDB(B0, 1, 0); PG_LDB(B1, 1, 1); PG_SCHED; PG_LDA(At, 1, 0); PG_STAGE(PG_SA(0, 1), a2 + hstepA, voffA);
            PG_WAIT_V(8); PG_WAIT_L(0); PG_BAR; PG_MMA(0, 0, At, B0); PG_MMA(0, 1, At, B1); PG_BAR; PG_SCHED;
            PG_LDA(At, 1, 1); PG_STAGE(PG_SB(1, 0), b3, voffB); PG_STAGE(PG_SB(1, 1), b3 + hstepB, voffB); PG_STAGE(PG_SA(1, 0), a3, voffA);
            PG_WAIT_V(8); PG_WAIT_L(0); PG_BAR; PG_MMA(1, 0, At, B0); PG_MMA(1, 1, At, B1); PG_BAR; PG_SCHED;
        }
        if constexpr (ALIGN_EPI) { if (wr == 0) PG_BAR; }
        if constexpr (F8) mma8_drain();
        if constexpr (!Epi::AFTER_DRAIN) { int t2 = threadIdx.x; asm volatile("" : "+v"(t2));
          const int l2 = t2 & 63; E(acc, cur, wr, wc, l2 & 15, l2 >> 4); }
        if (!has_next) break;
#pragma unroll
        for (int a = 0; a < 2; ++a)
#pragma unroll
            for (int b = 0; b < 2; ++b)
#pragma unroll
                for (int m = 0; m < 4; ++m)
#pragma unroll
                    for (int n = 0; n < 2; ++n) acc[a][b][m][n] = (f32x4){0.f, 0.f, 0.f, 0.f};
        cur = nxt; cA = nA; cB = nB; ++ui;
        if constexpr (ALIGN_EPI) { if (wr == 1) PG_BAR; }
    }
    PG_WAIT_V(0);
    if constexpr (!ALIGN_EPI) { if (wr == 0) PG_BAR; }
    PG_BAR;
    if constexpr (Epi::AFTER_DRAIN) { int t2 = threadIdx.x; asm volatile("" : "+v"(t2)); const int l2 = t2 & 63; E.fused(acc, cur, wr, wc, l2 & 15, l2 >> 4, lds); }
#undef PG_SA
#undef PG_SB
#undef PG_STAGE
#undef PG_LDA
#undef PG_LDB
#undef PG_MMA
#undef PG_WAIT_V
#undef PG_WAIT_L
#undef PG_BAR
#undef PG_SCHED
}
}

#define XB_TMO      128
#define XB_XCNT(j)  (256  + 64 * (j))
#define XB_XSUB(j)  (1280 + 64 * (j))
#define XB_XGEN(j)  (2304 + 64 * (j))
#define XB_TOP      3328
#define XB_TOPGEN   3392
#define XCD_BAR_WORDS 3456
#define XB_SPIN_CAP (1u << 18)
__device__ __forceinline__ unsigned xb_ld(unsigned* p)              { return __hip_atomic_load(p, __ATOMIC_RELAXED, __HIP_MEMORY_SCOPE_AGENT); }
__device__ __forceinline__ unsigned xb_add(unsigned* p, unsigned v) { return __hip_atomic_fetch_add(p, v, __ATOMIC_RELAXED, __HIP_MEMORY_SCOPE_AGENT); }
__device__ __forceinline__ unsigned xb_xcc_id() { return (unsigned)__builtin_amdgcn_s_getreg((3 << 11) | 20) & 0xFu; }
#define XB_SPIN(cond, bar) do { unsigned _sp = 0; while (cond) { __builtin_amdgcn_s_sleep(1); \
    if ((++_sp & 255u) == 0u) { if (xb_ld(&(bar)[XB_TMO])) break; if (_sp > XB_SPIN_CAP) { atomicAdd(&(bar)[XB_TMO], 1u); break; } } } } while (0)
struct XcdBarrier { unsigned* bar; unsigned x; volatile LAS unsigned* st; };
__device__ __forceinline__ XcdBarrier xcd_barrier_post(unsigned* bar, volatile LAS unsigned* st) {
    XcdBarrier b; b.bar = bar; b.x = xb_xcc_id(); b.st = st;
    if (threadIdx.x == 0) (void)xb_add(&bar[XB_XCNT(b.x)], 1u);
    return b;
}
__device__ __forceinline__ void xcd_barrier_complete(unsigned* bar, unsigned x, unsigned& nloc, unsigned& nx) {
    const unsigned G = NBLOCKS;
    unsigned sum, cnt, mine, sp = 0u;
    for (;;) {
        sum = 0u; cnt = 0u; mine = 0u;
#pragma unroll
        for (unsigned j = 0; j < 16; ++j) { const unsigned c = xb_ld(&bar[XB_XCNT(j)]); sum += c; cnt += (c > 0u) ? 1u : 0u; mine = (j == x) ? c : mine; }
        if (sum == G) break;
        __builtin_amdgcn_s_sleep(1);
        if ((++sp & 255u) == 0u) { if (xb_ld(&bar[XB_TMO])) break; if (sp > XB_SPIN_CAP) { atomicAdd(&bar[XB_TMO], 1u); break; } }
    }
    nloc = mine > 0u ? mine : 1u; nx = cnt > 0u ? cnt : 1u;
}
__device__ __forceinline__ void xcd_barrier(unsigned* bar_, volatile LAS unsigned* st_) {
    asm volatile("s_waitcnt vmcnt(0)" ::: "memory");
    __syncthreads();
    if (threadIdx.x == 0) {
        XcdBarrier b; b.bar = bar_; b.x = xb_xcc_id(); b.st = st_;
        unsigned* bar = b.bar;
        __builtin_amdgcn_s_waitcnt(0);
        unsigned nloc = b.st[0], nx = b.st[1];
        if (nloc == 0u) { xcd_barrier_complete(bar, b.x, nloc, nx); b.st[0] = nloc; b.st[1] = nx; }
        const unsigned old = xb_add(&bar[XB_XSUB(b.x)], 1u);
        const unsigned gen = old / nloc;
        if (old + 1u == (gen + 1u) * nloc) {
            __builtin_amdgcn_fence(__ATOMIC_RELEASE, "agent");
            asm volatile("s_waitcnt vmcnt(0)" ::: "memory");
            const unsigned og = xb_add(&bar[XB_TOP], 1u);
            const unsigned tg = og / nx;
            if (og + 1u == (tg + 1u) * nx) xb_add(&bar[XB_TOPGEN], 1u);
            else XB_SPIN(xb_ld(&bar[XB_TOPGEN]) == tg, bar);
            __builtin_amdgcn_fence(__ATOMIC_ACQUIRE, "agent");
            xb_add(&bar[XB_XGEN(b.x)], 1u);
            asm volatile("s_waitcnt vmcnt(0)" ::: "memory");
        } else {
            XB_SPIN(xb_ld(&bar[XB_XGEN(b.x)]) == gen, bar);
            __builtin_amdgcn_fence(__ATOMIC_ACQUIRE, "agent");
            asm volatile("s_waitcnt vmcnt(0)" ::: "memory");
        }
    }
    __syncthreads();
}

constexpr int NPHASE = 13;
constexpr int TILE_OFF = 131072;
constexpr int LDS_BYTES = 147456, PT_OFF = LDS_BYTES - 512, MISC_OFF = LDS_BYTES - 128;
__device__ __forceinline__ const float* pt_load(const LAS unsigned* pt, int i) {
    const unsigned lo = __builtin_amdgcn_readfirstlane(pt[2 * i]), hi = __builtin_amdgcn_readfirstlane(pt[2 * i + 1]);
    return (const float*)(((unsigned long long)hi << 32) | lo);
}
__device__ __forceinline__ unsigned char* opaque_ws(P& p) { asm volatile("" : "+s"(p.ws) :: "memory"); return p.ws; }
__device__ __forceinline__ P make_p(const LAS unsigned* pt, float* out, unsigned char* ws) {
    P p;
    p.x = pt_load(pt, 0); p.mem = pt_load(pt, 1); p.g_mix = pt_load(pt, 2); p.w_in = pt_load(pt, 3); p.w_pool = pt_load(pt, 4); p.pool_scale = pt_load(pt, 5); p.w_gate_up = pt_load(pt, 6); p.b_gate_up = pt_load(pt, 7);
    p.gla_g = pt_load(pt, 8); p.w_out = pt_load(pt, 9); p.g_xattn = pt_load(pt, 10); p.g_mem = pt_load(pt, 11); p.w_xq = pt_load(pt, 12); p.w_xk = pt_load(pt, 13); p.w_xv = pt_load(pt, 14); p.w_xo = pt_load(pt, 15);
    p.g_moe = pt_load(pt, 16); p.w_router = pt_load(pt, 17); p.b_router = pt_load(pt, 18); p.w_gu = pt_load(pt, 19); p.b_gu = pt_load(pt, 20); p.w_dn = pt_load(pt, 21); p.b_dn = pt_load(pt, 22); p.g_final = pt_load(pt, 23);
    p.out = out; p.ws = ws; return p;
}
struct Args { const float* in[24]; float* out; unsigned char* ws; int ph_lo, ph_hi; };

__global__ void __launch_bounds__(NTHREADS, 2) mk_fwd(Args a) {
    extern __shared__ __attribute__((aligned(16))) unsigned char lds[];
    float* ldsf = (float*)lds;
    { volatile LAS unsigned long long* PT = (volatile LAS unsigned long long*)((LAS unsigned char*)lds + PT_OFF);
      if (threadIdx.x == 0) {
#define PTS(i) PT[i] = (unsigned long long)a.in[i];
          PTS(0) PTS(1) PTS(2) PTS(3) PTS(4) PTS(5) PTS(6) PTS(7) PTS(8) PTS(9) PTS(10) PTS(11) PTS(12) PTS(13) PTS(14) PTS(15) PTS(16) PTS(17) PTS(18) PTS(19) PTS(20) PTS(21) PTS(22) PTS(23)
#undef PTS
      } }
    const int bid = blockIdx.x; constexpr int nb = NBLOCKS;
#if defined(MK_PER_PHASE)
    const int lo = a.ph_lo, hi = a.ph_hi;
#else
    constexpr int lo = 0, hi = NPHASE;
#endif
#ifndef PH
#define PH -1
#endif
#ifndef REPMASK
#define REPMASK 0
#endif
#define REP(k) ((((REPMASK) >> (k)) & 1) ? 2 : 1)
#define IN(k) ((PH < 0 || PH == (k)) && lo <= (k) && (k) < hi)
    LAS unsigned char* ldsl = (LAS unsigned char*)lds;
    volatile LAS unsigned* MISC = (volatile LAS unsigned*)(ldsl + MISC_OFF);
    if (threadIdx.x < 32) MISC[threadIdx.x] = 0u;
    __syncthreads();
    const bool fused = (hi - lo) > 1;
    if (fused) (void)xcd_barrier_post((unsigned*)(a.ws + WS_CTL) + CW_BAR, MISC + 8);
#define GRID_BAR() xcd_barrier((unsigned*)(a.ws + WS_CTL) + CW_BAR, (volatile LAS unsigned*)(ldsl + MISC_OFF) + 8)
#define SEAM(k) do { if (fused && IN(k) && IN((k) + 1)) GRID_BAR(); } while (0)
#define PHASE(k) if (IN(k)) for (int rep_ = 0; rep_ < REP(k); ++rep_) if (bool once_ = true) for (P p = (rep_ ? (GRID_BAR(), make_p((const LAS unsigned*)(ldsl + PT_OFF), a.out, a.ws)) : make_p((const LAS unsigned*)(ldsl + PT_OFF), a.out, a.ws)); once_; once_ = false) \
        for (unsigned char* ws = opaque_ws(p); once_; once_ = false)
    PHASE(0) { phase_prologue(p, ldsf, bid, nb); }
    SEAM(0);
    PHASE(1) { pg::Sched2D S{(unsigned)WS_XN, (unsigned)WS_WT_IN, D * 2, D * 2, M / 256, NZ / 256, nb, bid}; pg::EpiBf3 E{ws, WS_Z1, WS_Z1, WS_Z1, NZ, NZ, NZ};
        pg::gemm_phase<pg::EpiBf3, pg::Sched2D, true>(ldsl, ws, pg::Gemm{D, D, D}, S, E); }
    SEAM(1);
    PHASE(2) { phase_pool2(p, lds, bid, nb); phase_gla_a2(p, lds, bid, nb); }
    SEAM(2);
    PHASE(3) { const int t3 = otid(), wv = __builtin_amdgcn_readfirstlane(t3 >> 6); if (wv < 4) phase_scan2(p, bid, nb); else kv_tile(p, bid, wv - 4, t3 & 63); }
    SEAM(3);
    PHASE(4) { phase_gla_b2(p, lds, bid, nb); }
    SEAM(4);
    PHASE(5) { pg::Sched2D S{(unsigned)WS_MIX, (unsigned)WS_WT_OUT, D * 2, D * 2, M / 256, D / 256, nb, bid}; pg::EpiOutF E{p.x, p.x1(), p.a2(), p.g_xattn, (float*)(p.ctl() + CW_ROWSQ1)};
        pg::gemm_phase<pg::EpiOutF, pg::Sched2D, false>(ldsl, ws, pg::Gemm{D, D, D}, S, E); }
    SEAM(5);
    PHASE(6) { pg::Sched2D S{(unsigned)WS_A2, (unsigned)WS_WT_XQ, D * 2, D * 2, M / 256, D / 256, nb, bid};
        pg::EpiQAttn E{(const float*)(p.ctl() + CW_ROWSQ1), p.kx(), p.vxt(), p.ox()};
        pg::gemm_phase<pg::EpiQAttn, pg::Sched2D, false>(ldsl, ws, pg::Gemm{D, D, D}, S, E); }
    SEAM(6);
    PHASE(7) { pg::Sched2D S{(unsigned)WS_OX, (unsigned)WS_WT_XO, D * 2, D * 2, M / 256, D / 256, nb, bid}; pg::EpiResF E{p.x1(), p.x2()};
        pg::gemm_phase<pg::EpiResF, pg::Sched2D, false>(ldsl, ws, pg::Gemm{D, D, D}, S, E); }
    SEAM(7);
    PHASE(8) { phase_router3(p, ldsf, (int*)(ws + WS_BLKCNT), (int*)(ws + WS_WAVEBASE), bid, nb); }
    SEAM(8);
    PHASE(9) { phase_dispatch3(p, (int*)lds, (const int*)(ws + WS_BLKCNT), (const int*)(ws + WS_WAVEBASE), bid, nb); }
    SEAM(9);
    PHASE(10) { const int nmt = __builtin_amdgcn_readfirstlane(p.tilee()[MAXMT]);
        LAS int* tl = (LAS int*)(ldsl + TILE_OFF); for (int i = otid(); i < MAXMT; i += NTHREADS) tl[i] = p.tilee()[i]; __syncthreads();
        pg::SchedMoE S{(unsigned)WS_XS, (unsigned)WS_WT_GU, tl, 2 * DFF * D, D, D, nmt, 8, nb, bid}; pg::EpiUp8 E{(unsigned char*)p.h(), p.b_gu};
        pg::gemm_phase<pg::EpiUp8, pg::SchedMoE, true, true>(ldsl, ws, pg::Gemm{D / 2, D / 2, D / 2}, S, E); }
    SEAM(10);
    PHASE(11) { const int nmt = __builtin_amdgcn_readfirstlane(p.tilee()[MAXMT]);
        LAS int* tl = (LAS int*)(ldsl + TILE_OFF); for (int i = otid(); i < MAXMT; i += NTHREADS) tl[i] = p.tilee()[i]; __syncthreads();
        pg::SchedMoE S{(unsigned)WS_H, (unsigned)WS_WT_DN, tl, D * DFF, DFF, DFF, nmt, 4, nb, bid}; pg::EpiDn8 E{p.y(), p.b_dn, p.gslot()};
        pg::gemm_phase<pg::EpiDn8, pg::SchedMoE, true, true>(ldsl, ws, pg::Gemm{DFF / 2, DFF / 2, DFF / 2}, S, E); }
    SEAM(11);
    PHASE(12) { phase_final(p, bid, nb); }
#undef PHASE
#undef IN
#undef SEAM
}

extern "C" void kernel_launch(void* const* d_in, const int* in_sizes, int n_in, void* d_out, int out_size, void* d_ws, size_t ws_size, hipStream_t stream) {
    static int grid = 0;
    if (grid == 0) {
        if (n_in != 24 || in_sizes[0] != M * D || out_size != M * D || ws_size < WS_END) { fprintf(stderr, "kernel_launch: unexpected shapes (n_in %d, in0 %d, out %d, ws %zu)\n", n_in, n_in > 0 ? in_sizes[0] : -1, out_size, ws_size); grid = -1; return; }
        int dev = 0, cus = 0;
        if (hipGetDevice(&dev) != hipSuccess || hipDeviceGetAttribute(&cus, hipDeviceAttributeMultiprocessorCount, dev) != hipSuccess) { grid = -1; return; }
        if (hipFuncSetAttribute((const void*)mk_fwd, hipFuncAttributeMaxDynamicSharedMemorySize, LDS_BYTES) != hipSuccess) { fprintf(stderr, "kernel_launch: hipFuncSetAttribute failed\n"); grid = -1; return; }
        if (cus != NBLOCKS) fprintf(stderr, "kernel_launch: device reports %d CUs; this kernel launches %d workgroups (one per CU of a 256-CU device)\n", cus, NBLOCKS);
        grid = NBLOCKS;
    }
    if (grid < 0) return;
    (void)hipMemsetAsync((char*)d_ws + WS_CTL, 0, CTL_BYTES, stream);
    Args a{};
    for (int i = 0; i < 24; ++i) a.in[i] = (const float*)d_in[i];
    a.out = (float*)d_out; a.ws = (unsigned char*)d_ws;
#if defined(MK_PER_PHASE)
    for (int ph = 0; ph < NPHASE; ++ph) { a.ph_lo = ph; a.ph_hi = ph + 1; hipLaunchKernelGGL(mk_fwd, dim3(grid), dim3(NTHREADS), LDS_BYTES, stream, a); }
#else
    a.ph_lo = 0; a.ph_hi = NPHASE; hipLaunchKernelGGL(mk_fwd, dim3(grid), dim3(NTHREADS), LDS_BYTES, stream, a);
#endif
}
```

```cpp
#include <hip/hip_runtime.h>
#include <cstdio>
#include <cstdint>

#define LAS __attribute__((address_space(3)))
#define GAS __attribute__((address_space(1)))
typedef unsigned short bf16;
typedef float f32x4 __attribute__((ext_vector_type(4)));
typedef unsigned u32x4 __attribute__((ext_vector_type(4)));
typedef unsigned u32x2 __attribute__((ext_vector_type(2)));
typedef int i32x4g __attribute__((ext_vector_type(4)));

constexpr int BATCH = 2, SEQ = 8192, M = BATCH * SEQ, D = 1024;
constexpr int IN_COLS = 2064, NZ = 2048;
constexpr int ZQ = 512, ZK = 768, ZV = 1024, ZR = 1536, GLR_COL0 = 1536;
constexpr int NE = 32, TOPK = 4, DFF = 1024, MEMLEN = 256;
constexpr int NASSIGN = M * TOPK, MAXSLOT = NASSIGN + NE * 256, MAXMT = MAXSLOT / 256;
constexpr int NCHUNK = SEQ / 64;
constexpr float EPS = 1e-6f;
constexpr int NTHREADS = 512, NWAVES = 8, NBLOCKS = 256;

constexpr size_t MiB = 1u << 20;
constexpr size_t WS_CTL = 0, CTL_BYTES = 1 * MiB;
constexpr size_t WS_WT_OUT = 2 * MiB, WS_WT_XQ = 4 * MiB, WS_WT_XK = 6 * MiB, WS_WT_XV = 8 * MiB, WS_WT_XO = 10 * MiB, WS_WT_IN = 12 * MiB;
constexpr size_t WS_GLR = 16 * MiB, WS_SMALL = 17 * MiB, WS_RSQP = 19 * MiB;
constexpr size_t WS_RS2 = WS_SMALL, WS_TOPI = WS_SMALL + 64 * 1024, WS_TOPG = WS_TOPI + 256 * 1024, WS_SLOTOF = WS_TOPG + 256 * 1024,
                 WS_GSLOT = WS_SLOTOF + 256 * 1024, WS_TILEE = WS_GSLOT + 320 * 1024, WS_BLKCNT = WS_TILEE + 4096, WS_WAVEBASE = WS_BLKCNT + 32768;
constexpr size_t WS_WT_GU = 20 * MiB, WS_WT_DN = 148 * MiB, WS_X2 = 212 * MiB, WS_B = 276 * MiB;
constexpr size_t WS_XN = WS_B, WS_HM = WS_B + 32 * MiB, WS_Z1 = WS_B + 33 * MiB, WS_MIX = WS_B + 121 * MiB, WS_SPREV = WS_B + 153 * MiB,
                 WS_DS = WS_B + 185 * MiB, WS_DEC = WS_B + 217 * MiB, WS_X1 = WS_B + 218 * MiB, WS_A2 = WS_B + 282 * MiB, WS_KX = WS_B + 314 * MiB, WS_VXT = WS_B + 315 * MiB;
constexpr size_t WS_QX = WS_Z1, WS_PX = WS_Z1 + 32 * MiB, WS_SC = WS_MIX, WS_OX = WS_DS;
constexpr size_t WS_X8 = WS_B, WS_TOKSLOT = WS_SMALL + 1536 * 1024;
constexpr size_t WS_XS = WS_B, WS_H = WS_B + 144 * MiB, WS_Y = WS_B + 288 * MiB, WS_END = WS_B + 432 * MiB;
constexpr int CW_BAR = 4096, CW_COUNT = 8192, CW_CURSOR = 8256, CW_ROWSQ1 = 16384;

__device__ __forceinline__ float bf_lo(unsigned w) { return __uint_as_float(w << 16); }
__device__ __forceinline__ float bf_hi(unsigned w) { return __uint_as_float(w & 0xffff0000u); }
__device__ __forceinline__ float bf2f(bf16 v) { return __uint_as_float((unsigned)v << 16); }
__device__ __forceinline__ unsigned f2bf(float f) { unsigned u = __float_as_uint(f); return (u + 0x7fffu + ((u >> 16) & 1u)) >> 16; }
typedef float f32x2_t __attribute__((ext_vector_type(2)));
typedef __bf16 bf16x2_t __attribute__((ext_vector_type(2)));
__device__ __forceinline__ unsigned pk2(float lo, float hi) { const f32x2_t v = {lo, hi}; return __builtin_bit_cast(unsigned, __builtin_convertvector(v, bf16x2_t)); }
__device__ __forceinline__ int otid() { int t = threadIdx.x; asm volatile("" : "+v"(t)); return t; }
__device__ __forceinline__ float wave_sum(float v) {
#pragma unroll
    for (int o = 1; o < 64; o <<= 1) v += __shfl_xor(v, o);
    return v;
}
__device__ __forceinline__ float clamp8(float v) { return fminf(fmaxf(v, -448.f), 448.f); }
__device__ __forceinline__ unsigned pk4_fp8(float a, float b, float c, float d) { int w = __builtin_amdgcn_cvt_pk_fp8_f32(clamp8(a), clamp8(b), 0, false); w = __builtin_amdgcn_cvt_pk_fp8_f32(clamp8(c), clamp8(d), w, true); return (unsigned)w; }
__device__ __forceinline__ unsigned pk4_fp8_nc(float a, float b, float c, float d) { int w = __builtin_amdgcn_cvt_pk_fp8_f32(a, b, 0, false); w = __builtin_amdgcn_cvt_pk_fp8_f32(c, d, w, true); return (unsigned)w; }
constexpr float W8_SCALE = 32.f, W8_INV = 1.f / 32.f, Y8_SCALE = 32.f, Y8_INV = 1.f / 32.f;
constexpr float SWI_C = 1.702f * 1.44269504089f, W8_GATE = -SWI_C * 32.f;
#ifndef MOE_FP8
#define MOE_FP8 1
#endif
__device__ __forceinline__ float logsigmoid(float x) { return fminf(x, 0.f) - log1pf(expf(-fabsf(x))); }

struct P {
    const float *x, *mem, *g_mix, *w_in, *w_pool, *pool_scale, *w_gate_up, *b_gate_up, *gla_g, *w_out, *g_xattn, *g_mem, *w_xq, *w_xk, *w_xv, *w_xo,
                *g_moe, *w_router, *b_router, *w_gu, *b_gu, *w_dn, *b_dn, *g_final;
    float* out; unsigned char* ws;
#define PACC(type, name, off) __device__ __forceinline__ type* name() const { return (type*)(ws + (off)); }
    PACC(unsigned, ctl, WS_CTL) PACC(float, glr, WS_GLR) PACC(float, rsqp, WS_RSQP)
    PACC(bf16, wt_in, WS_WT_IN) PACC(bf16, wt_out, WS_WT_OUT) PACC(bf16, wt_xq, WS_WT_XQ) PACC(bf16, wt_xk, WS_WT_XK) PACC(bf16, wt_xv, WS_WT_XV) PACC(bf16, wt_xo, WS_WT_XO) PACC(bf16, wt_gu, WS_WT_GU) PACC(bf16, wt_dn, WS_WT_DN)
    PACC(bf16, xn, WS_XN) PACC(bf16, hm, WS_HM) PACC(bf16, z1, WS_Z1) PACC(bf16, mix, WS_MIX) PACC(bf16, a2, WS_A2) PACC(bf16, kx, WS_KX) PACC(bf16, vxt, WS_VXT)
    PACC(bf16, qx, WS_QX) PACC(bf16, px, WS_PX) PACC(bf16, ox, WS_OX) PACC(bf16, xs, WS_XS) PACC(bf16, h, WS_H) PACC(bf16, y, WS_Y)
    PACC(float, sprev, WS_SPREV) PACC(float, ds, WS_DS) PACC(float, dec, WS_DEC) PACC(bf16, x1, WS_X1) PACC(bf16, x2, WS_X2) PACC(float, sc, WS_SC)
    PACC(float, rs2, WS_RS2) PACC(float, topg, WS_TOPG) PACC(float, gslot, WS_GSLOT) PACC(int, topi, WS_TOPI) PACC(int, slotof, WS_SLOTOF) PACC(int, tilee, WS_TILEE)
#undef PACC
};

struct MapId { __device__ __forceinline__ int operator()(int n) const { return n; } };
struct MapIn { __device__ __forceinline__ int operator()(int n) const { return n < 1536 ? n : 1552 + (n - 1536); } };
struct MapGu { __device__ __forceinline__ int operator()(int n) const { const int pn = n >> 8, w = n & 255; return w < 128 ? pn * 128 + w : 1024 + pn * 128 + (w - 128); } };

template <class Map>
__device__ __forceinline__ void transpose_item(const float* W, int ldw, int K, bf16* WT, float* scr, int kb, int nb, int lane, Map map, const float* kscale = nullptr) {
    const int k0 = 64 * kb, n0 = 32 * nb;
    const int sc = map(n0 + (lane & 31));
#pragma unroll
    for (int i = 0; i < 32; ++i) { const int kk = 2 * i + (lane >> 5); scr[kk * 33 + (lane & 31)] = sc >= 0 ? W[(size_t)(k0 + kk) * ldw + sc] * (kscale ? kscale[k0 + kk] : 1.f) : 0.f; }
    __builtin_amdgcn_s_waitcnt(0xC07F); asm volatile("" ::: "memory");
    const int c = lane & 7;
#pragma unroll
    for (int j = 0; j < 4; ++j) { const int n = (lane >> 3) + 8 * j; const float* s = scr + (8 * c) * 33 + n;
        u32x4 o; o.x = pk2(s[0 * 33], s[1 * 33]); o.y = pk2(s[2 * 33], s[3 * 33]); o.z = pk2(s[4 * 33], s[5 * 33]); o.w = pk2(s[6 * 33], s[7 * 33]);
        *(u32x4*)(WT + (size_t)(n0 + n) * K + k0 + 8 * c) = o; }
    __builtin_amdgcn_s_waitcnt(0xC07F); asm volatile("" ::: "memory");
}
constexpr int CONV_CHUNKS = NE * (16 * 8 + 16 * 4) * 4;
static_assert(CONV_CHUNKS == NBLOCKS * 96, "one chunk per wave and per pool / GLA unit iteration");
struct ConvChunk { const float* src; unsigned char* dst; int ldw, K; float scale; };
constexpr int CONV_IT_B_END = 10, CONV_IT_SCAN = 10, CONV_IT_DISP = 11;
__device__ __forceinline__ ConvChunk conv_chunk_decode(const P& p, int c, int lane) {
    constexpr int I_GU = 16 * 8, I_DN = 16 * 4; const int item = c >> 2, sub = c & 3; ConvChunk cc;
    if (item < NE * I_GU) { const int e = item / I_GU, q = item % I_GU, kb = q >> 3, nb = q & 7, k0 = 64 * kb + 16 * sub, n0 = 256 * nb + 4 * lane; const int up = n0 >> 10, ff = n0 & 1023;
        cc.ldw = 2 * DFF; cc.K = D; cc.scale = up ? W8_SCALE : W8_GATE; cc.src = p.w_gu + (size_t)e * D * 2 * DFF + (size_t)k0 * (2 * DFF) + n0;
        cc.dst = (unsigned char*)p.wt_gu() + (size_t)e * 2 * DFF * D + (size_t)((ff >> 7) * 256 + up * 128 + (ff & 127)) * D + k0; }
    else { const int r = item - NE * I_GU, e = r / I_DN, q = r % I_DN, kb = q >> 2, nb = q & 3, k0 = 64 * kb + 16 * sub, n0 = 256 * nb + 4 * lane;
        cc.ldw = D; cc.K = DFF; cc.scale = W8_SCALE; cc.src = p.w_dn + (size_t)e * DFF * D + (size_t)k0 * D + n0;
        cc.dst = (unsigned char*)p.wt_dn() + (size_t)e * D * DFF + (size_t)n0 * DFF + k0; }
    return cc;
}
__device__ __forceinline__ void conv_chunk_load(const ConvChunk& cc, f32x4 (&v)[16]) {
#pragma unroll
    for (int i = 0; i < 16; ++i) v[i] = __builtin_nontemporal_load((const f32x4*)(cc.src + (size_t)i * cc.ldw));
}
__device__ __forceinline__ void conv_chunk_store(const ConvChunk& cc, const f32x4 (&v)[16]) {
    const float sc = cc.scale;
#pragma unroll
    for (int j = 0; j < 4; ++j) { u32x4 o;
        o.x = pk4_fp8(v[0][j] * sc, v[1][j] * sc, v[2][j] * sc, v[3][j] * sc); o.y = pk4_fp8(v[4][j] * sc, v[5][j] * sc, v[6][j] * sc, v[7][j] * sc);
        o.z = pk4_fp8(v[8][j] * sc, v[9][j] * sc, v[10][j] * sc, v[11][j] * sc); o.w = pk4_fp8(v[12][j] * sc, v[13][j] * sc, v[14][j] * sc, v[15][j] * sc);
        *(u32x4*)(cc.dst + (size_t)j * cc.K) = o; }
}
template <int NR>
__device__ __forceinline__ void rms_rows_bf16(const float* xrow, const float* g, bf16* orow, size_t rstride, int lane) {
    f32x4 v[NR][4]; float s[NR];
#pragma unroll
    for (int r = 0; r < NR; ++r)
#pragma unroll
        for (int j = 0; j < 4; ++j) v[r][j] = *((const f32x4*)(xrow + r * rstride) + lane + 64 * j);
#pragma unroll
    for (int r = 0; r < NR; ++r) { s[r] = 0.f;
#pragma unroll
        for (int j = 0; j < 4; ++j) s[r] += (v[r][j].x * v[r][j].x + v[r][j].y * v[r][j].y) + (v[r][j].z * v[r][j].z + v[r][j].w * v[r][j].w); }
#pragma unroll
    for (int o = 1; o < 64; o <<= 1)
#pragma unroll
        for (int r = 0; r < NR; ++r) s[r] += __shfl_xor(s[r], o);
    const f32x4* gr = (const f32x4*)g + lane;
#pragma unroll
    for (int r = 0; r < NR; ++r) { const float rs = 1.0f / sqrtf(s[r] * (1.f / D) + EPS); u32x2* o8 = (u32x2*)(orow + r * rstride) + lane;
#pragma unroll
        for (int j = 0; j < 4; ++j) { const f32x4 gg = gr[64 * j]; u32x2 w; w.x = pk2(v[r][j].x * rs * gg.x, v[r][j].y * rs * gg.y); w.y = pk2(v[r][j].z * rs * gg.z, v[r][j].w * rs * gg.w); o8[64 * j] = w; } }
}
__device__ __forceinline__ void rms_rows4_glr(const float* xrow, const float* g, bf16* orow, float* glr_out, const float* wgt, int lane) {
    f32x4 v[4][4]; float s[4];
#pragma unroll
    for (int r = 0; r < 4; ++r)
#pragma unroll
        for (int j = 0; j < 4; ++j) v[r][j] = *((const f32x4*)(xrow + r * D) + lane + 64 * j);
#pragma unroll
    for (int r = 0; r < 4; ++r) { s[r] = 0.f;
#pragma unroll
        for (int j = 0; j < 4; ++j) s[r] += (v[r][j].x * v[r][j].x + v[r][j].y * v[r][j].y) + (v[r][j].z * v[r][j].z + v[r][j].w * v[r][j].w); }
#pragma unroll
    for (int o = 1; o < 64; o <<= 1)
#pragma unroll
        for (int r = 0; r < 4; ++r) s[r] += __shfl_xor(s[r], o);
    float acc[64];
#pragma unroll
    for (int i = 0; i < 64; ++i) acc[i] = 0.f;
    const f32x4* gr = (const f32x4*)g + lane;
#pragma unroll
    for (int j = 0; j < 4; ++j) { const f32x4 gg = gr[64 * j]; f32x4 xn[4];
#pragma unroll
        for (int r = 0; r < 4; ++r) { const float rs = 1.0f / sqrtf(s[r] * (1.f / D) + EPS); xn[r] = v[r][j] * rs * gg;
            u32x2 w; w.x = pk2(xn[r].x, xn[r].y); w.y = pk2(xn[r].z, xn[r].w); *((u32x2*)(orow + r * D) + lane + 64 * j) = w; }
#pragma unroll
        for (int i = 0; i < 4; ++i) { const int kp = i * 256 + lane + 64 * j, sw = (kp >> 2) & 3; const float* wr = wgt + kp * 16;
#pragma unroll
            for (int c4 = 0; c4 < 4; ++c4) { const f32x4 w = *(const f32x4*)(wr + ((c4 ^ sw) << 2));
#pragma unroll
                for (int r = 0; r < 4; ++r) { const float x = xn[r][i]; acc[r * 16 + c4 * 4 + 0] += x * w.x; acc[r * 16 + c4 * 4 + 1] += x * w.y; acc[r * 16 + c4 * 4 + 2] += x * w.z; acc[r * 16 + c4 * 4 + 3] += x * w.w; } }
            __builtin_amdgcn_sched_barrier(0); } }
#pragma unroll
    for (int k = 0; k < 32; ++k) { const bool up = (lane & 32) != 0; const float send = up ? acc[k] : acc[k + 32]; const float keep = up ? acc[k + 32] : acc[k]; acc[k] = keep + __shfl_xor(send, 32); }
#pragma unroll
    for (int k = 0; k < 16; ++k) { const bool up = (lane & 16) != 0; const float send = up ? acc[k] : acc[k + 16]; const float keep = up ? acc[k + 16] : acc[k]; acc[k] = keep + __shfl_xor(send, 16); }
#pragma unroll
    for (int k = 0; k < 8; ++k) { const bool up = (lane & 8) != 0; const float send = up ? acc[k] : acc[k + 8]; const float keep = up ? acc[k + 8] : acc[k]; acc[k] = keep + __shfl_xor(send, 8); }
#pragma unroll
    for (int k = 0; k < 4; ++k) { const bool up = (lane & 4) != 0; const float send = up ? acc[k] : acc[k + 4]; const float keep = up ? acc[k + 4] : acc[k]; acc[k] = keep + __shfl_xor(send, 4); }
#pragma unroll
    for (int k = 0; k < 2; ++k) { const bool up = (lane & 2) != 0; const float send = up ? acc[k] : acc[k + 2]; const float keep = up ? acc[k + 2] : acc[k]; acc[k] = keep + __shfl_xor(send, 2); }
    { const bool up = (lane & 1) != 0; const float send = up ? acc[0] : acc[1]; const float keep = up ? acc[1] : acc[0]; acc[0] = keep + __shfl_xor(send, 1); }
    glr_out[lane] = acc[0];
}
#ifndef PROBE_PRO
#define PROBE_PRO 0
#endif
__device__ __forceinline__ void phase_prologue(const P& p, float* ldsf, int bid, int nb) {
    const int tid = otid(), lane = tid & 63, wave = tid >> 6;
    float* scr = ldsf + wave * (128 * 33);
    const int gw = bid * NWAVES + wave, NGW = nb * NWAVES;
    constexpr int I_IN = 16 * (NZ / 32), I_SQ = 16 * 32, I_GU = MOE_FP8 ? 16 * 8 : 16 * 64, I_DN = MOE_FP8 ? 16 * 4 : 16 * 32;
    for (int rep = 0; rep < ((PROBE_PRO & 1) ? 2 : 1); ++rep)
    for (int it = gw; it < I_IN + 5 * I_SQ; it += NGW) {
        int r = it;
        if (r < I_IN) { transpose_item(p.w_in, IN_COLS, D, p.wt_in(), scr, r / (NZ / 32), r % (NZ / 32), lane, MapIn()); continue; } r -= I_IN;
        { const int w = r / I_SQ, q = r % I_SQ; const float* src = w == 0 ? p.w_out : w == 1 ? p.w_xq : w == 2 ? p.w_xk : w == 3 ? p.w_xv : p.w_xo;
            bf16* dst = w == 0 ? p.wt_out() : w == 1 ? p.wt_xq() : w == 2 ? p.wt_xk() : w == 3 ? p.wt_xv() : p.wt_xo();
            transpose_item(src, D, D, dst, scr, q / 32, q % 32, lane, MapId(), w == 1 ? p.g_xattn : nullptr); }
    }
    for (int rep = 0; rep < ((PROBE_PRO & 4) ? 2 : 1); ++rep) {
    __syncthreads();
    { f32x4 tv[8];
#pragma unroll
      for (int q = 0; q < 8; ++q) { const int i = tid + NTHREADS * q, k = i >> 2, c4 = i & 3; tv[q] = *(const f32x4*)(p.w_in + (size_t)k * IN_COLS + GLR_COL0 + 4 * c4); }
#pragma unroll
      for (int q = 0; q < 8; ++q) { const int i = tid + NTHREADS * q, k = i >> 2, c4 = i & 3, kp = (k & 3) * 256 + (k >> 2); *(f32x4*)(ldsf + kp * 16 + ((c4 ^ ((kp >> 2) & 3)) << 2)) = tv[q]; } }
    __syncthreads();
    for (int m = gw * 4; m < M; m += NGW * 4) rms_rows4_glr(p.x + (size_t)m * D, p.g_mix, p.xn() + (size_t)m * D, p.glr() + (size_t)m * 16, ldsf, lane);
    for (int m = gw; m < BATCH * MEMLEN; m += NGW) rms_rows_bf16<1>(p.mem + (size_t)m * D, p.g_mem, p.hm() + (size_t)m * D, D, lane);
    }
}

__device__ __forceinline__ float swiglu(float g, float u) { g = fminf(g, 7.f); u = fminf(fmaxf(u, -7.f), 7.f);
    return g * __builtin_amdgcn_rcpf(1.f + __builtin_amdgcn_exp2f(-1.702f * 1.44269504089f * g)) * (u + 1.f); }

__device__ __forceinline__ void phase_final(const P& p, int bid, int nb) {
    const int tid = otid(), lane = tid & 63, gw = bid * NWAVES + (tid >> 6), NGW = nb * NWAVES;
    for (int t = gw * 2; t < M; t += NGW * 2) {
        f32x4 v[2][4]; unsigned yv[2][4][4];
#pragma unroll
        for (int q = 0; q < 2; ++q) { const u32x2* xr = (const u32x2*)(p.x2() + (size_t)(t + q) * D) + lane;
#pragma unroll
            for (int j = 0; j < 4; ++j) { const u32x2 w = xr[64 * j]; v[q][j] = (f32x4){bf_lo(w.x), bf_hi(w.x), bf_lo(w.y), bf_hi(w.y)}; }
#pragma unroll
            for (int k = 0; k < 4; ++k) { const int sl = p.slotof()[(t + q) * 4 + k]; const unsigned* yr = (const unsigned*)((const unsigned char*)p.y() + (size_t)sl * D) + lane;
#pragma unroll
                for (int j = 0; j < 4; ++j) yv[q][k][j] = yr[64 * j]; } }
#pragma unroll
        for (int q = 0; q < 2; ++q) {
#pragma unroll
            for (int k = 0; k < 4; ++k)
#pragma unroll
                for (int j = 0; j < 4; ++j) { const int w = (int)yv[q][k][j]; const f32x2_t lo = __builtin_amdgcn_cvt_pk_f32_fp8(w, false), hi = __builtin_amdgcn_cvt_pk_f32_fp8(w, true);
                    v[q][j].x += lo.x * Y8_INV; v[q][j].y += lo.y * Y8_INV; v[q][j].z += hi.x * Y8_INV; v[q][j].w += hi.y * Y8_INV; }
            float s = 0.f;
#pragma unroll
            for (int j = 0; j < 4; ++j) s += (v[q][j].x * v[q][j].x + v[q][j].y * v[q][j].y) + (v[q][j].z * v[q][j].z + v[q][j].w * v[q][j].w);
            const float rs = 1.0f / sqrtf(wave_sum(s) * (1.f / D) + EPS);
            f32x4* o = (f32x4*)(p.out + (size_t)(t + q) * D) + lane;
#pragma unroll
            for (int j = 0; j < 4; ++j) { const f32x4 gg = *((const f32x4*)p.g_final + lane + 64 * j); o[64 * j] = v[q][j] * rs * gg; }
        }
    }
}

typedef short bf16x8 __attribute__((ext_vector_type(8)));
typedef float f32x16 __attribute__((ext_vector_type(16)));
template <int K>
__device__ __forceinline__ void mma_tile(f32x16& acc, const bf16* a, int pa, const bf16* b, int pb, int lane) {
    const int r = lane & 31, hf = lane >> 5;
#pragma unroll
    for (int k0 = 0; k0 < K; k0 += 16) { const bf16x8 av = *(const bf16x8*)(a + r * pa + k0 + 8 * hf); const bf16x8 bv = *(const bf16x8*)(b + r * pb + k0 + 8 * hf);
        acc = __builtin_amdgcn_mfma_f32_32x32x16_bf16(av, bv, acc, 0, 0, 0); }
}
__device__ __forceinline__ int crow(int reg, int hf) { return (reg & 3) + 8 * (reg >> 2) + 4 * hf; }
__device__ __forceinline__ f32x16 zero16() { f32x16 z;
#pragma unroll
    for (int i = 0; i < 16; ++i) z[i] = 0.f;
    return z; }
__device__ __forceinline__ float fast_logsigmoid(float x) { return fminf(x, 0.f) - __logf(1.f + __expf(-fabsf(x))); }

__device__ __forceinline__ void phase_pool2(const P& p, unsigned char* lds, int bid, int nb) {
    bf16* wpT = (bf16*)lds;
    float* ut = (float*)(lds + 34816);
    bf16* pt = (bf16*)(lds + 34816 + 40960);
    const int tid = otid(), lane = tid & 63, w = tid >> 6;
    int cur_g = -1;
    u32x4 zv[3];
#define POOL_ZLOAD(uu) do { const int _g = (uu) & 3, _t0 = ((uu) >> 2) * 64, _s0 = _t0 & (SEQ - 1); _Pragma("unroll") for (int q = 0; q < 3; ++q) { const int c = tid + NTHREADS * q, r = c >> 4, ch = (c & 15) * 8; \
        zv[q] = (u32x4){0u, 0u, 0u, 0u}; if (c < 80 * 16 && _s0 - 16 + r >= 0) zv[q] = *(const u32x4*)(p.z1() + (size_t)(_t0 - 16 + r) * NZ + _g * 128 + ch); } } while (0)
    if (bid < (M / 64) * 4) POOL_ZLOAD(bid);
    for (int u = bid, it = 0; u < (M / 64) * 4; u += nb, ++it) {
        const int g = u & 3, t0 = (u >> 2) * 64, win = 2 << g, s0 = t0 & (SEQ - 1);
        const ConvChunk cc = conv_chunk_decode(p, bid * 96 + it * 8 + w, lane); f32x4 cv[16]; conv_chunk_load(cc, cv);
        __syncthreads();
        if (g != cur_g) { cur_g = g;
            f32x4 wv[8];
#pragma unroll
            for (int k = 0; k < 8; ++k) wv[k] = *((const f32x4*)(p.w_pool + (size_t)g * 16384) + tid + NTHREADS * k);
#pragma unroll
            for (int k = 0; k < 8; ++k) { const int i = 4 * (tid + NTHREADS * k), c = i >> 7, d = i & 127;
                wpT[d * 136 + c] = (bf16)f2bf(wv[k].x); wpT[(d + 1) * 136 + c] = (bf16)f2bf(wv[k].y); wpT[(d + 2) * 136 + c] = (bf16)f2bf(wv[k].z); wpT[(d + 3) * 136 + c] = (bf16)f2bf(wv[k].w); } }
#pragma unroll
        for (int q = 0; q < 3; ++q) { const int c = tid + NTHREADS * q, r = c >> 4, ch = (c & 15) * 8; const u32x4 v = zv[q];
            if (c < 80 * 16) { *(f32x4*)(ut + r * 128 + ch) = (f32x4){bf_lo(v.x), bf_hi(v.x), bf_lo(v.y), bf_hi(v.y)}; *(f32x4*)(ut + r * 128 + ch + 4) = (f32x4){bf_lo(v.z), bf_hi(v.z), bf_lo(v.w), bf_hi(v.w)}; } }
        if (u + nb < (M / 64) * 4) POOL_ZLOAD(u + nb);
        __syncthreads();
        { const int c = tid & 127, q = tid >> 7, i0 = 16 * q; float sum = 0.f;
          for (int d = 1; d < win; ++d) sum += ut[(16 + i0 - d) * 128 + c];
          for (int ii = 0; ii < 16; ++ii) { const int i = i0 + ii, s = s0 + i; const float uv = ut[(16 + i) * 128 + c]; sum += uv; const int cnt = (s + 1 < win) ? s + 1 : win;
              pt[i * 136 + c] = (bf16)f2bf(sum / (float)cnt - uv); sum -= ut[(16 + i - win + 1) * 128 + c]; } }
        __syncthreads();
        { const int db = w >> 1, ib = w & 1, r = lane & 31, hf = lane >> 5; f32x16 acc = zero16();
          mma_tile<128>(acc, wpT + (db * 32) * 136, 136, pt + (ib * 32) * 136, 136, lane);
          bf16* orow = p.mix() + (size_t)(t0 + ib * 32 + r) * D + g * 128 + db * 32;
#pragma unroll
          for (int rg = 0; rg < 4; ++rg) { const int d0 = 8 * rg + 4 * hf; const f32x4 sc = *(const f32x4*)(p.pool_scale + g * 128 + db * 32 + d0);
              u32x2 o; o.x = pk2(acc[4 * rg] * sc.x, acc[4 * rg + 1] * sc.y); o.y = pk2(acc[4 * rg + 2] * sc.z, acc[4 * rg + 3] * sc.w); *(u32x2*)(orow + d0) = o; } }
        conv_chunk_store(cc, cv);
    }
#undef POOL_ZLOAD
}

template <int K, bool SWA, bool SWB>
__device__ __forceinline__ void mma_tile_sw(f32x16& acc, const bf16* a, int arow0, const bf16* b, int brow0, int lane) {
    const int r = lane & 31, hf = lane >> 5, ra = arow0 + r, rb = brow0 + r, fa = SWA ? ((ra >> 3) & 7) : 0, fb = SWB ? ((rb >> 3) & 7) : 0;
#pragma unroll
    for (int k0 = 0; k0 < K; k0 += 16) { const int c = (k0 >> 3) + hf;
        const bf16x8 av = *(const bf16x8*)(a + ra * 72 + ((c ^ fa) << 3)); const bf16x8 bv = *(const bf16x8*)(b + rb * 72 + ((c ^ fb) << 3));
        acc = __builtin_amdgcn_mfma_f32_32x32x16_bf16(av, bv, acc, 0, 0, 0); }
}
__device__ __forceinline__ void pair_write_T(bf16* T, const u32x4 x0, const u32x4 x1, int c0, int jp) {
    const int f = (c0 >> 3) & 7, col = (((jp >> 2) ^ f) << 3) + ((2 * jp) & 7);
    unsigned* base = (unsigned*)(T + c0 * 72 + col);
#pragma unroll
    for (int q = 0; q < 4; ++q) { const unsigned a = x0[q], b = x1[q];
        base[(2 * q) * 36] = (a & 0xffffu) | (b << 16); base[(2 * q + 1) * 36] = (a >> 16) | (b & 0xffff0000u); }
}
__device__ __forceinline__ void unpack8(const u32x4 w, float (&f)[8]) { f[0] = bf_lo(w.x); f[1] = bf_hi(w.x); f[2] = bf_lo(w.y); f[3] = bf_hi(w.y); f[4] = bf_lo(w.z); f[5] = bf_hi(w.z); f[6] = bf_lo(w.w); f[7] = bf_hi(w.w); }

struct GlaLoads { float g0, g1, wg[16], bias; u32x4 q, k, v0, v1, s0, s1, k0, k1; u32x2 rr[4]; };
template <bool ISB>
__device__ __forceinline__ void gla_load(const P& p, int u, int tid, GlaLoads& L) {
    const int bh = u / NCHUNK, n = u % NCHUNK, b = bh >> 2, h = bh & 3, t0 = b * SEQ + n * 64, lane = tid & 63, w = tid >> 6;
    L.g0 = p.glr()[(size_t)t0 * 16 + tid]; L.g1 = p.glr()[(size_t)t0 * 16 + 512 + tid];
#pragma unroll
    for (int r = 0; r < 16; ++r) L.wg[r] = p.w_gate_up[r * 256 + h * 64 + (tid & 63)];
    L.bias = p.b_gate_up[h * 64 + (tid & 63)];
    { const int jp = tid >> 4, c16 = tid & 15; const bf16* vp = p.z1() + (size_t)(t0 + 2 * jp) * NZ + ZV + h * 128 + 8 * c16; L.v0 = *(const u32x4*)vp; L.v1 = *(const u32x4*)(vp + NZ); }
    if (ISB) {
        { const int i = tid >> 3, c8 = tid & 7; const bf16* zp = p.z1() + (size_t)(t0 + i) * NZ + h * 64 + 8 * c8; L.q = *(const u32x4*)(zp + ZQ); L.k = *(const u32x4*)(zp + ZK); }
        { const bf16* sp = (const bf16*)p.sprev() + (size_t)u * 8192; L.s0 = *(const u32x4*)(sp + tid * 8); L.s1 = *(const u32x4*)(sp + (tid + 512) * 8); }
        { const int eb = w >> 1, ib = w & 1, i = ib * 32 + (lane & 31), hf = lane >> 5; const bf16* rp = p.z1() + (size_t)(t0 + i) * NZ + ZR + h * 128 + eb * 32 + 4 * hf;
#pragma unroll
          for (int rg = 0; rg < 4; ++rg) L.rr[rg] = *(const u32x2*)(rp + 8 * rg); }
    } else {
        const int jp = (tid >> 3) & 31, d8 = tid & 7; const bf16* kp = p.z1() + (size_t)(t0 + 2 * jp) * NZ + ZK + h * 64 + 8 * d8; L.k0 = *(const u32x4*)kp; L.k1 = *(const u32x4*)(kp + NZ);
    }
}
__device__ __forceinline__ void gla_gc3(const GlaLoads& L, const float* glr, float* wtot, float* gcs, int tid) {
    const int d = tid & 63, w = tid >> 6; float gcl[8]; float run = 0.f;
#pragma unroll
    for (int ii = 0; ii < 8; ++ii) { const float* gr = glr + (8 * w + ii) * 16; float s = L.bias;
#pragma unroll
        for (int r = 0; r < 16; ++r) s += gr[r] * L.wg[r];
        run += fast_logsigmoid(s) * (1.f / 16.f); gcl[ii] = run; }
    wtot[w * 64 + d] = run;
    __syncthreads();
    float pre = 0.f;
#pragma unroll
    for (int ww = 0; ww < 8; ++ww) { const float v = wtot[ww * 64 + d]; pre += (ww < w) ? v : 0.f; }
#pragma unroll
    for (int ii = 0; ii < 8; ++ii) gcs[(8 * w + ii) * 68 + d] = gcl[ii] + pre;
    __syncthreads();
}
__device__ __forceinline__ void phase_gla_a3(const P& p, unsigned char* lds, int bid, int nb) {
    float* glr = (float*)lds; float* wtot = (float*)(lds + 4096); float* gcs = (float*)(lds + 8192); bf16* kdT = (bf16*)(lds + 25600); bf16* vT = (bf16*)(lds + 34816);
    const int tid = otid(), lane = tid & 63, w = tid >> 6;
    GlaLoads cur, nxt;
    if (bid < 8 * NCHUNK) gla_load<false>(p, bid, tid, cur);
    for (int u = bid, it = 4; u < 8 * NCHUNK; u += nb, ++it) {
        const bool has = u + nb < 8 * NCHUNK;
        const ConvChunk cc = conv_chunk_decode(p, bid * 96 + it * 8 + w, lane); f32x4 cv[16]; conv_chunk_load(cc, cv);
        if (has) gla_load<false>(p, u + nb, tid, nxt);
        __syncthreads();
        glr[tid] = cur.g0; glr[tid + 512] = cur.g1;
        pair_write_T(vT, cur.v0, cur.v1, 8 * (tid & 15), tid >> 4);
        __syncthreads();
        gla_gc3(cur, glr, wtot, gcs, tid);
        if (tid < 64) p.dec()[(size_t)u * 64 + tid] = __expf(gcs[63 * 68 + tid]);
        if (tid < 256) { const int jp = tid >> 3, d8 = tid & 7; float k0[8], k1[8]; unpack8(cur.k0, k0); unpack8(cur.k1, k1);
            const f32x4 ta = *(const f32x4*)(gcs + 63 * 68 + 8 * d8), tb = *(const f32x4*)(gcs + 63 * 68 + 8 * d8 + 4);
            const f32x4 a0 = *(const f32x4*)(gcs + (2 * jp) * 68 + 8 * d8), b0 = *(const f32x4*)(gcs + (2 * jp) * 68 + 8 * d8 + 4), a1 = *(const f32x4*)(gcs + (2 * jp + 1) * 68 + 8 * d8), b1 = *(const f32x4*)(gcs + (2 * jp + 1) * 68 + 8 * d8 + 4);
            u32x4 x0, x1;
            x0.x = pk2(k0[0] * __expf(ta[0] - a0[0]), k0[1] * __expf(ta[1] - a0[1])); x0.y = pk2(k0[2] * __expf(ta[2] - a0[2]), k0[3] * __expf(ta[3] - a0[3]));
            x0.z = pk2(k0[4] * __expf(tb[0] - b0[0]), k0[5] * __expf(tb[1] - b0[1])); x0.w = pk2(k0[6] * __expf(tb[2] - b0[2]), k0[7] * __expf(tb[3] - b0[3]));
            x1.x = pk2(k1[0] * __expf(ta[0] - a1[0]), k1[1] * __expf(ta[1] - a1[1])); x1.y = pk2(k1[2] * __expf(ta[2] - a1[2]), k1[3] * __expf(ta[3] - a1[3]));
            x1.z = pk2(k1[4] * __expf(tb[0] - b1[0]), k1[5] * __expf(tb[1] - b1[1])); x1.w = pk2(k1[6] * __expf(tb[2] - b1[2]), k1[7] * __expf(tb[3] - b1[3]));
            pair_write_T(kdT, x0, x1, 8 * d8, jp); }
        __syncthreads();
        { const int eb = w >> 1, db = w & 1, r = lane & 31, hf = lane >> 5; f32x16 acc = zero16();
          mma_tile_sw<64, true, true>(acc, vT, eb * 32, kdT, db * 32, lane);
          bf16* o = (bf16*)p.ds() + (size_t)u * 8192 + db * 32 + r;
#pragma unroll
          for (int reg = 0; reg < 16; ++reg) o[(eb * 32 + crow(reg, hf)) * 64] = (bf16)f2bf(acc[reg]); }
        conv_chunk_store(cc, cv);
        if (has) cur = nxt;
    }
}
__device__ __forceinline__ void phase_gla_b3(const P& p, unsigned char* lds, int bid, int nb) {
    float* glr = (float*)lds; float* wtot = (float*)(lds + 4096); float* ssq = (float*)(lds + 6144); float* gcs = (float*)(lds + 8192);
    bf16* qe = (bf16*)(lds + 25600); bf16* ke = qe + 64 * 72; bf16* att = ke + 64 * 72; bf16* vT = att + 64 * 72; bf16* spT = vT + 128 * 72;
    const int tid = otid(), lane = tid & 63, w = tid >> 6, r = lane & 31, hf = lane >> 5;
    GlaLoads cur, nxt;
    if (bid < 8 * NCHUNK) gla_load<true>(p, bid, tid, cur);
    for (int u = bid, it = 8; u < 8 * NCHUNK; u += nb, ++it) {
        const int bh = u / NCHUNK, n = u % NCHUNK, b = bh >> 2, h = bh & 3, t0 = b * SEQ + n * 64;
        const bool has = u + nb < 8 * NCHUNK;
        const bool hasc = it < CONV_IT_B_END;
        ConvChunk cc = conv_chunk_decode(p, bid * 96 + (hasc ? it : 8) * 8 + w, lane); f32x4 cv[16]; if (hasc) conv_chunk_load(cc, cv);
        if (has) gla_load<true>(p, u + nb, tid, nxt);
        __syncthreads();
        glr[tid] = cur.g0; glr[tid + 512] = cur.g1;
        pair_write_T(vT, cur.v0, cur.v1, 8 * (tid & 15), tid >> 4);
        *(u32x4*)(spT + (tid >> 3) * 72 + (tid & 7) * 8) = cur.s0; *(u32x4*)(spT + ((tid + 512) >> 3) * 72 + (tid & 7) * 8) = cur.s1;
        __syncthreads();
        gla_gc3(cur, glr, wtot, gcs, tid);
        { const int i = tid >> 3, c8 = tid & 7; float q[8], k[8]; unpack8(cur.q, q); unpack8(cur.k, k);
          const f32x4 ga = *(const f32x4*)(gcs + i * 68 + 8 * c8), gb = *(const f32x4*)(gcs + i * 68 + 8 * c8 + 4); float e[8];
#pragma unroll
          for (int t = 0; t < 4; ++t) { e[t] = __expf(ga[t]); e[4 + t] = __expf(gb[t]); }
          u32x4 xq, xk;
          xq.x = pk2(q[0] * 0.125f * e[0], q[1] * 0.125f * e[1]); xq.y = pk2(q[2] * 0.125f * e[2], q[3] * 0.125f * e[3]); xq.z = pk2(q[4] * 0.125f * e[4], q[5] * 0.125f * e[5]); xq.w = pk2(q[6] * 0.125f * e[6], q[7] * 0.125f * e[7]);
          xk.x = pk2(k[0] / e[0], k[1] / e[1]); xk.y = pk2(k[2] / e[2], k[3] / e[3]); xk.z = pk2(k[4] / e[4], k[5] / e[5]); xk.w = pk2(k[6] / e[6], k[7] / e[7]);
          *(u32x4*)(qe + i * 72 + 8 * c8) = xq; *(u32x4*)(ke + i * 72 + 8 * c8) = xk; }
        __syncthreads();
        if (w < 4) { const int ib = w & 1, jb = w >> 1; f32x16 acc = zero16();
            if (jb <= ib) mma_tile_sw<64, false, false>(acc, qe, ib * 32, ke, jb * 32, lane);
#pragma unroll
            for (int reg = 0; reg < 16; ++reg) { const int i = ib * 32 + crow(reg, hf), j = jb * 32 + r; att[i * 72 + j] = (bf16)f2bf(j <= i ? acc[reg] : 0.f); } }
        __syncthreads();
        { const int eb = w >> 1, ib = w & 1, i = ib * 32 + r; f32x16 acc = zero16();
          mma_tile_sw<64, true, false>(acc, vT, eb * 32, att, ib * 32, lane);
          mma_tile_sw<64, false, false>(acc, spT, eb * 32, qe, ib * 32, lane);
          float ss = 0.f;
#pragma unroll
          for (int reg = 0; reg < 16; ++reg) ss += acc[reg] * acc[reg];
          ss += __shfl_xor(ss, 32);
          if (hf == 0) ssq[eb * 64 + i] = ss;
          __syncthreads();
          const float rs = 1.0f / sqrtf((ssq[i] + ssq[64 + i] + ssq[128 + i] + ssq[192 + i]) * (1.f / 128.f) + EPS);
          bf16* op = p.mix() + (size_t)(t0 + i) * D + 512 + h * 128 + eb * 32;
#pragma unroll
          for (int rg = 0; rg < 4; ++rg) { const int e0 = 8 * rg + 4 * hf; const u32x2 rv = cur.rr[rg]; const f32x4 gg = *(const f32x4*)(p.gla_g + eb * 32 + e0);
              const float r0 = bf_lo(rv.x), r1 = bf_hi(rv.x), r2 = bf_lo(rv.y), r3 = bf_hi(rv.y);
              const float o0 = acc[4 * rg] * rs * gg.x * (r0 / (1.f + __expf(-r0))), o1 = acc[4 * rg + 1] * rs * gg.y * (r1 / (1.f + __expf(-r1)));
              const float o2 = acc[4 * rg + 2] * rs * gg.z * (r2 / (1.f + __expf(-r2))), o3 = acc[4 * rg + 3] * rs * gg.w * (r3 / (1.f + __expf(-r3)));
              u32x2 o; o.x = pk2(o0, o1); o.y = pk2(o2, o3); *(u32x2*)(op + e0) = o; } }
        if (hasc) conv_chunk_store(cc, cv);
        if (has) cur = nxt;
    }
}
__device__ __forceinline__ void kv_tile(const P& p, int bid, int q, int lane) {
    const int job = bid >> 7, b7 = bid & 127, r = lane & 31, hf = lane >> 5;
    const int rb = job ? (b7 >> 3) : (b7 >> 4), cb = job ? (b7 & 7) : (b7 & 15), ld = job ? BATCH * MEMLEN : D;
    const bf16* A = job ? p.wt_xv() : p.hm(); const bf16* Bt = job ? p.hm() : p.wt_xk(); bf16* O = job ? p.vxt() : p.kx();
    const int row0 = rb * 64 + (q >> 1) * 32, col0 = cb * 64 + (q & 1) * 32;
    const bf16* ap = A + (size_t)(row0 + r) * D + 8 * hf; const bf16* bp = Bt + (size_t)(col0 + r) * D + 8 * hf;
    f32x16 acc = zero16();
#pragma unroll 8
    for (int k0 = 0; k0 < D; k0 += 16) acc = __builtin_amdgcn_mfma_f32_32x32x16_bf16(*(const bf16x8*)(ap + k0), *(const bf16x8*)(bp + k0), acc, 0, 0, 0);
#pragma unroll
    for (int reg = 0; reg < 16; ++reg) O[(size_t)(row0 + crow(reg, hf)) * ld + col0 + r] = (bf16)f2bf(acc[reg]);
}
__device__ __forceinline__ void phase_scan2(const P& p, int bid, int nb) {
    bf16* sp = (bf16*)p.sprev();
    const int tid = otid();
    if (tid < 256)
    for (int idx = bid * 256 + tid; idx < 8 * 8192; idx += nb * 256) {
        const int bh = idx >> 13, ed = idx & 8191, d = ed & 63; float st = 0.f;
        for (int n0 = 0; n0 < NCHUNK; n0 += 8) { float dv[8], dc[8];
#pragma unroll
            for (int k = 0; k < 8; ++k) { const size_t u = (size_t)bh * NCHUNK + n0 + k; dv[k] = bf2f(((const bf16*)p.ds())[u * 8192 + ed]); dc[k] = p.dec()[u * 64 + d]; }
#pragma unroll
            for (int k = 0; k < 8; ++k) { const size_t u = (size_t)bh * NCHUNK + n0 + k; sp[u * 8192 + ed] = (bf16)f2bf(st); st = dc[k] * st + dv[k]; } }
    }
}
__device__ __forceinline__ bf16x8 split_hi(const f32x4 a, const f32x4 b, f32x4& ra, f32x4& rb) {
    u32x4 h; h.x = pk2(a.x, a.y); h.y = pk2(a.z, a.w); h.z = pk2(b.x, b.y); h.w = pk2(b.z, b.w);
    ra = (f32x4){a.x - bf_lo(h.x), a.y - bf_hi(h.x), a.z - bf_lo(h.y), a.w - bf_hi(h.y)}; rb = (f32x4){b.x - bf_lo(h.z), b.y - bf_hi(h.z), b.z - bf_lo(h.w), b.w - bf_hi(h.w)};
    return __builtin_bit_cast(bf16x8, h);
}
__device__ __forceinline__ bf16x8 pack_bf8(const f32x4 a, const f32x4 b) { u32x4 h; h.x = pk2(a.x, a.y); h.y = pk2(a.z, a.w); h.z = pk2(b.x, b.y); h.w = pk2(b.z, b.w); return __builtin_bit_cast(bf16x8, h); }
__device__ __forceinline__ void phase_router3(const P& p, float* lds, int* blkcnt, int* rank, int bid, int nb) {
    const int tid = otid(), lane = tid & 63, w = tid >> 6, r = lane & 31, hf = lane >> 5;
    float* part = lds;
    float* ssqp = lds + 16384;
    float* lgt = lds + 16384 + 512;
    float* rsl = lgt + 64 * 33;
    bf16x8 bh[8], bl[8];
#pragma unroll
    for (int s = 0; s < 8; ++s) { const int k0 = 128 * w + 16 * s + 8 * hf; f32x4 a, b, ra, rb;
#pragma unroll
        for (int j = 0; j < 4; ++j) { a[j] = p.w_router[(k0 + j) * NE + r] * p.g_moe[k0 + j]; b[j] = p.w_router[(k0 + 4 + j) * NE + r] * p.g_moe[k0 + 4 + j]; }
        bh[s] = split_hi(a, b, ra, rb); bl[s] = pack_bf8(ra, rb); }
    for (int gidx = bid; gidx < M / 64; gidx += nb) {
        const int t0 = gidx * 64;
        __syncthreads();
#pragma unroll
        for (int mt = 0; mt < 2; ++mt) {
            const bf16* xr = p.x2() + (size_t)(t0 + 32 * mt + r) * D + 128 * w + 8 * hf;
            bf16x8 xa[8];
#pragma unroll
            for (int s = 0; s < 8; ++s) xa[s] = *(const bf16x8*)(xr + 16 * s);
            f32x16 acc = zero16(); float ss = 0.f;
#pragma unroll
            for (int s = 0; s < 8; ++s) { const u32x4 xu = __builtin_bit_cast(u32x4, xa[s]);
                const float x0 = bf_lo(xu.x), x1 = bf_hi(xu.x), x2 = bf_lo(xu.y), x3 = bf_hi(xu.y), x4 = bf_lo(xu.z), x5 = bf_hi(xu.z), x6 = bf_lo(xu.w), x7 = bf_hi(xu.w);
                ss += (x0 * x0 + x1 * x1) + (x2 * x2 + x3 * x3) + (x4 * x4 + x5 * x5) + (x6 * x6 + x7 * x7);
                acc = __builtin_amdgcn_mfma_f32_32x32x16_bf16(bh[s], xa[s], acc, 0, 0, 0);
                acc = __builtin_amdgcn_mfma_f32_32x32x16_bf16(bl[s], xa[s], acc, 0, 0, 0); }
            ss += __shfl_xor(ss, 32);
            if (hf == 0) ssqp[w * 64 + 32 * mt + r] = ss;
            float* po = part + (w * 64 + 32 * mt + r) * 32;
#pragma unroll
            for (int rg = 0; rg < 4; ++rg) *(f32x4*)(po + 8 * rg + 4 * hf) = (f32x4){acc[4 * rg], acc[4 * rg + 1], acc[4 * rg + 2], acc[4 * rg + 3]};
        }
        __syncthreads();
        { const int tk = tid >> 3, e4 = (tid & 7) * 4; f32x4 s4 = {0.f, 0.f, 0.f, 0.f}; float sq = 0.f;
#pragma unroll
          for (int ww = 0; ww < 8; ++ww) { s4 += *(const f32x4*)(part + (ww * 64 + tk) * 32 + e4); sq += ssqp[ww * 64 + tk]; }
          const float rs = 1.0f / sqrtf(sq * (1.f / D) + EPS); const f32x4 bb = *(const f32x4*)(p.b_router + e4);
          lgt[tk * 33 + e4] = s4.x * rs + bb.x; lgt[tk * 33 + e4 + 1] = s4.y * rs + bb.y; lgt[tk * 33 + e4 + 2] = s4.z * rs + bb.z; lgt[tk * 33 + e4 + 3] = s4.w * rs + bb.w;
          if ((tid & 7) == 0) rsl[tk] = rs; }
        __syncthreads();
        { const f32x4* gr = (const f32x4*)p.g_moe + 4 * lane; const f32x4 g0 = gr[0], g1 = gr[1], g2 = gr[2], g3 = gr[3];
#pragma unroll 4
          for (int ii = 0; ii < 8; ++ii) { const int t = t0 + 8 * w + ii; const float rs = rsl[8 * w + ii]; const u32x4* xr = (const u32x4*)(p.x2() + (size_t)t * D) + 2 * lane; const u32x4 w0 = xr[0], w1 = xr[1]; u32x4 o8;
              { const f32x4 v = (f32x4){bf_lo(w0.x), bf_hi(w0.x), bf_lo(w0.y), bf_hi(w0.y)} * rs * g0; o8.x = pk4_fp8(v.x, v.y, v.z, v.w); } { const f32x4 v = (f32x4){bf_lo(w0.z), bf_hi(w0.z), bf_lo(w0.w), bf_hi(w0.w)} * rs * g1; o8.y = pk4_fp8(v.x, v.y, v.z, v.w); }
              { const f32x4 v = (f32x4){bf_lo(w1.x), bf_hi(w1.x), bf_lo(w1.y), bf_hi(w1.y)} * rs * g2; o8.z = pk4_fp8(v.x, v.y, v.z, v.w); } { const f32x4 v = (f32x4){bf_lo(w1.z), bf_hi(w1.z), bf_lo(w1.w), bf_hi(w1.w)} * rs * g3; o8.w = pk4_fp8(v.x, v.y, v.z, v.w); }
              *((u32x4*)(p.ws + WS_X8 + (size_t)t * D) + lane) = o8; } }
        if (w == 0) {
            float lg[NE];
#pragma unroll
            for (int e = 0; e < NE; ++e) lg[e] = lgt[lane * 33 + e];
            int idx[4]; float val[4];
#pragma unroll
            for (int j = 0; j < 4; ++j) { float best = lg[0]; int bi = 0;
#pragma unroll
                for (int e = 1; e < NE; ++e) { const bool tk = lg[e] > best; best = tk ? lg[e] : best; bi = tk ? e : bi; }
                idx[j] = bi; val[j] = best;
#pragma unroll
                for (int e = 0; e < NE; ++e) lg[e] = (e == bi) ? -INFINITY : lg[e]; }
            const float e1 = __expf(val[1] - val[0]), e2 = __expf(val[2] - val[0]), e3 = __expf(val[3] - val[0]); const float inv = 1.f / (1.f + e1 + e2 + e3);
            int rk[4] = {0, 0, 0, 0}; int mycnt = 0; const unsigned long long lt = (1ull << lane) - 1ull;
#pragma unroll 4
            for (int e = 0; e < NE; ++e) { const bool h0 = idx[0] == e, h1 = idx[1] == e, h2 = idx[2] == e, h3 = idx[3] == e; const unsigned long long m = __ballot(h0 || h1 || h2 || h3);
                const int below = __popcll(m & lt); rk[0] = h0 ? below : rk[0]; rk[1] = h1 ? below : rk[1]; rk[2] = h2 ? below : rk[2]; rk[3] = h3 ? below : rk[3];
                mycnt = (lane == e) ? __popcll(m) : mycnt; }
            const int t = t0 + lane;
            *(i32x4g*)(p.topi() + t * 4) = (i32x4g){idx[0], idx[1], idx[2], idx[3]};
            *(f32x4*)(p.topg() + t * 4) = (f32x4){inv, e1 * inv, e2 * inv, e3 * inv};
            *(i32x4g*)(rank + t * 4) = (i32x4g){rk[0], rk[1], rk[2], rk[3]};
            if (lane < NE) blkcnt[gidx * NE + lane] = mycnt;
        }
    }
}
__device__ __forceinline__ int scan32_incl(int v, int lane) {
#pragma unroll
    for (int o = 1; o < 32; o <<= 1) { const int u = __shfl_up(v, o, 32); v += ((lane & 31) >= o) ? u : 0; }
    return v;
}
__device__ __forceinline__ void phase_dispatch3(const P& p, int* ldsi, const int* blkcnt, const int* rank, int bid, int nb) {
    const int tid = otid(), lane = tid & 63, w = tid >> 6;
    int* red_t = ldsi; int* red_p = ldsi + 512; int* base = ldsi + 1024;
    static_assert(MOE_FP8, "dispatch writes e4m3 activation rows");
    for (int gidx = bid; gidx < M / 64; gidx += nb) {
        __syncthreads();
        const int a = gidx * 256 + (tid & 255);
        const int my_e = p.topi()[a], my_r = rank[a]; const float my_g = p.topg()[a];
        { const int e = tid & 31, part = tid >> 5; int v[16];
#pragma unroll
          for (int k = 0; k < 16; ++k) v[k] = blkcnt[(part * 16 + k) * 32 + e];
          int tt = 0, pp = 0;
#pragma unroll
          for (int k = 0; k < 16; ++k) { tt += v[k]; pp += (part * 16 + k < gidx) ? v[k] : 0; }
          red_t[part * 32 + e] = tt; red_p[part * 32 + e] = pp; }
        __syncthreads();
        if (w == 0) {
            const int e = lane & 31; int tt = 0, pp = 0;
#pragma unroll
            for (int q = 0; q < 16; ++q) { tt += red_t[q * 32 + e]; pp += red_p[q * 32 + e]; }
            const int nt = (tt + 255) >> 8, off = scan32_incl(nt << 8, lane) - (nt << 8);
            if (lane < 32) { base[e] = off + pp; red_t[e] = tt; }
            if (gidx == 0) {
                const int lr = tt - ((nt - 1) << 8); const int isH = (nt > 0 && lr <= 128) ? 1 : 0, nfe = nt - isH;
                const int fi = scan32_incl(nfe, lane), hi = scan32_incl(isH, lane); const int NF = __shfl(fi, 31), NH = __shfl(hi, 31);
                if (lane < 32) { const int f0 = fi - nfe;
                    for (int i = 0; i < nfe; ++i) p.tilee()[f0 + i] = (((off >> 8) + i) << 7) | e;
                    if (isH) p.tilee()[NF + hi - 1] = (((off >> 8) + nt - 1) << 7) | (lr <= 64 ? 64 : 0) | 32 | e;
                    if (lane == 0) { p.tilee()[MAXMT] = NF + NH; p.tilee()[MAXMT + 1] = NF; } } } }
        __syncthreads();
        if (gidx == 0) { const int e = tid >> 4; const int c = red_t[e], s0 = base[e] + c, s1 = base[e] + (((c + 255) >> 8) << 8);
            for (int s = s0 + (tid & 15); s < s1; s += 16) ((int*)(p.ws + WS_TOKSLOT))[s] = 0; }
        if (tid < 256) { const int slot = base[my_e] + my_r;
            p.slotof()[a] = slot; p.gslot()[slot] = my_g; ((int*)(p.ws + WS_TOKSLOT))[slot] = a >> 2; }
    }
}
namespace pg {
typedef short bf16x8 __attribute__((ext_vector_type(8)));
constexpr int BM = 256, BK = 64, HALF = 128, HTB = HALF * BK * 2, STAGE_BYTES = 8 * HTB;
__device__ __forceinline__ int lds_byte(int r, int c) { const int st = (r >> 4) * 2 + (c >> 5), rr = r & 15, cc = c & 31, ob = rr * 64 + cc * 2; return st * 1024 + (ob ^ (((ob >> 9) & 1) << 5)); }
__device__ __forceinline__ void stage_rc(int b, int& R, int& C) { const int st = b / 1024, sb = b % 1024, swz = sb ^ (((sb >> 9) & 1) << 5); R = (st >> 1) * 16 + swz / 64; C = (st & 1) * 32 + (swz % 64) / 2; }
__device__ __forceinline__ int perm32(int rho) { const int n = rho >> 4, i = rho & 15; return 8 * (i >> 2) + 4 * n + (i & 3); }
struct Unit { int pm, pn, e, ord, half; unsigned ao, bo; };
struct Gemm { int lda, ldb, K; const LAS int* ltok = nullptr; };
__device__ __forceinline__ void map2d(int L, int nM, int nN, int& pm, int& pn) {
    const int nwg = nM * nN; int wgid = L;
    { const int q = nwg / 8, r = nwg % 8, xcd = wgid % 8, off = wgid / 8; wgid = (xcd < r ? xcd * (q + 1) : r * (q + 1) + (xcd - r) * q) + off; }
    const int nig = 8 * nN, gid = wgid / nig, fm = gid * 8, gsz = (nM - fm) < 8 ? (nM - fm) : 8;
    pm = fm + ((wgid % nig) % gsz); pn = (wgid % nig) / gsz;
}
struct Sched2D { unsigned aoff, boff, rowA, rowB; int nM, nN, G, c;
    __device__ __forceinline__ bool next(int i, Unit& u) const { const long L = (long)i * G + c; if (L >= (long)nM * nN) return false; map2d((int)L, nM, nN, u.pm, u.pn); u.e = 0; u.ord = i; u.half = 0;
        u.ao = aoff + (unsigned)u.pm * 256u * rowA; u.bo = boff + (unsigned)u.pn * 256u * rowB; return true; } };
struct SchedMoE { unsigned aoff, boff; const LAS int* tile_e; unsigned sBe, rowA, rowB; int nM, nF, nN, G, c; bool gatherA = false;
    __device__ __forceinline__ bool next(int i, Unit& u) const { const long L = (long)i * G + c; if (L >= (long)nM * nN) return false; int idx, pn;
        if (L < (long)nF * nN) map2d((int)L, nF, nN, idx, pn); else { const int t = (int)L - nF * nN; idx = nF + t / nN; pn = t % nN; }
        const int ent = __builtin_amdgcn_readfirstlane(tile_e[idx]); u.pm = ent >> 7; u.pn = pn; u.e = ent & 31; u.half = (ent >> 5) & 3; u.ord = i;
        u.ao = gatherA ? aoff : aoff + (unsigned)u.pm * 256u * rowA; u.bo = boff + (unsigned)u.e * sBe + (unsigned)u.pn * 256u * rowB; return true; } };

typedef f32x4 Acc[2][2][4][2];
__device__ __forceinline__ u32x4 pack8(const f32x4 v0, const f32x4 v1) { u32x4 w; w.x = pk2(v0[0], v0[1]); w.y = pk2(v0[2], v0[3]); w.z = pk2(v1[0], v1[1]); w.w = pk2(v1[2], v1[3]); return w; }
struct EpiBf3 { static constexpr bool AFTER_DRAIN = false, PERM = true, INIT = false; unsigned char* ws; size_t o0, o1, o2; int ld0, ld1, ld2;
    __device__ __forceinline__ void operator()(const Acc& acc, const Unit& u, int wr, int wc, int fr, int fq) const {
        const size_t m1 = (size_t)(u.e == 1), m2 = (size_t)(u.e == 2);
        bf16* base = (bf16*)(ws + o0 + m1 * (o1 - o0) + m2 * (o2 - o0)); const int ld = ld0 + (int)m1 * (ld1 - ld0) + (int)m2 * (ld2 - ld0);
        const int row0 = u.pm * BM + wr * 64 + fr, col0 = u.pn * BM + wc * 32 + 8 * fq;
#pragma unroll
        for (int ai = 0; ai < 2; ++ai)
#pragma unroll
            for (int m = 0; m < 4; ++m) { bf16* rowp = base + (size_t)(row0 + ai * HALF + m * 16) * ld + col0;
#pragma unroll
                for (int bj = 0; bj < 2; ++bj) *(u32x4*)(rowp + bj * HALF) = pack8(acc[ai][bj][m][0], acc[ai][bj][m][1]); } } };
struct EpiOutF { static constexpr bool AFTER_DRAIN = false, PERM = true, INIT = false; const float* x; bf16* x1; float* rsqp;
    __device__ __forceinline__ void operator()(const Acc& acc, const Unit& u, int wr, int wc, int fr, int fq) const {
        const int row0 = u.pm * BM + wr * 64 + fr, col0 = u.pn * BM + wc * 32 + 8 * fq;
        f32x4 xv[4][2][2]; u32x4 res[4][2]; float ssv[4];
#pragma unroll
        for (int ai = 0; ai < 2; ++ai) {
#pragma unroll
            for (int m = 0; m < 4; ++m)
#pragma unroll
                for (int bj = 0; bj < 2; ++bj) { const float* xp = x + (size_t)(row0 + ai * HALF + m * 16) * D + col0 + bj * HALF; xv[m][bj][0] = *(const f32x4*)xp; xv[m][bj][1] = *(const f32x4*)(xp + 4); }
            if (ai == 1) {
#pragma unroll
                for (int m = 0; m < 4; ++m) { const int row = row0 + m * 16;
#pragma unroll
                    for (int bj = 0; bj < 2; ++bj) *(u32x4*)(x1 + (size_t)row * D + col0 + bj * HALF) = res[m][bj];
                    if (fq == 0) rsqp[(size_t)row * 16 + u.pn * 4 + wc] = ssv[m]; } }
            __builtin_amdgcn_sched_barrier(0);
#pragma unroll
            for (int m = 0; m < 4; ++m) { float ss = 0.f;
#pragma unroll
                for (int bj = 0; bj < 2; ++bj) { const f32x4 v0 = xv[m][bj][0] + acc[ai][bj][m][0], v1 = xv[m][bj][1] + acc[ai][bj][m][1];
                    res[m][bj] = pack8(v0, v1);
                    ss += (v0[0] * v0[0] + v0[1] * v0[1]) + (v0[2] * v0[2] + v0[3] * v0[3]) + (v1[0] * v1[0] + v1[1] * v1[1]) + (v1[2] * v1[2] + v1[3] * v1[3]); }
                ss += __shfl_xor(ss, 16); ss += __shfl_xor(ss, 32); ssv[m] = ss; }
            __builtin_amdgcn_sched_barrier(0);
        }
#pragma unroll
        for (int m = 0; m < 4; ++m) { const int row = row0 + HALF + m * 16;
#pragma unroll
            for (int bj = 0; bj < 2; ++bj) *(u32x4*)(x1 + (size_t)row * D + col0 + bj * HALF) = res[m][bj];
            if (fq == 0) rsqp[(size_t)row * 16 + u.pn * 4 + wc] = ssv[m]; } } };
struct EpiResF { static constexpr bool AFTER_DRAIN = false, PERM = true, INIT = false; const bf16* base; bf16* o;
    __device__ __forceinline__ void operator()(const Acc& acc, const Unit& u, int wr, int wc, int fr, int fq) const {
        const int row0 = u.pm * BM + wr * 64 + fr, col0 = u.pn * BM + wc * 32 + 8 * fq;
        u32x4 bv[2][4][2];
#pragma unroll
        for (int ai = 0; ai < 2; ++ai)
#pragma unroll
            for (int m = 0; m < 4; ++m)
#pragma unroll
                for (int bj = 0; bj < 2; ++bj) bv[ai][m][bj] = *(const u32x4*)(base + (size_t)(row0 + ai * HALF + m * 16) * D + col0 + bj * HALF);
        __builtin_amdgcn_sched_barrier(0);
#pragma unroll
        for (int ai = 0; ai < 2; ++ai)
#pragma unroll
            for (int m = 0; m < 4; ++m)
#pragma unroll
                for (int bj = 0; bj < 2; ++bj) { const u32x4 b = bv[ai][m][bj];
                    const f32x4 v0 = (f32x4){bf_lo(b.x), bf_hi(b.x), bf_lo(b.y), bf_hi(b.y)} + acc[ai][bj][m][0], v1 = (f32x4){bf_lo(b.z), bf_hi(b.z), bf_lo(b.w), bf_hi(b.w)} + acc[ai][bj][m][1];
                    *(u32x4*)(o + (size_t)(row0 + ai * HALF + m * 16) * D + col0 + bj * HALF) = pack8(v0, v1); } } };
__device__ __forceinline__ f32x2_t swiglu_tu2(f32x2_t T, f32x2_t U) {
    constexpr float C = -1024.f * SWI_C;
    T.x = __builtin_amdgcn_fmed3f(T.x, -224.f * SWI_C, 3.0e38f); T.y = __builtin_amdgcn_fmed3f(T.y, -224.f * SWI_C, 3.0e38f);
    U.x = __builtin_amdgcn_fmed3f(U.x, -192.f, 256.f); U.y = __builtin_amdgcn_fmed3f(U.y, -192.f, 256.f);
    f32x2_t e = T * (1.f / 32.f); e.x = __builtin_amdgcn_exp2f(e.x); e.y = __builtin_amdgcn_exp2f(e.y);
    f32x2_t d = e * C + C; d.x = __builtin_amdgcn_rcpf(d.x); d.y = __builtin_amdgcn_rcpf(d.y);
    return (T * d) * U;
}
struct EpiUp8 { static constexpr bool AFTER_DRAIN = false, PERM = true, INIT = true; unsigned char* h8; const LAS float* lb;
    __device__ __forceinline__ void init(Acc& acc, const Unit& u, int wr, int wc, int fr, int fq) const {
        const LAS float* bb = lb + u.ord * 256 + wc * 32 + 8 * fq;
        const f32x4 bg0 = *(const LAS f32x4*)bb, bg1 = *(const LAS f32x4*)(bb + 4), bu0 = *(const LAS f32x4*)(bb + 128), bu1 = *(const LAS f32x4*)(bb + 132);
#pragma unroll
        for (int ai = 0; ai < 2; ++ai)
#pragma unroll
            for (int m = 0; m < 4; ++m) { acc[ai][0][m][0] = bg0; acc[ai][0][m][1] = bg1; acc[ai][1][m][0] = bu0; acc[ai][1][m][1] = bu1; } }
    __device__ __forceinline__ void operator()(const Acc& acc, const Unit& u, int wr, int wc, int fr, int fq) const {
        const int row0 = u.pm * BM + wr * 64 + fr, ff0 = u.pn * HALF + wc * 32 + 8 * fq;
#pragma unroll
        for (int ai = 0; ai < 2; ++ai)
#pragma unroll
            for (int m = 0; m < 4; ++m) { const f32x4 g0 = acc[ai][0][m][0], g1 = acc[ai][0][m][1], u0 = acc[ai][1][m][0], u1 = acc[ai][1][m][1];
                const f32x2_t r00 = swiglu_tu2((f32x2_t){g0[0], g0[1]}, (f32x2_t){u0[0], u0[1]}), r01 = swiglu_tu2((f32x2_t){g0[2], g0[3]}, (f32x2_t){u0[2], u0[3]});
                const f32x2_t r10 = swiglu_tu2((f32x2_t){g1[0], g1[1]}, (f32x2_t){u1[0], u1[1]}), r11 = swiglu_tu2((f32x2_t){g1[2], g1[3]}, (f32x2_t){u1[2], u1[3]});
                u32x2 o; o.x = pk4_fp8_nc(r00.x, r00.y, r01.x, r01.y); o.y = pk4_fp8_nc(r10.x, r10.y, r11.x, r11.y);
                *(u32x2*)(h8 + (size_t)(row0 + ai * HALF + m * 16) * DFF + ff0) = o; } } };
struct EpiDn8 { static constexpr bool AFTER_DRAIN = false, PERM = true, INIT = true; unsigned char* y8; const LAS float* lb;
    __device__ __forceinline__ void init(Acc& acc, const Unit& u, int wr, int wc, int fr, int fq) const {
        const LAS float* bb = lb + u.ord * 512 + wc * 32 + 8 * fq;
#pragma unroll
        for (int bj = 0; bj < 2; ++bj)
#pragma unroll
            for (int n = 0; n < 2; ++n) { const f32x4 b = *(const LAS f32x4*)(bb + bj * HALF + 4 * n);
#pragma unroll
                for (int ai = 0; ai < 2; ++ai)
#pragma unroll
                    for (int m = 0; m < 4; ++m) acc[ai][bj][m][n] = b; } }
    __device__ __forceinline__ void operator()(const Acc& acc, const Unit& u, int wr, int wc, int fr, int fq) const {
        const int row0 = u.pm * BM + wr * 64 + fr, col0 = u.pn * BM + wc * 32 + 8 * fq; const LAS float* gs = lb + u.ord * 512 + 256 + wr * 64 + fr;
#pragma unroll
        for (int ai = 0; ai < 2; ++ai)
#pragma unroll
            for (int m = 0; m < 4; ++m) { const int row = row0 + ai * HALF + m * 16; const float g = gs[ai * HALF + m * 16] * (W8_INV * Y8_SCALE); unsigned char* rowp = y8 + (size_t)row * D + col0;
#pragma unroll
                for (int bj = 0; bj < 2; ++bj) { const f32x4 v0 = acc[ai][bj][m][0] * g, v1 = acc[ai][bj][m][1] * g;
                    u32x2 o; o.x = pk4_fp8(v0[0], v0[1], v0[2], v0[3]); o.y = pk4_fp8(v1[0], v1[1], v1[2], v1[3]); *(u32x2*)(rowp + bj * HALF) = o; } } } };

__device__ __forceinline__ void tiles_store(LAS unsigned char* lds, const Acc& v, int wr, int wc, int fr, int fq) {
#pragma unroll
    for (int ai = 0; ai < 2; ++ai)
#pragma unroll
        for (int bj = 0; bj < 2; ++bj)
#pragma unroll
            for (int m = 0; m < 4; ++m) { const int t = 2 * bj + (wc >> 1);
                *(LAS u32x4*)(lds + (t * 2 + ai) * HTB + lds_byte(64 * wr + 16 * m + fr, (wc & 1) * 32 + 8 * fq)) = pack8(v[ai][bj][m][0], v[ai][bj][m][1]); }
}
__device__ __forceinline__ void mm_ldsA_globB(Acc& acc, LAS unsigned char* lds, const bf16* Bg, int ldb, int wr, int wc, int fr, int fq) {
    const int aoff = lds_byte(wr * 64 + fr, fq * 8);
    unsigned bo[2][2];
#pragma unroll
    for (int bj = 0; bj < 2; ++bj)
#pragma unroll
        for (int n = 0; n < 2; ++n) bo[bj][n] = (unsigned)(128 * bj + 32 * wc + perm32(16 * n + fr)) * (unsigned)ldb + 8u * fq;
    bf16x8 B0[2][2][2], B1[2][2][2];
#define MM_LOADB(dst, t) do { _Pragma("unroll") for (int bj = 0; bj < 2; ++bj) _Pragma("unroll") for (int n = 0; n < 2; ++n) _Pragma("unroll") for (int k = 0; k < 2; ++k) \
        dst[bj][n][k] = *(const bf16x8*)(Bg + bo[bj][n] + (t) * 64 + k * 32); } while (0)
#define MM_TILE(Bt, t) do { _Pragma("unroll") for (int ai = 0; ai < 2; ++ai) _Pragma("unroll") for (int mh = 0; mh < 2; ++mh) { bf16x8 At[2][2]; \
        _Pragma("unroll") for (int m = 0; m < 2; ++m) _Pragma("unroll") for (int k = 0; k < 2; ++k) At[m][k] = *(const LAS bf16x8*)(lds + ((t) * 2 + ai) * HTB + aoff + (2 * mh + m) * 2048 + k * 1024); \
        _Pragma("unroll") for (int bj = 0; bj < 2; ++bj) _Pragma("unroll") for (int m = 0; m < 2; ++m) _Pragma("unroll") for (int n = 0; n < 2; ++n) _Pragma("unroll") for (int k = 0; k < 2; ++k) \
            acc[ai][bj][2 * mh + m][n] = __builtin_amdgcn_mfma_f32_16x16x32_bf16(Bt[bj][n][k], At[m][k], acc[ai][bj][2 * mh + m][n], 0, 0, 0); \
        __builtin_amdgcn_sched_barrier(0); } } while (0)
    MM_LOADB(B0, 0);
#pragma unroll 1
    for (int t = 0; t < 4; t += 2) {
        MM_LOADB(B1, t + 1); __builtin_amdgcn_sched_barrier(0);
        MM_TILE(B0, t);
        if (t < 2) MM_LOADB(B0, t + 2);
        __builtin_amdgcn_sched_barrier(0);
        MM_TILE(B1, t + 1);
    }
#undef MM_LOADB
#undef MM_TILE
}
struct EpiQAttn { static constexpr bool AFTER_DRAIN = true, PERM = true, INIT = false; const float* rsqp; const bf16* kx; const bf16* vxt; bf16* ox;
    __device__ __forceinline__ void fused(Acc& acc, const Unit& u, int wr, int wc, int fr, int fq, LAS unsigned char* lds) const {
        const int b = u.pm >> 5, h = u.pn;
        LAS float* st = (LAS float*)(lds + STAGE_BYTES);
#pragma unroll
        for (int ai = 0; ai < 2; ++ai)
#pragma unroll
            for (int m = 0; m < 4; ++m) { const f32x4* rp = (const f32x4*)(rsqp + (size_t)(u.pm * BM + 128 * ai + 64 * wr + 16 * m + fr) * 16); const f32x4 p0 = rp[0], p1 = rp[1], p2 = rp[2], p3 = rp[3];
                const float sq = (((p0[0] + p0[1]) + (p0[2] + p0[3])) + ((p1[0] + p1[1]) + (p1[2] + p1[3]))) + (((p2[0] + p2[1]) + (p2[2] + p2[3])) + ((p3[0] + p3[1]) + (p3[2] + p3[3])));
                const float s = 0.0625f / sqrtf(sq * (1.f / D) + EPS);
#pragma unroll
                for (int bj = 0; bj < 2; ++bj)
#pragma unroll
                    for (int n = 0; n < 2; ++n) acc[ai][bj][m][n] = acc[ai][bj][m][n] * s; }
        tiles_store(lds, acc, wr, wc, fr, fq);
        __syncthreads();
#pragma unroll
        for (int ai = 0; ai < 2; ++ai)
#pragma unroll
            for (int bj = 0; bj < 2; ++bj)
#pragma unroll
                for (int m = 0; m < 4; ++m)
#pragma unroll
                    for (int n = 0; n < 2; ++n) acc[ai][bj][m][n] = (f32x4){0.f, 0.f, 0.f, 0.f};
        mm_ldsA_globB(acc, lds, kx + (size_t)(b * MEMLEN) * D + h * 256, D, wr, wc, fr, fq);
        float wm[2][4];
#pragma unroll
        for (int ai = 0; ai < 2; ++ai)
#pragma unroll
            for (int m = 0; m < 4; ++m) { float mx = -INFINITY;
#pragma unroll
                for (int bj = 0; bj < 2; ++bj)
#pragma unroll
                    for (int n = 0; n < 2; ++n) { const f32x4 v = acc[ai][bj][m][n]; mx = fmaxf(mx, fmaxf(fmaxf(v[0], v[1]), fmaxf(v[2], v[3]))); }
                mx = fmaxf(mx, __shfl_xor(mx, 16)); mx = fmaxf(mx, __shfl_xor(mx, 32)); wm[ai][m] = mx; float sm = 0.f;
#pragma unroll
                for (int bj = 0; bj < 2; ++bj)
#pragma unroll
                    for (int n = 0; n < 2; ++n) { f32x4 v = acc[ai][bj][m][n];
#pragma unroll
                        for (int i = 0; i < 4; ++i) { v[i] = __builtin_amdgcn_exp2f((v[i] - mx) * 1.44269504089f); sm += v[i]; }
                        acc[ai][bj][m][n] = v; }
                sm += __shfl_xor(sm, 16); sm += __shfl_xor(sm, 32);
                if (fq == 0) { const int row = 128 * ai + 64 * wr + 16 * m + fr; st[(row * 4 + wc) * 2] = mx; st[(row * 4 + wc) * 2 + 1] = sm; } }
        __syncthreads();
#pragma unroll
        for (int ai = 0; ai < 2; ++ai)
#pragma unroll
            for (int m = 0; m < 4; ++m) { const int row = 128 * ai + 64 * wr + 16 * m + fr; const LAS f32x4* sp = (const LAS f32x4*)(st + row * 8); const f32x4 s0 = sp[0], s1 = sp[1];
                const float gm = fmaxf(fmaxf(s0[0], s0[2]), fmaxf(s1[0], s1[2]));
                const float f = __builtin_amdgcn_exp2f((wm[ai][m] - gm) * 1.44269504089f);
#pragma unroll
                for (int bj = 0; bj < 2; ++bj)
#pragma unroll
                    for (int n = 0; n < 2; ++n) acc[ai][bj][m][n] = acc[ai][bj][m][n] * f; }
        tiles_store(lds, acc, wr, wc, fr, fq);
        __syncthreads();
#pragma unroll
        for (int ai = 0; ai < 2; ++ai)
#pragma unroll
            for (int bj = 0; bj < 2; ++bj)
#pragma unroll
                for (int m = 0; m < 4; ++m)
#pragma unroll
                    for (int n = 0; n < 2; ++n) acc[ai][bj][m][n] = (f32x4){0.f, 0.f, 0.f, 0.f};
        mm_ldsA_globB(acc, lds, vxt + (size_t)(h * 256) * (BATCH * MEMLEN) + b * MEMLEN, BATCH * MEMLEN, wr, wc, fr, fq);
        int t3 = threadIdx.x; asm volatile("" : "+v"(t3));
        const int fr3 = t3 & 15, fq3 = (t3 >> 4) & 3;
        const int row0 = u.pm * BM + wr * 64 + fr3, col0 = h * 256 + wc * 32 + 8 * fq3;
#pragma unroll
        for (int ai = 0; ai < 2; ++ai)
#pragma unroll
            for (int m = 0; m < 4; ++m) { bf16* rowp = ox + (size_t)(row0 + ai * HALF + m * 16) * D + col0;
                const int row = 128 * ai + 64 * wr + 16 * m + fr3; const LAS f32x4* sp = (const LAS f32x4*)(st + row * 8); const f32x4 s0 = sp[0], s1 = sp[1];
                const float gm = fmaxf(fmaxf(s0[0], s0[2]), fmaxf(s1[0], s1[2]));
                const float tot = s0[1] * __builtin_amdgcn_exp2f((s0[0] - gm) * 1.44269504089f) + s0[3] * __builtin_amdgcn_exp2f((s0[2] - gm) * 1.44269504089f)
                                + s1[1] * __builtin_amdgcn_exp2f((s1[0] - gm) * 1.44269504089f) + s1[3] * __builtin_amdgcn_exp2f((s1[2] - gm) * 1.44269504089f);
                const float inv = 1.f / tot;
#pragma unroll
                for (int bj = 0; bj < 2; ++bj) *(u32x4*)(rowp + bj * HALF) = pack8(acc[ai][bj][m][0] * inv, acc[ai][bj][m][1] * inv); }
    }
};

typedef int i32x4 __attribute__((ext_vector_type(4)));
typedef int i32x8 __attribute__((ext_vector_type(8)));
__device__ __forceinline__ void mma8(const i32x8 bb, const i32x8 aa, f32x4& c) {
    asm volatile("v_mfma_f32_16x16x128_f8f6f4 %0, %1, %2, %0" : "+v"(c) : "v"(bb), "v"(aa));
}
__device__ __forceinline__ void mma8_drain() { asm volatile("s_nop 15\n\ts_nop 7" ::: "memory"); }
template <class Epi, class Sched, bool ALIGN_EPI, bool F8 = false, bool GATHER = false, bool HALFABLE = false>
__device__ __forceinline__ void gemm_phase(LAS unsigned char* lds, const unsigned char* ws, const Gemm g, const Sched& S, const Epi& E) {
    const __amdgpu_buffer_rsrc_t rsrc = __builtin_amdgcn_make_buffer_rsrc((void*)ws, 0, 0x7fffffff, 0x00020000);
    const int tid = otid(), wid = __builtin_amdgcn_readfirstlane(tid >> 6), lane = tid & 63, wr = wid >> 2, wc = wid & 3, fr = lane & 15, fq = lane >> 4;
    const int K = g.K, nt = K / BK;
    unsigned voffA[2], voffB[2]; int gR[2]; unsigned gC[2];
#pragma unroll
    for (int i = 0; i < 2; ++i) { int R, C; stage_rc(tid * 16 + i * 8192, R, C); const int Rb = Epi::PERM ? ((R & ~31) + perm32(R & 31)) : R;
        voffA[i] = (unsigned)(R * g.lda + C) * 2u; voffB[i] = (unsigned)(Rb * g.ldb + C) * 2u; gR[i] = R; gC[i] = (unsigned)C * 2u; }
    unsigned vgc[2][2], vgn[2][2];
#define PG_GATH(dst, ord) do { _Pragma("unroll") for (int _h = 0; _h < 2; ++_h) _Pragma("unroll") for (int _i = 0; _i < 2; ++_i) \
        dst[_h][_i] = (unsigned)g.ltok[(ord) * 256 + 128 * _h + gR[_i]] * (unsigned)(g.lda * 2) + gC[_i]; } while (0)
    const unsigned kstep = (unsigned)(BK * 2);
    const unsigned hstepA = (unsigned)HALF * g.lda * 2, hstepB = (unsigned)HALF * g.ldb * 2;
    const unsigned ldsw = (unsigned)wid * 1024u, ldsbase = (unsigned)(size_t)lds;
    const int aoff = lds_byte(wr * 64 + fr, fq * 8), boff = lds_byte(wc * 32 + fr, fq * 8);
#define PG_SA(b, h) (((b) * 2 + (h)) * HTB)
#define PG_SB(b, h) ((4 + (b) * 2 + (h)) * HTB)
#ifndef STAGE_GLDS
#define STAGE_GLDS 0
#endif
#if STAGE_GLDS
#define PG_STAGE(bufoff, gbase, voff) do { _Pragma("unroll") for (int _i = 0; _i < 2; ++_i) \
        __builtin_amdgcn_global_load_lds((const unsigned*)((const char*)ws + (gbase) + (voff)[_i]), (LAS unsigned*)(lds + (bufoff) + ldsw + _i * 8192), 16, 0, 0); } while (0)
#else
#define PG_STAGE(bufoff, gbase, voff) do { _Pragma("unroll") for (int _i = 0; _i < 2; ++_i) \
        asm volatile("s_mov_b32 m0, %0\n\ts_nop 0\n\tbuffer_load_dwordx4 %1, %2, %3 offen lds" :: "s"(ldsbase + (unsigned)(bufoff) + ldsw + (unsigned)(_i * 8192)), "v"((voff)[_i]), "s"(rsrc), "s"((unsigned)(gbase)) : "m0", "memory"); } while (0)
#endif
#define PG_LD8(base) __builtin_shufflevector(*(const LAS i32x4*)(lds + (base)), *(const LAS i32x4*)(lds + (base) + 1024), 0, 1, 2, 3, 4, 5, 6, 7)
#define PG_LDA(dst, b, h) do { _Pragma("unroll") for (int m = 0; m < 4; ++m) { if constexpr (F8) dst##8[m] = PG_LD8(PG_SA(b, h) + aoff + m * 2048); \
        else { _Pragma("unroll") for (int k = 0; k < 2; ++k) dst[m][k] = *(const LAS bf16x8*)(lds + PG_SA(b, h) + aoff + m * 2048 + k * 1024); } } } while (0)
#define PG_LDB(dst, b, h) do { _Pragma("unroll") for (int n = 0; n < 2; ++n) { if constexpr (F8) dst##8[n] = PG_LD8(PG_SB(b, h) + boff + n * 2048); \
        else { _Pragma("unroll") for (int k = 0; k < 2; ++k) dst[n][k] = *(const LAS bf16x8*)(lds + PG_SB(b, h) + boff + n * 2048 + k * 1024); } } } while (0)
#define PG_MMA(ai, bj, At, Bt) do { __builtin_amdgcn_s_setprio(1); _Pragma("unroll") for (int m = 0; m < 4; ++m) _Pragma("unroll") for (int n = 0; n < 2; ++n) { \
        if constexpr (F8) mma8(Bt##8[n], At##8[m], acc[ai][bj][m][n]); \
        else { _Pragma("unroll") for (int k = 0; k < 2; ++k) acc[ai][bj][m][n] = __builtin_amdgcn_mfma_f32_16x16x32_bf16(Bt[n][k], At[m][k], acc[ai][bj][m][n], 0, 0, 0); } } \
        __builtin_amdgcn_s_setprio(0); } while (0)
#define PG_WAIT_V(n) asm volatile("s_waitcnt vmcnt(" #n ")" ::: "memory")
#define PG_WAIT_L(n) asm volatile("s_waitcnt lgkmcnt(" #n ")" ::: "memory")
#define PG_BAR __builtin_amdgcn_s_barrier()
#define PG_SCHED __builtin_amdgcn_sched_barrier(0)
    Unit cur, nxt; int ui = 0;
    if (!S.next(0, cur)) return;
    f32x4 acc[2][2][4][2];
    if constexpr (Epi::INIT) E.init(acc, cur, wr, wc, fr, fq);
    else {
#pragma unroll
    for (int a = 0; a < 2; ++a)
#pragma unroll
        for (int b = 0; b < 2; ++b)
#pragma unroll
            for (int m = 0; m < 4; ++m)
#pragma unroll
                for (int n = 0; n < 2; ++n) acc[a][b][m][n] = (f32x4){0.f, 0.f, 0.f, 0.f}; }
    bf16x8 At[4][2], B0[2][2], B1[2][2]; i32x8 At8[4], B08[2], B18[2];
    unsigned cA = cur.ao, cB = cur.bo;
    if constexpr (GATHER) { PG_GATH(vgc, cur.ord); }
#define PG_STAGE_A(b, h, base, vg) do { if constexpr (GATHER) PG_STAGE(PG_SA(b, h), (base), (vg)[h]); else PG_STAGE(PG_SA(b, h), (base) + (h) * hstepA, voffA); } while (0)
    asm volatile("s_nop 4" ::: "memory");
    PG_STAGE(PG_SB(0, 0), cB, voffB); PG_STAGE(PG_SB(0, 1), cB + hstepB, voffB); PG_STAGE_A(0, 0, cA, vgc); PG_STAGE_A(0, 1, cA, vgc);
    if (wr == 1) PG_BAR;
    PG_WAIT_V(2); PG_BAR;
    PG_STAGE(PG_SB(1, 0), cB + kstep, voffB); PG_STAGE_A(1, 0, cA + kstep, vgc); PG_STAGE(PG_SB(1, 1), cB + hstepB + kstep, voffB);
    PG_WAIT_V(6); PG_BAR;
    for (;;) {
        const bool has_next = S.next(ui + 1, nxt);
        const unsigned nA = has_next ? nxt.ao : cA, nB = has_next ? nxt.bo : cB;
        if constexpr (GATHER) { if (has_next) { PG_GATH(vgn, nxt.ord); } else {
#pragma unroll
            for (int _h = 0; _h < 2; ++_h)
#pragma unroll
                for (int _i = 0; _i < 2; ++_i) vgn[_h][_i] = vgc[_h][_i]; } }
#pragma unroll 1
        for (int t = 0; t < nt; t += 2) {
            const bool last = (t == nt - 2);
            const unsigned a1 = cA + (unsigned)(t + 1) * kstep;
            const unsigned a2 = last ? nA : cA + (unsigned)(t + 2) * kstep, b2 = last ? nB : cB + (unsigned)(t + 2) * kstep;
            const unsigned a3 = a2 + kstep, b3 = b2 + kstep;
            unsigned vg2[2][2];
            if constexpr (GATHER) {
#pragma unroll
                for (int _h = 0; _h < 2; ++_h)
#pragma unroll
                    for (int _i = 0; _i < 2; ++_i) vg2[_h][_i] = last ? vgn[_h][_i] : vgc[_h][_i]; }
            PG_LDB(B0, 0, 0); PG_LDB(B1, 0, 1); PG_SCHED; PG_LDA(At, 0, 0); PG_STAGE_A(1, 1, a1, vgc);
            PG_WAIT_V(8); PG_WAIT_L(0); PG_BAR; if (!(HALFABLE && cur.half == 3 && wr == 1)) { PG_MMA(0, 0, At, B0); PG_MMA(0, 1, At, B1); } PG_BAR; PG_SCHED;
            PG_LDA(At, 0, 1); PG_STAGE(PG_SB(0, 0), b2, voffB); PG_STAGE(PG_SB(0, 1), b2 + hstepB, voffB); PG_STAGE_A(0, 0, a2, vg2);
            PG_WAIT_V(8); PG_WAIT_L(0); PG_BAR; if (!(HALFABLE && cur.half)) { PG_MMA(1, 0, At, B0); PG_MMA(1, 1, At, B1); } PG_BAR; PG_SCHED;
            PG_LDB(B0, 1, 0); PG_LDB(B1, 1, 1); PG_SCHED; PG_LDA(At, 1, 0); PG_STAGE_A(0, 1, a2, vg2);
            PG_WAIT_V(8); PG_WAIT_L(0); PG_BAR; if (!(HALFABLE && cur.half == 3 && wr == 1)) { PG_MMA(0, 0, At, B0); PG_MMA(0, 1, At, B1); } PG_BAR; PG_SCHED;
            PG_LDA(At, 1, 1); PG_STAGE(PG_SB(1, 0), b3, voffB); PG_STAGE(PG_SB(1, 1), b3 + hstepB, voffB); PG_STAGE_A(1, 0, a3, vg2);
            PG_WAIT_V(8); PG_WAIT_L(0); PG_BAR; if (!(HALFABLE && cur.half)) { PG_MMA(1, 0, At, B0); PG_MMA(1, 1, At, B1); } PG_BAR; PG_SCHED;
        }
        if constexpr (ALIGN_EPI) { if (wr == 0) PG_BAR; }
        if constexpr (F8) mma8_drain();
        if constexpr (!Epi::AFTER_DRAIN) { int t2 = threadIdx.x; asm volatile("" : "+v"(t2));
          const int l2 = t2 & 63; E(acc, cur, wr, wc, l2 & 15, l2 >> 4);
#ifdef PROBE_EPI2
          if constexpr (F8) {
#pragma unroll 1
            for (int rep = 0; rep < PROBE_EPI2; ++rep) {
#pragma unroll
              for (int a = 0; a < 2; ++a)
#pragma unroll
                for (int b = 0; b < 2; ++b)
#pragma unroll
                  for (int m = 0; m < 4; ++m)
#pragma unroll
                    for (int n = 0; n < 2; ++n) asm volatile("" : "+v"(acc[a][b][m][n]));
              E(acc, cur, wr, wc, l2 & 15, l2 >> 4); } }
#endif
          }
        if (!has_next) break;
        if constexpr (Epi::INIT) { int t3 = threadIdx.x; asm volatile("" : "+v"(t3)); const int l3 = t3 & 63; E.init(acc, nxt, wr, wc, l3 & 15, l3 >> 4); }
        else {
#pragma unroll
        for (int a = 0; a < 2; ++a)
#pragma unroll
            for (int b = 0; b < 2; ++b)
#pragma unroll
                for (int m = 0; m < 4; ++m)
#pragma unroll
                    for (int n = 0; n < 2; ++n) acc[a][b][m][n] = (f32x4){0.f, 0.f, 0.f, 0.f}; }
        cur = nxt; cA = nA; cB = nB; ++ui;
        if constexpr (GATHER) {
#pragma unroll
            for (int _h = 0; _h < 2; ++_h)
#pragma unroll
                for (int _i = 0; _i < 2; ++_i) vgc[_h][_i] = vgn[_h][_i]; }
        if constexpr (ALIGN_EPI) { if (wr == 1) PG_BAR; }
    }
    PG_WAIT_V(0);
    if constexpr (!ALIGN_EPI) { if (wr == 0) PG_BAR; }
    PG_BAR;
    if constexpr (Epi::AFTER_DRAIN) { int t2 = threadIdx.x; asm volatile("" : "+v"(t2)); const int l2 = t2 & 63; E.fused(acc, cur, wr, wc, l2 & 15, l2 >> 4, lds); }
#undef PG_SA
#undef PG_SB
#undef PG_STAGE
#undef PG_STAGE_A
#undef PG_GATH
#undef PG_LDA
#undef PG_LDB
#undef PG_MMA
#undef PG_WAIT_V
#undef PG_WAIT_L
#undef PG_BAR
#undef PG_SCHED
}
}

#define XB_TMO      128
#define XB_XCNT(j)  (256  + 64 * (j))
#define XB_XSUB(j)  (1280 + 64 * (j))
#define XB_XGEN(j)  (2304 + 64 * (j))
#define XB_TOP      3328
#define XB_TOPGEN   3392
#define XCD_BAR_WORDS 3456
#define XB_SPIN_CAP (1u << 18)
__device__ __forceinline__ unsigned xb_ld(unsigned* p)              { return __hip_atomic_load(p, __ATOMIC_RELAXED, __HIP_MEMORY_SCOPE_AGENT); }
__device__ __forceinline__ unsigned xb_add(unsigned* p, unsigned v) { return __hip_atomic_fetch_add(p, v, __ATOMIC_RELAXED, __HIP_MEMORY_SCOPE_AGENT); }
__device__ __forceinline__ unsigned xb_xcc_id() { return (unsigned)__builtin_amdgcn_s_getreg((3 << 11) | 20) & 0xFu; }
#define XB_SPIN(cond, bar) do { unsigned _sp = 0; while (cond) { __builtin_amdgcn_s_sleep(1); \
    if ((++_sp & 255u) == 0u) { if (xb_ld(&(bar)[XB_TMO])) break; if (_sp > XB_SPIN_CAP) { atomicAdd(&(bar)[XB_TMO], 1u); break; } } } } while (0)
struct XcdBarrier { unsigned* bar; unsigned x; volatile LAS unsigned* st; };
__device__ __forceinline__ XcdBarrier xcd_barrier_post(unsigned* bar, volatile LAS unsigned* st) {
    XcdBarrier b; b.bar = bar; b.x = xb_xcc_id(); b.st = st;
    if (threadIdx.x == 0) (void)xb_add(&bar[XB_XCNT(b.x)], 1u);
    return b;
}
__device__ __forceinline__ void xcd_barrier_complete(unsigned* bar, unsigned x, unsigned& nloc, unsigned& nx) {
    const unsigned G = NBLOCKS;
    unsigned sum, cnt, mine, sp = 0u;
    for (;;) {
        sum = 0u; cnt = 0u; mine = 0u;
#pragma unroll
        for (unsigned j = 0; j < 16; ++j) { const unsigned c = xb_ld(&bar[XB_XCNT(j)]); sum += c; cnt += (c > 0u) ? 1u : 0u; mine = (j == x) ? c : mine; }
        if (sum == G) break;
        __builtin_amdgcn_s_sleep(1);
        if ((++sp & 255u) == 0u) { if (xb_ld(&bar[XB_TMO])) break; if (sp > XB_SPIN_CAP) { atomicAdd(&bar[XB_TMO], 1u); break; } }
    }
    nloc = mine > 0u ? mine : 1u; nx = cnt > 0u ? cnt : 1u;
}
__device__ __forceinline__ void xcd_barrier(unsigned* bar_, volatile LAS unsigned* st_) {
    asm volatile("s_waitcnt vmcnt(0)" ::: "memory");
    __syncthreads();
    if (threadIdx.x == 0) {
        XcdBarrier b; b.bar = bar_; b.x = xb_xcc_id(); b.st = st_;
        unsigned* bar = b.bar;
        __builtin_amdgcn_s_waitcnt(0);
        unsigned nloc = b.st[0], nx = b.st[1];
        if (nloc == 0u) { xcd_barrier_complete(bar, b.x, nloc, nx); b.st[0] = nloc; b.st[1] = nx; }
        const unsigned old = xb_add(&bar[XB_XSUB(b.x)], 1u);
        const unsigned gen = old / nloc;
        if (old + 1u == (gen + 1u) * nloc) {
            __builtin_amdgcn_fence(__ATOMIC_RELEASE, "agent");
            asm volatile("s_waitcnt vmcnt(0)" ::: "memory");
            const unsigned og = xb_add(&bar[XB_TOP], 1u);
            if (og + 1u != (gen + 1u) * nx) XB_SPIN(xb_ld(&bar[XB_TOP]) < (gen + 1u) * nx, bar);
            __builtin_amdgcn_fence(__ATOMIC_ACQUIRE, "agent");
            asm volatile("s_waitcnt vmcnt(0)" ::: "memory");
        } else {
            XB_SPIN(xb_ld(&bar[XB_TOP]) < (gen + 1u) * nx, bar);
            __builtin_amdgcn_fence(__ATOMIC_ACQUIRE, "agent");
            asm volatile("s_waitcnt vmcnt(0)" ::: "memory");
        }
    }
    __syncthreads();
}

constexpr int NPHASE = 13;
constexpr int TILE_OFF = 131072, BIAS_OFF = TILE_OFF + 1280;
constexpr int LTOK_OFF = BIAS_OFF + 9216;
constexpr int LDS_BYTES = 155648, PT_OFF = LDS_BYTES - 512, MISC_OFF = LDS_BYTES - 128;
__device__ __forceinline__ const float* pt_load(const LAS unsigned* pt, int i) {
    const unsigned lo = __builtin_amdgcn_readfirstlane(pt[2 * i]), hi = __builtin_amdgcn_readfirstlane(pt[2 * i + 1]);
    return (const float*)(const GAS float*)(((unsigned long long)hi << 32) | lo);
}
__device__ __forceinline__ unsigned char* opaque_ws(P& p) { unsigned long long w = (unsigned long long)p.ws; asm volatile("" : "+s"(w) :: "memory"); p.ws = (unsigned char*)(GAS unsigned char*)w; return p.ws; }
__device__ __forceinline__ P make_p(const LAS unsigned* pt, float* out, unsigned char* ws) {
    P p;
    p.x = pt_load(pt, 0); p.mem = pt_load(pt, 1); p.g_mix = pt_load(pt, 2); p.w_in = pt_load(pt, 3); p.w_pool = pt_load(pt, 4); p.pool_scale = pt_load(pt, 5); p.w_gate_up = pt_load(pt, 6); p.b_gate_up = pt_load(pt, 7);
    p.gla_g = pt_load(pt, 8); p.w_out = pt_load(pt, 9); p.g_xattn = pt_load(pt, 10); p.g_mem = pt_load(pt, 11); p.w_xq = pt_load(pt, 12); p.w_xk = pt_load(pt, 13); p.w_xv = pt_load(pt, 14); p.w_xo = pt_load(pt, 15);
    p.g_moe = pt_load(pt, 16); p.w_router = pt_load(pt, 17); p.b_router = pt_load(pt, 18); p.w_gu = pt_load(pt, 19); p.b_gu = pt_load(pt, 20); p.w_dn = pt_load(pt, 21); p.b_dn = pt_load(pt, 22); p.g_final = pt_load(pt, 23);
    p.out = (float*)(GAS float*)(unsigned long long)out; p.ws = ws; return p;
}
struct Args { const float* in[24]; float* out; unsigned char* ws; int ph_lo, ph_hi; };

__global__ void __launch_bounds__(NTHREADS, 2) mk_fwd(Args a) {
    extern __shared__ __attribute__((aligned(16))) unsigned char lds[];
    float* ldsf = (float*)lds;
    { volatile LAS unsigned long long* PT = (volatile LAS unsigned long long*)((LAS unsigned char*)lds + PT_OFF);
      if (threadIdx.x == 0) {
#define PTS(i) PT[i] = (unsigned long long)a.in[i];
          PTS(0) PTS(1) PTS(2) PTS(3) PTS(4) PTS(5) PTS(6) PTS(7) PTS(8) PTS(9) PTS(10) PTS(11) PTS(12) PTS(13) PTS(14) PTS(15) PTS(16) PTS(17) PTS(18) PTS(19) PTS(20) PTS(21) PTS(22) PTS(23)
#undef PTS
      } }
    const int bid = blockIdx.x; constexpr int nb = NBLOCKS;
#if defined(PROBE_SLEEP_US)
    { const unsigned long long t0 = __builtin_amdgcn_s_memrealtime(); while (__builtin_amdgcn_s_memrealtime() - t0 < (unsigned long long)(PROBE_SLEEP_US) * 100ull) __builtin_amdgcn_s_sleep(64); }
#endif
#if defined(MK_PER_PHASE)
    const int lo = a.ph_lo, hi = a.ph_hi;
#else
    constexpr int lo = 0, hi = NPHASE;
#endif
#ifndef PH
#define PH -1
#endif
#ifndef REPMASK
#define REPMASK 0
#endif
#define REP(k) ((((REPMASK) >> (k)) & 1) ? 2 : 1)
#define IN(k) ((PH < 0 || PH == (k)) && lo <= (k) && (k) < hi)
    LAS unsigned char* ldsl = (LAS unsigned char*)lds;
    volatile LAS unsigned* MISC = (volatile LAS unsigned*)(ldsl + MISC_OFF);
    if (threadIdx.x < 32) MISC[threadIdx.x] = 0u;
    __syncthreads();
    const bool fused = (hi - lo) > 1;
    if (fused) (void)xcd_barrier_post((unsigned*)(a.ws + WS_CTL) + CW_BAR, MISC + 8);
#define GRID_BAR() xcd_barrier((unsigned*)(a.ws + WS_CTL) + CW_BAR, (volatile LAS unsigned*)(ldsl + MISC_OFF) + 8)
#define SEAM(k) do { if (fused && IN(k) && IN((k) + 1)) GRID_BAR(); } while (0)
#define PHASE(k) if (IN(k)) for (int rep_ = 0; rep_ < REP(k); ++rep_) if (bool once_ = true) for (P p = (rep_ ? (GRID_BAR(), make_p((const LAS unsigned*)(ldsl + PT_OFF), a.out, a.ws)) : make_p((const LAS unsigned*)(ldsl + PT_OFF), a.out, a.ws)); once_; once_ = false) \
        for (unsigned char* ws = opaque_ws(p); once_; once_ = false)
    PHASE(0) { phase_prologue(p, ldsf, bid, nb); }
    SEAM(0);
    PHASE(1) { pg::Sched2D S{(unsigned)WS_XN, (unsigned)WS_WT_IN, D * 2, D * 2, M / 256, NZ / 256, nb, bid}; pg::EpiBf3 E{ws, WS_Z1, WS_Z1, WS_Z1, NZ, NZ, NZ};
        pg::gemm_phase<pg::EpiBf3, pg::Sched2D, true>(ldsl, ws, pg::Gemm{D, D, D}, S, E); }
    SEAM(1);
#ifndef PROBE_P2
#define PROBE_P2 0
#endif
    PHASE(2) { phase_pool2(p, lds, bid, nb); if (PROBE_P2 & 1) { __syncthreads(); phase_pool2(p, lds, bid, nb); } phase_gla_a3(p, lds, bid, nb); if (PROBE_P2 & 2) { __syncthreads(); phase_gla_a3(p, lds, bid, nb); } }
    SEAM(2);
    PHASE(3) { const int t3 = otid(), wv = __builtin_amdgcn_readfirstlane(t3 >> 6);
        const ConvChunk cc = conv_chunk_decode(p, bid * 96 + CONV_IT_SCAN * 8 + wv, t3 & 63); f32x4 cv[16]; conv_chunk_load(cc, cv);
        if (wv < 4) phase_scan2(p, bid, nb); else kv_tile(p, bid, wv - 4, t3 & 63);
        conv_chunk_store(cc, cv); }
    SEAM(3);
    PHASE(4) { phase_gla_b3(p, lds, bid, nb); }
    SEAM(4);
    PHASE(5) { pg::Sched2D S{(unsigned)WS_MIX, (unsigned)WS_WT_OUT, D * 2, D * 2, M / 256, D / 256, nb, bid}; pg::EpiOutF E{p.x, p.x1(), p.rsqp()};
        pg::gemm_phase<pg::EpiOutF, pg::Sched2D, false>(ldsl, ws, pg::Gemm{D, D, D}, S, E); }
    SEAM(5);
    PHASE(6) { pg::Sched2D S{(unsigned)WS_X1, (unsigned)WS_WT_XQ, D * 2, D * 2, M / 256, D / 256, nb, bid};
        pg::EpiQAttn E{p.rsqp(), p.kx(), p.vxt(), p.ox()};
        pg::gemm_phase<pg::EpiQAttn, pg::Sched2D, false>(ldsl, ws, pg::Gemm{D, D, D}, S, E); }
    SEAM(6);
    PHASE(7) { pg::Sched2D S{(unsigned)WS_OX, (unsigned)WS_WT_XO, D * 2, D * 2, M / 256, D / 256, nb, bid}; pg::EpiResF E{p.x1(), p.x2()};
        pg::gemm_phase<pg::EpiResF, pg::Sched2D, false>(ldsl, ws, pg::Gemm{D, D, D}, S, E); }
    SEAM(7);
    PHASE(8) { phase_router3(p, ldsf, (int*)(ws + WS_BLKCNT), (int*)(ws + WS_WAVEBASE), bid, nb); }
    SEAM(8);
    PHASE(9) { const int t9 = otid(); const ConvChunk cc = conv_chunk_decode(p, bid * 96 + CONV_IT_DISP * 8 + (t9 >> 6), t9 & 63); f32x4 cv[16]; conv_chunk_load(cc, cv);
        phase_dispatch3(p, (int*)lds, (const int*)(ws + WS_BLKCNT), (const int*)(ws + WS_WAVEBASE), bid, nb);
        conv_chunk_store(cc, cv); }
    SEAM(9);
    PHASE(10) { LAS int* tl = (LAS int*)(ldsl + TILE_OFF); { const int t = otid(); if (t < MAXMT + 2) tl[t] = p.tilee()[t]; } __syncthreads();
        const int nmt = __builtin_amdgcn_readfirstlane(tl[MAXMT]), nfull = __builtin_amdgcn_readfirstlane(tl[MAXMT + 1]);
        pg::SchedMoE S{(unsigned)WS_X8, (unsigned)WS_WT_GU, tl, 2 * DFF * D, D, D, nmt, nfull, 8, nb, bid, true};
        LAS float* lb = (LAS float*)(ldsl + BIAS_OFF);
        LAS int* lt = (LAS int*)(ldsl + LTOK_OFF);
        { const int t10 = otid() & 255, hsel = otid() >> 8; float bvv[5]; int tvv[5];
#pragma unroll
          for (int j = 0; j < 5; ++j) { pg::Unit uu; const int i = 2 * j + hsel; bvv[j] = 0.f; tvv[j] = 0;
              if (S.next(i, uu)) { const float b = p.b_gu[(size_t)uu.e * 2 * DFF + (t10 >> 7) * DFF + uu.pn * 128 + (t10 & 127)]; bvv[j] = (t10 >> 7) ? (b + 1.0f) * W8_SCALE : b * W8_GATE;
                  tvv[j] = ((const int*)(ws + WS_TOKSLOT))[uu.pm * 256 + t10]; } }
#pragma unroll
          for (int j = 0; j < 5; ++j) { const int i = 2 * j + hsel; if (i < 9) { lb[i * 256 + t10] = bvv[j]; lt[i * 256 + t10] = tvv[j]; } } }
        __syncthreads();
        pg::EpiUp8 E{(unsigned char*)p.h(), lb};
        pg::gemm_phase<pg::EpiUp8, pg::SchedMoE, true, true, true, true>(ldsl, ws, pg::Gemm{D / 2, D / 2, D / 2, lt}, S, E); }
    SEAM(10);
    PHASE(11) { LAS int* tl = (LAS int*)(ldsl + TILE_OFF); { const int t = otid(); if (t < MAXMT + 2) tl[t] = p.tilee()[t]; } __syncthreads();
        const int nmt = __builtin_amdgcn_readfirstlane(tl[MAXMT]), nfull = __builtin_amdgcn_readfirstlane(tl[MAXMT + 1]);
        pg::SchedMoE S{(unsigned)WS_H, (unsigned)WS_WT_DN, tl, D * DFF, DFF, DFF, nmt, nfull, 4, nb, bid};
        LAS float* lb = (LAS float*)(ldsl + BIAS_OFF);
        { const int t11 = otid(); float bvv[5];
#pragma unroll
          for (int i = 0; i < 5; ++i) { pg::Unit uu; bvv[i] = 0.f; if (S.next(i, uu)) bvv[i] = t11 < 256 ? p.b_dn[(size_t)uu.e * D + uu.pn * 256 + t11] * W8_SCALE : p.gslot()[uu.pm * 256 + (t11 - 256)]; }
#pragma unroll
          for (int i = 0; i < 5; ++i) lb[i * 512 + t11] = bvv[i]; }
        __syncthreads();
        pg::EpiDn8 E{(unsigned char*)p.y(), lb};
        pg::gemm_phase<pg::EpiDn8, pg::SchedMoE, true, true, false, true>(ldsl, ws, pg::Gemm{DFF / 2, DFF / 2, DFF / 2}, S, E); }
    SEAM(11);
    PHASE(12) { phase_final(p, bid, nb); }
#undef PHASE
#undef IN
#undef SEAM
}

extern "C" void kernel_launch(void* const* d_in, const int* in_sizes, int n_in, void* d_out, int out_size, void* d_ws, size_t ws_size, hipStream_t stream) {
    static int grid = 0;
    if (grid == 0) {
        if (n_in != 24 || in_sizes[0] != M * D || out_size != M * D || ws_size < WS_END) { fprintf(stderr, "kernel_launch: unexpected shapes (n_in %d, in0 %d, out %d, ws %zu)\n", n_in, n_in > 0 ? in_sizes[0] : -1, out_size, ws_size); grid = -1; return; }
        int dev = 0, cus = 0;
        if (hipGetDevice(&dev) != hipSuccess || hipDeviceGetAttribute(&cus, hipDeviceAttributeMultiprocessorCount, dev) != hipSuccess) { grid = -1; return; }
        if (hipFuncSetAttribute((const void*)mk_fwd, hipFuncAttributeMaxDynamicSharedMemorySize, LDS_BYTES) != hipSuccess) { fprintf(stderr, "kernel_launch: hipFuncSetAttribute failed\n"); grid = -1; return; }
        if (cus != NBLOCKS) fprintf(stderr, "kernel_launch: device reports %d CUs; this kernel launches %d workgroups (one per CU of a 256-CU device)\n", cus, NBLOCKS);
        grid = NBLOCKS;
    }
    if (grid < 0) return;
    (void)hipMemsetAsync((char*)d_ws + WS_CTL + CW_BAR * 4, 0, 16384, stream);
    Args a{};
    for (int i = 0; i < 24; ++i) a.in[i] = (const float*)d_in[i];
    a.out = (float*)d_out; a.ws = (unsigned char*)d_ws;
#if defined(MK_PER_PHASE)
    for (int ph = 0; ph < NPHASE; ++ph) { a.ph_lo = ph; a.ph_hi = ph + 1; hipLaunchKernelGGL(mk_fwd, dim3(grid), dim3(NTHREADS), LDS_BYTES, stream, a); }
#else
    a.ph_lo = 0; a.ph_hi = NPHASE; hipLaunchKernelGGL(mk_fwd, dim3(grid), dim3(NTHREADS), LDS_BYTES, stream, a);
#endif
}
```

```cpp
#include <hip/hip_runtime.h>
#include <cstdio>
#include <cstdint>

#define LAS __attribute__((address_space(3)))
#define GAS __attribute__((address_space(1)))
typedef unsigned short bf16;
typedef float f32x4 __attribute__((ext_vector_type(4)));
typedef unsigned u32x4 __attribute__((ext_vector_type(4)));
typedef unsigned u32x2 __attribute__((ext_vector_type(2)));
typedef int i32x4g __attribute__((ext_vector_type(4)));

constexpr int BATCH = 2, SEQ = 8192, M = BATCH * SEQ, D = 1024;
constexpr int IN_COLS = 2064, NZ = 2048;
constexpr int ZQ = 512, ZK = 768, ZV = 1024, ZR = 1536, GLR_COL0 = 1536;
constexpr int NE = 32, TOPK = 4, DFF = 1024, MEMLEN = 256;
constexpr int NASSIGN = M * TOPK, MAXSLOT = NASSIGN + NE * 256, MAXMT = MAXSLOT / 256;
constexpr int NCHUNK = SEQ / 64;
constexpr float EPS = 1e-6f;
constexpr int NTHREADS = 512, NWAVES = 8, NBLOCKS = 256;

constexpr size_t MiB = 1u << 20;
constexpr size_t WS_CTL = 0, CTL_BYTES = 1 * MiB;
constexpr size_t WS_WT_OUT = 2 * MiB, WS_WT_XQ = 4 * MiB, WS_WT_XK = 6 * MiB, WS_WT_XV = 8 * MiB, WS_WT_XO = 10 * MiB, WS_WT_IN = 12 * MiB;
constexpr size_t WS_GLR = 16 * MiB, WS_SMALL = 17 * MiB, WS_RSQP = 19 * MiB;
constexpr size_t WS_RS2 = WS_SMALL, WS_TOPI = WS_SMALL + 64 * 1024, WS_TOPG = WS_TOPI + 256 * 1024, WS_SLOTOF = WS_TOPG + 256 * 1024,
                 WS_GSLOT = WS_SLOTOF + 256 * 1024, WS_TILEE = WS_GSLOT + 320 * 1024, WS_BLKCNT = WS_TILEE + 4096, WS_WAVEBASE = WS_BLKCNT + 32768;
constexpr size_t WS_WT_GU = 20 * MiB, WS_WT_DN = 148 * MiB, WS_X2 = 212 * MiB, WS_B = 276 * MiB;
constexpr size_t WS_XN = WS_B, WS_HM = WS_B + 32 * MiB, WS_Z1 = WS_B + 33 * MiB, WS_MIX = WS_B + 121 * MiB, WS_SPREV = WS_B + 153 * MiB,
                 WS_DS = WS_B + 185 * MiB, WS_DEC = WS_B + 217 * MiB, WS_X1 = WS_B + 218 * MiB, WS_A2 = WS_B + 282 * MiB, WS_KX = WS_B + 314 * MiB, WS_VXT = WS_B + 315 * MiB;
constexpr size_t WS_QX = WS_Z1, WS_PX = WS_Z1 + 32 * MiB, WS_SC = WS_MIX, WS_OX = WS_DS;
constexpr size_t WS_X8 = WS_B, WS_TOKSLOT = WS_SMALL + 1536 * 1024;
constexpr size_t WS_XS = WS_B, WS_H = WS_B + 144 * MiB, WS_Y = WS_B + 288 * MiB, WS_END = WS_B + 432 * MiB;
constexpr int CW_BAR = 4096, CW_COUNT = 8192, CW_CURSOR = 8256, CW_ROWSQ1 = 16384;

__device__ __forceinline__ float bf_lo(unsigned w) { return __uint_as_float(w << 16); }
__device__ __forceinline__ float bf_hi(unsigned w) { return __uint_as_float(w & 0xffff0000u); }
__device__ __forceinline__ float bf2f(bf16 v) { return __uint_as_float((unsigned)v << 16); }
__device__ __forceinline__ unsigned f2bf(float f) { unsigned u = __float_as_uint(f); return (u + 0x7fffu + ((u >> 16) & 1u)) >> 16; }
typedef float f32x2_t __attribute__((ext_vector_type(2)));
typedef __bf16 bf16x2_t __attribute__((ext_vector_type(2)));
__device__ __forceinline__ unsigned pk2(float lo, float hi) { const f32x2_t v = {lo, hi}; return __builtin_bit_cast(unsigned, __builtin_convertvector(v, bf16x2_t)); }
__device__ __forceinline__ int otid() { int t = threadIdx.x; asm volatile("" : "+v"(t)); return t; }
__device__ __forceinline__ float wave_sum(float v) {
#pragma unroll
    for (int o = 1; o < 64; o <<= 1) v += __shfl_xor(v, o);
    return v;
}
__device__ __forceinline__ float clamp8(float v) { return fminf(fmaxf(v, -448.f), 448.f); }
__device__ __forceinline__ unsigned pk4_fp8(float a, float b, float c, float d) { int w = __builtin_amdgcn_cvt_pk_fp8_f32(clamp8(a), clamp8(b), 0, false); w = __builtin_amdgcn_cvt_pk_fp8_f32(clamp8(c), clamp8(d), w, true); return (unsigned)w; }
__device__ __forceinline__ unsigned pk4_fp8_nc(float a, float b, float c, float d) { int w = __builtin_amdgcn_cvt_pk_fp8_f32(a, b, 0, false); w = __builtin_amdgcn_cvt_pk_fp8_f32(c, d, w, true); return (unsigned)w; }
constexpr float W8_SCALE = 32.f, W8_INV = 1.f / 32.f, Y8_SCALE = 32.f, Y8_INV = 1.f / 32.f;
constexpr float SWI_C = 1.702f * 1.44269504089f, W8_GATE = -SWI_C * 32.f;
#ifndef MOE_FP8
#define MOE_FP8 1
#endif
__device__ __forceinline__ float logsigmoid(float x) { return fminf(x, 0.f) - log1pf(expf(-fabsf(x))); }

struct P {
    const float *x, *mem, *g_mix, *w_in, *w_pool, *pool_scale, *w_gate_up, *b_gate_up, *gla_g, *w_out, *g_xattn, *g_mem, *w_xq, *w_xk, *w_xv, *w_xo,
                *g_moe, *w_router, *b_router, *w_gu, *b_gu, *w_dn, *b_dn, *g_final;
    float* out; unsigned char* ws;
#define PACC(type, name, off) __device__ __forceinline__ type* name() const { return (type*)(ws + (off)); }
    PACC(unsigned, ctl, WS_CTL) PACC(float, glr, WS_GLR) PACC(float, rsqp, WS_RSQP)
    PACC(bf16, wt_in, WS_WT_IN) PACC(bf16, wt_out, WS_WT_OUT) PACC(bf16, wt_xq, WS_WT_XQ) PACC(bf16, wt_xk, WS_WT_XK) PACC(bf16, wt_xv, WS_WT_XV) PACC(bf16, wt_xo, WS_WT_XO) PACC(bf16, wt_gu, WS_WT_GU) PACC(bf16, wt_dn, WS_WT_DN)
    PACC(bf16, xn, WS_XN) PACC(bf16, hm, WS_HM) PACC(bf16, z1, WS_Z1) PACC(bf16, mix, WS_MIX) PACC(bf16, a2, WS_A2) PACC(bf16, kx, WS_KX) PACC(bf16, vxt, WS_VXT)
    PACC(bf16, qx, WS_QX) PACC(bf16, px, WS_PX) PACC(bf16, ox, WS_OX) PACC(bf16, xs, WS_XS) PACC(bf16, h, WS_H) PACC(bf16, y, WS_Y)
    PACC(float, sprev, WS_SPREV) PACC(float, ds, WS_DS) PACC(float, dec, WS_DEC) PACC(bf16, x1, WS_X1) PACC(bf16, x2, WS_X2) PACC(float, sc, WS_SC)
    PACC(float, rs2, WS_RS2) PACC(float, topg, WS_TOPG) PACC(float, gslot, WS_GSLOT) PACC(int, topi, WS_TOPI) PACC(int, slotof, WS_SLOTOF) PACC(int, tilee, WS_TILEE)
#undef PACC
};

struct MapId { __device__ __forceinline__ int operator()(int n) const { return n; } };
struct MapIn { __device__ __forceinline__ int operator()(int n) const { return n < 1536 ? n : 1552 + (n - 1536); } };
struct MapGu { __device__ __forceinline__ int operator()(int n) const { const int pn = n >> 8, w = n & 255; return w < 128 ? pn * 128 + w : 1024 + pn * 128 + (w - 128); } };

template <class Map>
__device__ __forceinline__ void transpose_item(const float* W, int ldw, int K, bf16* WT, float* scr, int kb, int nb, int lane, Map map, const float* kscale = nullptr) {
    const int k0 = 64 * kb, n0 = 32 * nb;
    const int sc = map(n0 + (lane & 31));
#pragma unroll
    for (int i = 0; i < 32; ++i) { const int kk = 2 * i + (lane >> 5); scr[kk * 33 + (lane & 31)] = sc >= 0 ? W[(size_t)(k0 + kk) * ldw + sc] * (kscale ? kscale[k0 + kk] : 1.f) : 0.f; }
    __builtin_amdgcn_s_waitcnt(0xC07F); asm volatile("" ::: "memory");
    const int c = lane & 7;
#pragma unroll
    for (int j = 0; j < 4; ++j) { const int n = (lane >> 3) + 8 * j; const float* s = scr + (8 * c) * 33 + n;
        u32x4 o; o.x = pk2(s[0 * 33], s[1 * 33]); o.y = pk2(s[2 * 33], s[3 * 33]); o.z = pk2(s[4 * 33], s[5 * 33]); o.w = pk2(s[6 * 33], s[7 * 33]);
        *(u32x4*)(WT + (size_t)(n0 + n) * K + k0 + 8 * c) = o; }
    __builtin_amdgcn_s_waitcnt(0xC07F); asm volatile("" ::: "memory");
}
constexpr int CONV_CHUNKS = NE * (16 * 8 + 16 * 4) * 4;
static_assert(CONV_CHUNKS == NBLOCKS * 96, "one chunk per wave and per pool / GLA unit iteration");
struct ConvChunk { const float* src; unsigned char* dst; int ldw, K; float scale; };
__device__ __forceinline__ ConvChunk conv_chunk_decode(const P& p, int c, int lane) {
    constexpr int I_GU = 16 * 8, I_DN = 16 * 4; const int item = c >> 2, sub = c & 3; ConvChunk cc;
    if (item < NE * I_GU) { const int e = item / I_GU, q = item % I_GU, kb = q >> 3, nb = q & 7, k0 = 64 * kb + 16 * sub, n0 = 256 * nb + 4 * lane; const int up = n0 >> 10, ff = n0 & 1023;
        cc.ldw = 2 * DFF; cc.K = D; cc.scale = up ? W8_SCALE : W8_GATE; cc.src = p.w_gu + (size_t)e * D * 2 * DFF + (size_t)k0 * (2 * DFF) + n0;
        cc.dst = (unsigned char*)p.wt_gu() + (size_t)e * 2 * DFF * D + (size_t)((ff >> 7) * 256 + up * 128 + (ff & 127)) * D + k0; }
    else { const int r = item - NE * I_GU, e = r / I_DN, q = r % I_DN, kb = q >> 2, nb = q & 3, k0 = 64 * kb + 16 * sub, n0 = 256 * nb + 4 * lane;
        cc.ldw = D; cc.K = DFF; cc.scale = W8_SCALE; cc.src = p.w_dn + (size_t)e * DFF * D + (size_t)k0 * D + n0;
        cc.dst = (unsigned char*)p.wt_dn() + (size_t)e * D * DFF + (size_t)n0 * DFF + k0; }
    return cc;
}
__device__ __forceinline__ void conv_chunk_load(const ConvChunk& cc, f32x4 (&v)[16]) {
#pragma unroll
    for (int i = 0; i < 16; ++i) v[i] = __builtin_nontemporal_load((const f32x4*)(cc.src + (size_t)i * cc.ldw));
}
__device__ __forceinline__ void conv_chunk_store(const ConvChunk& cc, const f32x4 (&v)[16]) {
    const float sc = cc.scale;
#pragma unroll
    for (int j = 0; j < 4; ++j) { u32x4 o;
        o.x = pk4_fp8(v[0][j] * sc, v[1][j] * sc, v[2][j] * sc, v[3][j] * sc); o.y = pk4_fp8(v[4][j] * sc, v[5][j] * sc, v[6][j] * sc, v[7][j] * sc);
        o.z = pk4_fp8(v[8][j] * sc, v[9][j] * sc, v[10][j] * sc, v[11][j] * sc); o.w = pk4_fp8(v[12][j] * sc, v[13][j] * sc, v[14][j] * sc, v[15][j] * sc);
        *(u32x4*)(cc.dst + (size_t)j * cc.K) = o; }
}
template <int NR>
__device__ __forceinline__ void rms_rows_bf16(const float* xrow, const float* g, bf16* orow, size_t rstride, int lane) {
    f32x4 v[NR][4]; float s[NR];
#pragma unroll
    for (int r = 0; r < NR; ++r)
#pragma unroll
        for (int j = 0; j < 4; ++j) v[r][j] = *((const f32x4*)(xrow + r * rstride) + lane + 64 * j);
#pragma unroll
    for (int r = 0; r < NR; ++r) { s[r] = 0.f;
#pragma unroll
        for (int j = 0; j < 4; ++j) s[r] += (v[r][j].x * v[r][j].x + v[r][j].y * v[r][j].y) + (v[r][j].z * v[r][j].z + v[r][j].w * v[r][j].w); }
#pragma unroll
    for (int o = 1; o < 64; o <<= 1)
#pragma unroll
        for (int r = 0; r < NR; ++r) s[r] += __shfl_xor(s[r], o);
    const f32x4* gr = (const f32x4*)g + lane;
#pragma unroll
    for (int r = 0; r < NR; ++r) { const float rs = 1.0f / sqrtf(s[r] * (1.f / D) + EPS); u32x2* o8 = (u32x2*)(orow + r * rstride) + lane;
#pragma unroll
        for (int j = 0; j < 4; ++j) { const f32x4 gg = gr[64 * j]; u32x2 w; w.x = pk2(v[r][j].x * rs * gg.x, v[r][j].y * rs * gg.y); w.y = pk2(v[r][j].z * rs * gg.z, v[r][j].w * rs * gg.w); o8[64 * j] = w; } }
}
__device__ __forceinline__ void rms_rows4_glr(const float* xrow, const float* g, bf16* orow, float* glr_out, const float* wgt, int lane) {
    f32x4 v[4][4]; float s[4];
#pragma unroll
    for (int r = 0; r < 4; ++r)
#pragma unroll
        for (int j = 0; j < 4; ++j) v[r][j] = *((const f32x4*)(xrow + r * D) + lane + 64 * j);
#pragma unroll
    for (int r = 0; r < 4; ++r) { s[r] = 0.f;
#pragma unroll
        for (int j = 0; j < 4; ++j) s[r] += (v[r][j].x * v[r][j].x + v[r][j].y * v[r][j].y) + (v[r][j].z * v[r][j].z + v[r][j].w * v[r][j].w); }
#pragma unroll
    for (int o = 1; o < 64; o <<= 1)
#pragma unroll
        for (int r = 0; r < 4; ++r) s[r] += __shfl_xor(s[r], o);
    float acc[64];
#pragma unroll
    for (int i = 0; i < 64; ++i) acc[i] = 0.f;
    const f32x4* gr = (const f32x4*)g + lane;
#pragma unroll
    for (int j = 0; j < 4; ++j) { const f32x4 gg = gr[64 * j]; f32x4 xn[4];
#pragma unroll
        for (int r = 0; r < 4; ++r) { const float rs = 1.0f / sqrtf(s[r] * (1.f / D) + EPS); xn[r] = v[r][j] * rs * gg;
            u32x2 w; w.x = pk2(xn[r].x, xn[r].y); w.y = pk2(xn[r].z, xn[r].w); *((u32x2*)(orow + r * D) + lane + 64 * j) = w; }
#pragma unroll
        for (int i = 0; i < 4; ++i) { const int kp = i * 256 + lane + 64 * j, sw = (kp >> 2) & 3; const float* wr = wgt + kp * 16;
#pragma unroll
            for (int c4 = 0; c4 < 4; ++c4) { const f32x4 w = *(const f32x4*)(wr + ((c4 ^ sw) << 2));
#pragma unroll
                for (int r = 0; r < 4; ++r) { const float x = xn[r][i]; acc[r * 16 + c4 * 4 + 0] += x * w.x; acc[r * 16 + c4 * 4 + 1] += x * w.y; acc[r * 16 + c4 * 4 + 2] += x * w.z; acc[r * 16 + c4 * 4 + 3] += x * w.w; } }
            __builtin_amdgcn_sched_barrier(0); } }
#pragma unroll
    for (int k = 0; k < 32; ++k) { const bool up = (lane & 32) != 0; const float send = up ? acc[k] : acc[k + 32]; const float keep = up ? acc[k + 32] : acc[k]; acc[k] = keep + __shfl_xor(send, 32); }
#pragma unroll
    for (int k = 0; k < 16; ++k) { const bool up = (lane & 16) != 0; const float send = up ? acc[k] : acc[k + 16]; const float keep = up ? acc[k + 16] : acc[k]; acc[k] = keep + __shfl_xor(send, 16); }
#pragma unroll
    for (int k = 0; k < 8; ++k) { const bool up = (lane & 8) != 0; const float send = up ? acc[k] : acc[k + 8]; const float keep = up ? acc[k + 8] : acc[k]; acc[k] = keep + __shfl_xor(send, 8); }
#pragma unroll
    for (int k = 0; k < 4; ++k) { const bool up = (lane & 4) != 0; const float send = up ? acc[k] : acc[k + 4]; const float keep = up ? acc[k + 4] : acc[k]; acc[k] = keep + __shfl_xor(send, 4); }
#pragma unroll
    for (int k = 0; k < 2; ++k) { const bool up = (lane & 2) != 0; const float send = up ? acc[k] : acc[k + 2]; const float keep = up ? acc[k + 2] : acc[k]; acc[k] = keep + __shfl_xor(send, 2); }
    { const bool up = (lane & 1) != 0; const float send = up ? acc[0] : acc[1]; const float keep = up ? acc[1] : acc[0]; acc[0] = keep + __shfl_xor(send, 1); }
    glr_out[lane] = acc[0];
}
#ifndef PROBE_PRO
#define PROBE_PRO 0
#endif
__device__ __forceinline__ void phase_prologue(const P& p, float* ldsf, int bid, int nb) {
    const int tid = otid(), lane = tid & 63, wave = tid >> 6;
    float* scr = ldsf + wave * (128 * 33);
    const int gw = bid * NWAVES + wave, NGW = nb * NWAVES;
    constexpr int I_IN = 16 * (NZ / 32), I_SQ = 16 * 32, I_GU = MOE_FP8 ? 16 * 8 : 16 * 64, I_DN = MOE_FP8 ? 16 * 4 : 16 * 32;
    for (int rep = 0; rep < ((PROBE_PRO & 1) ? 2 : 1); ++rep)
    for (int it = gw; it < I_IN + 5 * I_SQ; it += NGW) {
        int r = it;
        if (r < I_IN) { transpose_item(p.w_in, IN_COLS, D, p.wt_in(), scr, r / (NZ / 32), r % (NZ / 32), lane, MapIn()); continue; } r -= I_IN;
        { const int w = r / I_SQ, q = r % I_SQ; const float* src = w == 0 ? p.w_out : w == 1 ? p.w_xq : w == 2 ? p.w_xk : w == 3 ? p.w_xv : p.w_xo;
            bf16* dst = w == 0 ? p.wt_out() : w == 1 ? p.wt_xq() : w == 2 ? p.wt_xk() : w == 3 ? p.wt_xv() : p.wt_xo();
            transpose_item(src, D, D, dst, scr, q / 32, q % 32, lane, MapId(), w == 1 ? p.g_xattn : nullptr); }
    }
    for (int rep = 0; rep < ((PROBE_PRO & 4) ? 2 : 1); ++rep) {
    __syncthreads();
    { f32x4 tv[8];
#pragma unroll
      for (int q = 0; q < 8; ++q) { const int i = tid + NTHREADS * q, k = i >> 2, c4 = i & 3; tv[q] = *(const f32x4*)(p.w_in + (size_t)k * IN_COLS + GLR_COL0 + 4 * c4); }
#pragma unroll
      for (int q = 0; q < 8; ++q) { const int i = tid + NTHREADS * q, k = i >> 2, c4 = i & 3, kp = (k & 3) * 256 + (k >> 2); *(f32x4*)(ldsf + kp * 16 + ((c4 ^ ((kp >> 2) & 3)) << 2)) = tv[q]; } }
    __syncthreads();
    for (int m = gw * 4; m < M; m += NGW * 4) rms_rows4_glr(p.x + (size_t)m * D, p.g_mix, p.xn() + (size_t)m * D, p.glr() + (size_t)m * 16, ldsf, lane);
    for (int m = gw; m < BATCH * MEMLEN; m += NGW) rms_rows_bf16<1>(p.mem + (size_t)m * D, p.g_mem, p.hm() + (size_t)m * D, D, lane);
    }
}

__device__ __forceinline__ float swiglu(float g, float u) { g = fminf(g, 7.f); u = fminf(fmaxf(u, -7.f), 7.f);
    return g * __builtin_amdgcn_rcpf(1.f + __builtin_amdgcn_exp2f(-1.702f * 1.44269504089f * g)) * (u + 1.f); }

__device__ __forceinline__ void phase_final(const P& p, int bid, int nb) {
    const int tid = otid(), lane = tid & 63, gw = bid * NWAVES + (tid >> 6), NGW = nb * NWAVES;
    for (int t = gw * 2; t < M; t += NGW * 2) {
        f32x4 v[2][4]; unsigned yv[2][4][4];
#pragma unroll
        for (int q = 0; q < 2; ++q) { const u32x2* xr = (const u32x2*)(p.x2() + (size_t)(t + q) * D) + lane;
#pragma unroll
            for (int j = 0; j < 4; ++j) { const u32x2 w = xr[64 * j]; v[q][j] = (f32x4){bf_lo(w.x), bf_hi(w.x), bf_lo(w.y), bf_hi(w.y)}; }
#pragma unroll
            for (int k = 0; k < 4; ++k) { const int sl = p.slotof()[(t + q) * 4 + k]; const unsigned* yr = (const unsigned*)((const unsigned char*)p.y() + (size_t)sl * D) + lane;
#pragma unroll
                for (int j = 0; j < 4; ++j) yv[q][k][j] = yr[64 * j]; } }
#pragma unroll
        for (int q = 0; q < 2; ++q) {
#pragma unroll
            for (int k = 0; k < 4; ++k)
#pragma unroll
                for (int j = 0; j < 4; ++j) { const int w = (int)yv[q][k][j]; const f32x2_t lo = __builtin_amdgcn_cvt_pk_f32_fp8(w, false), hi = __builtin_amdgcn_cvt_pk_f32_fp8(w, true);
                    v[q][j].x += lo.x * Y8_INV; v[q][j].y += lo.y * Y8_INV; v[q][j].z += hi.x * Y8_INV; v[q][j].w += hi.y * Y8_INV; }
            float s = 0.f;
#pragma unroll
            for (int j = 0; j < 4; ++j) s += (v[q][j].x * v[q][j].x + v[q][j].y * v[q][j].y) + (v[q][j].z * v[q][j].z + v[q][j].w * v[q][j].w);
            const float rs = 1.0f / sqrtf(wave_sum(s) * (1.f / D) + EPS);
            f32x4* o = (f32x4*)(p.out + (size_t)(t + q) * D) + lane;
#pragma unroll
            for (int j = 0; j < 4; ++j) { const f32x4 gg = *((const f32x4*)p.g_final + lane + 64 * j); o[64 * j] = v[q][j] * rs * gg; }
        }
    }
}

typedef short bf16x8 __attribute__((ext_vector_type(8)));
typedef float f32x16 __attribute__((ext_vector_type(16)));
template <int K>
__device__ __forceinline__ void mma_tile(f32x16& acc, const bf16* a, int pa, const bf16* b, int pb, int lane) {
    const int r = lane & 31, hf = lane >> 5;
#pragma unroll
    for (int k0 = 0; k0 < K; k0 += 16) { const bf16x8 av = *(const bf16x8*)(a + r * pa + k0 + 8 * hf); const bf16x8 bv = *(const bf16x8*)(b + r * pb + k0 + 8 * hf);
        acc = __builtin_amdgcn_mfma_f32_32x32x16_bf16(av, bv, acc, 0, 0, 0); }
}
__device__ __forceinline__ int crow(int reg, int hf) { return (reg & 3) + 8 * (reg >> 2) + 4 * hf; }
__device__ __forceinline__ f32x16 zero16() { f32x16 z;
#pragma unroll
    for (int i = 0; i < 16; ++i) z[i] = 0.f;
    return z; }
__device__ __forceinline__ float fast_logsigmoid(float x) { return fminf(x, 0.f) - 0.69314718056f * __builtin_amdgcn_logf(1.f + __expf(-fabsf(x))); }
__device__ __forceinline__ float frcp(float x) { return __builtin_amdgcn_rcpf(x); }
__device__ __forceinline__ float frsq(float x) { return __builtin_amdgcn_rsqf(x); }

__device__ __forceinline__ void phase_pool2(const P& p, unsigned char* lds, int bid, int nb) {
    bf16* wpT = (bf16*)lds;
    float* ut = (float*)(lds + 34816);
    bf16* pt = (bf16*)(lds + 34816 + 40960);
    const int tid = otid(), lane = tid & 63, w = tid >> 6;
    int cur_g = -1;
    u32x4 zv[3];
#define POOL_ZLOAD(uu) do { const int _g = (uu) & 3, _t0 = ((uu) >> 2) * 64, _s0 = _t0 & (SEQ - 1); _Pragma("unroll") for (int q = 0; q < 3; ++q) { const int c = tid + NTHREADS * q, r = c >> 4, ch = (c & 15) * 8; \
        zv[q] = (u32x4){0u, 0u, 0u, 0u}; if (c < 80 * 16 && _s0 - 16 + r >= 0) zv[q] = *(const u32x4*)(p.z1() + (size_t)(_t0 - 16 + r) * NZ + _g * 128 + ch); } } while (0)
    if (bid < (M / 64) * 4) POOL_ZLOAD(bid);
    for (int u = bid, it = 0; u < (M / 64) * 4; u += nb, ++it) {
        const int g = u & 3, t0 = (u >> 2) * 64, win = 2 << g, s0 = t0 & (SEQ - 1);
        const ConvChunk cc = conv_chunk_decode(p, bid * 96 + it * 8 + w, lane); f32x4 cv[16]; conv_chunk_load(cc, cv);
        __syncthreads();
        if (g != cur_g) { cur_g = g;
            f32x4 wv[8];
#pragma unroll
            for (int k = 0; k < 8; ++k) wv[k] = *((const f32x4*)(p.w_pool + (size_t)g * 16384) + tid + NTHREADS * k);
#pragma unroll
            for (int k = 0; k < 8; ++k) { const int i = 4 * (tid + NTHREADS * k), c = i >> 7, d = i & 127;
                wpT[d * 136 + c] = (bf16)f2bf(wv[k].x); wpT[(d + 1) * 136 + c] = (bf16)f2bf(wv[k].y); wpT[(d + 2) * 136 + c] = (bf16)f2bf(wv[k].z); wpT[(d + 3) * 136 + c] = (bf16)f2bf(wv[k].w); } }
#pragma unroll
        for (int q = 0; q < 3; ++q) { const int c = tid + NTHREADS * q, r = c >> 4, ch = (c & 15) * 8; const u32x4 v = zv[q];
            if (c < 80 * 16) { *(f32x4*)(ut + r * 128 + ch) = (f32x4){bf_lo(v.x), bf_hi(v.x), bf_lo(v.y), bf_hi(v.y)}; *(f32x4*)(ut + r * 128 + ch + 4) = (f32x4){bf_lo(v.z), bf_hi(v.z), bf_lo(v.w), bf_hi(v.w)}; } }
        if (u + nb < (M / 64) * 4) POOL_ZLOAD(u + nb);
        __syncthreads();
        { const int c = tid & 127, q = tid >> 7, i0 = 16 * q; float sum = 0.f;
          for (int d = 1; d < win; ++d) sum += ut[(16 + i0 - d) * 128 + c];
          for (int ii = 0; ii < 16; ++ii) { const int i = i0 + ii, s = s0 + i; const float uv = ut[(16 + i) * 128 + c]; sum += uv; const int cnt = (s + 1 < win) ? s + 1 : win;
              pt[i * 136 + c] = (bf16)f2bf(sum * frcp((float)cnt) - uv); sum -= ut[(16 + i - win + 1) * 128 + c]; } }
        __syncthreads();
        { const int db = w >> 1, ib = w & 1, r = lane & 31, hf = lane >> 5; f32x16 acc = zero16();
          mma_tile<128>(acc, wpT + (db * 32) * 136, 136, pt + (ib * 32) * 136, 136, lane);
          bf16* orow = p.mix() + (size_t)(t0 + ib * 32 + r) * D + g * 128 + db * 32;
#pragma unroll
          for (int rg = 0; rg < 4; ++rg) { const int d0 = 8 * rg + 4 * hf; const f32x4 sc = *(const f32x4*)(p.pool_scale + g * 128 + db * 32 + d0);
              u32x2 o; o.x = pk2(acc[4 * rg] * sc.x, acc[4 * rg + 1] * sc.y); o.y = pk2(acc[4 * rg + 2] * sc.z, acc[4 * rg + 3] * sc.w); *(u32x2*)(orow + d0) = o; } }
        conv_chunk_store(cc, cv);
    }
#undef POOL_ZLOAD
}

template <int K, bool SWA, bool SWB>
__device__ __forceinline__ void mma_tile_sw(f32x16& acc, const bf16* a, int arow0, const bf16* b, int brow0, int lane) {
    const int r = lane & 31, hf = lane >> 5, ra = arow0 + r, rb = brow0 + r, fa = SWA ? ((ra >> 3) & 7) : 0, fb = SWB ? ((rb >> 3) & 7) : 0;
#pragma unroll
    for (int k0 = 0; k0 < K; k0 += 16) { const int c = (k0 >> 3) + hf;
        const bf16x8 av = *(const bf16x8*)(a + ra * 72 + ((c ^ fa) << 3)); const bf16x8 bv = *(const bf16x8*)(b + rb * 72 + ((c ^ fb) << 3));
        acc = __builtin_amdgcn_mfma_f32_32x32x16_bf16(av, bv, acc, 0, 0, 0); }
}
__device__ __forceinline__ void pair_write_T(bf16* T, const u32x4 x0, const u32x4 x1, int c0, int jp) {
    const int f = (c0 >> 3) & 7, col = (((jp >> 2) ^ f) << 3) + ((2 * jp) & 7);
    unsigned* base = (unsigned*)(T + c0 * 72 + col);
#pragma unroll
    for (int q = 0; q < 4; ++q) { const unsigned a = x0[q], b = x1[q];
        base[(2 * q) * 36] = (a & 0xffffu) | (b << 16); base[(2 * q + 1) * 36] = (a >> 16) | (b & 0xffff0000u); }
}
__device__ __forceinline__ void unpack8(const u32x4 w, float (&f)[8]) { f[0] = bf_lo(w.x); f[1] = bf_hi(w.x); f[2] = bf_lo(w.y); f[3] = bf_hi(w.y); f[4] = bf_lo(w.z); f[5] = bf_hi(w.z); f[6] = bf_lo(w.w); f[7] = bf_hi(w.w); }

struct GlaLoads { float g0, g1, wg[16], bias; u32x4 q, k, v0, v1, s0, s1, k0, k1; u32x2 rr[4]; };
template <bool ISB>
__device__ __forceinline__ void gla_load(const P& p, int u, int tid, GlaLoads& L) {
    const int bh = u / NCHUNK, n = u % NCHUNK, b = bh >> 2, h = bh & 3, t0 = b * SEQ + n * 64, lane = tid & 63, w = tid >> 6;
    L.g0 = p.glr()[(size_t)t0 * 16 + tid]; L.g1 = p.glr()[(size_t)t0 * 16 + 512 + tid];
#pragma unroll
    for (int r = 0; r < 16; ++r) L.wg[r] = p.w_gate_up[r * 256 + h * 64 + (tid & 63)];
    L.bias = p.b_gate_up[h * 64 + (tid & 63)];
    { const int jp = tid >> 4, c16 = tid & 15; const bf16* vp = p.z1() + (size_t)(t0 + 2 * jp) * NZ + ZV + h * 128 + 8 * c16; L.v0 = *(const u32x4*)vp; L.v1 = *(const u32x4*)(vp + NZ); }
    if (ISB) {
        { const int i = tid >> 3, c8 = tid & 7; const bf16* zp = p.z1() + (size_t)(t0 + i) * NZ + h * 64 + 8 * c8; L.q = *(const u32x4*)(zp + ZQ); L.k = *(const u32x4*)(zp + ZK); }
        { const bf16* sp = (const bf16*)p.sprev() + (size_t)u * 8192; L.s0 = *(const u32x4*)(sp + tid * 8); L.s1 = *(const u32x4*)(sp + (tid + 512) * 8); }
        { const int eb = w >> 1, ib = w & 1, i = ib * 32 + (lane & 31), hf = lane >> 5; const bf16* rp = p.z1() + (size_t)(t0 + i) * NZ + ZR + h * 128 + eb * 32 + 4 * hf;
#pragma unroll
          for (int rg = 0; rg < 4; ++rg) L.rr[rg] = *(const u32x2*)(rp + 8 * rg); }
    } else {
        const int jp = (tid >> 3) & 31, d8 = tid & 7; const bf16* kp = p.z1() + (size_t)(t0 + 2 * jp) * NZ + ZK + h * 64 + 8 * d8; L.k0 = *(const u32x4*)kp; L.k1 = *(const u32x4*)(kp + NZ);
    }
}
__device__ __forceinline__ void gla_gc3(const GlaLoads& L, const float* glr, float* wtot, float* gcs, int tid) {
    const int d = tid & 63, w = tid >> 6; float gcl[8]; float run = 0.f;
#pragma unroll
    for (int ii = 0; ii < 8; ++ii) { const float* gr = glr + (8 * w + ii) * 16; float s = L.bias;
#pragma unroll
        for (int r = 0; r < 16; ++r) s += gr[r] * L.wg[r];
        run += fast_logsigmoid(s) * (1.f / 16.f); gcl[ii] = run; }
    wtot[w * 64 + d] = run;
    __syncthreads();
    float pre = 0.f;
#pragma unroll
    for (int ww = 0; ww < 8; ++ww) { const float v = wtot[ww * 64 + d]; pre += (ww < w) ? v : 0.f; }
#pragma unroll
    for (int ii = 0; ii < 8; ++ii) gcs[(8 * w + ii) * 68 + d] = gcl[ii] + pre;
    __syncthreads();
}
__device__ __forceinline__ void phase_gla_a3(const P& p, unsigned char* lds, int bid, int nb) {
    float* glr = (float*)lds; float* wtot = (float*)(lds + 4096); float* gcs = (float*)(lds + 8192); bf16* kdT = (bf16*)(lds + 25600); bf16* vT = (bf16*)(lds + 34816);
    const int tid = otid(), lane = tid & 63, w = tid >> 6;
    GlaLoads cur, nxt;
    if (bid < 8 * NCHUNK) gla_load<false>(p, bid, tid, cur);
    for (int u = bid, it = 4; u < 8 * NCHUNK; u += nb, ++it) {
        const bool has = u + nb < 8 * NCHUNK;
        const ConvChunk cc = conv_chunk_decode(p, bid * 96 + it * 8 + w, lane); f32x4 cv[16]; conv_chunk_load(cc, cv);
        if (has) gla_load<false>(p, u + nb, tid, nxt);
        __syncthreads();
        glr[tid] = cur.g0; glr[tid + 512] = cur.g1;
        pair_write_T(vT, cur.v0, cur.v1, 8 * (tid & 15), tid >> 4);
        __syncthreads();
        gla_gc3(cur, glr, wtot, gcs, tid);
        if (tid < 64) p.dec()[(size_t)u * 64 + tid] = __expf(gcs[63 * 68 + tid]);
        if (tid < 256) { const int jp = tid >> 3, d8 = tid & 7; float k0[8], k1[8]; unpack8(cur.k0, k0); unpack8(cur.k1, k1);
            const f32x4 ta = *(const f32x4*)(gcs + 63 * 68 + 8 * d8), tb = *(const f32x4*)(gcs + 63 * 68 + 8 * d8 + 4);
            const f32x4 a0 = *(const f32x4*)(gcs + (2 * jp) * 68 + 8 * d8), b0 = *(const f32x4*)(gcs + (2 * jp) * 68 + 8 * d8 + 4), a1 = *(const f32x4*)(gcs + (2 * jp + 1) * 68 + 8 * d8), b1 = *(const f32x4*)(gcs + (2 * jp + 1) * 68 + 8 * d8 + 4);
            u32x4 x0, x1;
            x0.x = pk2(k0[0] * __expf(ta[0] - a0[0]), k0[1] * __expf(ta[1] - a0[1])); x0.y = pk2(k0[2] * __expf(ta[2] - a0[2]), k0[3] * __expf(ta[3] - a0[3]));
            x0.z = pk2(k0[4] * __expf(tb[0] - b0[0]), k0[5] * __expf(tb[1] - b0[1])); x0.w = pk2(k0[6] * __expf(tb[2] - b0[2]), k0[7] * __expf(tb[3] - b0[3]));
            x1.x = pk2(k1[0] * __expf(ta[0] - a1[0]), k1[1] * __expf(ta[1] - a1[1])); x1.y = pk2(k1[2] * __expf(ta[2] - a1[2]), k1[3] * __expf(ta[3] - a1[3]));
            x1.z = pk2(k1[4] * __expf(tb[0] - b1[0]), k1[5] * __expf(tb[1] - b1[1])); x1.w = pk2(k1[6] * __expf(tb[2] - b1[2]), k1[7] * __expf(tb[3] - b1[3]));
            pair_write_T(kdT, x0, x1, 8 * d8, jp); }
        __syncthreads();
        { const int eb = w >> 1, db = w & 1, r = lane & 31, hf = lane >> 5; f32x16 acc = zero16();
          mma_tile_sw<64, true, true>(acc, vT, eb * 32, kdT, db * 32, lane);
          bf16* o = (bf16*)p.ds() + (size_t)u * 8192 + db * 32 + r;
#pragma unroll
          for (int reg = 0; reg < 16; ++reg) o[(eb * 32 + crow(reg, hf)) * 64] = (bf16)f2bf(acc[reg]); }
        conv_chunk_store(cc, cv);
        if (has) cur = nxt;
    }
}
__device__ __forceinline__ void phase_gla_b3(const P& p, unsigned char* lds, int bid, int nb) {
    float* glr = (float*)lds; float* wtot = (float*)(lds + 4096); float* ssq = (float*)(lds + 6144); float* gcs = (float*)(lds + 8192);
    bf16* qe = (bf16*)(lds + 25600); bf16* ke = qe + 64 * 72; bf16* att = ke + 64 * 72; bf16* vT = att + 64 * 72; bf16* spT = vT + 128 * 72;
    const int tid = otid(), lane = tid & 63, w = tid >> 6, r = lane & 31, hf = lane >> 5;
    GlaLoads cur, nxt;
    if (bid < 8 * NCHUNK) gla_load<true>(p, bid, tid, cur);
    for (int u = bid, it = 8; u < 8 * NCHUNK; u += nb, ++it) {
        const int bh = u / NCHUNK, n = u % NCHUNK, b = bh >> 2, h = bh & 3, t0 = b * SEQ + n * 64;
        const bool has = u + nb < 8 * NCHUNK;
        const ConvChunk cc = conv_chunk_decode(p, bid * 96 + it * 8 + w, lane); f32x4 cv[16]; conv_chunk_load(cc, cv);
        if (has) gla_load<true>(p, u + nb, tid, nxt);
        __syncthreads();
        glr[tid] = cur.g0; glr[tid + 512] = cur.g1;
        pair_write_T(vT, cur.v0, cur.v1, 8 * (tid & 15), tid >> 4);
        *(u32x4*)(spT + (tid >> 3) * 72 + (tid & 7) * 8) = cur.s0; *(u32x4*)(spT + ((tid + 512) >> 3) * 72 + (tid & 7) * 8) = cur.s1;
        __syncthreads();
        gla_gc3(cur, glr, wtot, gcs, tid);
        { const int i = tid >> 3, c8 = tid & 7; float q[8], k[8]; unpack8(cur.q, q); unpack8(cur.k, k);
          const f32x4 ga = *(const f32x4*)(gcs + i * 68 + 8 * c8), gb = *(const f32x4*)(gcs + i * 68 + 8 * c8 + 4); float e[8];
#pragma unroll
          for (int t = 0; t < 4; ++t) { e[t] = __expf(ga[t]); e[4 + t] = __expf(gb[t]); }
          u32x4 xq, xk;
          xq.x = pk2(q[0] * 0.125f * e[0], q[1] * 0.125f * e[1]); xq.y = pk2(q[2] * 0.125f * e[2], q[3] * 0.125f * e[3]); xq.z = pk2(q[4] * 0.125f * e[4], q[5] * 0.125f * e[5]); xq.w = pk2(q[6] * 0.125f * e[6], q[7] * 0.125f * e[7]);
          float ri[8];
#pragma unroll
          for (int t = 0; t < 8; ++t) ri[t] = frcp(e[t]);
          xk.x = pk2(k[0] * ri[0], k[1] * ri[1]); xk.y = pk2(k[2] * ri[2], k[3] * ri[3]); xk.z = pk2(k[4] * ri[4], k[5] * ri[5]); xk.w = pk2(k[6] * ri[6], k[7] * ri[7]);
          *(u32x4*)(qe + i * 72 + 8 * c8) = xq; *(u32x4*)(ke + i * 72 + 8 * c8) = xk; }
        __syncthreads();
        if (w < 4) { const int ib = w & 1, jb = w >> 1; f32x16 acc = zero16();
            if (jb <= ib) mma_tile_sw<64, false, false>(acc, qe, ib * 32, ke, jb * 32, lane);
#pragma unroll
            for (int reg = 0; reg < 16; ++reg) { const int i = ib * 32 + crow(reg, hf), j = jb * 32 + r; att[i * 72 + j] = (bf16)f2bf(j <= i ? acc[reg] : 0.f); } }
        __syncthreads();
        { const int eb = w >> 1, ib = w & 1, i = ib * 32 + r; f32x16 acc = zero16();
          mma_tile_sw<64, true, false>(acc, vT, eb * 32, att, ib * 32, lane);
          mma_tile_sw<64, false, false>(acc, spT, eb * 32, qe, ib * 32, lane);
          float ss = 0.f;
#pragma unroll
          for (int reg = 0; reg < 16; ++reg) ss += acc[reg] * acc[reg];
          ss += __shfl_xor(ss, 32);
          if (hf == 0) ssq[eb * 64 + i] = ss;
          __syncthreads();
          const float rs = frsq((ssq[i] + ssq[64 + i] + ssq[128 + i] + ssq[192 + i]) * (1.f / 128.f) + EPS);
          bf16* op = p.mix() + (size_t)(t0 + i) * D + 512 + h * 128 + eb * 32;
#pragma unroll
          for (int rg = 0; rg < 4; ++rg) { const int e0 = 8 * rg + 4 * hf; const u32x2 rv = cur.rr[rg]; const f32x4 gg = *(const f32x4*)(p.gla_g + eb * 32 + e0);
              const float r0 = bf_lo(rv.x), r1 = bf_hi(rv.x), r2 = bf_lo(rv.y), r3 = bf_hi(rv.y);
              const float o0 = acc[4 * rg] * rs * gg.x * (r0 * frcp(1.f + __expf(-r0))), o1 = acc[4 * rg + 1] * rs * gg.y * (r1 * frcp(1.f + __expf(-r1)));
              const float o2 = acc[4 * rg + 2] * rs * gg.z * (r2 * frcp(1.f + __expf(-r2))), o3 = acc[4 * rg + 3] * rs * gg.w * (r3 * frcp(1.f + __expf(-r3)));
              u32x2 o; o.x = pk2(o0, o1); o.y = pk2(o2, o3); *(u32x2*)(op + e0) = o; } }
        conv_chunk_store(cc, cv);
        if (has) cur = nxt;
    }
}
__device__ __forceinline__ void kv_tile(const P& p, int bid, int q, int lane) {
    const int job = bid >> 7, b7 = bid & 127, r = lane & 31, hf = lane >> 5;
    const int rb = job ? (b7 >> 3) : (b7 >> 4), cb = job ? (b7 & 7) : (b7 & 15), ld = job ? BATCH * MEMLEN : D;
    const bf16* A = job ? p.wt_xv() : p.hm(); const bf16* Bt = job ? p.hm() : p.wt_xk(); bf16* O = job ? p.vxt() : p.kx();
    const int row0 = rb * 64 + (q >> 1) * 32, col0 = cb * 64 + (q & 1) * 32;
    const bf16* ap = A + (size_t)(row0 + r) * D + 8 * hf; const bf16* bp = Bt + (size_t)(col0 + r) * D + 8 * hf;
    f32x16 acc = zero16();
#pragma unroll 8
    for (int k0 = 0; k0 < D; k0 += 16) acc = __builtin_amdgcn_mfma_f32_32x32x16_bf16(*(const bf16x8*)(ap + k0), *(const bf16x8*)(bp + k0), acc, 0, 0, 0);
#pragma unroll
    for (int reg = 0; reg < 16; ++reg) O[(size_t)(row0 + crow(reg, hf)) * ld + col0 + r] = (bf16)f2bf(acc[reg]);
}
__device__ __forceinline__ void phase_scan2(const P& p, int bid, int nb) {
    bf16* sp = (bf16*)p.sprev();
    const int tid = otid();
    if (tid < 256)
    for (int idx = bid * 256 + tid; idx < 8 * 8192; idx += nb * 256) {
        const int bh = idx >> 13, ed = idx & 8191, d = ed & 63; float st = 0.f;
        for (int n0 = 0; n0 < NCHUNK; n0 += 8) { float dv[8], dc[8];
#pragma unroll
            for (int k = 0; k < 8; ++k) { const size_t u = (size_t)bh * NCHUNK + n0 + k; dv[k] = bf2f(((const bf16*)p.ds())[u * 8192 + ed]); dc[k] = p.dec()[u * 64 + d]; }
#pragma unroll
            for (int k = 0; k < 8; ++k) { const size_t u = (size_t)bh * NCHUNK + n0 + k; sp[u * 8192 + ed] = (bf16)f2bf(st); st = dc[k] * st + dv[k]; } }
    }
}
__device__ __forceinline__ bf16x8 split_hi(const f32x4 a, const f32x4 b, f32x4& ra, f32x4& rb) {
    u32x4 h; h.x = pk2(a.x, a.y); h.y = pk2(a.z, a.w); h.z = pk2(b.x, b.y); h.w = pk2(b.z, b.w);
    ra = (f32x4){a.x - bf_lo(h.x), a.y - bf_hi(h.x), a.z - bf_lo(h.y), a.w - bf_hi(h.y)}; rb = (f32x4){b.x - bf_lo(h.z), b.y - bf_hi(h.z), b.z - bf_lo(h.w), b.w - bf_hi(h.w)};
    return __builtin_bit_cast(bf16x8, h);
}
__device__ __forceinline__ bf16x8 pack_bf8(const f32x4 a, const f32x4 b) { u32x4 h; h.x = pk2(a.x, a.y); h.y = pk2(a.z, a.w); h.z = pk2(b.x, b.y); h.w = pk2(b.z, b.w); return __builtin_bit_cast(bf16x8, h); }
__device__ __forceinline__ void phase_router3(const P& p, float* lds, int* blkcnt, int* rank, int bid, int nb) {
    const int tid = otid(), lane = tid & 63, w = tid >> 6, r = lane & 31, hf = lane >> 5;
    float* part = lds;
    float* ssqp = lds + 16384;
    float* lgt = lds + 16384 + 512;
    float* rsl = lgt + 64 * 33;
    bf16x8 bh[8], bl[8];
#pragma unroll
    for (int s = 0; s < 8; ++s) { const int k0 = 128 * w + 16 * s + 8 * hf; f32x4 a, b, ra, rb;
#pragma unroll
        for (int j = 0; j < 4; ++j) { a[j] = p.w_router[(k0 + j) * NE + r] * p.g_moe[k0 + j]; b[j] = p.w_router[(k0 + 4 + j) * NE + r] * p.g_moe[k0 + 4 + j]; }
        bh[s] = split_hi(a, b, ra, rb); bl[s] = pack_bf8(ra, rb); }
    for (int gidx = bid; gidx < M / 64; gidx += nb) {
        const int t0 = gidx * 64;
        __syncthreads();
#pragma unroll
        for (int mt = 0; mt < 2; ++mt) {
            const bf16* xr = p.x2() + (size_t)(t0 + 32 * mt + r) * D + 128 * w + 8 * hf;
            bf16x8 xa[8];
#pragma unroll
            for (int s = 0; s < 8; ++s) xa[s] = *(const bf16x8*)(xr + 16 * s);
            f32x16 acc = zero16(); float ss = 0.f;
#pragma unroll
            for (int s = 0; s < 8; ++s) { const u32x4 xu = __builtin_bit_cast(u32x4, xa[s]);
                const float x0 = bf_lo(xu.x), x1 = bf_hi(xu.x), x2 = bf_lo(xu.y), x3 = bf_hi(xu.y), x4 = bf_lo(xu.z), x5 = bf_hi(xu.z), x6 = bf_lo(xu.w), x7 = bf_hi(xu.w);
                ss += (x0 * x0 + x1 * x1) + (x2 * x2 + x3 * x3) + (x4 * x4 + x5 * x5) + (x6 * x6 + x7 * x7);
                acc = __builtin_amdgcn_mfma_f32_32x32x16_bf16(bh[s], xa[s], acc, 0, 0, 0);
                acc = __builtin_amdgcn_mfma_f32_32x32x16_bf16(bl[s], xa[s], acc, 0, 0, 0); }
            ss += __shfl_xor(ss, 32);
            if (hf == 0) ssqp[w * 64 + 32 * mt + r] = ss;
            float* po = part + (w * 64 + 32 * mt + r) * 32;
#pragma unroll
            for (int rg = 0; rg < 4; ++rg) *(f32x4*)(po + 8 * rg + 4 * hf) = (f32x4){acc[4 * rg], acc[4 * rg + 1], acc[4 * rg + 2], acc[4 * rg + 3]};
        }
        __syncthreads();
        { const int tk = tid >> 3, e4 = (tid & 7) * 4; f32x4 s4 = {0.f, 0.f, 0.f, 0.f}; float sq = 0.f;
#pragma unroll
          for (int ww = 0; ww < 8; ++ww) { s4 += *(const f32x4*)(part + (ww * 64 + tk) * 32 + e4); sq += ssqp[ww * 64 + tk]; }
          const float rs = 1.0f / sqrtf(sq * (1.f / D) + EPS); const f32x4 bb = *(const f32x4*)(p.b_router + e4);
          lgt[tk * 33 + e4] = s4.x * rs + bb.x; lgt[tk * 33 + e4 + 1] = s4.y * rs + bb.y; lgt[tk * 33 + e4 + 2] = s4.z * rs + bb.z; lgt[tk * 33 + e4 + 3] = s4.w * rs + bb.w;
          if ((tid & 7) == 0) rsl[tk] = rs; }
        __syncthreads();
        { const f32x4* gr = (const f32x4*)p.g_moe + 4 * lane; const f32x4 g0 = gr[0], g1 = gr[1], g2 = gr[2], g3 = gr[3];
#pragma unroll 4
          for (int ii = 0; ii < 8; ++ii) { const int t = t0 + 8 * w + ii; const float rs = rsl[8 * w + ii]; const u32x4* xr = (const u32x4*)(p.x2() + (size_t)t * D) + 2 * lane; const u32x4 w0 = xr[0], w1 = xr[1]; u32x4 o8;
              { const f32x4 v = (f32x4){bf_lo(w0.x), bf_hi(w0.x), bf_lo(w0.y), bf_hi(w0.y)} * rs * g0; o8.x = pk4_fp8(v.x, v.y, v.z, v.w); } { const f32x4 v = (f32x4){bf_lo(w0.z), bf_hi(w0.z), bf_lo(w0.w), bf_hi(w0.w)} * rs * g1; o8.y = pk4_fp8(v.x, v.y, v.z, v.w); }
              { const f32x4 v = (f32x4){bf_lo(w1.x), bf_hi(w1.x), bf_lo(w1.y), bf_hi(w1.y)} * rs * g2; o8.z = pk4_fp8(v.x, v.y, v.z, v.w); } { const f32x4 v = (f32x4){bf_lo(w1.z), bf_hi(w1.z), bf_lo(w1.w), bf_hi(w1.w)} * rs * g3; o8.w = pk4_fp8(v.x, v.y, v.z, v.w); }
              *((u32x4*)(p.ws + WS_X8 + (size_t)t * D) + lane) = o8; } }
        if (w == 0) {
            float lg[NE];
#pragma unroll
            for (int e = 0; e < NE; ++e) lg[e] = lgt[lane * 33 + e];
            int idx[4]; float val[4];
#pragma unroll
            for (int j = 0; j < 4; ++j) { float best = lg[0]; int bi = 0;
#pragma unroll
                for (int e = 1; e < NE; ++e) { const bool tk = lg[e] > best; best = tk ? lg[e] : best; bi = tk ? e : bi; }
                idx[j] = bi; val[j] = best;
#pragma unroll
                for (int e = 0; e < NE; ++e) lg[e] = (e == bi) ? -INFINITY : lg[e]; }
            const float e1 = __expf(val[1] - val[0]), e2 = __expf(val[2] - val[0]), e3 = __expf(val[3] - val[0]); const float inv = 1.f / (1.f + e1 + e2 + e3);
            int rk[4] = {0, 0, 0, 0}; int mycnt = 0; const unsigned long long lt = (1ull << lane) - 1ull;
#pragma unroll 4
            for (int e = 0; e < NE; ++e) { const bool h0 = idx[0] == e, h1 = idx[1] == e, h2 = idx[2] == e, h3 = idx[3] == e; const unsigned long long m = __ballot(h0 || h1 || h2 || h3);
                const int below = __popcll(m & lt); rk[0] = h0 ? below : rk[0]; rk[1] = h1 ? below : rk[1]; rk[2] = h2 ? below : rk[2]; rk[3] = h3 ? below : rk[3];
                mycnt = (lane == e) ? __popcll(m) : mycnt; }
            const int t = t0 + lane;
            *(i32x4g*)(p.topi() + t * 4) = (i32x4g){idx[0], idx[1], idx[2], idx[3]};
            *(f32x4*)(p.topg() + t * 4) = (f32x4){inv, e1 * inv, e2 * inv, e3 * inv};
            *(i32x4g*)(rank + t * 4) = (i32x4g){rk[0], rk[1], rk[2], rk[3]};
            if (lane < NE) blkcnt[gidx * NE + lane] = mycnt;
        }
    }
}
__device__ __forceinline__ int scan32_incl(int v, int lane) {
#pragma unroll
    for (int o = 1; o < 32; o <<= 1) { const int u = __shfl_up(v, o, 32); v += ((lane & 31) >= o) ? u : 0; }
    return v;
}
__device__ __forceinline__ void phase_dispatch3(const P& p, int* ldsi, const int* blkcnt, const int* rank, int bid, int nb) {
    const int tid = otid(), lane = tid & 63, w = tid >> 6;
    int* red_t = ldsi; int* red_p = ldsi + 512; int* base = ldsi + 1024;
    static_assert(MOE_FP8, "dispatch writes e4m3 activation rows");
    for (int gidx = bid; gidx < M / 64; gidx += nb) {
        __syncthreads();
        const int a = gidx * 256 + (tid & 255);
        const int my_e = p.topi()[a], my_r = rank[a]; const float my_g = p.topg()[a];
        { const int e = tid & 31, part = tid >> 5; int v[16];
#pragma unroll
          for (int k = 0; k < 16; ++k) v[k] = blkcnt[(part * 16 + k) * 32 + e];
          int tt = 0, pp = 0;
#pragma unroll
          for (int k = 0; k < 16; ++k) { tt += v[k]; pp += (part * 16 + k < gidx) ? v[k] : 0; }
          red_t[part * 32 + e] = tt; red_p[part * 32 + e] = pp; }
        __syncthreads();
        if (w == 0) {
            const int e = lane & 31; int tt = 0, pp = 0;
#pragma unroll
            for (int q = 0; q < 16; ++q) { tt += red_t[q * 32 + e]; pp += red_p[q * 32 + e]; }
            const int nt = (tt + 255) >> 8, off = scan32_incl(nt << 8, lane) - (nt << 8);
            if (lane < 32) { base[e] = off + pp; red_t[e] = tt; }
            if (gidx == 0) {
                const int lr = tt - ((nt - 1) << 8); const int isH = (nt > 0 && lr <= 128) ? 1 : 0, nfe = nt - isH;
                const int fi = scan32_incl(nfe, lane), hi = scan32_incl(isH, lane); const int NF = __shfl(fi, 31), NH = __shfl(hi, 31);
                if (lane < 32) { const int f0 = fi - nfe;
                    for (int i = 0; i < nfe; ++i) p.tilee()[f0 + i] = (((off >> 8) + i) << 7) | e;
                    if (isH) p.tilee()[NF + hi - 1] = (((off >> 8) + nt - 1) << 7) | (lr <= 64 ? 64 : 0) | 32 | e;
                    if (lane == 0) { p.tilee()[MAXMT] = NF + NH; p.tilee()[MAXMT + 1] = NF; } } } }
        __syncthreads();
        if (gidx == 0) { const int e = tid >> 4; const int c = red_t[e], s0 = base[e] + c, s1 = base[e] + (((c + 255) >> 8) << 8);
            for (int s = s0 + (tid & 15); s < s1; s += 16) ((int*)(p.ws + WS_TOKSLOT))[s] = 0; }
        if (tid < 256) { const int slot = base[my_e] + my_r;
            p.slotof()[a] = slot; p.gslot()[slot] = my_g; ((int*)(p.ws + WS_TOKSLOT))[slot] = a >> 2; }
    }
}
namespace pg {
typedef short bf16x8 __attribute__((ext_vector_type(8)));
constexpr int BM = 256, BK = 64, HALF = 128, HTB = HALF * BK * 2, STAGE_BYTES = 8 * HTB;
__device__ __forceinline__ int lds_byte(int r, int c) { const int st = (r >> 4) * 2 + (c >> 5), rr = r & 15, cc = c & 31, ob = rr * 64 + cc * 2; return st * 1024 + (ob ^ (((ob >> 9) & 1) << 5)); }
__device__ __forceinline__ void stage_rc(int b, int& R, int& C) { const int st = b / 1024, sb = b % 1024, swz = sb ^ (((sb >> 9) & 1) << 5); R = (st >> 1) * 16 + swz / 64; C = (st & 1) * 32 + (swz % 64) / 2; }
__device__ __forceinline__ int perm32(int rho) { const int n = rho >> 4, i = rho & 15; return 8 * (i >> 2) + 4 * n + (i & 3); }
struct Unit { int pm, pn, e, ord, half; unsigned ao, bo; };
struct Gemm { int lda, ldb, K; const LAS int* ltok = nullptr; };
__device__ __forceinline__ void map2d(int L, int nM, int nN, int& pm, int& pn) {
    const int nwg = nM * nN; int wgid = L;
    { const int q = nwg / 8, r = nwg % 8, xcd = wgid % 8, off = wgid / 8; wgid = (xcd < r ? xcd * (q + 1) : r * (q + 1) + (xcd - r) * q) + off; }
    const int nig = 8 * nN, gid = wgid / nig, fm = gid * 8, gsz = (nM - fm) < 8 ? (nM - fm) : 8;
    pm = fm + ((wgid % nig) % gsz); pn = (wgid % nig) / gsz;
}
struct Sched2D { unsigned aoff, boff, rowA, rowB; int nM, nN, G, c;
    __device__ __forceinline__ bool next(int i, Unit& u) const { const long L = (long)i * G + c; if (L >= (long)nM * nN) return false; map2d((int)L, nM, nN, u.pm, u.pn); u.e = 0; u.ord = i; u.half = 0;
        u.ao = aoff + (unsigned)u.pm * 256u * rowA; u.bo = boff + (unsigned)u.pn * 256u * rowB; return true; } };
struct SchedMoE { unsigned aoff, boff; const LAS int* tile_e; unsigned sBe, rowA, rowB; int nM, nF, nN, G, c; bool gatherA = false;
    __device__ __forceinline__ bool next(int i, Unit& u) const { const long L = (long)i * G + c; if (L >= (long)nM * nN) return false; int idx, pn;
        if (L < (long)nF * nN) map2d((int)L, nF, nN, idx, pn); else { const int t = (int)L - nF * nN; idx = nF + t / nN; pn = t % nN; }
        const int ent = __builtin_amdgcn_readfirstlane(tile_e[idx]); u.pm = ent >> 7; u.pn = pn; u.e = ent & 31; u.half = (ent >> 5) & 3; u.ord = i;
        u.ao = gatherA ? aoff : aoff + (unsigned)u.pm * 256u * rowA; u.bo = boff + (unsigned)u.e * sBe + (unsigned)u.pn * 256u * rowB; return true; } };

typedef f32x4 Acc[2][2][4][2];
__device__ __forceinline__ u32x4 pack8(const f32x4 v0, const f32x4 v1) { u32x4 w; w.x = pk2(v0[0], v0[1]); w.y = pk2(v0[2], v0[3]); w.z = pk2(v1[0], v1[1]); w.w = pk2(v1[2], v1[3]); return w; }
struct EpiBf3 { static constexpr bool AFTER_DRAIN = false, PERM = true, INIT = false; unsigned char* ws; size_t o0, o1, o2; int ld0, ld1, ld2;
    __device__ __forceinline__ void operator()(const Acc& acc, const Unit& u, int wr, int wc, int fr, int fq) const {
        const size_t m1 = (size_t)(u.e == 1), m2 = (size_t)(u.e == 2);
        bf16* base = (bf16*)(ws + o0 + m1 * (o1 - o0) + m2 * (o2 - o0)); const int ld = ld0 + (int)m1 * (ld1 - ld0) + (int)m2 * (ld2 - ld0);
        const int row0 = u.pm * BM + wr * 64 + fr, col0 = u.pn * BM + wc * 32 + 8 * fq;
#pragma unroll
        for (int ai = 0; ai < 2; ++ai)
#pragma unroll
            for (int m = 0; m < 4; ++m) { bf16* rowp = base + (size_t)(row0 + ai * HALF + m * 16) * ld + col0;
#pragma unroll
                for (int bj = 0; bj < 2; ++bj) *(u32x4*)(rowp + bj * HALF) = pack8(acc[ai][bj][m][0], acc[ai][bj][m][1]); } } };
struct EpiOutF { static constexpr bool AFTER_DRAIN = false, PERM = true, INIT = false; const float* x; bf16* x1; float* rsqp;
    __device__ __forceinline__ void operator()(const Acc& acc, const Unit& u, int wr, int wc, int fr, int fq) const {
        const int row0 = u.pm * BM + wr * 64 + fr, col0 = u.pn * BM + wc * 32 + 8 * fq;
        f32x4 xv[4][2][2]; u32x4 res[4][2]; float ssv[4];
#pragma unroll
        for (int ai = 0; ai < 2; ++ai) {
#pragma unroll
            for (int m = 0; m < 4; ++m)
#pragma unroll
                for (int bj = 0; bj < 2; ++bj) { const float* xp = x + (size_t)(row0 + ai * HALF + m * 16) * D + col0 + bj * HALF; xv[m][bj][0] = *(const f32x4*)xp; xv[m][bj][1] = *(const f32x4*)(xp + 4); }
            if (ai == 1) {
#pragma unroll
                for (int m = 0; m < 4; ++m) { const int row = row0 + m * 16;
#pragma unroll
                    for (int bj = 0; bj < 2; ++bj) *(u32x4*)(x1 + (size_t)row * D + col0 + bj * HALF) = res[m][bj];
                    if (fq == 0) rsqp[(size_t)row * 16 + u.pn * 4 + wc] = ssv[m]; } }
            __builtin_amdgcn_sched_barrier(0);
#pragma unroll
            for (int m = 0; m < 4; ++m) { float ss = 0.f;
#pragma unroll
                for (int bj = 0; bj < 2; ++bj) { const f32x4 v0 = xv[m][bj][0] + acc[ai][bj][m][0], v1 = xv[m][bj][1] + acc[ai][bj][m][1];
                    res[m][bj] = pack8(v0, v1);
                    ss += (v0[0] * v0[0] + v0[1] * v0[1]) + (v0[2] * v0[2] + v0[3] * v0[3]) + (v1[0] * v1[0] + v1[1] * v1[1]) + (v1[2] * v1[2] + v1[3] * v1[3]); }
                ss += __shfl_xor(ss, 16); ss += __shfl_xor(ss, 32); ssv[m] = ss; }
            __builtin_amdgcn_sched_barrier(0);
        }
#pragma unroll
        for (int m = 0; m < 4; ++m) { const int row = row0 + HALF + m * 16;
#pragma unroll
            for (int bj = 0; bj < 2; ++bj) *(u32x4*)(x1 + (size_t)row * D + col0 + bj * HALF) = res[m][bj];
            if (fq == 0) rsqp[(size_t)row * 16 + u.pn * 4 + wc] = ssv[m]; } } };
struct EpiResF { static constexpr bool AFTER_DRAIN = false, PERM = true, INIT = false; const bf16* base; bf16* o;
    __device__ __forceinline__ void operator()(const Acc& acc, const Unit& u, int wr, int wc, int fr, int fq) const {
        const int row0 = u.pm * BM + wr * 64 + fr, col0 = u.pn * BM + wc * 32 + 8 * fq;
        u32x4 bv[2][4][2];
#pragma unroll
        for (int ai = 0; ai < 2; ++ai)
#pragma unroll
            for (int m = 0; m < 4; ++m)
#pragma unroll
                for (int bj = 0; bj < 2; ++bj) bv[ai][m][bj] = *(const u32x4*)(base + (size_t)(row0 + ai * HALF + m * 16) * D + col0 + bj * HALF);
        __builtin_amdgcn_sched_barrier(0);
#pragma unroll
        for (int ai = 0; ai < 2; ++ai)
#pragma unroll
            for (int m = 0; m < 4; ++m)
#pragma unroll
                for (int bj = 0; bj < 2; ++bj) { const u32x4 b = bv[ai][m][bj];
                    const f32x4 v0 = (f32x4){bf_lo(b.x), bf_hi(b.x), bf_lo(b.y), bf_hi(b.y)} + acc[ai][bj][m][0], v1 = (f32x4){bf_lo(b.z), bf_hi(b.z), bf_lo(b.w), bf_hi(b.w)} + acc[ai][bj][m][1];
                    *(u32x4*)(o + (size_t)(row0 + ai * HALF + m * 16) * D + col0 + bj * HALF) = pack8(v0, v1); } } };
__device__ __forceinline__ f32x2_t swiglu_tu2(f32x2_t T, f32x2_t U) {
    constexpr float C = -1024.f * SWI_C;
    T.x = __builtin_amdgcn_fmed3f(T.x, -224.f * SWI_C, 3.0e38f); T.y = __builtin_amdgcn_fmed3f(T.y, -224.f * SWI_C, 3.0e38f);
    U.x = __builtin_amdgcn_fmed3f(U.x, -192.f, 256.f); U.y = __builtin_amdgcn_fmed3f(U.y, -192.f, 256.f);
    f32x2_t e = T * (1.f / 32.f); e.x = __builtin_amdgcn_exp2f(e.x); e.y = __builtin_amdgcn_exp2f(e.y);
    f32x2_t d = e * C + C; d.x = __builtin_amdgcn_rcpf(d.x); d.y = __builtin_amdgcn_rcpf(d.y);
    return (T * d) * U;
}
struct EpiUp8 { static constexpr bool AFTER_DRAIN = false, PERM = true, INIT = true; unsigned char* h8; const LAS float* lb;
    __device__ __forceinline__ void init(Acc& acc, const Unit& u, int wr, int wc, int fr, int fq) const {
        const LAS float* bb = lb + u.ord * 256 + wc * 32 + 8 * fq;
        const f32x4 bg0 = *(const LAS f32x4*)bb, bg1 = *(const LAS f32x4*)(bb + 4), bu0 = *(const LAS f32x4*)(bb + 128), bu1 = *(const LAS f32x4*)(bb + 132);
#pragma unroll
        for (int ai = 0; ai < 2; ++ai)
#pragma unroll
            for (int m = 0; m < 4; ++m) { acc[ai][0][m][0] = bg0; acc[ai][0][m][1] = bg1; acc[ai][1][m][0] = bu0; acc[ai][1][m][1] = bu1; } }
    __device__ __forceinline__ void operator()(const Acc& acc, const Unit& u, int wr, int wc, int fr, int fq) const {
        const int row0 = u.pm * BM + wr * 64 + fr, ff0 = u.pn * HALF + wc * 32 + 8 * fq;
#pragma unroll
        for (int ai = 0; ai < 2; ++ai)
#pragma unroll
            for (int m = 0; m < 4; ++m) { const f32x4 g0 = acc[ai][0][m][0], g1 = acc[ai][0][m][1], u0 = acc[ai][1][m][0], u1 = acc[ai][1][m][1];
                const f32x2_t r00 = swiglu_tu2((f32x2_t){g0[0], g0[1]}, (f32x2_t){u0[0], u0[1]}), r01 = swiglu_tu2((f32x2_t){g0[2], g0[3]}, (f32x2_t){u0[2], u0[3]});
                const f32x2_t r10 = swiglu_tu2((f32x2_t){g1[0], g1[1]}, (f32x2_t){u1[0], u1[1]}), r11 = swiglu_tu2((f32x2_t){g1[2], g1[3]}, (f32x2_t){u1[2], u1[3]});
                u32x2 o; o.x = pk4_fp8_nc(r00.x, r00.y, r01.x, r01.y); o.y = pk4_fp8_nc(r10.x, r10.y, r11.x, r11.y);
                *(u32x2*)(h8 + (size_t)(row0 + ai * HALF + m * 16) * DFF + ff0) = o; } } };
struct EpiDn8 { static constexpr bool AFTER_DRAIN = false, PERM = true, INIT = true; unsigned char* y8; const LAS float* lb;
    __device__ __forceinline__ void init(Acc& acc, const Unit& u, int wr, int wc, int fr, int fq) const {
        const LAS float* bb = lb + u.ord * 512 + wc * 32 + 8 * fq;
#pragma unroll
        for (int bj = 0; bj < 2; ++bj)
#pragma unroll
            for (int n = 0; n < 2; ++n) { const f32x4 b = *(const LAS f32x4*)(bb + bj * HALF + 4 * n);
#pragma unroll
                for (int ai = 0; ai < 2; ++ai)
#pragma unroll
                    for (int m = 0; m < 4; ++m) acc[ai][bj][m][n] = b; } }
    __device__ __forceinline__ void operator()(const Acc& acc, const Unit& u, int wr, int wc, int fr, int fq) const {
        const int row0 = u.pm * BM + wr * 64 + fr, col0 = u.pn * BM + wc * 32 + 8 * fq; const LAS float* gs = lb + u.ord * 512 + 256 + wr * 64 + fr;
#pragma unroll
        for (int ai = 0; ai < 2; ++ai)
#pragma unroll
            for (int m = 0; m < 4; ++m) { const int row = row0 + ai * HALF + m * 16; const float g = gs[ai * HALF + m * 16] * (W8_INV * Y8_SCALE); unsigned char* rowp = y8 + (size_t)row * D + col0;
#pragma unroll
                for (int bj = 0; bj < 2; ++bj) { const f32x4 v0 = acc[ai][bj][m][0] * g, v1 = acc[ai][bj][m][1] * g;
                    u32x2 o; o.x = pk4_fp8(v0[0], v0[1], v0[2], v0[3]); o.y = pk4_fp8(v1[0], v1[1], v1[2], v1[3]); *(u32x2*)(rowp + bj * HALF) = o; } } } };

__device__ __forceinline__ void tiles_store(LAS unsigned char* lds, const Acc& v, int wr, int wc, int fr, int fq) {
#pragma unroll
    for (int ai = 0; ai < 2; ++ai)
#pragma unroll
        for (int bj = 0; bj < 2; ++bj)
#pragma unroll
            for (int m = 0; m < 4; ++m) { const int t = 2 * bj + (wc >> 1);
                *(LAS u32x4*)(lds + (t * 2 + ai) * HTB + lds_byte(64 * wr + 16 * m + fr, (wc & 1) * 32 + 8 * fq)) = pack8(v[ai][bj][m][0], v[ai][bj][m][1]); }
}
__device__ __forceinline__ void mm_ldsA_globB(Acc& acc, LAS unsigned char* lds, const bf16* Bg, int ldb, int wr, int wc, int fr, int fq) {
    const int aoff = lds_byte(wr * 64 + fr, fq * 8);
    unsigned bo[2][2];
#pragma unroll
    for (int bj = 0; bj < 2; ++bj)
#pragma unroll
        for (int n = 0; n < 2; ++n) bo[bj][n] = (unsigned)(128 * bj + 32 * wc + perm32(16 * n + fr)) * (unsigned)ldb + 8u * fq;
    bf16x8 B0[2][2][2], B1[2][2][2];
#define MM_LOADB(dst, t) do { _Pragma("unroll") for (int bj = 0; bj < 2; ++bj) _Pragma("unroll") for (int n = 0; n < 2; ++n) _Pragma("unroll") for (int k = 0; k < 2; ++k) \
        dst[bj][n][k] = *(const bf16x8*)(Bg + bo[bj][n] + (t) * 64 + k * 32); } while (0)
#define MM_TILE(Bt, t) do { _Pragma("unroll") for (int ai = 0; ai < 2; ++ai) _Pragma("unroll") for (int mh = 0; mh < 2; ++mh) { bf16x8 At[2][2]; \
        _Pragma("unroll") for (int m = 0; m < 2; ++m) _Pragma("unroll") for (int k = 0; k < 2; ++k) At[m][k] = *(const LAS bf16x8*)(lds + ((t) * 2 + ai) * HTB + aoff + (2 * mh + m) * 2048 + k * 1024); \
        _Pragma("unroll") for (int bj = 0; bj < 2; ++bj) _Pragma("unroll") for (int m = 0; m < 2; ++m) _Pragma("unroll") for (int n = 0; n < 2; ++n) _Pragma("unroll") for (int k = 0; k < 2; ++k) \
            acc[ai][bj][2 * mh + m][n] = __builtin_amdgcn_mfma_f32_16x16x32_bf16(Bt[bj][n][k], At[m][k], acc[ai][bj][2 * mh + m][n], 0, 0, 0); \
        __builtin_amdgcn_sched_barrier(0); } } while (0)
    MM_LOADB(B0, 0);
#pragma unroll 1
    for (int t = 0; t < 4; t += 2) {
        MM_LOADB(B1, t + 1); __builtin_amdgcn_sched_barrier(0);
        MM_TILE(B0, t);
        if (t < 2) MM_LOADB(B0, t + 2);
        __builtin_amdgcn_sched_barrier(0);
        MM_TILE(B1, t + 1);
    }
#undef MM_LOADB
#undef MM_TILE
}
struct EpiQAttn { static constexpr bool AFTER_DRAIN = true, PERM = true, INIT = false; const float* rsqp; const bf16* kx; const bf16* vxt; bf16* ox;
    __device__ __forceinline__ void fused(Acc& acc, const Unit& u, int wr, int wc, int fr, int fq, LAS unsigned char* lds) const {
        const int b = u.pm >> 5, h = u.pn;
        LAS float* st = (LAS float*)(lds + STAGE_BYTES);
#pragma unroll
        for (int ai = 0; ai < 2; ++ai)
#pragma unroll
            for (int m = 0; m < 4; ++m) { const f32x4* rp = (const f32x4*)(rsqp + (size_t)(u.pm * BM + 128 * ai + 64 * wr + 16 * m + fr) * 16); const f32x4 p0 = rp[0], p1 = rp[1], p2 = rp[2], p3 = rp[3];
                const float sq = (((p0[0] + p0[1]) + (p0[2] + p0[3])) + ((p1[0] + p1[1]) + (p1[2] + p1[3]))) + (((p2[0] + p2[1]) + (p2[2] + p2[3])) + ((p3[0] + p3[1]) + (p3[2] + p3[3])));
                const float s = 0.0625f / sqrtf(sq * (1.f / D) + EPS);
#pragma unroll
                for (int bj = 0; bj < 2; ++bj)
#pragma unroll
                    for (int n = 0; n < 2; ++n) acc[ai][bj][m][n] = acc[ai][bj][m][n] * s; }
        tiles_store(lds, acc, wr, wc, fr, fq);
        __syncthreads();
#pragma unroll
        for (int ai = 0; ai < 2; ++ai)
#pragma unroll
            for (int bj = 0; bj < 2; ++bj)
#pragma unroll
                for (int m = 0; m < 4; ++m)
#pragma unroll
                    for (int n = 0; n < 2; ++n) acc[ai][bj][m][n] = (f32x4){0.f, 0.f, 0.f, 0.f};
        mm_ldsA_globB(acc, lds, kx + (size_t)(b * MEMLEN) * D + h * 256, D, wr, wc, fr, fq);
        float wm[2][4];
#pragma unroll
        for (int ai = 0; ai < 2; ++ai)
#pragma unroll
            for (int m = 0; m < 4; ++m) { float mx = -INFINITY;
#pragma unroll
                for (int bj = 0; bj < 2; ++bj)
#pragma unroll
                    for (int n = 0; n < 2; ++n) { const f32x4 v = acc[ai][bj][m][n]; mx = fmaxf(mx, fmaxf(fmaxf(v[0], v[1]), fmaxf(v[2], v[3]))); }
                mx = fmaxf(mx, __shfl_xor(mx, 16)); mx = fmaxf(mx, __shfl_xor(mx, 32)); wm[ai][m] = mx; float sm = 0.f;
#pragma unroll
                for (int bj = 0; bj < 2; ++bj)
#pragma unroll
                    for (int n = 0; n < 2; ++n) { f32x4 v = acc[ai][bj][m][n];
#pragma unroll
                        for (int i = 0; i < 4; ++i) { v[i] = __builtin_amdgcn_exp2f((v[i] - mx) * 1.44269504089f); sm += v[i]; }
                        acc[ai][bj][m][n] = v; }
                sm += __shfl_xor(sm, 16); sm += __shfl_xor(sm, 32);
                if (fq == 0) { const int row = 128 * ai + 64 * wr + 16 * m + fr; st[(row * 4 + wc) * 2] = mx; st[(row * 4 + wc) * 2 + 1] = sm; } }
        __syncthreads();
#pragma unroll
        for (int ai = 0; ai < 2; ++ai)
#pragma unroll
            for (int m = 0; m < 4; ++m) { const int row = 128 * ai + 64 * wr + 16 * m + fr; const LAS f32x4* sp = (const LAS f32x4*)(st + row * 8); const f32x4 s0 = sp[0], s1 = sp[1];
                const float gm = fmaxf(fmaxf(s0[0], s0[2]), fmaxf(s1[0], s1[2]));
                const float f = __builtin_amdgcn_exp2f((wm[ai][m] - gm) * 1.44269504089f);
#pragma unroll
                for (int bj = 0; bj < 2; ++bj)
#pragma unroll
                    for (int n = 0; n < 2; ++n) acc[ai][bj][m][n] = acc[ai][bj][m][n] * f; }
        tiles_store(lds, acc, wr, wc, fr, fq);
        __syncthreads();
#pragma unroll
        for (int ai = 0; ai < 2; ++ai)
#pragma unroll
            for (int bj = 0; bj < 2; ++bj)
#pragma unroll
                for (int m = 0; m < 4; ++m)
#pragma unroll
                    for (int n = 0; n < 2; ++n) acc[ai][bj][m][n] = (f32x4){0.f, 0.f, 0.f, 0.f};
        mm_ldsA_globB(acc, lds, vxt + (size_t)(h * 256) * (BATCH * MEMLEN) + b * MEMLEN, BATCH * MEMLEN, wr, wc, fr, fq);
        int t3 = threadIdx.x; asm volatile("" : "+v"(t3));
        const int fr3 = t3 & 15, fq3 = (t3 >> 4) & 3;
        const int row0 = u.pm * BM + wr * 64 + fr3, col0 = h * 256 + wc * 32 + 8 * fq3;
#pragma unroll
        for (int ai = 0; ai < 2; ++ai)
#pragma unroll
            for (int m = 0; m < 4; ++m) { bf16* rowp = ox + (size_t)(row0 + ai * HALF + m * 16) * D + col0;
                const int row = 128 * ai + 64 * wr + 16 * m + fr3; const LAS f32x4* sp = (const LAS f32x4*)(st + row * 8); const f32x4 s0 = sp[0], s1 = sp[1];
                const float gm = fmaxf(fmaxf(s0[0], s0[2]), fmaxf(s1[0], s1[2]));
                const float tot = s0[1] * __builtin_amdgcn_exp2f((s0[0] - gm) * 1.44269504089f) + s0[3] * __builtin_amdgcn_exp2f((s0[2] - gm) * 1.44269504089f)
                                + s1[1] * __builtin_amdgcn_exp2f((s1[0] - gm) * 1.44269504089f) + s1[3] * __builtin_amdgcn_exp2f((s1[2] - gm) * 1.44269504089f);
                const float inv = 1.f / tot;
#pragma unroll
                for (int bj = 0; bj < 2; ++bj) *(u32x4*)(rowp + bj * HALF) = pack8(acc[ai][bj][m][0] * inv, acc[ai][bj][m][1] * inv); }
    }
};

typedef int i32x4 __attribute__((ext_vector_type(4)));
typedef int i32x8 __attribute__((ext_vector_type(8)));
__device__ __forceinline__ void mma8(const i32x8 bb, const i32x8 aa, f32x4& c) {
    asm volatile("v_mfma_f32_16x16x128_f8f6f4 %0, %1, %2, %0" : "+v"(c) : "v"(bb), "v"(aa));
}
__device__ __forceinline__ void mma8_drain() { asm volatile("s_nop 15\n\ts_nop 7" ::: "memory"); }
template <class Epi, class Sched, bool ALIGN_EPI, bool F8 = false, bool GATHER = false, bool HALFABLE = false>
__device__ __forceinline__ void gemm_phase(LAS unsigned char* lds, const unsigned char* ws, const Gemm g, const Sched& S, const Epi& E) {
    const __amdgpu_buffer_rsrc_t rsrc = __builtin_amdgcn_make_buffer_rsrc((void*)ws, 0, 0x7fffffff, 0x00020000);
    const int tid = otid(), wid = __builtin_amdgcn_readfirstlane(tid >> 6), lane = tid & 63, wr = wid >> 2, wc = wid & 3, fr = lane & 15, fq = lane >> 4;
    const int K = g.K, nt = K / BK;
    unsigned voffA[2], voffB[2]; int gR[2]; unsigned gC[2];
#pragma unroll
    for (int i = 0; i < 2; ++i) { int R, C; stage_rc(tid * 16 + i * 8192, R, C); const int Rb = Epi::PERM ? ((R & ~31) + perm32(R & 31)) : R;
        voffA[i] = (unsigned)(R * g.lda + C) * 2u; voffB[i] = (unsigned)(Rb * g.ldb + C) * 2u; gR[i] = R; gC[i] = (unsigned)C * 2u; }
    unsigned vgc[2][2], vgn[2][2];
#define PG_GATH(dst, ord) do { _Pragma("unroll") for (int _h = 0; _h < 2; ++_h) _Pragma("unroll") for (int _i = 0; _i < 2; ++_i) \
        dst[_h][_i] = (unsigned)g.ltok[(ord) * 256 + 128 * _h + gR[_i]] * (unsigned)(g.lda * 2) + gC[_i]; } while (0)
    const unsigned kstep = (unsigned)(BK * 2);
    const unsigned hstepA = (unsigned)HALF * g.lda * 2, hstepB = (unsigned)HALF * g.ldb * 2;
    const unsigned ldsw = (unsigned)wid * 1024u, ldsbase = (unsigned)(size_t)lds;
    const int aoff = lds_byte(wr * 64 + fr, fq * 8), boff = lds_byte(wc * 32 + fr, fq * 8);
#define PG_SA(b, h) (((b) * 2 + (h)) * HTB)
#define PG_SB(b, h) ((4 + (b) * 2 + (h)) * HTB)
#ifndef STAGE_GLDS
#define STAGE_GLDS 0
#endif
#if STAGE_GLDS
#define PG_STAGE(bufoff, gbase, voff) do { _Pragma("unroll") for (int _i = 0; _i < 2; ++_i) \
        __builtin_amdgcn_global_load_lds((const unsigned*)((const char*)ws + (gbase) + (voff)[_i]), (LAS unsigned*)(lds + (bufoff) + ldsw + _i * 8192), 16, 0, 0); } while (0)
#else
#define PG_STAGE(bufoff, gbase, voff) do { _Pragma("unroll") for (int _i = 0; _i < 2; ++_i) \
        asm volatile("s_mov_b32 m0, %0\n\ts_nop 0\n\tbuffer_load_dwordx4 %1, %2, %3 offen lds" :: "s"(ldsbase + (unsigned)(bufoff) + ldsw + (unsigned)(_i * 8192)), "v"((voff)[_i]), "s"(rsrc), "s"((unsigned)(gbase)) : "m0", "memory"); } while (0)
#endif
#define PG_LD8(base) __builtin_shufflevector(*(const LAS i32x4*)(lds + (base)), *(const LAS i32x4*)(lds + (base) + 1024), 0, 1, 2, 3, 4, 5, 6, 7)
#define PG_LDA(dst, b, h) do { _Pragma("unroll") for (int m = 0; m < 4; ++m) { if constexpr (F8) dst##8[m] = PG_LD8(PG_SA(b, h) + aoff + m * 2048); \
        else { _Pragma("unroll") for (int k = 0; k < 2; ++k) dst[m][k] = *(const LAS bf16x8*)(lds + PG_SA(b, h) + aoff + m * 2048 + k * 1024); } } } while (0)
#define PG_LDB(dst, b, h) do { _Pragma("unroll") for (int n = 0; n < 2; ++n) { if constexpr (F8) dst##8[n] = PG_LD8(PG_SB(b, h) + boff + n * 2048); \
        else { _Pragma("unroll") for (int k = 0; k < 2; ++k) dst[n][k] = *(const LAS bf16x8*)(lds + PG_SB(b, h) + boff + n * 2048 + k * 1024); } } } while (0)
#define PG_MMA(ai, bj, At, Bt) do { __builtin_amdgcn_s_setprio(1); _Pragma("unroll") for (int m = 0; m < 4; ++m) _Pragma("unroll") for (int n = 0; n < 2; ++n) { \
        if constexpr (F8) mma8(Bt##8[n], At##8[m], acc[ai][bj][m][n]); \
        else { _Pragma("unroll") for (int k = 0; k < 2; ++k) acc[ai][bj][m][n] = __builtin_amdgcn_mfma_f32_16x16x32_bf16(Bt[n][k], At[m][k], acc[ai][bj][m][n], 0, 0, 0); } } \
        __builtin_amdgcn_s_setprio(0); } while (0)
#define PG_WAIT_V(n) asm volatile("s_waitcnt vmcnt(" #n ")" ::: "memory")
#define PG_WAIT_L(n) asm volatile("s_waitcnt lgkmcnt(" #n ")" ::: "memory")
#define PG_BAR __builtin_amdgcn_s_barrier()
#define PG_SCHED __builtin_amdgcn_sched_barrier(0)
    Unit cur, nxt; int ui = 0;
    if (!S.next(0, cur)) return;
    f32x4 acc[2][2][4][2];
    if constexpr (Epi::INIT) E.init(acc, cur, wr, wc, fr, fq);
    else {
#pragma unroll
    for (int a = 0; a < 2; ++a)
#pragma unroll
        for (int b = 0; b < 2; ++b)
#pragma unroll
            for (int m = 0; m < 4; ++m)
#pragma unroll
                for (int n = 0; n < 2; ++n) acc[a][b][m][n] = (f32x4){0.f, 0.f, 0.f, 0.f}; }
    bf16x8 At[4][2], B0[2][2], B1[2][2]; i32x8 At8[4], B08[2], B18[2];
    unsigned cA = cur.ao, cB = cur.bo;
    if constexpr (GATHER) { PG_GATH(vgc, cur.ord); }
#define PG_STAGE_A(b, h, base, vg) do { if constexpr (GATHER) PG_STAGE(PG_SA(b, h), (base), (vg)[h]); else PG_STAGE(PG_SA(b, h), (base) + (h) * hstepA, voffA); } while (0)
    asm volatile("s_nop 4" ::: "memory");
    PG_STAGE(PG_SB(0, 0), cB, voffB); PG_STAGE(PG_SB(0, 1), cB + hstepB, voffB); PG_STAGE_A(0, 0, cA, vgc); PG_STAGE_A(0, 1, cA, vgc);
    if (wr == 1) PG_BAR;
    PG_WAIT_V(2); PG_BAR;
    PG_STAGE(PG_SB(1, 0), cB + kstep, voffB); PG_STAGE_A(1, 0, cA + kstep, vgc); PG_STAGE(PG_SB(1, 1), cB + hstepB + kstep, voffB);
    PG_WAIT_V(6); PG_BAR;
    for (;;) {
        const bool has_next = S.next(ui + 1, nxt);
        const unsigned nA = has_next ? nxt.ao : cA, nB = has_next ? nxt.bo : cB;
        if constexpr (GATHER) { if (has_next) { PG_GATH(vgn, nxt.ord); } else {
#pragma unroll
            for (int _h = 0; _h < 2; ++_h)
#pragma unroll
                for (int _i = 0; _i < 2; ++_i) vgn[_h][_i] = vgc[_h][_i]; } }
#pragma unroll 1
        for (int t = 0; t < nt; t += 2) {
            const bool last = (t == nt - 2);
            const unsigned a1 = cA + (unsigned)(t + 1) * kstep;
            const unsigned a2 = last ? nA : cA + (unsigned)(t + 2) * kstep, b2 = last ? nB : cB + (unsigned)(t + 2) * kstep;
            const unsigned a3 = a2 + kstep, b3 = b2 + kstep;
            unsigned vg2[2][2];
            if constexpr (GATHER) {
#pragma unroll
                for (int _h = 0; _h < 2; ++_h)
#pragma unroll
                    for (int _i = 0; _i < 2; ++_i) vg2[_h][_i] = last ? vgn[_h][_i] : vgc[_h][_i]; }
            PG_LDB(B0, 0, 0); PG_LDB(B1, 0, 1); PG_SCHED; PG_LDA(At, 0, 0); PG_STAGE_A(1, 1, a1, vgc);
            PG_WAIT_V(8); PG_WAIT_L(0); PG_BAR; if (!(HALFABLE && cur.half == 3 && wr == 1)) { PG_MMA(0, 0, At, B0); PG_MMA(0, 1, At, B1); } PG_BAR; PG_SCHED;
            PG_LDA(At, 0, 1); PG_STAGE(PG_SB(0, 0), b2, voffB); PG_STAGE(PG_SB(0, 1), b2 + hstepB, voffB); PG_STAGE_A(0, 0, a2, vg2);
            PG_WAIT_V(8); PG_WAIT_L(0); PG_BAR; if (!(HALFABLE && cur.half)) { PG_MMA(1, 0, At, B0); PG_MMA(1, 1, At, B1); } PG_BAR; PG_SCHED;
            PG_LDB(B0, 1, 0); PG_LDB(B1, 1, 1); PG_SCHED; PG_LDA(At, 1, 0); PG_STAGE_A(0, 1, a2, vg2);
            PG_WAIT_V(8); PG_WAIT_L(0); PG_BAR; if (!(HALFABLE && cur.half == 3 && wr == 1)) { PG_MMA(0, 0, At, B0); PG_MMA(0, 1, At, B1); } PG_BAR; PG_SCHED;
            PG_LDA(At, 1, 1); PG_STAGE(PG_SB(1, 0), b3, voffB); PG_STAGE(PG_SB(1, 1), b3 + hstepB, voffB); PG_STAGE_A(1, 0, a3, vg2);
            PG_WAIT_V(8); PG_WAIT_L(0); PG_BAR; if (!(HALFABLE && cur.half)) { PG_MMA(1, 0, At, B0); PG_MMA(1, 1, At, B1); } PG_BAR; PG_SCHED;
        }
        if constexpr (ALIGN_EPI) { if (wr == 0) PG_BAR; }
        if constexpr (F8) mma8_drain();
        if constexpr (!Epi::AFTER_DRAIN) { int t2 = threadIdx.x; asm volatile("" : "+v"(t2));
          const int l2 = t2 & 63; E(acc, cur, wr, wc, l2 & 15, l2 >> 4);
#ifdef PROBE_EPI2
          if constexpr (F8) {
#pragma unroll 1
            for (int rep = 0; rep < PROBE_EPI2; ++rep) {
#pragma unroll
              for (int a = 0; a < 2; ++a)
#pragma unroll
                for (int b = 0; b < 2; ++b)
#pragma unroll
                  for (int m = 0; m < 4; ++m)
#pragma unroll
                    for (int n = 0; n < 2; ++n) asm volatile("" : "+v"(acc[a][b][m][n]));
              E(acc, cur, wr, wc, l2 & 15, l2 >> 4); } }
#endif
          }
        if (!has_next) break;
        if constexpr (Epi::INIT) { int t3 = threadIdx.x; asm volatile("" : "+v"(t3)); const int l3 = t3 & 63; E.init(acc, nxt, wr, wc, l3 & 15, l3 >> 4); }
        else {
#pragma unroll
        for (int a = 0; a < 2; ++a)
#pragma unroll
            for (int b = 0; b < 2; ++b)
#pragma unroll
                for (int m = 0; m < 4; ++m)
#pragma unroll
                    for (int n = 0; n < 2; ++n) acc[a][b][m][n] = (f32x4){0.f, 0.f, 0.f, 0.f}; }
        cur = nxt; cA = nA; cB = nB; ++ui;
        if constexpr (GATHER) {
#pragma unroll
            for (int _h = 0; _h < 2; ++_h)
#pragma unroll
                for (int _i = 0; _i < 2; ++_i) vgc[_h][_i] = vgn[_h][_i]; }
        if constexpr (ALIGN_EPI) { if (wr == 1) PG_BAR; }
    }
    PG_WAIT_V(0);
    if constexpr (!ALIGN_EPI) { if (wr == 0) PG_BAR; }
    PG_BAR;
    if constexpr (Epi::AFTER_DRAIN) { int t2 = threadIdx.x; asm volatile("" : "+v"(t2)); const int l2 = t2 & 63; E.fused(acc, cur, wr, wc, l2 & 15, l2 >> 4, lds); }
#undef PG_SA
#undef PG_SB
#undef PG_STAGE
#undef PG_STAGE_A
#undef PG_GATH
#undef PG_LDA
#undef PG_LDB
#undef PG_MMA
#undef PG_WAIT_V
#undef PG_WAIT_L
#undef PG_BAR
#undef PG_SCHED
}
}

#define XB_TMO      128
#define XB_XCNT(j)  (256  + 64 * (j))
#define XB_XSUB(j)  (1280 + 64 * (j))
#define XB_XGEN(j)  (2304 + 64 * (j))
#define XB_TOP      3328
#define XB_TOPGEN   3392
#define XCD_BAR_WORDS 3456
#define XB_SPIN_CAP (1u << 18)
__device__ __forceinline__ unsigned xb_ld(unsigned* p)              { return __hip_atomic_load(p, __ATOMIC_RELAXED, __HIP_MEMORY_SCOPE_AGENT); }
__device__ __forceinline__ unsigned xb_add(unsigned* p, unsigned v) { return __hip_atomic_fetch_add(p, v, __ATOMIC_RELAXED, __HIP_MEMORY_SCOPE_AGENT); }
__device__ __forceinline__ unsigned xb_xcc_id() { return (unsigned)__builtin_amdgcn_s_getreg((3 << 11) | 20) & 0xFu; }
#define XB_SPIN(cond, bar) do { unsigned _sp = 0; while (cond) { __builtin_amdgcn_s_sleep(1); \
    if ((++_sp & 255u) == 0u) { if (xb_ld(&(bar)[XB_TMO])) break; if (_sp > XB_SPIN_CAP) { atomicAdd(&(bar)[XB_TMO], 1u); break; } } } } while (0)
struct XcdBarrier { unsigned* bar; unsigned x; volatile LAS unsigned* st; };
__device__ __forceinline__ XcdBarrier xcd_barrier_post(unsigned* bar, volatile LAS unsigned* st) {
    XcdBarrier b; b.bar = bar; b.x = xb_xcc_id(); b.st = st;
    if (threadIdx.x == 0) (void)xb_add(&bar[XB_XCNT(b.x)], 1u);
    return b;
}
__device__ __forceinline__ void xcd_barrier_complete(unsigned* bar, unsigned x, unsigned& nloc, unsigned& nx) {
    const unsigned G = NBLOCKS;
    unsigned sum, cnt, mine, sp = 0u;
    for (;;) {
        sum = 0u; cnt = 0u; mine = 0u;
#pragma unroll
        for (unsigned j = 0; j < 16; ++j) { const unsigned c = xb_ld(&bar[XB_XCNT(j)]); sum += c; cnt += (c > 0u) ? 1u : 0u; mine = (j == x) ? c : mine; }
        if (sum == G) break;
        __builtin_amdgcn_s_sleep(1);
        if ((++sp & 255u) == 0u) { if (xb_ld(&bar[XB_TMO])) break; if (sp > XB_SPIN_CAP) { atomicAdd(&bar[XB_TMO], 1u); break; } }
    }
    nloc = mine > 0u ? mine : 1u; nx = cnt > 0u ? cnt : 1u;
}
__device__ __forceinline__ void xcd_barrier(unsigned* bar_, volatile LAS unsigned* st_) {
    asm volatile("s_waitcnt vmcnt(0)" ::: "memory");
    __syncthreads();
    if (threadIdx.x == 0) {
        XcdBarrier b; b.bar = bar_; b.x = xb_xcc_id(); b.st = st_;
        unsigned* bar = b.bar;
        __builtin_amdgcn_s_waitcnt(0);
        unsigned nloc = b.st[0], nx = b.st[1];
        if (nloc == 0u) { xcd_barrier_complete(bar, b.x, nloc, nx); b.st[0] = nloc; b.st[1] = nx; }
        const unsigned old = xb_add(&bar[XB_XSUB(b.x)], 1u);
        const unsigned gen = old / nloc;
        if (old + 1u == (gen + 1u) * nloc) {
            __builtin_amdgcn_fence(__ATOMIC_RELEASE, "agent");
            asm volatile("s_waitcnt vmcnt(0)" ::: "memory");
            const unsigned og = xb_add(&bar[XB_TOP], 1u);
            if (og + 1u != (gen + 1u) * nx) XB_SPIN(xb_ld(&bar[XB_TOP]) < (gen + 1u) * nx, bar);
            __builtin_amdgcn_fence(__ATOMIC_ACQUIRE, "agent");
            asm volatile("s_waitcnt vmcnt(0)" ::: "memory");
        } else {
            XB_SPIN(xb_ld(&bar[XB_TOP]) < (gen + 1u) * nx, bar);
            __builtin_amdgcn_fence(__ATOMIC_ACQUIRE, "agent");
            asm volatile("s_waitcnt vmcnt(0)" ::: "memory");
        }
    }
    __syncthreads();
}

constexpr int NPHASE = 13;
constexpr int TILE_OFF = 131072, BIAS_OFF = TILE_OFF + 1280;
constexpr int LTOK_OFF = BIAS_OFF + 9216;
constexpr int LDS_BYTES = 155648, PT_OFF = LDS_BYTES - 512, MISC_OFF = LDS_BYTES - 128;
__device__ __forceinline__ const float* pt_load(const LAS unsigned* pt, int i) {
    const unsigned lo = __builtin_amdgcn_readfirstlane(pt[2 * i]), hi = __builtin_amdgcn_readfirstlane(pt[2 * i + 1]);
    return (const float*)(const GAS float*)(((unsigned long long)hi << 32) | lo);
}
__device__ __forceinline__ unsigned char* opaque_ws(P& p) { unsigned long long w = (unsigned long long)p.ws; asm volatile("" : "+s"(w) :: "memory"); p.ws = (unsigned char*)(GAS unsigned char*)w; return p.ws; }
__device__ __forceinline__ P make_p(const LAS unsigned* pt, float* out, unsigned char* ws) {
    P p;
    p.x = pt_load(pt, 0); p.mem = pt_load(pt, 1); p.g_mix = pt_load(pt, 2); p.w_in = pt_load(pt, 3); p.w_pool = pt_load(pt, 4); p.pool_scale = pt_load(pt, 5); p.w_gate_up = pt_load(pt, 6); p.b_gate_up = pt_load(pt, 7);
    p.gla_g = pt_load(pt, 8); p.w_out = pt_load(pt, 9); p.g_xattn = pt_load(pt, 10); p.g_mem = pt_load(pt, 11); p.w_xq = pt_load(pt, 12); p.w_xk = pt_load(pt, 13); p.w_xv = pt_load(pt, 14); p.w_xo = pt_load(pt, 15);
    p.g_moe = pt_load(pt, 16); p.w_router = pt_load(pt, 17); p.b_router = pt_load(pt, 18); p.w_gu = pt_load(pt, 19); p.b_gu = pt_load(pt, 20); p.w_dn = pt_load(pt, 21); p.b_dn = pt_load(pt, 22); p.g_final = pt_load(pt, 23);
    p.out = (float*)(GAS float*)(unsigned long long)out; p.ws = ws; return p;
}
struct Args { const float* in[24]; float* out; unsigned char* ws; int ph_lo, ph_hi; };

__global__ void __launch_bounds__(NTHREADS, 2) mk_fwd(Args a) {
    extern __shared__ __attribute__((aligned(16))) unsigned char lds[];
    float* ldsf = (float*)lds;
    { volatile LAS unsigned long long* PT = (volatile LAS unsigned long long*)((LAS unsigned char*)lds + PT_OFF);
      if (threadIdx.x == 0) {
#define PTS(i) PT[i] = (unsigned long long)a.in[i];
          PTS(0) PTS(1) PTS(2) PTS(3) PTS(4) PTS(5) PTS(6) PTS(7) PTS(8) PTS(9) PTS(10) PTS(11) PTS(12) PTS(13) PTS(14) PTS(15) PTS(16) PTS(17) PTS(18) PTS(19) PTS(20) PTS(21) PTS(22) PTS(23)
#undef PTS
      } }
    const int bid = blockIdx.x; constexpr int nb = NBLOCKS;
#if defined(PROBE_SLEEP_US)
    { const unsigned long long t0 = __builtin_amdgcn_s_memrealtime(); while (__builtin_amdgcn_s_memrealtime() - t0 < (unsigned long long)(PROBE_SLEEP_US) * 100ull) __builtin_amdgcn_s_sleep(64); }
#endif
#if defined(MK_PER_PHASE)
    const int lo = a.ph_lo, hi = a.ph_hi;
#else
    constexpr int lo = 0, hi = NPHASE;
#endif
#ifndef PH
#define PH -1
#endif
#ifndef REPMASK
#define REPMASK 0
#endif
#define REP(k) ((((REPMASK) >> (k)) & 1) ? 2 : 1)
#define IN(k) ((PH < 0 || PH == (k)) && lo <= (k) && (k) < hi)
    LAS unsigned char* ldsl = (LAS unsigned char*)lds;
    volatile LAS unsigned* MISC = (volatile LAS unsigned*)(ldsl + MISC_OFF);
    if (threadIdx.x < 32) MISC[threadIdx.x] = 0u;
    __syncthreads();
    const bool fused = (hi - lo) > 1;
    if (fused) (void)xcd_barrier_post((unsigned*)(a.ws + WS_CTL) + CW_BAR, MISC + 8);
#define GRID_BAR() xcd_barrier((unsigned*)(a.ws + WS_CTL) + CW_BAR, (volatile LAS unsigned*)(ldsl + MISC_OFF) + 8)
#define SEAM(k) do { if (fused && IN(k) && IN((k) + 1)) GRID_BAR(); } while (0)
#define PHASE(k) if (IN(k)) for (int rep_ = 0; rep_ < REP(k); ++rep_) if (bool once_ = true) for (P p = (rep_ ? (GRID_BAR(), make_p((const LAS unsigned*)(ldsl + PT_OFF), a.out, a.ws)) : make_p((const LAS unsigned*)(ldsl + PT_OFF), a.out, a.ws)); once_; once_ = false) \
        for (unsigned char* ws = opaque_ws(p); once_; once_ = false)
    PHASE(0) { phase_prologue(p, ldsf, bid, nb); }
    SEAM(0);
    PHASE(1) { pg::Sched2D S{(unsigned)WS_XN, (unsigned)WS_WT_IN, D * 2, D * 2, M / 256, NZ / 256, nb, bid}; pg::EpiBf3 E{ws, WS_Z1, WS_Z1, WS_Z1, NZ, NZ, NZ};
        pg::gemm_phase<pg::EpiBf3, pg::Sched2D, true>(ldsl, ws, pg::Gemm{D, D, D}, S, E); }
    SEAM(1);
#ifndef PROBE_P2
#define PROBE_P2 0
#endif
    PHASE(2) { phase_pool2(p, lds, bid, nb); if (PROBE_P2 & 1) { __syncthreads(); phase_pool2(p, lds, bid, nb); } phase_gla_a3(p, lds, bid, nb); if (PROBE_P2 & 2) { __syncthreads(); phase_gla_a3(p, lds, bid, nb); } }
    SEAM(2);
    PHASE(3) { const int t3 = otid(), wv = __builtin_amdgcn_readfirstlane(t3 >> 6); if (wv < 4) phase_scan2(p, bid, nb); else kv_tile(p, bid, wv - 4, t3 & 63); }
    SEAM(3);
    PHASE(4) { phase_gla_b3(p, lds, bid, nb); }
    SEAM(4);
    PHASE(5) { pg::Sched2D S{(unsigned)WS_MIX, (unsigned)WS_WT_OUT, D * 2, D * 2, M / 256, D / 256, nb, bid}; pg::EpiOutF E{p.x, p.x1(), p.rsqp()};
        pg::gemm_phase<pg::EpiOutF, pg::Sched2D, false>(ldsl, ws, pg::Gemm{D, D, D}, S, E); }
    SEAM(5);
    PHASE(6) { pg::Sched2D S{(unsigned)WS_X1, (unsigned)WS_WT_XQ, D * 2, D * 2, M / 256, D / 256, nb, bid};
        pg::EpiQAttn E{p.rsqp(), p.kx(), p.vxt(), p.ox()};
        pg::gemm_phase<pg::EpiQAttn, pg::Sched2D, false>(ldsl, ws, pg::Gemm{D, D, D}, S, E); }
    SEAM(6);
    PHASE(7) { pg::Sched2D S{(unsigned)WS_OX, (unsigned)WS_WT_XO, D * 2, D * 2, M / 256, D / 256, nb, bid}; pg::EpiResF E{p.x1(), p.x2()};
        pg::gemm_phase<pg::EpiResF, pg::Sched2D, false>(ldsl, ws, pg::Gemm{D, D, D}, S, E); }
    SEAM(7);
    PHASE(8) { phase_router3(p, ldsf, (int*)(ws + WS_BLKCNT), (int*)(ws + WS_WAVEBASE), bid, nb); }
    SEAM(8);
    PHASE(9) { phase_dispatch3(p, (int*)lds, (const int*)(ws + WS_BLKCNT), (const int*)(ws + WS_WAVEBASE), bid, nb); }
    SEAM(9);
    PHASE(10) { LAS int* tl = (LAS int*)(ldsl + TILE_OFF); { const int t = otid(); if (t < MAXMT + 2) tl[t] = p.tilee()[t]; } __syncthreads();
        const int nmt = __builtin_amdgcn_readfirstlane(tl[MAXMT]), nfull = __builtin_amdgcn_readfirstlane(tl[MAXMT + 1]);
        pg::SchedMoE S{(unsigned)WS_X8, (unsigned)WS_WT_GU, tl, 2 * DFF * D, D, D, nmt, nfull, 8, nb, bid, true};
        LAS float* lb = (LAS float*)(ldsl + BIAS_OFF);
        LAS int* lt = (LAS int*)(ldsl + LTOK_OFF);
        { const int t10 = otid() & 255, hsel = otid() >> 8; float bvv[5]; int tvv[5];
#pragma unroll
          for (int j = 0; j < 5; ++j) { pg::Unit uu; const int i = 2 * j + hsel; bvv[j] = 0.f; tvv[j] = 0;
              if (S.next(i, uu)) { const float b = p.b_gu[(size_t)uu.e * 2 * DFF + (t10 >> 7) * DFF + uu.pn * 128 + (t10 & 127)]; bvv[j] = (t10 >> 7) ? (b + 1.0f) * W8_SCALE : b * W8_GATE;
                  tvv[j] = ((const int*)(ws + WS_TOKSLOT))[uu.pm * 256 + t10]; } }
#pragma unroll
          for (int j = 0; j < 5; ++j) { const int i = 2 * j + hsel; if (i < 9) { lb[i * 256 + t10] = bvv[j]; lt[i * 256 + t10] = tvv[j]; } } }
        __syncthreads();
        pg::EpiUp8 E{(unsigned char*)p.h(), lb};
        pg::gemm_phase<pg::EpiUp8, pg::SchedMoE, true, true, true, true>(ldsl, ws, pg::Gemm{D / 2, D / 2, D / 2, lt}, S, E); }
    SEAM(10);
    PHASE(11) { LAS int* tl = (LAS int*)(ldsl + TILE_OFF); { const int t = otid(); if (t < MAXMT + 2) tl[t] = p.tilee()[t]; } __syncthreads();
        const int nmt = __builtin_amdgcn_readfirstlane(tl[MAXMT]), nfull = __builtin_amdgcn_readfirstlane(tl[MAXMT + 1]);
        pg::SchedMoE S{(unsigned)WS_H, (unsigned)WS_WT_DN, tl, D * DFF, DFF, DFF, nmt, nfull, 4, nb, bid};
        LAS float* lb = (LAS float*)(ldsl + BIAS_OFF);
        { const int t11 = otid(); float bvv[5];
#pragma unroll
          for (int i = 0; i < 5; ++i) { pg::Unit uu; bvv[i] = 0.f; if (S.next(i, uu)) bvv[i] = t11 < 256 ? p.b_dn[(size_t)uu.e * D + uu.pn * 256 + t11] * W8_SCALE : p.gslot()[uu.pm * 256 + (t11 - 256)]; }
#pragma unroll
          for (int i = 0; i < 5; ++i) lb[i * 512 + t11] = bvv[i]; }
        __syncthreads();
        pg::EpiDn8 E{(unsigned char*)p.y(), lb};
        pg::gemm_phase<pg::EpiDn8, pg::SchedMoE, true, true, false, true>(ldsl, ws, pg::Gemm{DFF / 2, DFF / 2, DFF / 2}, S, E); }
    SEAM(11);
    PHASE(12) { phase_final(p, bid, nb); }
#undef PHASE
#undef IN
#undef SEAM
}

extern "C" void kernel_launch(void* const* d_in, const int* in_sizes, int n_in, void* d_out, int out_size, void* d_ws, size_t ws_size, hipStream_t stream) {
    static int grid = 0;
    if (grid == 0) {
        if (n_in != 24 || in_sizes[0] != M * D || out_size != M * D || ws_size < WS_END) { fprintf(stderr, "kernel_launch: unexpected shapes (n_in %d, in0 %d, out %d, ws %zu)\n", n_in, n_in > 0 ? in_sizes[0] : -1, out_size, ws_size); grid = -1; return; }
        int dev = 0, cus = 0;
        if (hipGetDevice(&dev) != hipSuccess || hipDeviceGetAttribute(&cus, hipDeviceAttributeMultiprocessorCount, dev) != hipSuccess) { grid = -1; return; }
        if (hipFuncSetAttribute((const void*)mk_fwd, hipFuncAttributeMaxDynamicSharedMemorySize, LDS_BYTES) != hipSuccess) { fprintf(stderr, "kernel_launch: hipFuncSetAttribute failed\n"); grid = -1; return; }
        if (cus != NBLOCKS) fprintf(stderr, "kernel_launch: device reports %d CUs; this kernel launches %d workgroups (one per CU of a 256-CU device)\n", cus, NBLOCKS);
        grid = NBLOCKS;
    }
    if (grid < 0) return;
    (void)hipMemsetAsync((char*)d_ws + WS_CTL + CW_BAR * 4, 0, 16384, stream);
    Args a{};
    for (int i = 0; i < 24; ++i) a.in[i] = (const float*)d_in[i];
    a.out = (float*)d_out; a.ws = (unsigned char*)d_ws;
#if defined(MK_PER_PHASE)
    for (int ph = 0; ph < NPHASE; ++ph) { a.ph_lo = ph; a.ph_hi = ph + 1; hipLaunchKernelGGL(mk_fwd, dim3(grid), dim3(NTHREADS), LDS_BYTES, stream, a); }
#else
    a.ph_lo = 0; a.ph_hi = NPHASE; hipLaunchKernelGGL(mk_fwd, dim3(grid), dim3(NTHREADS), LDS_BYTES, stream, a);
#endif
}
```
